# Optimizing an MI355X kernel written in HIP

```python
import math
import jax, jax.numpy as jnp
from jax import lax
import numpy as np


D_MODEL = 1024
BATCH = 16
SEQ = 2048
DEPTH = 1

CHUNK = 64
H_A = 8
D_A = 64
H_I = 4
D_I = 64
TOPK_MAX = 256
SPARSE_Q_BLOCK = 32
H_B = 4
D_B = 64
DENSE_Q_BLOCK = 128
D_FF = ((8 * D_MODEL + 3 * 256 - 1) // (3 * 256)) * 256
RMS_EPS = 1e-6
MASK_VALUE = -1e30

W_QA = H_A * D_A
W_KA = H_A * D_A
W_VA = H_A * D_A
W_QB = H_B * 2 * D_B
W_KB = H_B * 2 * D_B
W_VB = H_B * 2 * D_B
W_QI = H_I * D_I
W_KI = D_I
W_WI = H_I
W_G = 2 * D_MODEL
_WIDTHS = [W_QA, W_KA, W_VA, W_QB, W_KB, W_VB, W_QI, W_KI, W_WI, W_G]
SPLITS = [int(v) for v in np.cumsum(_WIDTHS)[:-1]]
W_IN = int(sum(_WIDTHS))

kernel_name = 'hybrid_dsa_diffattn_gated_block'


def rms_norm(x, g):
    xf = x.astype(jnp.float32)
    y = xf * lax.rsqrt(jnp.mean(xf * xf, axis=-1, keepdims=True) + RMS_EPS)
    return (y * g.astype(jnp.float32)).astype(x.dtype)


def alibi_slopes(n):
    return jnp.asarray(2.0 ** (-8.0 * np.arange(1, n + 1) / n), dtype=jnp.float32)


def dsa_sparse_attention(q, k, v, q_idx, k_idx, w_idx):
    B, S = q.shape[0], q.shape[1]
    n_sel = min(TOPK_MAX, S // 4)
    nblk = S // SPARSE_Q_BLOCK
    slopes = alibi_slopes(H_A)
    key_chunk = jnp.arange(S) // CHUNK
    kif = k_idx.astype(jnp.float32)

    def to_blocks(a):
        return a.reshape((B, nblk, SPARSE_Q_BLOCK) + a.shape[2:]).swapaxes(0, 1)

    def block(args):
        i, qb, qib, wb = args
        t = i * SPARSE_Q_BLOCK + jnp.arange(SPARSE_Q_BLOCK)
        t_chunk = t // CHUNK
        admissible = key_chunk[None, :] <= t_chunk[:, None]
        logits = jnp.einsum('bqhd,bsd->bqhs', qib.astype(jnp.float32), kif)
        idx_score = jnp.einsum('bqh,bqhs->bqs', wb.astype(jnp.float32), jax.nn.relu(logits))
        idx_score = jnp.where(admissible[None], idx_score, -jnp.inf)
        _, sel = lax.top_k(idx_score, n_sel)
        valid = (sel // CHUNK) <= t_chunk[None, :, None]
        k_sel = jax.vmap(lambda kk, ii: kk[ii])(k, sel)
        v_sel = jax.vmap(lambda vv, ii: vv[ii])(v, sel)
        s = jnp.einsum('bqhd,bqkhd->bhqk', qb.astype(jnp.float32),
                       k_sel.astype(jnp.float32)) * (D_A ** -0.5)
        dist = jnp.abs(t[None, :, None] - sel).astype(jnp.float32)
        s = s - slopes[None, :, None, None] * dist[:, None]
        s = jnp.where(valid[:, None], s, MASK_VALUE)
        p = jax.nn.softmax(s, axis=-1)
        o = jnp.einsum('bhqk,bqkhd->bqhd', p, v_sel.astype(jnp.float32))
        return o.astype(q.dtype)

    out = lax.map(block, (jnp.arange(nblk), to_blocks(q), to_blocks(q_idx), to_blocks(w_idx)))
    return out.swapaxes(0, 1).reshape(B, S, H_A * D_A)


def differential_attention(q, k, v, lam, subln_g, lambda_init):
    B, S = q.shape[0], q.shape[1]
    nblk = S // DENSE_Q_BLOCK
    slopes = alibi_slopes(H_B)
    key_pos = jnp.arange(S)
    key_chunk = key_pos // CHUNK
    kf = k.astype(jnp.float32)
    vf = v.astype(jnp.float32)

    def block(args):
        i, qb = args
        t = i * DENSE_Q_BLOCK + jnp.arange(DENSE_Q_BLOCK)
        s = jnp.einsum('bqhmd,bshmd->bhmqs', qb.astype(jnp.float32), kf) * (D_B ** -0.5)
        dist = jnp.abs(t[:, None] - key_pos[None, :]).astype(jnp.float32)
        bias = -slopes[:, None, None, None] * dist[None, None]
        allowed = key_chunk[None, :] <= (t // CHUNK)[:, None]
        s = jnp.where(allowed, s + bias, MASK_VALUE)
        p = jax.nn.softmax(s, axis=-1)
        a = p[:, :, 0] - lam * p[:, :, 1]
        o = jnp.einsum('bhqs,bshe->bqhe', a, vf)
        o = rms_norm(o, subln_g) * (1.0 - lambda_init)
        return o.astype(q.dtype)

    qblk = q.reshape((B, nblk, DENSE_Q_BLOCK) + q.shape[2:]).swapaxes(0, 1)
    out = lax.map(block, (jnp.arange(nblk), qblk))
    return out.swapaxes(0, 1).reshape(B, S, H_B * 2 * D_B)


def setup_inputs(seed: int = 0) -> dict:
    key = jax.random.key(seed)
    ks = jax.random.split(key, 24)
    f32 = jnp.float32

    def w(k, shape, fan_in, gain=1.0):
        return jax.random.normal(k, shape, f32) * (gain * fan_in ** -0.5)

    def g(k, n):
        return 1.0 + 0.02 * jax.random.normal(k, (DEPTH, n), f32)

    return {
        'x': jax.random.normal(ks[0], (BATCH, SEQ, D_MODEL), f32),
        'c': jax.random.normal(ks[1], (BATCH, D_MODEL), f32),
        'w_ada': w(ks[2], (DEPTH, D_MODEL, 6 * D_MODEL), D_MODEL, 0.5),
        'b_ada': 0.02 * jax.random.normal(ks[3], (DEPTH, 6 * D_MODEL), f32),
        'norm1_g': g(ks[4], D_MODEL),
        'w_in': w(ks[5], (DEPTH, D_MODEL, W_IN), D_MODEL),
        'qn_a': g(ks[6], D_A),
        'kn_a': g(ks[7], D_A),
        'qn_b': g(ks[8], D_B),
        'kn_b': g(ks[9], D_B),
        'lam_q1': 0.1 * jax.random.normal(ks[10], (DEPTH, D_B), f32),
        'lam_k1': 0.1 * jax.random.normal(ks[11], (DEPTH, D_B), f32),
        'lam_q2': 0.1 * jax.random.normal(ks[12], (DEPTH, D_B), f32),
        'lam_k2': 0.1 * jax.random.normal(ks[13], (DEPTH, D_B), f32),
        'subln_g': g(ks[14], 2 * D_B),
        'w_up_a': w(ks[15], (DEPTH, H_A * D_A, D_MODEL), H_A * D_A),
        'w_up_b': w(ks[16], (DEPTH, H_B * 2 * D_B, D_MODEL), H_B * 2 * D_B),
        'w_o': w(ks[17], (DEPTH, D_MODEL, D_MODEL), D_MODEL),
        'norm2_g': g(ks[18], D_MODEL),
        'w_ff1': w(ks[19], (DEPTH, D_MODEL, D_FF), D_MODEL),
        'w_ff3': w(ks[20], (DEPTH, D_MODEL, D_FF), D_MODEL),
        'w_ff2': w(ks[21], (DEPTH, D_FF, D_MODEL), D_FF),
    }


def reference(x, c, w_ada, b_ada, norm1_g, w_in, qn_a, kn_a, qn_b, kn_b,
              lam_q1, lam_k1, lam_q2, lam_k2, subln_g, w_up_a, w_up_b, w_o,
              norm2_g, w_ff1, w_ff3, w_ff2):
    B, S = x.shape[0], x.shape[1]
    cs = jax.nn.silu(c)
    for l in range(DEPTH):
        lambda_init = 0.8 - 0.6 * math.exp(-0.3 * l)
        mod = cs @ w_ada[l] + b_ada[l]
        shift1, scale1, gate1, shift2, scale2, gate2 = jnp.split(mod, 6, axis=-1)

        h = rms_norm(x, norm1_g[l]) * (1.0 + scale1[:, None]) + shift1[:, None]
        proj = h @ w_in[l]
        qa, ka, va, qb, kb, vb, qi, ki, wi, gates = jnp.split(proj, SPLITS, axis=-1)

        qa = rms_norm(qa.reshape(B, S, H_A, D_A), qn_a[l])
        ka = rms_norm(ka.reshape(B, S, H_A, D_A), kn_a[l])
        va = va.reshape(B, S, H_A, D_A)
        y_a = dsa_sparse_attention(qa, ka, va, qi.reshape(B, S, H_I, D_I), ki, wi)

        qb = rms_norm(qb.reshape(B, S, H_B, 2, D_B), qn_b[l])
        kb = rms_norm(kb.reshape(B, S, H_B, 2, D_B), kn_b[l])
        vb = vb.reshape(B, S, H_B, 2 * D_B)
        lam = (jnp.exp(jnp.sum(lam_q1[l].astype(jnp.float32) * lam_k1[l].astype(jnp.float32)))
               - jnp.exp(jnp.sum(lam_q2[l].astype(jnp.float32) * lam_k2[l].astype(jnp.float32)))
               + lambda_init)
        y_b = differential_attention(qb, kb, vb, lam, subln_g[l], lambda_init)

        g_a, g_b = jnp.split(jax.nn.sigmoid(gates), 2, axis=-1)
        merged = g_a * (y_a @ w_up_a[l]) + g_b * (y_b @ w_up_b[l])
        x = x + gate1[:, None] * (merged @ w_o[l])

        h2 = rms_norm(x, norm2_g[l]) * (1.0 + scale2[:, None]) + shift2[:, None]
        ff = (jax.nn.silu(h2 @ w_ff1[l]) * (h2 @ w_ff3[l])) @ w_ff2[l]
        x = x + gate2[:, None] * ff
    return x
```

```cpp
#define MK_N_LAUNCHES 10
#include <hip/hip_runtime.h>
#include <cstdio>
#include <cstdint>
namespace pg8 {
#define PG8_LAS __attribute__((address_space(3)))
typedef unsigned short bf16_t;
typedef short bf16x8 __attribute__((ext_vector_type(8)));
typedef float f32x4 __attribute__((ext_vector_type(4)));
typedef unsigned u32x4 __attribute__((ext_vector_type(4)));
constexpr int BM = 256, BK = 64, HALF = 128, HTB = HALF * BK * 2  , STAGE_BYTES = 8 * HTB, NXCD = 8, WGM = 8;

__host__ __device__ __forceinline__ int lds_byte(int r, int c) { const int st = (r >> 4) * 2 + (c >> 5), rr = r & 15, cc = c & 31, ob = rr * 64 + cc * 2; return st * 1024 + (ob ^ (((ob >> 9) & 1) << 5)); }
__host__ __device__ __forceinline__ void stage_rc(int b, int& R, int& C) { const int st = b / 1024, sb = b % 1024, swz = sb ^ (((sb >> 9) & 1) << 5); R = (st >> 1) * 16 + swz / 64; C = (st & 1) * 32 + (swz % 64) / 2; }
__host__ __device__ __forceinline__ int perm32(int rho) { const int n = rho >> 4, i = rho & 15; return 8 * (i >> 2) + 4 * n + (i & 3); }

struct Unit { int pm, pn; };
struct Gemm { const bf16_t* A; const bf16_t* Bt; int M, N, K; };

struct StaticOrder {
    int nM, nN, nwg, G, c;
    __host__ __device__ void init(int M, int N, int G_, int c_) { nM = M / BM; nN = N / BM; nwg = nM * nN; G = G_; c = c_; }
    __host__ __device__ bool next(int i, Unit& u) const {
        const long L = (long)i * G + c; if (L >= nwg) return false;
        int wgid = (int)L; { const int q = nwg / NXCD, r = nwg % NXCD, xcd = wgid % NXCD, off = wgid / NXCD; wgid = (xcd < r ? xcd * (q + 1) : r * (q + 1) + (xcd - r) * q) + off; }
        const int nig = WGM * nN, gid = wgid / nig, fm = gid * WGM, gsz = (nM - fm) < WGM ? (nM - fm) : WGM;
        u.pm = fm + ((wgid % nig) % gsz); u.pn = (wgid % nig) / gsz; return true;
    }
    __device__ __forceinline__ void a_ready(const Unit&) const {}
    __device__ __forceinline__ void done(const Unit&) const {}
};
__device__ __forceinline__ unsigned cvt_pk_bf16(float lo, float hi) { unsigned r; asm volatile("v_cvt_pk_bf16_f32 %0, %1, %2" : "=v"(r) : "v"(lo), "v"(hi)); return r; }
typedef float f32x2 __attribute__((ext_vector_type(2)));
template <class Epi, class Sched, bool ALIGN_EPI = false, bool SP2 = false>
__device__ __forceinline__ void gemm_phase(PG8_LAS unsigned char* lds, const Gemm g, const Sched& S, const Epi& E) {
    const int tid = threadIdx.x, wid = __builtin_amdgcn_readfirstlane(tid >> 6), lane = tid & 63, wr = wid >> 2, wc = wid & 3, fr = lane & 15, fq = lane >> 4;
    const int K = g.K, nt = K / BK;
    unsigned voffA[2], voffB[2];
#pragma unroll
    for (int i = 0; i < 2; ++i) { int R, C; stage_rc(tid * 16 + i * 8192, R, C); const int Rb = Epi::PERM ? ((R & ~31) + perm32(R & 31)) : R;
        voffA[i] = (unsigned)(R * K + C) * 2u; voffB[i] = (unsigned)(Rb * K + C) * 2u; }
    const size_t kstep = (size_t)(BK * 2);
    const size_t hstep = (size_t)HALF * K * 2;
    const size_t tstep = 2 * hstep;
    const unsigned ldsw = (unsigned)wid * 1024u;
    const int aoff = lds_byte(wr * 64 + fr, fq * 8), boff = lds_byte(wc * 32 + fr, fq * 8);
#define PG8_SA(b, h) (((b) * 2 + (h)) * HTB)
#define PG8_SB(b, h) ((4 + (b) * 2 + (h)) * HTB)
#define PG8_STAGE(bufoff, gbase, voff) do { _Pragma("unroll") for (int _i = 0; _i < 2; ++_i) \
        __builtin_amdgcn_global_load_lds((const unsigned*)((const char*)(gbase) + (voff)[_i]), (PG8_LAS unsigned*)(lds + (bufoff) + ldsw + _i * 8192), 16, 0, 0); } while (0)
#define PG8_LDA(dst, b, h) do { _Pragma("unroll") for (int m = 0; m < 4; ++m) _Pragma("unroll") for (int k = 0; k < 2; ++k) dst[m][k] = *(const PG8_LAS bf16x8*)(lds + PG8_SA(b, h) + aoff + m * 2048 + k * 1024); } while (0)
#define PG8_LDB(dst, b, h) do { _Pragma("unroll") for (int n = 0; n < 2; ++n) _Pragma("unroll") for (int k = 0; k < 2; ++k) dst[n][k] = *(const PG8_LAS bf16x8*)(lds + PG8_SB(b, h) + boff + n * 2048 + k * 1024); } while (0)
#define PG8_MMA(ai, bj, At, Bt) do { __builtin_amdgcn_s_setprio(1); _Pragma("unroll") for (int m = 0; m < 4; ++m) _Pragma("unroll") for (int n = 0; n < 2; ++n) _Pragma("unroll") for (int k = 0; k < 2; ++k) \
        acc[ai][bj][m][n] = __builtin_amdgcn_mfma_f32_16x16x32_bf16(Bt[n][k], At[m][k], acc[ai][bj][m][n], 0, 0, 0); __builtin_amdgcn_s_setprio(0); } while (0)
#define PG8_WAIT_V(n) asm volatile("s_waitcnt vmcnt(" #n ")" ::: "memory")
#define PG8_WAIT_L(n) asm volatile("s_waitcnt lgkmcnt(" #n ")" ::: "memory")
#define PG8_BAR __builtin_amdgcn_s_barrier()
#define PG8_SCHED __builtin_amdgcn_sched_barrier(0)
    Unit cur, nxt; int ui = 0;
    if (!S.next(0, cur)) return;
    f32x4 acc[2][2][4][2];
#pragma unroll
    for (int a = 0; a < 2; ++a)
#pragma unroll
        for (int b = 0; b < 2; ++b)
#pragma unroll
            for (int m = 0; m < 4; ++m)
#pragma unroll
                for (int n = 0; n < 2; ++n) acc[a][b][m][n] = (f32x4){0.f, 0.f, 0.f, 0.f};
    bf16x8 At[4][2], B0[2][2], B1[2][2];
    const char* cA = (const char*)g.A + (size_t)cur.pm * tstep; const char* cB = (const char*)g.Bt + (size_t)cur.pn * tstep;
    S.a_ready(cur);
    if constexpr (SP2) {
        PG8_STAGE(PG8_SB(0, 0), cB, voffB); PG8_STAGE(PG8_SB(0, 1), cB + hstep, voffB); PG8_STAGE(PG8_SA(0, 0), cA, voffA); PG8_STAGE(PG8_SA(0, 1), cA + hstep, voffA);
        if (wr == 1) PG8_BAR;
        PG8_WAIT_V(2); PG8_BAR;
        PG8_STAGE(PG8_SB(1, 0), cB + kstep, voffB); PG8_STAGE(PG8_SA(1, 0), cA + kstep, voffA); PG8_STAGE(PG8_SB(1, 1), cB + hstep + kstep, voffB);
        PG8_WAIT_V(6); PG8_BAR;
    } else {
        PG8_STAGE(PG8_SB(0, 0), cB, voffB); PG8_STAGE(PG8_SA(0, 0), cA, voffA); PG8_STAGE(PG8_SB(0, 1), cB + hstep, voffB); PG8_STAGE(PG8_SA(0, 1), cA + hstep, voffA);
        if (wr == 1) PG8_BAR;
        PG8_WAIT_V(4); PG8_BAR;
        PG8_STAGE(PG8_SB(1, 0), cB + kstep, voffB); PG8_STAGE(PG8_SA(1, 0), cA + kstep, voffA); PG8_STAGE(PG8_SB(1, 1), cB + hstep + kstep, voffB);
        PG8_WAIT_V(6); PG8_BAR;
    }
    for (;;) {
        const bool has_next = S.next(ui + 1, nxt);
        const char* nA = has_next ? (const char*)g.A + (size_t)nxt.pm * tstep : cA; const char* nB = has_next ? (const char*)g.Bt + (size_t)nxt.pn * tstep : cB;
        for (int t = 0; t < nt; t += 2) {
            const bool last = (t == nt - 2);
            const char* a1 = cA + (size_t)(t + 1) * kstep;
            const char* a2 = last ? nA : cA + (size_t)(t + 2) * kstep; const char* b2 = last ? nB : cB + (size_t)(t + 2) * kstep;
            const char* a3 = a2 + kstep; const char* b3 = b2 + kstep;
            if (last && has_next) S.a_ready(nxt);
            if constexpr (SP2) {
            PG8_LDB(B0, 0, 0); PG8_LDB(B1, 0, 1); PG8_SCHED; PG8_LDA(At, 0, 0); PG8_STAGE(PG8_SA(1, 1), a1 + hstep, voffA);
            PG8_WAIT_V(8); PG8_WAIT_L(0); PG8_BAR; PG8_MMA(0, 0, At, B0); PG8_MMA(0, 1, At, B1); PG8_BAR; PG8_SCHED;
            PG8_LDA(At, 0, 1); PG8_STAGE(PG8_SB(0, 0), b2, voffB); PG8_STAGE(PG8_SB(0, 1), b2 + hstep, voffB); PG8_STAGE(PG8_SA(0, 0), a2, voffA);
            PG8_WAIT_V(8); PG8_WAIT_L(0); PG8_BAR; PG8_MMA(1, 0, At, B0); PG8_MMA(1, 1, At, B1); PG8_BAR; PG8_SCHED;
            PG8_LDB(B0, 1, 0); PG8_LDB(B1, 1, 1); PG8_SCHED; PG8_LDA(At, 1, 0); PG8_STAGE(PG8_SA(0, 1), a2 + hstep, voffA);
            PG8_WAIT_V(8); PG8_WAIT_L(0); PG8_BAR; PG8_MMA(0, 0, At, B0); PG8_MMA(0, 1, At, B1); PG8_BAR; PG8_SCHED;
            PG8_LDA(At, 1, 1); PG8_STAGE(PG8_SB(1, 0), b3, voffB); PG8_STAGE(PG8_SB(1, 1), b3 + hstep, voffB); PG8_STAGE(PG8_SA(1, 0), a3, voffA);
            PG8_WAIT_V(8); PG8_WAIT_L(0); PG8_BAR; PG8_MMA(1, 0, At, B0); PG8_MMA(1, 1, At, B1); PG8_BAR; PG8_SCHED;
            } else {
            PG8_LDB(B0, 0, 0); PG8_SCHED; PG8_LDA(At, 0, 0); PG8_STAGE(PG8_SA(1, 1), a1 + hstep, voffA);
            PG8_WAIT_L(8); PG8_BAR; PG8_WAIT_L(0); PG8_MMA(0, 0, At, B0); PG8_BAR; PG8_SCHED;
            PG8_LDB(B1, 0, 1); PG8_STAGE(PG8_SB(0, 0), b2, voffB);
            PG8_BAR; PG8_WAIT_L(0); PG8_MMA(0, 1, At, B1); PG8_BAR;
            PG8_LDA(At, 0, 1); PG8_STAGE(PG8_SA(0, 0), a2, voffA);
            PG8_BAR; PG8_WAIT_L(0); PG8_MMA(1, 0, At, B0); PG8_BAR; PG8_SCHED;
            PG8_STAGE(PG8_SB(0, 1), b2 + hstep, voffB);
            PG8_WAIT_V(6); PG8_BAR; PG8_MMA(1, 1, At, B1); PG8_BAR;
            PG8_LDB(B0, 1, 0); PG8_SCHED; PG8_LDA(At, 1, 0); PG8_STAGE(PG8_SA(0, 1), a2 + hstep, voffA);
            PG8_WAIT_L(8); PG8_BAR; PG8_WAIT_L(0); PG8_MMA(0, 0, At, B0); PG8_BAR; PG8_SCHED;
            PG8_LDB(B1, 1, 1); PG8_STAGE(PG8_SB(1, 0), b3, voffB);
            PG8_BAR; PG8_WAIT_L(0); PG8_MMA(0, 1, At, B1); PG8_BAR;
            PG8_LDA(At, 1, 1); PG8_STAGE(PG8_SA(1, 0), a3, voffA);
            PG8_BAR; PG8_WAIT_L(0); PG8_MMA(1, 0, At, B0); PG8_BAR; PG8_SCHED;
            PG8_STAGE(PG8_SB(1, 1), b3 + hstep, voffB);
            PG8_WAIT_V(6); PG8_BAR; PG8_MMA(1, 1, At, B1); PG8_BAR;
            }
        }
        if constexpr (ALIGN_EPI) { if (wr == 0) PG8_BAR; }
        if constexpr (!Epi::AFTER_DRAIN) { E(acc, cur, wr, wc, fr, fq); S.done(cur); }
        if (!has_next) break;
#pragma unroll
        for (int a = 0; a < 2; ++a)
#pragma unroll
            for (int b = 0; b < 2; ++b)
#pragma unroll
                for (int m = 0; m < 4; ++m)
#pragma unroll
                    for (int n = 0; n < 2; ++n) acc[a][b][m][n] = (f32x4){0.f, 0.f, 0.f, 0.f};
        cur = nxt; cA = nA; cB = nB; ++ui;
        if constexpr (ALIGN_EPI) { if (wr == 1) PG8_BAR; }
    }
    PG8_WAIT_V(0);
    if constexpr (!ALIGN_EPI) { if (wr == 0) PG8_BAR; }
    PG8_BAR;
    if constexpr (Epi::AFTER_DRAIN) { E.fused(acc, cur, wr, wc, fr, fq, lds, wid, lane); S.done(cur); }
#undef PG8_SA
#undef PG8_SB
#undef PG8_STAGE
#undef PG8_LDA
#undef PG8_LDB
#undef PG8_MMA
#undef PG8_WAIT_V
#undef PG8_WAIT_L
#undef PG8_BAR
#undef PG8_SCHED
}
}
namespace epi {
constexpr size_t PWS_GN = (1u << 20) + 768 * 1024, PWS_QA = 128u << 20, PWS_QI = 320u << 20, PWS_KI = 336u << 20, PWS_WI = 340u << 20, PWS_GT = 344u << 20;
using pg8::f32x4; using pg8::u32x4; using pg8::bf16_t; using pg8::Unit; using pg8::BM; using pg8::HALF;
__device__ __forceinline__ unsigned pk2(float lo, float hi) { return pg8::cvt_pk_bf16(lo, hi); }
__device__ __forceinline__ float bflo(unsigned u) { return __uint_as_float(u << 16); }
__device__ __forceinline__ float bfhi(unsigned u) { return __uint_as_float(u & 0xffff0000u); }
__device__ __forceinline__ float sigm(float v) { return __builtin_amdgcn_rcpf(1.f + __expf(-v)); }
__device__ __forceinline__ u32x4 pack8(const f32x4& a, const f32x4& b) { u32x4 w; w.x = pk2(a[0], a[1]); w.y = pk2(a[2], a[3]); w.z = pk2(b[0], b[1]); w.w = pk2(b[2], b[3]); return w; }
__device__ __forceinline__ float dot4(const f32x4& a) { return (a[0] * a[0] + a[1] * a[1]) + (a[2] * a[2] + a[3] * a[3]); }

struct EpiProj {
    static constexpr bool PERM = true, AFTER_DRAIN = false;
    unsigned char* ws;
    template <int MODE  >
    __device__ __forceinline__ void emit(const f32x4 (&acc)[2][2][4][2], bf16_t* dst, int pitch, int cb, const float* g, int row0, int wc, int fq) const {
        f32x4 gv[2][2];
#pragma unroll
        for (int bj = 0; bj < 2; ++bj)
#pragma unroll
            for (int n = 0; n < 2; ++n) gv[bj][n] = (MODE == 1) ? *(const f32x4*)(g + 32 * bj + 8 * fq + 4 * n) : (f32x4){1.f, 1.f, 1.f, 1.f};
#pragma unroll
        for (int ai = 0; ai < 2; ++ai)
#pragma unroll
            for (int m = 0; m < 4; ++m) {
                f32x4 v[2][2];
#pragma unroll
                for (int bj = 0; bj < 2; ++bj)
#pragma unroll
                    for (int n = 0; n < 2; ++n) v[bj][n] = acc[ai][bj][m][n];
                if (MODE == 1) {
                    float ss = (dot4(v[0][0]) + dot4(v[0][1])) + (dot4(v[1][0]) + dot4(v[1][1]));
                    ss += __shfl_xor(ss, 16); ss += __shfl_xor(ss, 32);
                    const float rs = __builtin_amdgcn_rsqf(ss * (1.0f / 64.0f) + 1e-6f);
#pragma unroll
                    for (int bj = 0; bj < 2; ++bj)
#pragma unroll
                        for (int n = 0; n < 2; ++n) v[bj][n] = v[bj][n] * rs * gv[bj][n];
                } else if (MODE == 2) {
#pragma unroll
                    for (int bj = 0; bj < 2; ++bj)
#pragma unroll
                        for (int n = 0; n < 2; ++n)
#pragma unroll
                            for (int i = 0; i < 4; ++i) v[bj][n][i] = sigm(v[bj][n][i]);
                }
                bf16_t* rowp = dst + (size_t)(row0 + ai * HALF + m * 16) * pitch + cb + 64 * wc + 8 * fq;
#pragma unroll
                for (int bj = 0; bj < 2; ++bj) *(u32x4*)(rowp + 32 * bj) = pack8(v[bj][0], v[bj][1]);
            }
    }
    __device__ __forceinline__ void operator()(const f32x4 (&acc)[2][2][4][2], const Unit& u, int wr, int wc, int fr, int fq) const {
        const int pn = u.pn, row0 = u.pm * BM + wr * 64 + fr, cb = (pn & 1) * 256;
        bf16_t* const QA = (bf16_t*)(ws + PWS_QA); const float* const gn = (const float*)(ws + PWS_GN);
        bf16_t* const KI = (bf16_t*)(ws + PWS_KI); float* const WI = (float*)(ws + PWS_WI); bf16_t* const GT = (bf16_t*)(ws + PWS_GT);
        if (pn < 12) {
            const int tsr = pn >> 1; bf16_t* dst = QA + (size_t)tsr * (size_t)(32u << 19);
            if (tsr == 2 || tsr == 5) emit<0>(acc, dst, 512, cb, nullptr, row0, wc, fq);
            else emit<1>(acc, dst, 512, cb, gn + 64 * (tsr - (tsr > 2 ? 1 : 0)), row0, wc, fq);
        }
        else if (pn == 12) emit<0>(acc, (bf16_t*)(ws + PWS_QI), 256, 0, nullptr, row0, wc, fq);
        else if (pn == 13) {
            if (wc == 0) emit<0>(acc, KI, 64, 0, nullptr, row0, 0, fq);
            else if (wc == 1) { if (fq == 0) {
#pragma unroll
                for (int ai = 0; ai < 2; ++ai)
#pragma unroll
                    for (int m = 0; m < 4; ++m) *(f32x4*)(WI + (size_t)(row0 + ai * HALF + m * 16) * 4) = acc[ai][0][m][0]; } }
        } else emit<2>(acc, GT, 2048, (pn - 14) * 256, nullptr, row0, wc, fq);
    }
};
template <int PASS> struct EpiUp {
    static constexpr bool PERM = true, AFTER_DRAIN = false;
    bf16_t* MG; const bf16_t* GT;
    __device__ __forceinline__ void operator()(const f32x4 (&acc)[2][2][4][2], const Unit& u, int wr, int wc, int fr, int fq) const {
        const int row0 = u.pm * BM + wr * 64 + fr, col0 = u.pn * BM + wc * 32 + 8 * fq;
#pragma unroll
        for (int ai = 0; ai < 2; ++ai)
#pragma unroll
            for (int m = 0; m < 4; ++m) { const size_t row = (size_t)(row0 + ai * HALF + m * 16);
#pragma unroll
                for (int bj = 0; bj < 2; ++bj) { const int c = col0 + bj * HALF;
                    const u32x4 gw = *(const u32x4*)(GT + row * 2048 + PASS * 1024 + c);
                    f32x4 v0 = acc[ai][bj][m][0], v1 = acc[ai][bj][m][1];
                    v0 = v0 * (f32x4){bflo(gw.x), bfhi(gw.x), bflo(gw.y), bfhi(gw.y)}; v1 = v1 * (f32x4){bflo(gw.z), bfhi(gw.z), bflo(gw.w), bfhi(gw.w)};
                    if (PASS == 1) { const u32x4 pw = *(const u32x4*)(MG + row * 1024 + c);
                        v0 = v0 + (f32x4){bflo(pw.x), bfhi(pw.x), bflo(pw.y), bfhi(pw.y)}; v1 = v1 + (f32x4){bflo(pw.z), bfhi(pw.z), bflo(pw.w), bfhi(pw.w)}; }
                    *(u32x4*)(MG + row * 1024 + c) = pack8(v0, v1); } }
    }
};
struct EpiRes {
    static constexpr bool PERM = false, AFTER_DRAIN = false;
    const float* X; float* O; const float* gate;
    __device__ __forceinline__ void operator()(const f32x4 (&acc)[2][2][4][2], const Unit& u, int wr, int wc, int fr, int fq) const {
        const int row0 = u.pm * BM + wr * 64 + fr, col0 = u.pn * BM + wc * 32 + 4 * fq; const float* gp = gate + (size_t)(u.pm >> 3) * 6144 + col0;
        f32x4 gv[2][2];
#pragma unroll
        for (int bj = 0; bj < 2; ++bj)
#pragma unroll
            for (int n = 0; n < 2; ++n) gv[bj][n] = *(const f32x4*)(gp + bj * HALF + n * 16);
#pragma unroll
        for (int ai = 0; ai < 2; ++ai)
#pragma unroll
            for (int m = 0; m < 4; ++m) { const size_t off = (size_t)(row0 + ai * HALF + m * 16) * 1024 + col0;
#pragma unroll
                for (int bj = 0; bj < 2; ++bj)
#pragma unroll
                    for (int n = 0; n < 2; ++n) { const f32x4 xv = *(const f32x4*)(X + off + bj * HALF + n * 16); *(f32x4*)(O + off + bj * HALF + n * 16) = xv + gv[bj][n] * acc[ai][bj][m][n]; } }
    }
};
struct EpiFF13 {
    static constexpr bool PERM = true, AFTER_DRAIN = false;
    bf16_t* H;
    __device__ __forceinline__ void operator()(const f32x4 (&acc)[2][2][4][2], const Unit& u, int wr, int wc, int fr, int fq) const {
        const int row0 = u.pm * BM + wr * 64 + fr, col0 = u.pn * HALF + wc * 32 + 8 * fq;
#pragma unroll
        for (int ai = 0; ai < 2; ++ai)
#pragma unroll
            for (int m = 0; m < 4; ++m) { f32x4 h[2];
#pragma unroll
                for (int n = 0; n < 2; ++n)
#pragma unroll
                    for (int i = 0; i < 4; ++i) { const float a = acc[ai][0][m][n][i]; h[n][i] = a * sigm(a) * acc[ai][1][m][n][i]; }
                *(u32x4*)(H + (size_t)(row0 + ai * HALF + m * 16) * 2816 + col0) = pack8(h[0], h[1]); }
    }
};
}
namespace att {
using bf16x8 = __attribute__((ext_vector_type(8))) short;
using s16x4 = __attribute__((ext_vector_type(4))) short;
using f32x16 = __attribute__((ext_vector_type(16))) float;
using u32x4 = __attribute__((ext_vector_type(4))) unsigned;
typedef unsigned short bf16;
constexpr int SEQ = 2048, NW = 8, QBLK = 32, QB = QBLK * NW, KVBLK = 64;
constexpr float C2 = 0.125f * 1.4426950408889634f;
constexpr int SLOTB = 8192, LDS_K = 0, LDS_V = 3 * SLOTB, LDS_WS = 6 * SLOTB, WSW = 128, LDS_OST = LDS_WS + NW * WSW * 4, LDS_X = LDS_OST + NW * 4096, XW = 8192, LDS_BYTES = LDS_X + NW * XW;
#define SBAR() __builtin_amdgcn_sched_barrier(0)
#define PIN(x) asm volatile("" : "+v"(x))
#define MFMA(a, b, c) __builtin_amdgcn_mfma_f32_32x32x16_bf16(a, b, c, 0, 0, 0)
#define WAIT_BAR(N) asm volatile("s_waitcnt vmcnt(" #N ") lgkmcnt(0)\n\ts_barrier" ::: "memory")
#define ATT_THR 8.0f
typedef __attribute__((address_space(3))) const char* lds_cptr;
typedef __attribute__((address_space(3))) char* lds_ptr;
typedef __attribute__((address_space(3))) float* lds_fptr;
typedef __attribute__((address_space(3))) const unsigned* lds_cuptr;
typedef short v4i16_t __attribute__((ext_vector_type(4)));
__device__ __forceinline__ int crow(int r, int hi) { return (r & 3) + 8 * (r >> 2) + 4 * hi; }
__device__ __forceinline__ unsigned cvtpk(float lo, float hi) { unsigned r; asm("v_cvt_pk_bf16_f32 %0, %1, %2" : "=v"(r) : "v"(lo), "v"(hi)); return r; }
__device__ __forceinline__ void glds16(const void* g, unsigned lds_base) {
    unsigned sv; asm volatile("s_mov_b32 %0, m0\n\ts_mov_b32 m0, %2\n\ts_nop 0\n\tglobal_load_lds_dwordx4 %1, off\n\ts_mov_b32 m0, %0" : "=&s"(sv) : "v"(g), "s"(lds_base) : "memory"); }
__device__ __forceinline__ void kload2(bf16x8* kf, lds_cptr kp, int d0) { kf[2 * d0] = *(const __attribute__((address_space(3))) bf16x8*)(kp + d0 * 2048); kf[2 * d0 + 1] = *(const __attribute__((address_space(3))) bf16x8*)(kp + d0 * 2048 + 512); }
__device__ __forceinline__ s16x4 vtr(lds_cptr p) { return __builtin_bit_cast(s16x4, __builtin_amdgcn_ds_read_tr16_b64_v4i16((__attribute__((address_space(3))) v4i16_t*)p)); }
#define MX3(a, b, c) __builtin_fmaxf(__builtin_fmaxf((a), (b)), (c))
__device__ __forceinline__ float rowmax2(const f32x16& p0, const f32x16& p1, float p1off) {
    float a = MX3(p0[0], p0[1], p0[2]), b = MX3(p1[0], p1[1], p1[2]);
#pragma unroll
    for (int r = 3; r < 15; r += 2) { a = MX3(a, p0[r], p0[r + 1]); b = MX3(b, p1[r], p1[r + 1]); }
    a = __builtin_fmaxf(a, p0[15]); b = __builtin_fmaxf(b, p1[15]);
    float m = __builtin_fmaxf(a, b + p1off); auto rr = __builtin_amdgcn_permlane32_swap(__float_as_uint(m), __float_as_uint(m), false, false);
    return __builtin_fmaxf(__uint_as_float(rr[0]), __uint_as_float(rr[1])); }
__device__ __forceinline__ float msel(float x, unsigned mw, int e) { const unsigned m = (unsigned)(((int)(mw << e)) >> 31); return __uint_as_float((__float_as_uint(x) & m) | (0xff800000u & ~m)); }
__device__ __forceinline__ unsigned short f2bf(float f) { unsigned u = __float_as_uint(f); return (unsigned short)((u + 0x7fffu + ((u >> 16) & 1u)) >> 16); }

#ifndef EXP_NOBAND
#define EXP_NOBAND 0
#endif
#ifndef EXP_NOMASK
#define EXP_NOMASK 0
#endif
#ifdef EXP_NOAPPLY
#define EXP_APPLY(C0, C1, t, BAND) do {} while (0)
#else
#define EXP_APPLY(C0, C1, t, BAND) APPLY(C0, C1, t, BAND)
#endif
#ifdef EXP_NOADV
#define EXP_ADV do {} while (0)
#elif defined(EXP_ADVPIN)
#define EXP_ADV do { _Pragma("unroll") for (int r = 0; r < 16; ++r) ali[r] += tstep; PIN(ali); } while (0)
#else
#define EXP_ADV do { _Pragma("unroll") for (int r = 0; r < 16; ++r) ali[r] += tstep; } while (0)
#endif
template <bool MASKED>
__device__ __forceinline__ void attn_core(f32x16 (&o)[2], const bf16* Qw, int qp, const bf16* Kh, int kp, const bf16* Vh, int vp, int qb, float s8, const unsigned* gmask, char* lds) {
    int lz_ = threadIdx.x & 63; asm volatile("" : "+v"(lz_));
    const int tid = threadIdx.x, lane = lz_, r32 = lane & 31, hi = lane >> 5; const int wid = __builtin_amdgcn_readfirstlane(tid >> 6);
    const int NT = 4 * qb + 4;
    const unsigned lds0 = (unsigned)(uintptr_t)lds; const lds_fptr wsf = (lds_fptr)((lds_ptr)lds + LDS_WS) + wid * WSW;
    const bf16* ksrc = Kh + (long)lane * kp + wid * 8;
    const bf16* vsrc = Vh + (long)(16 * (wid & 3) + (lane >> 2)) * vp + (wid >> 2) * 32 + (lane & 3) * 8;
    const unsigned kdst = lds0 + LDS_K + wid * 1024, vdst = lds0 + LDS_V + wid * 1024;
#define DMA_K(t, slot) glds16(ksrc + (long)(t) * KVBLK * kp, (unsigned)__builtin_amdgcn_readfirstlane(kdst + (slot)))
#define DMA_V(t, slot) glds16(vsrc + (long)(t) * KVBLK * vp, (unsigned)__builtin_amdgcn_readfirstlane(vdst + (slot)))
    const lds_cptr vp0 = (lds_cptr)lds + LDS_V + ((lane >> 4) & 1) * 32 + (lane & 3) * 8 + (4 * hi + ((lane & 15) >> 2)) * 64;
    const lds_cptr kp0 = (lds_cptr)lds + LDS_K + hi * 1024 + r32 * 16;
    const lds_cuptr mrow = (lds_cuptr)((lds_cptr)lds + LDS_X + wid * XW) + lane;
    if (MASKED) { for (int i = 0; i <= qb; ++i) glds16(gmask + i * 256 + lane * 4, (unsigned)__builtin_amdgcn_readfirstlane(lds0 + LDS_X + wid * XW + i * 1024)); }
    DMA_K(0, 0); DMA_V(0, 0); DMA_K(1, SLOTB);
    bf16x8 qr[4];
#pragma unroll
    for (int d0 = 0; d0 < 4; ++d0) qr[d0] = *reinterpret_cast<const bf16x8*>(&Qw[(long)r32 * qp + d0 * 16 + hi * 8]);
    float mhat = 0.f, l_reg = 0.f; o[0] = f32x16{}; o[1] = f32x16{};
    const int qrel = wid * QBLK + r32, wch = wid >> 1; bool resc = false;
    const float p1off = 32.f * s8, tstep = 64.f * s8, nm1off = p1off * C2;
    f32x16 ali;
    { const float tq = (float)(QB * qb + qrel);
#pragma unroll
      for (int r = 0; r < 16; ++r) ali[r] = -s8 * (tq - (float)crow(r, hi)); }
    PIN(ali);
    f32x16 pA0, pA1, pB0, pB1; bf16x8 kf[8]; s16x4 vlo[8], vhi[8]; u32x4 pw0, pw1, pw2, pw3;
    int sl_prev = 0, sl_cur = 0, sl_next = SLOTB;
#define ROT() do { sl_prev = sl_cur; sl_cur = sl_next; sl_next = (sl_next == 2 * SLOTB) ? 0 : sl_next + SLOTB; } while (0)
#define EX(v, nm) __builtin_amdgcn_exp2f(__builtin_fmaf((v), C2, (nm)))
#define RESC() do { if (resc) { _Pragma("unroll") for (int d_ = 0; d_ < 2; ++d_) _Pragma("unroll") for (int r = 0; r < 16; ++r) o[d_][r] *= wsf[crow(r, hi)]; } } while (0)
#define APPLY(C0, C1, t, BAND) do { \
    const int jb_ = (t) - (NT - 4); \
    if (MASKED && !EXP_NOMASK) { unsigned mw_ = mrow[(t) * 64]; if (BAND) mw_ = (jb_ > wch) ? 0u : mw_; SBAR(); \
        _Pragma("unroll") for (int e = 0; e < 16; e += 4) { C0[e] = msel(C0[e], mw_, e); C0[e + 1] = msel(C0[e + 1], mw_, e + 1); C0[e + 2] = msel(C0[e + 2], mw_, e + 2); C0[e + 3] = msel(C0[e + 3], mw_, e + 3); SBAR(); } \
        _Pragma("unroll") for (int e = 0; e < 16; e += 4) { C1[e] = msel(C1[e], mw_, 16 + e); C1[e + 1] = msel(C1[e + 1], mw_, 17 + e); C1[e + 2] = msel(C1[e + 2], mw_, 18 + e); C1[e + 3] = msel(C1[e + 3], mw_, 19 + e); SBAR(); } } \
    if (BAND && !EXP_NOBAND) { const float binv_ = (!MASKED && jb_ > wch) ? -INFINITY : 0.f, m2_ = (jb_ == wch) ? -2.f * s8 : 0.f, fb_ = (float)(4 * hi - (qrel - 64 * wch)); float fbo_ = fb_; asm volatile("" : "+v"(fbo_)); SBAR(); \
        _Pragma("unroll") for (int e = 0; e < 16; ++e) { const float d0_ = fbo_ + (float)((e & 3) + 8 * (e >> 2)); \
            C0[e] = __builtin_fmaf(__builtin_fmaxf(d0_, 0.f), m2_, C0[e] + binv_); C1[e] = __builtin_fmaf(__builtin_fmaxf(d0_ + 32.f, 0.f), m2_, C1[e] + binv_); if ((e & 1) == 1) SBAR(); } } } while (0)
    DMA_K(2, 2 * SLOTB);
    WAIT_BAR(3);
    _Pragma("unroll") for (int d0 = 0; d0 < 4; ++d0) kload2(kf, kp0, d0);
    pA0 = MFMA(kf[0], qr[0], ali); pA1 = MFMA(kf[1], qr[0], ali); pA0 = MFMA(kf[2], qr[1], pA0); pA1 = MFMA(kf[3], qr[1], pA1);
    pA0 = MFMA(kf[4], qr[2], pA0); pA1 = MFMA(kf[5], qr[2], pA1); pA0 = MFMA(kf[6], qr[3], pA0); pA1 = MFMA(kf[7], qr[3], pA1);
    APPLY(pA0, pA1, 0, true);
    { const float rm = rowmax2(pA0, pA1, p1off); mhat = __builtin_fmaxf(rm * C2, -30000.f); const float nmh = -mhat, nmh1 = nmh + nm1off;
#pragma unroll
      for (int r = 0; r < 16; ++r) { pA0[r] = EX(pA0[r], nmh); pA1[r] = EX(pA1[r], nmh1); } }
#pragma unroll
    for (int r = 0; r < 16; ++r) ali[r] += tstep;
    WAIT_BAR(0);
    DMA_K(3, 0); DMA_V(1, SLOTB); ROT();
    _Pragma("unroll") for (int d0 = 0; d0 < 4; ++d0) kload2(kf, kp0 + sl_cur, d0);
    WAIT_BAR(2);
#define PKW(P, i) cvtpk(P[i], P[i + 1])
#define PAF(k) __builtin_bit_cast(bf16x8, pw##k)
#define VFR(i) (bf16x8){vlo[i][0], vlo[i][1], vlo[i][2], vlo[i][3], vhi[i][0], vhi[i][1], vhi[i][2], vhi[i][3]}
#define VRD(i) do { vlo[i] = vtr(vp_ + (((i) >> 2) * 4096 + ((i) & 3) * 1024)); vhi[i] = vtr(vp_ + (((i) >> 2) * 4096 + ((i) & 3) * 1024 + 512)); } while (0)
#define KRD(G, d0) do { if (G) { kload2(kf, kp0 + sl_next, d0); SBAR(); } } while (0)
#define GAPA(MF, a0, a1, a2, a3, W0, W1, PW) do { MF; sacc += a0; sacc += a1; sacc += a2; sacc += a3; W0; W1; PIN(PW); PIN(sacc); SBAR(); } while (0)
#define GAPB(MF, X, i, nm) do { MF; X[i] = EX(X[i], nm); X[i + 1] = EX(X[i + 1], nm); X[i + 2] = EX(X[i + 2], nm); X[i + 3] = EX(X[i + 3], nm); PIN(X); SBAR(); } while (0)
#define STEP(C0, C1, P0, P1, t, BAND, GK, GV, GL) do { SBAR(); \
    const lds_cptr vp_ = vp0 + sl_prev; \
    VRD(0); SBAR(); float sacc = P0[0] + P0[1]; \
                    GAPA(C0 = MFMA(kf[0], qr[0], ali), P0[2], P0[3], P0[4], P0[5],     pw0[0] = PKW(P0, 0),  pw0[1] = PKW(P0, 2),  pw0); \
    VRD(4); SBAR(); GAPA(C1 = MFMA(kf[1], qr[0], ali), P0[6], P0[7], P0[8], P0[9],     pw0[2] = PKW(P0, 4),  pw0[3] = PKW(P0, 6),  pw0); \
    VRD(1); SBAR(); GAPA(C0 = MFMA(kf[2], qr[1], C0),  P0[10], P0[11], P0[12], P0[13], pw1[0] = PKW(P0, 8),  pw1[1] = PKW(P0, 10), pw1); \
    VRD(5); SBAR(); GAPA(C1 = MFMA(kf[3], qr[1], C1),  P0[14], P0[15], P1[0], P1[1],   pw1[2] = PKW(P0, 12), pw1[3] = PKW(P0, 14), pw1); \
    VRD(2); SBAR(); GAPA(C0 = MFMA(kf[4], qr[2], C0),  P1[2], P1[3], P1[4], P1[5],     pw2[0] = PKW(P1, 0),  pw2[1] = PKW(P1, 2),  pw2); \
    VRD(6); SBAR(); GAPA(C1 = MFMA(kf[5], qr[2], C1),  P1[6], P1[7], P1[8], P1[9],     pw2[2] = PKW(P1, 4),  pw2[3] = PKW(P1, 6),  pw2); \
    VRD(3); SBAR(); GAPA(C0 = MFMA(kf[6], qr[3], C0),  P1[10], P1[11], P1[12], P1[13], pw3[0] = PKW(P1, 8),  pw3[1] = PKW(P1, 10), pw3); \
    VRD(7); SBAR(); GAPA(C1 = MFMA(kf[7], qr[3], C1),  P1[14], P1[15], 0.f, 0.f,       pw3[2] = PKW(P1, 12), pw3[3] = PKW(P1, 14), pw3); \
    l_reg += sacc; \
    if (GK) DMA_K((t) + 3, sl_cur); if (GV) DMA_V((t) + 1, sl_next); \
    EXP_APPLY(C0, C1, t, BAND); \
    EXP_ADV; \
    { const float rm = __builtin_fmaf(rowmax2(C0, C1, p1off), C2, -mhat); resc = false; \
      if (__builtin_expect(__any(rm > ATT_THR), 0)) { const float dl = __builtin_fmaxf(rm, 0.f); mhat += dl; \
          const float f = __builtin_amdgcn_exp2f(-dl); l_reg *= f; if (hi == 0) wsf[r32] = f; resc = true; } } \
    const float nmh = -mhat, nmh1 = nmh + nm1off; SBAR(); \
    GAPB(o[0] = MFMA(PAF(0), VFR(0), o[0]), C0, 0, nmh);              GAPB(o[1] = MFMA(PAF(0), VFR(4), o[1]), C0, 4, nmh); \
    KRD(GL, 0); GAPB(o[0] = MFMA(PAF(1), VFR(1), o[0]), C0, 8, nmh);  KRD(GL, 1); GAPB(o[1] = MFMA(PAF(1), VFR(5), o[1]), C0, 12, nmh); \
    KRD(GL, 2); GAPB(o[0] = MFMA(PAF(2), VFR(2), o[0]), C1, 0, nmh1); KRD(GL, 3); GAPB(o[1] = MFMA(PAF(2), VFR(6), o[1]), C1, 4, nmh1); \
    GAPB(o[0] = MFMA(PAF(3), VFR(3), o[0]), C1, 8, nmh1);             GAPB(o[1] = MFMA(PAF(3), VFR(7), o[1]), C1, 12, nmh1); \
    } while (0)
    int t = 1;
    for (; t + 5 < NT; t += 2) {
        STEP(pB0, pB1, pA0, pA1, t, false, true, true, true);     WAIT_BAR(2); RESC(); ROT();
        STEP(pA0, pA1, pB0, pB1, t + 1, false, true, true, true); WAIT_BAR(2); RESC(); ROT();
    }
#define ENDW(tt) do { if ((tt) + 3 < NT) { WAIT_BAR(2); } else if ((tt) + 2 < NT) { WAIT_BAR(1); } else { WAIT_BAR(0); } } while (0)
    for (; t + 1 < NT; t += 2) {
        STEP(pB0, pB1, pA0, pA1, t, true, (t + 3 < NT), (t + 1 < NT), (t + 1 < NT));         ENDW(t);     RESC(); ROT();
        STEP(pA0, pA1, pB0, pB1, t + 1, true, (t + 4 < NT), (t + 2 < NT), (t + 2 < NT));     ENDW(t + 1); RESC(); ROT();
    }
    STEP(pB0, pB1, pA0, pA1, NT - 1, true, false, false, false); RESC();
    { float sacc = pB0[0] + pB0[1];
#pragma unroll
      for (int r = 2; r < 16; ++r) sacc += pB0[r];
#pragma unroll
      for (int r = 0; r < 16; ++r) sacc += pB1[r];
      l_reg += sacc;
      pw0 = (u32x4){PKW(pB0, 0), PKW(pB0, 2), PKW(pB0, 4), PKW(pB0, 6)}; pw1 = (u32x4){PKW(pB0, 8), PKW(pB0, 10), PKW(pB0, 12), PKW(pB0, 14)};
      pw2 = (u32x4){PKW(pB1, 0), PKW(pB1, 2), PKW(pB1, 4), PKW(pB1, 6)}; pw3 = (u32x4){PKW(pB1, 8), PKW(pB1, 10), PKW(pB1, 12), PKW(pB1, 14)};
      const lds_cptr vp_ = vp0 + sl_cur; _Pragma("unroll") for (int i = 0; i < 8; ++i) VRD(i);
      o[0] = MFMA(PAF(0), VFR(0), o[0]); o[1] = MFMA(PAF(0), VFR(4), o[1]); o[0] = MFMA(PAF(1), VFR(1), o[0]); o[1] = MFMA(PAF(1), VFR(5), o[1]);
      o[0] = MFMA(PAF(2), VFR(2), o[0]); o[1] = MFMA(PAF(2), VFR(6), o[1]); o[0] = MFMA(PAF(3), VFR(3), o[0]); o[1] = MFMA(PAF(3), VFR(7), o[1]); }
    { auto rr = __builtin_amdgcn_permlane32_swap(__float_as_uint(l_reg), __float_as_uint(l_reg), false, false); l_reg = __uint_as_float(rr[0]) + __uint_as_float(rr[1]); }
    if (hi == 0) wsf[32 + r32] = l_reg;
    asm volatile("s_waitcnt lgkmcnt(0)\n\ts_barrier" ::: "memory");
#undef DMA_K
#undef DMA_V
#undef ROT
#undef EX
#undef RESC
#undef APPLY
#undef PKW
#undef PAF
#undef VFR
#undef VRD
#undef KRD
#undef ENDW
#undef GAPA
#undef GAPB
#undef STEP
}
__device__ __forceinline__ void unit_a(int b, int h, int qb, const bf16* QA, const bf16* KA, const bf16* VA, const unsigned* MASK, bf16* YA, char* lds) {
    const int tid = threadIdx.x; const int wid = __builtin_amdgcn_readfirstlane(tid >> 6);
    const long rowbase = (long)b * SEQ; const long qrow0 = rowbase + qb * QB + wid * QBLK;
    const float s8 = 8.f * __builtin_amdgcn_exp2f(-(float)(h + 1));
    f32x16 o[2];
    attn_core<true>(o, QA + qrow0 * 512 + h * 64, 512, KA + rowbase * 512 + h * 64, 512, VA + rowbase * 512 + h * 64, 512, qb, s8,
                    MASK + ((size_t)(b * 64 + qb * 8 + wid) * 32) * 64, lds);
    int lz = threadIdx.x & 63; asm volatile("" : "+v"(lz));
    const int lane = lz, r32 = lz & 31, hi = lz >> 5;
    const lds_fptr wsf = (lds_fptr)((lds_ptr)lds + LDS_WS) + wid * WSW;
    float rli[16];
#pragma unroll
    for (int r = 0; r < 16; ++r) rli[r] = __builtin_amdgcn_rcpf(wsf[32 + crow(r, hi)]);
    typedef __attribute__((address_space(3))) unsigned short* lds_hptr;
    const lds_hptr stg = (lds_hptr)((lds_ptr)lds + LDS_OST) + wid * 2048;
#pragma unroll
    for (int r = 0; r < 16; ++r) { const int orow = crow(r, hi);
#pragma unroll
        for (int d0 = 0; d0 < 2; ++d0) stg[orow * 64 + d0 * 32 + r32] = f2bf(o[d0][r] * rli[r]); }
    asm volatile("s_waitcnt lgkmcnt(0)" ::: "memory");
    bf16* Ow = YA + qrow0 * 512 + h * 64;
#pragma unroll
    for (int i = 0; i < 4; ++i) { const int row = i * 8 + (lane >> 3), ch = lane & 7; *(u32x4*)(Ow + (long)row * 512 + ch * 8) = *(const __attribute__((address_space(3))) u32x4*)(stg + row * 64 + ch * 8); }
    asm volatile("s_waitcnt lgkmcnt(0)" ::: "memory");
}
__device__ __forceinline__ void unit_b(int b, int h, int qb, const bf16* QBq, const bf16* KBk, const bf16* VBv, const float* subln_g, float lam, bf16* YB, char* lds) {
    const int tid = threadIdx.x; const int wid = __builtin_amdgcn_readfirstlane(tid >> 6);
    const long rowbase = (long)b * SEQ; const long qrow0 = rowbase + qb * QB + wid * QBLK;
    const float s8 = 8.f * __builtin_amdgcn_exp2f(-2.f * (float)(h + 1));
    typedef __attribute__((address_space(3))) unsigned short* lds_hptr;
    _Pragma("nounroll") for (int e = 0; e < 2; ++e) {
        _Pragma("nounroll") for (int m = 0; m < 2; ++m) {
            f32x16 o[2];
            attn_core<false>(o, QBq + qrow0 * 512 + (2 * h + m) * 64, 512, KBk + rowbase * 512 + (2 * h + m) * 64, 512, VBv + rowbase * 512 + h * 128 + e * 64, 512, qb, s8, nullptr, lds);
            int lz = threadIdx.x & 63; asm volatile("" : "+v"(lz));
            const int lane = lz, r32 = lz & 31, hi = lz >> 5;
            const lds_fptr wsf = (lds_fptr)((lds_ptr)lds + LDS_WS) + wid * WSW;
            const lds_fptr stash = (lds_fptr)((lds_ptr)lds + LDS_X + wid * XW) + lane;
            const lds_hptr stg = (lds_hptr)((lds_ptr)lds + LDS_OST) + wid * 2048;
            bf16* Ow = YB + qrow0 * 512 + h * 128;
            float rli[16];
#pragma unroll
            for (int r = 0; r < 16; ++r) rli[r] = __builtin_amdgcn_rcpf(wsf[32 + crow(r, hi)]);
            if (m == 0) {
#pragma unroll
                for (int d0 = 0; d0 < 2; ++d0)
#pragma unroll
                    for (int r = 0; r < 16; ++r) stash[(d0 * 16 + r) * 64] = o[d0][r] * rli[r];
                asm volatile("s_waitcnt lgkmcnt(0)" ::: "memory");
            } else {
                float ssp[16];
#pragma unroll
                for (int r = 0; r < 16; ++r) { const float d0v = stash[r * 64] - lam * (o[0][r] * rli[r]), d1v = stash[(16 + r) * 64] - lam * (o[1][r] * rli[r]);
                    o[0][r] = d0v; o[1][r] = d1v; ssp[r] = d0v * d0v + d1v * d1v; }
#pragma unroll
                for (int r = 0; r < 16; ++r) {
#pragma unroll
                    for (int off = 1; off < 32; off <<= 1) ssp[r] += __shfl_xor(ssp[r], off); }
                if (e == 0) {
                    if (r32 == 0) {
#pragma unroll
                        for (int r = 0; r < 16; ++r) wsf[64 + crow(r, hi)] = ssp[r]; }
                } else {
#pragma unroll
                    for (int r = 0; r < 16; ++r) ssp[r] = __builtin_amdgcn_rsqf((ssp[r] + wsf[64 + crow(r, hi)]) * (1.0f / 128.0f) + 1e-6f) * 0.8f;
                    asm volatile("s_waitcnt lgkmcnt(0)" ::: "memory");
                    if (r32 == 0) {
#pragma unroll
                        for (int r = 0; r < 16; ++r) wsf[64 + crow(r, hi)] = ssp[r]; }
                    asm volatile("s_waitcnt lgkmcnt(0)" ::: "memory");
                }
#define B_STAGE() do { _Pragma("unroll") for (int r = 0; r < 16; ++r) { const int orow = crow(r, hi); \
                    _Pragma("unroll") for (int d0 = 0; d0 < 2; ++d0) stg[orow * 64 + d0 * 32 + r32] = f2bf(o[d0][r]); } \
                    asm volatile("s_waitcnt lgkmcnt(0)" ::: "memory"); } while (0)
#define B_FLUSH(eh) do { const int ch = lane & 7; \
                    const float4 g0 = *(const float4*)(subln_g + (eh) * 64 + ch * 8), g1 = *(const float4*)(subln_g + (eh) * 64 + ch * 8 + 4); \
                    _Pragma("unroll") for (int i = 0; i < 4; ++i) { const int row = i * 8 + (lane >> 3); const float rs = wsf[64 + row]; \
                        const u32x4 w = *(const __attribute__((address_space(3))) u32x4*)(stg + row * 64 + ch * 8); u32x4 ov; \
                        ov.x = cvtpk(__uint_as_float(w.x << 16) * rs * g0.x, __uint_as_float(w.x & 0xffff0000u) * rs * g0.y); \
                        ov.y = cvtpk(__uint_as_float(w.y << 16) * rs * g0.z, __uint_as_float(w.y & 0xffff0000u) * rs * g0.w); \
                        ov.z = cvtpk(__uint_as_float(w.z << 16) * rs * g1.x, __uint_as_float(w.z & 0xffff0000u) * rs * g1.y); \
                        ov.w = cvtpk(__uint_as_float(w.w << 16) * rs * g1.z, __uint_as_float(w.w & 0xffff0000u) * rs * g1.w); \
                        *(u32x4*)(Ow + (long)row * 512 + (eh) * 64 + ch * 8) = ov; } \
                    asm volatile("s_waitcnt lgkmcnt(0)" ::: "memory"); } while (0)
                if (e == 0) { B_STAGE(); }
                else { B_FLUSH(0); B_STAGE(); B_FLUSH(1); }
#undef B_STAGE
#undef B_FLUSH
            }
        }
    }
}
#undef SBAR
#undef PIN
#undef MFMA
#undef WAIT_BAR
#undef MX3
}
namespace sel {
using att::bf16x8; using att::f32x16; using att::crow; typedef unsigned short bf16;
__device__ __forceinline__ void select_unit(int b, int qk, const bf16* QI, const bf16* KI, const float* WI, unsigned* MASK, char* lds) {
    int lz_ = threadIdx.x & 63; asm volatile("" : "+v"(lz_));
    const int tid = threadIdx.x, lane = lz_, r32 = lane & 31, hi = lane >> 5; const int wid = __builtin_amdgcn_readfirstlane(tid >> 6);
    const int ntv = (qk >> 1) + 1;
    unsigned* mrow = MASK + ((size_t)(b * 64 + qk) * 32) * 64 + lane;
    if (qk < 8) {
#pragma unroll
        for (int jj = 0; jj < 4; ++jj) { const int j = wid + 8 * jj; mrow[j * 64] = (j < ntv) ? 0xffffffffu : 0u; }
        return;
    }
    const int ntw = (ntv - wid + 7) >> 3;
    const size_t qrow = (size_t)b * 2048 + qk * 32 + r32;
    const float4 wv = *(const float4*)(WI + qrow * 4);
    unsigned key[4][32];
#pragma unroll
    for (int jj = 0; jj < 4; ++jj) {
        if (jj < ntw) {
            const int j = wid + 8 * jj;
#pragma unroll
            for (int p = 0; p < 2; ++p) {
                bf16x8 kf[4];
#pragma unroll
                for (int d0 = 0; d0 < 4; ++d0) kf[d0] = *(const bf16x8*)(KI + ((size_t)b * 2048 + j * 64 + p * 32 + r32) * 64 + d0 * 16 + hi * 8);
                f32x16 s0 = f32x16{};
#pragma unroll
                for (int h = 0; h < 4; ++h) {
                    bf16x8 qf[4];
#pragma unroll
                    for (int d0 = 0; d0 < 4; ++d0) qf[d0] = *(const bf16x8*)(QI + qrow * 256 + h * 64 + d0 * 16 + hi * 8);
                    f32x16 y0 = f32x16{};
#pragma unroll
                    for (int d0 = 0; d0 < 4; ++d0) y0 = __builtin_amdgcn_mfma_f32_32x32x16_bf16(kf[d0], qf[d0], y0, 0, 0, 0);
                    const float w = (h == 0) ? wv.x : (h == 1) ? wv.y : (h == 2) ? wv.z : wv.w;
#pragma unroll
                    for (int r = 0; r < 16; ++r) s0[r] = __builtin_fmaf(__builtin_fmaxf(y0[r], 0.f), w, s0[r]);
                }
#pragma unroll
                for (int r = 0; r < 16; ++r) {
                    const unsigned idx = (unsigned)(j * 64 + p * 32 + crow(r, hi));
                    const unsigned u = __float_as_uint(s0[r]); const unsigned m = (unsigned)(((int)u) >> 31) | 0x80000000u; key[jj][16 * p + r] = ((u ^ m) & 0xfffff800u) | (2047u - idx);
                }
                __builtin_amdgcn_sched_barrier(0);
            }
        } else {
#pragma unroll
            for (int e = 0; e < 32; ++e) key[jj][e] = 0u;
        }
    }
    typedef __attribute__((address_space(3))) unsigned* lds_uptr;
    const lds_uptr part = (lds_uptr)((__attribute__((address_space(3))) char*)lds);
    unsigned T = 0u;
    for (int bit = 31; bit >= 0; --bit) {
        const unsigned cand = T | (1u << bit);
        unsigned cnt = 0u;
#pragma unroll
        for (int jj = 0; jj < 4; ++jj) { if (jj < ntw) {
#pragma unroll
            for (int e = 0; e < 32; ++e) cnt += (key[jj][e] >= cand) ? 1u : 0u; } }
        cnt += __shfl_xor(cnt, 32);
        const int par = bit & 1;
        if (hi == 0) part[(par * 8 + wid) * 32 + r32] = cnt;
        __syncthreads();
        unsigned tot = 0u;
#pragma unroll
        for (int w = 0; w < 8; ++w) tot += part[(par * 8 + w) * 32 + r32];
        if (tot >= 256u) T = cand;
    }
#pragma unroll
    for (int jj = 0; jj < 4; ++jj) {
        const int j = wid + 8 * jj; unsigned word = 0u;
        if (jj < ntw) {
#pragma unroll
            for (int e = 0; e < 32; ++e) word = (word << 1) | ((key[jj][e] >= T) ? 1u : 0u); }
        mrow[j * 64] = word;
    }
    __syncthreads();
}
}
constexpr int NWAVES = 8;
#ifndef MK_N_LAUNCHES
#define MK_N_LAUNCHES 1
#endif
constexpr int N_PHASES = 10;
constexpr int N_LAUNCHES = MK_N_LAUNCHES;
constexpr int BATCH = 16, SEQ = 2048, DM = 1024, M = BATCH * SEQ, DFF = 2816, W_IN = 5444, NPROJ = 5632, NFF13 = 5632;
constexpr size_t MiB = 1u << 20;
constexpr size_t WS_CTL = 0, CTL_ZERO_BYTES = 64 * 1024;
constexpr size_t WS_MOD = 1 * MiB;
constexpr size_t WS_LAM = 1 * MiB + 512 * 1024;
constexpr size_t WS_GN = 1 * MiB + 768 * 1024;
constexpr size_t WS_WIN = 2 * MiB, WS_WUA = 13 * MiB, WS_WUB = 14 * MiB, WS_WO = 15 * MiB, WS_W13 = 17 * MiB, WS_W2 = 28 * MiB;
constexpr size_t WS_XH = 64 * MiB;
constexpr size_t WS_YA = 64 * MiB, WS_YB = 96 * MiB;
constexpr size_t WS_QA = 128 * MiB, WS_KA = 160 * MiB, WS_VA = 192 * MiB, WS_QB = 224 * MiB, WS_KB = 256 * MiB, WS_VB = 288 * MiB, WS_QI = 320 * MiB, WS_KI = 336 * MiB, WS_WI = 340 * MiB;
constexpr size_t WS_MG = 128 * MiB;
constexpr size_t WS_HID = 128 * MiB;
constexpr size_t WS_GT = 344 * MiB;
constexpr size_t WS_MASK = 472 * MiB;
constexpr size_t WS_END = 480 * MiB;
static_assert(epi::PWS_GN == WS_GN && epi::PWS_QA == WS_QA && epi::PWS_QI == WS_QI && epi::PWS_KI == WS_KI && epi::PWS_WI == WS_WI && epi::PWS_GT == WS_GT && WS_KA - WS_QA == 32 * MiB && WS_VB - WS_QA == 160 * MiB, "EpiProj offsets");
static_assert(WS_W2 + (size_t)DM * DFF * 2 <= WS_XH && WS_WI + (size_t)M * 16 <= WS_GT && WS_HID + (size_t)M * DFF * 2 <= WS_GT && WS_GT + (size_t)M * 2048 * 2 <= WS_MASK, "d_ws map");
constexpr int CW_BAR = 1024;
constexpr int RING_BYTES = 151552;
constexpr int LDSCTL_OFF = RING_BYTES, MISC_OFF = LDSCTL_OFF + 320, LDS_BYTES = 155648;
static_assert(att::LDS_BYTES <= RING_BYTES && pg8::STAGE_BYTES <= RING_BYTES && MISC_OFF + 128 <= LDS_BYTES, "LDS map");

#define GAS __attribute__((address_space(1)))
#define LAS __attribute__((address_space(3)))
typedef unsigned short bf16;
typedef unsigned v4u __attribute__((ext_vector_type(4)));
typedef float f32x4 __attribute__((ext_vector_type(4)));
typedef GAS unsigned gu32;
#define RLX_AGENT __ATOMIC_RELAXED, __HIP_MEMORY_SCOPE_AGENT
#define LDS_WAIT() asm volatile("s_waitcnt lgkmcnt(0)" ::: "memory")
__device__ __forceinline__ unsigned f2bf(float f) { unsigned u = __builtin_bit_cast(unsigned, f); return (u + 0x7fffu + ((u >> 16) & 1u)) >> 16; }
__device__ __forceinline__ unsigned pk2(float lo, float hi) { return f2bf(lo) | (f2bf(hi) << 16); }
#define XB_TMO      128
#define XB_XCNT(j)  (256  + 64 * (j))
#define XB_XSUB(j)  (1280 + 64 * (j))
#define XB_XGEN(j)  (2304 + 64 * (j))
#define XB_TOP      3328
#define XB_TOPGEN   3392
#define XCD_BAR_WORDS 3456
#define XB_SPIN_CAP (1u << 18)

__device__ __forceinline__ unsigned xb_ld(unsigned* p)              { return __hip_atomic_load(p, __ATOMIC_RELAXED, __HIP_MEMORY_SCOPE_AGENT); }
__device__ __forceinline__ unsigned xb_add(unsigned* p, unsigned v) { return __hip_atomic_fetch_add(p, v, __ATOMIC_RELAXED, __HIP_MEMORY_SCOPE_AGENT); }
__device__ __forceinline__ unsigned xb_xcc_id() { return (unsigned)__builtin_amdgcn_s_getreg((3 << 11) | 20) & 0xFu; }
#define XB_SPIN(cond, bar) do { unsigned _sp = 0; while (cond) { __builtin_amdgcn_s_sleep(1); \
    if ((++_sp & 255u) == 0u) { if (xb_ld(&(bar)[XB_TMO])) break; if (_sp > XB_SPIN_CAP) { atomicAdd(&(bar)[XB_TMO], 1u); break; } } } } while (0)

struct XcdBarrier {
    unsigned* bar; unsigned x;
    volatile LAS unsigned* st;
};

__device__ __forceinline__ XcdBarrier xcd_barrier_post(unsigned* bar, volatile LAS unsigned* st) {
    XcdBarrier b; b.bar = bar; b.x = xb_xcc_id(); b.st = st;
    if (threadIdx.x == 0) (void)xb_add(&bar[XB_XCNT(b.x)], 1u);
    return b;
}
__device__ __forceinline__ void xcd_barrier_complete(unsigned* bar, unsigned x, unsigned& nloc, unsigned& nx) {
    const unsigned G = gridDim.x * gridDim.y * gridDim.z;
    unsigned sum, cnt, mine, sp = 0u;
    for (;;) {
        sum = 0u; cnt = 0u; mine = 0u;
#pragma unroll
        for (unsigned j = 0; j < 16; ++j) { const unsigned c = xb_ld(&bar[XB_XCNT(j)]); sum += c; cnt += (c > 0u) ? 1u : 0u; mine = (j == x) ? c : mine; }
        if (sum == G) break;
        __builtin_amdgcn_s_sleep(1);
        if ((++sp & 255u) == 0u) { if (xb_ld(&bar[XB_TMO])) break; if (sp > XB_SPIN_CAP) { atomicAdd(&bar[XB_TMO], 1u); break; } }
    }
    nloc = mine > 0u ? mine : 1u; nx = cnt > 0u ? cnt : 1u;
}

__device__ __forceinline__ void xcd_barrier(const XcdBarrier& b) {
    asm volatile("s_waitcnt vmcnt(0)" ::: "memory");
    __syncthreads();
    if (threadIdx.x == 0) {
        unsigned* bar = b.bar;
        __builtin_amdgcn_s_waitcnt(0);
        unsigned nloc = b.st[0], nx = b.st[1];
        if (nloc == 0u) { xcd_barrier_complete(bar, b.x, nloc, nx); b.st[0] = nloc; b.st[1] = nx; }
        const unsigned old = xb_add(&bar[XB_XSUB(b.x)], 1u);
        const unsigned gen = old / nloc;
        if (old + 1u == (gen + 1u) * nloc) {
            __builtin_amdgcn_fence(__ATOMIC_RELEASE, "agent");
            asm volatile("s_waitcnt vmcnt(0)" ::: "memory");
            const unsigned og = xb_add(&bar[XB_TOP], 1u);
            const unsigned tg = og / nx;
            if (og + 1u == (tg + 1u) * nx) xb_add(&bar[XB_TOPGEN], 1u);
            else XB_SPIN(xb_ld(&bar[XB_TOPGEN]) == tg, bar);
            __builtin_amdgcn_fence(__ATOMIC_ACQUIRE, "agent");
            xb_add(&bar[XB_XGEN(b.x)], 1u);
            asm volatile("s_waitcnt vmcnt(0)" ::: "memory");
        } else {
            XB_SPIN(xb_ld(&bar[XB_XGEN(b.x)]) == gen, bar);
            __builtin_amdgcn_fence(__ATOMIC_ACQUIRE, "agent");
            asm volatile("s_waitcnt vmcnt(0)" ::: "memory");
        }
    }
    __syncthreads();
}
struct Frame {
    LAS unsigned char* lds; volatile LAS unsigned* MISC; gu32* ctl;
    int tid, lane, wave, vcu, G;
};
__device__ __forceinline__ float wave_sum(float v) {
#pragma unroll
    for (int o = 1; o < 64; o <<= 1) v += __shfl_xor(v, o);
    return v;
}
template <class Map>
__device__ __forceinline__ void transpose_item(const float* W, int K, int N, bf16* WT, Map map, LAS float* scr, int item, int lane) {
    const int nblk = (N + 31) / 32, kb = item / nblk, nb = item % nblk, k0 = 64 * kb, n0 = 32 * nb;
    const int nr = n0 + (lane & 31);
#pragma unroll 8
    for (int i = 0; i < 32; ++i) { const int kk = 2 * i + (lane >> 5); scr[kk * 33 + (lane & 31)] = (nr < N) ? W[(size_t)(k0 + kk) * N + nr] : 0.f; }
    LDS_WAIT(); asm volatile("" ::: "memory");
    const int c = lane & 7;
#pragma unroll
    for (int j = 0; j < 4; ++j) { const int nl = (lane >> 3) + 8 * j; const LAS float* s = scr + (8 * c) * 33 + nl;
        v4u o; o.x = pk2(s[0 * 33], s[1 * 33]); o.y = pk2(s[2 * 33], s[3 * 33]); o.z = pk2(s[4 * 33], s[5 * 33]); o.w = pk2(s[6 * 33], s[7 * 33]);
        if (n0 + nl < N) *(GAS v4u*)(WT + (size_t)map(n0 + nl) * K + k0 + 8 * c) = o; }
    LDS_WAIT(); asm volatile("" ::: "memory");
}
struct MapId { __device__ __forceinline__ int operator()(int n) const { return n; } };
struct MapWin {
    __device__ __forceinline__ int operator()(int n) const { const int G = n < 3396 ? n : n + 188; const int L = G & 255, hd = L >> 6, d = L & 63; return (G & ~255) + 128 * (d >> 5) + 32 * hd + (d & 31); } };
struct MapFF { int off; __device__ __forceinline__ int operator()(int n) const { return (n >> 7) * 256 + (n & 127) + off; } };

struct P0In { const float *c, *w_ada, *b_ada, *w_in, *w_up_a, *w_up_b, *w_o, *w_ff1, *w_ff3, *w_ff2, *lq1, *lk1, *lq2, *lk2, *qn_a, *kn_a, *qn_b, *kn_b; };
__device__ __forceinline__ void p0_prologue(Frame& F, const P0In in, unsigned char* ws) {
    LAS float* scr = (LAS float*)(F.lds + F.wave * 16384);
    const int gw = F.vcu * NWAVES + F.wave, NGW = F.G * NWAVES;
    constexpr int I_IN = 16 * 171, I_UP = 8 * 32, I_O = 16 * 32, I_F1 = 16 * 88, I_F2 = 44 * 32;
    constexpr int NITEMS = I_IN + 2 * I_UP + I_O + 2 * I_F1 + I_F2;
    for (int it = gw; it < NITEMS; it += NGW) {
        int r = it;
        if (r < I_IN) { transpose_item(in.w_in, 1024, W_IN, (bf16*)(ws + WS_WIN), MapWin{}, scr, r, F.lane); continue; } r -= I_IN;
        if (r < I_UP) { transpose_item(in.w_up_a, 512, 1024, (bf16*)(ws + WS_WUA), MapId{}, scr, r, F.lane); continue; } r -= I_UP;
        if (r < I_UP) { transpose_item(in.w_up_b, 512, 1024, (bf16*)(ws + WS_WUB), MapId{}, scr, r, F.lane); continue; } r -= I_UP;
        if (r < I_O)  { transpose_item(in.w_o, 1024, 1024, (bf16*)(ws + WS_WO), MapId{}, scr, r, F.lane); continue; } r -= I_O;
        if (r < I_F1) { transpose_item(in.w_ff1, 1024, DFF, (bf16*)(ws + WS_W13), MapFF{0}, scr, r, F.lane); continue; } r -= I_F1;
        if (r < I_F1) { transpose_item(in.w_ff3, 1024, DFF, (bf16*)(ws + WS_W13), MapFF{128}, scr, r, F.lane); continue; } r -= I_F1;
        transpose_item(in.w_ff2, DFF, 1024, (bf16*)(ws + WS_W2), MapId{}, scr, r, F.lane);
    }
    __syncthreads();
    LAS float* S = (LAS float*)F.lds;
    LAS float* P = (LAS float*)(F.lds + 65536);
    for (int g = F.vcu; g < 192; g += F.G) {
        for (int i = F.tid; i < 16 * 1024; i += NWAVES * 64) { const float v = in.c[i]; S[i] = v / (1.f + __expf(-v)); }
        __syncthreads();
        const int c = F.tid & 31, kg = F.tid >> 5, col = 32 * g + c;
        float acc[16];
#pragma unroll
        for (int b = 0; b < 16; ++b) acc[b] = 0.f;
        for (int i = 0; i < 64; i += 4) { const int k = 64 * kg + i;
            float w[4];
#pragma unroll
            for (int u = 0; u < 4; ++u) w[u] = in.w_ada[(size_t)(k + u) * 6144 + col];
#pragma unroll
            for (int b = 0; b < 16; ++b) { const f32x4 s = *(const LAS f32x4*)(S + b * 1024 + k); acc[b] += (s[0] * w[0] + s[1] * w[1]) + (s[2] * w[2] + s[3] * w[3]); } }
#pragma unroll
        for (int b = 0; b < 16; ++b) P[(kg * 16 + b) * 32 + c] = acc[b];
        __syncthreads();
        { const int b = F.tid >> 5; float s = in.b_ada[col];
#pragma unroll
          for (int q = 0; q < 16; ++q) s += P[(q * 16 + b) * 32 + c];
          ((float*)(ws + WS_MOD))[b * 6144 + col] = s; }
        __syncthreads();
    }
    if (F.vcu == F.G - 2 && F.tid < 256) { const int t = F.tid >> 6, i = F.tid & 63; ((float*)(ws + WS_GN))[F.tid] = (t == 0 ? in.qn_a : t == 1 ? in.kn_a : t == 2 ? in.qn_b : in.kn_b)[i]; }
    if (F.vcu == F.G - 1 && F.tid == 0) {
        float s1 = 0.f, s2 = 0.f;
        for (int i = 0; i < 64; ++i) { s1 += in.lq1[i] * in.lk1[i]; s2 += in.lq2[i] * in.lk2[i]; }
        *(float*)(ws + WS_LAM) = expf(s1) - expf(s2) + 0.2f;
    }
}
__device__ __forceinline__ void norm_mod_pass(Frame& F, const float* X, const float* g, const float* scale, const float* shift, bf16* Y) {
    const int gw = F.vcu * NWAVES + F.wave, NGW = F.G * NWAVES;
    for (int blk = gw; blk < M / 16; blk += NGW) {
        const int row0 = blk * 16, b = row0 >> 11;
        f32x4 gs[4], sh[4];
#pragma unroll
        for (int j = 0; j < 4; ++j) { const f32x4 gg = ((const f32x4*)g)[F.lane + 64 * j], sc = ((const f32x4*)(scale + b * 6144))[F.lane + 64 * j]; gs[j] = gg * (sc + 1.0f); sh[j] = ((const f32x4*)(shift + b * 6144))[F.lane + 64 * j]; }
        for (int rr = 0; rr < 16; ++rr) {
            const f32x4* xr = (const f32x4*)(X + (size_t)(row0 + rr) * DM) + F.lane;
            f32x4 v[4]; float s = 0.f;
#pragma unroll
            for (int j = 0; j < 4; ++j) { v[j] = xr[64 * j]; s += (v[j][0] * v[j][0] + v[j][1] * v[j][1]) + (v[j][2] * v[j][2] + v[j][3] * v[j][3]); }
            const float rstd = __builtin_amdgcn_rsqf(wave_sum(s) * (1.0f / DM) + 1e-6f);
            unsigned long long* o8 = (unsigned long long*)(Y + (size_t)(row0 + rr) * DM) + F.lane;
#pragma unroll
            for (int j = 0; j < 4; ++j) { const f32x4 y = v[j] * rstd * gs[j] + sh[j]; o8[64 * j] = (unsigned long long)pk2(y[0], y[1]) | ((unsigned long long)pk2(y[2], y[3]) << 32); }
        }
    }
}
struct Args { const float* in[22]; float* out; unsigned char* ws; int ph_lo, ph_hi; };
__global__ void __launch_bounds__(NWAVES * 64, 2) mega_fwd(Args args) {
    extern __shared__ __attribute__((aligned(16))) unsigned char lds[];
    Frame F;
    F.lds = (LAS unsigned char*)lds;
    F.MISC = (volatile LAS unsigned*)(F.lds + MISC_OFF);
    F.tid = threadIdx.x; F.lane = F.tid & 63; F.wave = __builtin_amdgcn_readfirstlane(F.tid >> 6);
    F.G = gridDim.x; { const int bx = blockIdx.x; F.vcu = (F.G % 8 == 0) ? (bx % 8) * (F.G / 8) + bx / 8 : bx; }
    unsigned char* ws = args.ws;
    F.ctl = (gu32*)(ws + WS_CTL);
    for (int u = F.tid; u < (LDS_BYTES - LDSCTL_OFF) / 4; u += NWAVES * 64) ((LAS unsigned*)(F.lds + LDSCTL_OFF))[u] = 0u;
    __syncthreads();
    XcdBarrier bar; bar.bar = (unsigned*)(F.ctl + CW_BAR); bar.x = 0; bar.st = nullptr;
    if (N_LAUNCHES == 1) bar = xcd_barrier_post((unsigned*)(F.ctl + CW_BAR), F.MISC + 8);
    const int lo = args.ph_lo, hi = args.ph_hi;
#ifndef PH_MASK
#define PH_MASK 0x3ff
#endif
#define IN(k) (((PH_MASK >> (k)) & 1) && lo <= (k) && (k) < hi)
#define SEAM(k) do { if (IN(k) && IN((k) + 1)) xcd_barrier(bar); } while (0)
    float* const MOD = (float*)(ws + WS_MOD);
#define WSP(T, off) ((T*)(ws + (off)))

    if (IN(0)) { const P0In pin{args.in[1], args.in[2], args.in[3], args.in[5], args.in[15], args.in[16], args.in[17], args.in[19], args.in[20], args.in[21], args.in[10], args.in[11], args.in[12], args.in[13], args.in[6], args.in[7], args.in[8], args.in[9]};
                 p0_prologue(F, pin, ws); }
    SEAM(0);
    if (IN(1)) norm_mod_pass(F, args.in[0], args.in[4], MOD + 1024, MOD, WSP(bf16, WS_XH));
    SEAM(1);
    if (IN(2)) {
        pg8::Gemm g{WSP(bf16, WS_XH), (const bf16*)(ws + WS_WIN), M, NPROJ, DM}; pg8::StaticOrder S; S.init(M, NPROJ, F.G, (int)blockIdx.x);
        epi::EpiProj E{ws};
        pg8::gemm_phase<epi::EpiProj, pg8::StaticOrder, true, true>(F.lds, g, S, E);
    }
    SEAM(2);
    if (IN(3)) {
        const int b = F.vcu >> 4, j = F.vcu & 15;
        const bf16 *QI = WSP(bf16, WS_QI), *KI = WSP(bf16, WS_KI); const float* WI = WSP(float, WS_WI); unsigned* MASK = WSP(unsigned, WS_MASK);
        if (F.G == 256) {
            sel::select_unit(b, j, QI, KI, WI, MASK, (char*)lds); sel::select_unit(b, 31 - j, QI, KI, WI, MASK, (char*)lds);
            sel::select_unit(b, 32 + j, QI, KI, WI, MASK, (char*)lds); sel::select_unit(b, 63 - j, QI, KI, WI, MASK, (char*)lds);
        }
    }
    SEAM(3);
    if (IN(4)) {
        if (F.G == 256) {
            const int b = F.vcu >> 4, r = F.vcu & 15;
            const bf16 *QA = WSP(bf16, WS_QA), *KA = WSP(bf16, WS_KA), *VA = WSP(bf16, WS_VA), *QBt = WSP(bf16, WS_QB), *KBt = WSP(bf16, WS_KB), *VBt = WSP(bf16, WS_VB);
            bf16 *YA = WSP(bf16, WS_YA), *YB = WSP(bf16, WS_YB); const unsigned* MASK = WSP(unsigned, WS_MASK);
            const float lam = __hip_atomic_load((const float*)(ws + WS_LAM), RLX_AGENT);
#ifndef NO_UNIT_A
            for (int pi = 0; pi < 2; ++pi) { const int pr = 2 * r + pi, h = pr >> 2, s = pr & 3;
                att::unit_a(b, h, 7 - s, QA, KA, VA, MASK, YA, (char*)lds); att::unit_a(b, h, s, QA, KA, VA, MASK, YA, (char*)lds); }
#endif
#ifndef NO_UNIT_B
            { const int h = r >> 2, s = r & 3;
              att::unit_b(b, h, 7 - s, QBt, KBt, VBt, args.in[14], lam, YB, (char*)lds); att::unit_b(b, h, s, QBt, KBt, VBt, args.in[14], lam, YB, (char*)lds); }
#endif
        }
    }
    SEAM(4);
    if (IN(5)) {
        { pg8::Gemm g{WSP(bf16, WS_YA), (const bf16*)(ws + WS_WUA), M, DM, 512}; pg8::StaticOrder S; S.init(M, DM, F.G, (int)blockIdx.x);
          epi::EpiUp<0> E{WSP(bf16, WS_MG), WSP(bf16, WS_GT)}; pg8::gemm_phase<epi::EpiUp<0>, pg8::StaticOrder, true, true>(F.lds, g, S, E); }
        { pg8::Gemm g{WSP(bf16, WS_YB), (const bf16*)(ws + WS_WUB), M, DM, 512}; pg8::StaticOrder S; S.init(M, DM, F.G, (int)blockIdx.x);
          epi::EpiUp<1> E{WSP(bf16, WS_MG), WSP(bf16, WS_GT)}; pg8::gemm_phase<epi::EpiUp<1>, pg8::StaticOrder, true, true>(F.lds, g, S, E); }
    }
    SEAM(5);
    if (IN(6)) {
        pg8::Gemm g{WSP(bf16, WS_MG), (const bf16*)(ws + WS_WO), M, DM, DM}; pg8::StaticOrder S; S.init(M, DM, F.G, (int)blockIdx.x);
        epi::EpiRes E{args.in[0], args.out, MOD + 2048}; pg8::gemm_phase<epi::EpiRes, pg8::StaticOrder, true, true>(F.lds, g, S, E);
    }
    SEAM(6);
    if (IN(7)) norm_mod_pass(F, args.out, args.in[18], MOD + 4096, MOD + 3072, WSP(bf16, WS_XH));
    SEAM(7);
    if (IN(8)) {
        pg8::Gemm g{WSP(bf16, WS_XH), (const bf16*)(ws + WS_W13), M, NFF13, DM}; pg8::StaticOrder S; S.init(M, NFF13, F.G, (int)blockIdx.x);
        epi::EpiFF13 E{WSP(bf16, WS_HID)}; pg8::gemm_phase<epi::EpiFF13, pg8::StaticOrder, true, true>(F.lds, g, S, E);
    }
    SEAM(8);
    if (IN(9)) {
        pg8::Gemm g{WSP(bf16, WS_HID), (const bf16*)(ws + WS_W2), M, DM, DFF}; pg8::StaticOrder S; S.init(M, DM, F.G, (int)blockIdx.x);
        epi::EpiRes E{args.out, args.out, MOD + 5120}; pg8::gemm_phase<epi::EpiRes, pg8::StaticOrder, true, true>(F.lds, g, S, E);
    }
#undef IN
#undef SEAM
#undef WSP
}

extern "C" void kernel_launch(void* const* d_in, const int* in_sizes, int n_in, void* d_out, int out_size, void* d_ws, size_t ws_size, hipStream_t stream) {
    static int grid = 0;
    if (grid == 0) {
        if (n_in != 22 || in_sizes[0] != M * DM || out_size != M * DM || ws_size < WS_END) { fprintf(stderr, "kernel_launch: unexpected shapes (n_in %d, in0 %d, out %d, ws %zu); nothing launched\n", n_in, n_in > 0 ? in_sizes[0] : -1, out_size, ws_size); grid = -1; return; }
        int dev = 0, cus = 0, per_cu = 0;
        if (hipGetDevice(&dev) != hipSuccess || hipDeviceGetAttribute(&cus, hipDeviceAttributeMultiprocessorCount, dev) != hipSuccess) { fprintf(stderr, "kernel_launch: device query failed\n"); grid = -1; return; }
        if (hipFuncSetAttribute((const void*)mega_fwd, hipFuncAttributeMaxDynamicSharedMemorySize, LDS_BYTES) != hipSuccess) { fprintf(stderr, "kernel_launch: hipFuncSetAttribute failed\n"); grid = -1; return; }
        if (hipOccupancyMaxActiveBlocksPerMultiprocessor(&per_cu, (const void*)mega_fwd, NWAVES * 64, LDS_BYTES) != hipSuccess || per_cu < 1) fprintf(stderr, "kernel_launch: note: occupancy query reports %d workgroups per CU\n", per_cu);
        (void)hipGetLastError();
        grid = cus;
        if (grid != 256) fprintf(stderr, "kernel_launch: %d CUs; the attention/selection schedules need 256\n", grid);
    }
    if (grid < 0) return;
    if (hipMemsetAsync((char*)d_ws + WS_CTL, 0, CTL_ZERO_BYTES, stream) != hipSuccess) { fprintf(stderr, "kernel_launch: hipMemsetAsync failed\n"); return; }
    Args a{};
    for (int i = 0; i < 22; ++i) a.in[i] = (const float*)d_in[i];
    a.out = (float*)d_out; a.ws = (unsigned char*)d_ws;
    for (int li = 0; li < N_LAUNCHES; ++li) {
        a.ph_lo = (N_LAUNCHES == 1) ? 0 : li; a.ph_hi = (N_LAUNCHES == 1) ? N_PHASES : li + 1;
        hipLaunchKernelGGL(mega_fwd, dim3(grid), dim3(NWAVES * 64), LDS_BYTES, stream, a);
        const hipError_t le = hipPeekAtLastError();
        if (le != hipSuccess) { fprintf(stderr, "kernel_launch: launch %d failed: %s\n", li, hipGetErrorName(le)); break; }
    }
}
```

```cpp
#include <hip/hip_runtime.h>
#include <cstdio>
#include <cstdint>
namespace pg8 {
#define PG8_LAS __attribute__((address_space(3)))
typedef unsigned short bf16_t;
typedef short bf16x8 __attribute__((ext_vector_type(8)));
typedef float f32x4 __attribute__((ext_vector_type(4)));
typedef unsigned u32x4 __attribute__((ext_vector_type(4)));
constexpr int BM = 256, BK = 64, HALF = 128, HTB = HALF * BK * 2  , STAGE_BYTES = 8 * HTB, NXCD = 8, WGM = 8;

__host__ __device__ __forceinline__ int lds_byte(int r, int c) { const int st = (r >> 4) * 2 + (c >> 5), rr = r & 15, cc = c & 31, ob = rr * 64 + cc * 2; return st * 1024 + (ob ^ (((ob >> 9) & 1) << 5)); }
__host__ __device__ __forceinline__ void stage_rc(int b, int& R, int& C) { const int st = b / 1024, sb = b % 1024, swz = sb ^ (((sb >> 9) & 1) << 5); R = (st >> 1) * 16 + swz / 64; C = (st & 1) * 32 + (swz % 64) / 2; }
__host__ __device__ __forceinline__ int perm32(int rho) { const int n = rho >> 4, i = rho & 15; return 8 * (i >> 2) + 4 * n + (i & 3); }

struct Unit { int pm, pn; };
struct Gemm { const bf16_t* A; const bf16_t* Bt; int M, N, K; };

struct StaticOrder {
    int nM, nN, nwg, G, c;
    __host__ __device__ void init(int M, int N, int G_, int c_) { nM = M / BM; nN = N / BM; nwg = nM * nN; G = G_; c = c_; }
    __host__ __device__ bool next(int i, Unit& u) const {
        const long L = (long)i * G + c; if (L >= nwg) return false;
        int wgid = (int)L; { const int q = nwg / NXCD, r = nwg % NXCD, xcd = wgid % NXCD, off = wgid / NXCD; wgid = (xcd < r ? xcd * (q + 1) : r * (q + 1) + (xcd - r) * q) + off; }
        const int nig = WGM * nN, gid = wgid / nig, fm = gid * WGM, gsz = (nM - fm) < WGM ? (nM - fm) : WGM;
        u.pm = fm + ((wgid % nig) % gsz); u.pn = (wgid % nig) / gsz; return true;
    }
    __device__ __forceinline__ void a_ready(const Unit&) const {}
    __device__ __forceinline__ void done(const Unit&) const {}
};
__device__ __forceinline__ unsigned cvt_pk_bf16(float lo, float hi) { unsigned r; asm volatile("v_cvt_pk_bf16_f32 %0, %1, %2" : "=v"(r) : "v"(lo), "v"(hi)); return r; }
typedef float f32x2 __attribute__((ext_vector_type(2)));
template <class E, class = void> struct mid_t { static constexpr int v = 0; };
template <class E> struct mid_t<E, decltype((void)E::MID_T)> { static constexpr int v = E::MID_T; };
template <class Epi, class Sched, bool ALIGN_EPI = false, bool SP2 = false>
__device__ __forceinline__ void gemm_phase(PG8_LAS unsigned char* lds, const Gemm g, const Sched& S, const Epi& E) {
    const int tid = threadIdx.x, wid = __builtin_amdgcn_readfirstlane(tid >> 6), lane = tid & 63, wr = wid >> 2, wc = wid & 3, fr = lane & 15, fq = lane >> 4;
    const int K = g.K, nt = K / BK;
    unsigned voffA[2], voffB[2];
#pragma unroll
    for (int i = 0; i < 2; ++i) { int R, C; stage_rc(tid * 16 + i * 8192, R, C); const int Rb = Epi::PERM ? ((R & ~31) + perm32(R & 31)) : R;
        voffA[i] = (unsigned)(R * K + C) * 2u; voffB[i] = (unsigned)(Rb * K + C) * 2u; }
    const size_t kstep = (size_t)(BK * 2);
    const size_t hstep = (size_t)HALF * K * 2;
    const size_t tstep = 2 * hstep;
    const unsigned ldsw = (unsigned)wid * 1024u;
    const int aoff = lds_byte(wr * 64 + fr, fq * 8), boff = lds_byte(wc * 32 + fr, fq * 8);
#define PG8_SA(b, h) (((b) * 2 + (h)) * HTB)
#define PG8_SB(b, h) ((4 + (b) * 2 + (h)) * HTB)
#define PG8_STAGE(bufoff, gbase, voff) do { _Pragma("unroll") for (int _i = 0; _i < 2; ++_i) \
        __builtin_amdgcn_global_load_lds((const unsigned*)((const char*)(gbase) + (voff)[_i]), (PG8_LAS unsigned*)(lds + (bufoff) + ldsw + _i * 8192), 16, 0, 0); } while (0)
#define PG8_LDA(dst, b, h) do { _Pragma("unroll") for (int m = 0; m < 4; ++m) _Pragma("unroll") for (int k = 0; k < 2; ++k) dst[m][k] = *(const PG8_LAS bf16x8*)(lds + PG8_SA(b, h) + aoff + m * 2048 + k * 1024); } while (0)
#define PG8_LDB(dst, b, h) do { _Pragma("unroll") for (int n = 0; n < 2; ++n) _Pragma("unroll") for (int k = 0; k < 2; ++k) dst[n][k] = *(const PG8_LAS bf16x8*)(lds + PG8_SB(b, h) + boff + n * 2048 + k * 1024); } while (0)
#define PG8_MMA(ai, bj, At, Bt) do { __builtin_amdgcn_s_setprio(1); _Pragma("unroll") for (int m = 0; m < 4; ++m) _Pragma("unroll") for (int n = 0; n < 2; ++n) _Pragma("unroll") for (int k = 0; k < 2; ++k) \
        acc[ai][bj][m][n] = __builtin_amdgcn_mfma_f32_16x16x32_bf16(Bt[n][k], At[m][k], acc[ai][bj][m][n], 0, 0, 0); __builtin_amdgcn_s_setprio(0); } while (0)
#define PG8_WAIT_V(n) asm volatile("s_waitcnt vmcnt(" #n ")" ::: "memory")
#define PG8_WAIT_L(n) asm volatile("s_waitcnt lgkmcnt(" #n ")" ::: "memory")
#define PG8_BAR __builtin_amdgcn_s_barrier()
#define PG8_SCHED __builtin_amdgcn_sched_barrier(0)
    Unit cur, nxt; int ui = 0;
    if (!S.next(0, cur)) return;
    f32x4 acc[2][2][4][2];
#pragma unroll
    for (int a = 0; a < 2; ++a)
#pragma unroll
        for (int b = 0; b < 2; ++b)
#pragma unroll
            for (int m = 0; m < 4; ++m)
#pragma unroll
                for (int n = 0; n < 2; ++n) acc[a][b][m][n] = (f32x4){0.f, 0.f, 0.f, 0.f};
    bf16x8 At[4][2], B0[2][2], B1[2][2];
    const char* cA = (const char*)g.A + (size_t)cur.pm * tstep; const char* cB = (const char*)g.Bt + (size_t)cur.pn * tstep;
    S.a_ready(cur);
    if constexpr (SP2) {
        PG8_STAGE(PG8_SB(0, 0), cB, voffB); PG8_STAGE(PG8_SB(0, 1), cB + hstep, voffB); PG8_STAGE(PG8_SA(0, 0), cA, voffA); PG8_STAGE(PG8_SA(0, 1), cA + hstep, voffA);
        if (wr == 1) PG8_BAR;
        PG8_WAIT_V(2); PG8_BAR;
        PG8_STAGE(PG8_SB(1, 0), cB + kstep, voffB); PG8_STAGE(PG8_SA(1, 0), cA + kstep, voffA); PG8_STAGE(PG8_SB(1, 1), cB + hstep + kstep, voffB);
        PG8_WAIT_V(6); PG8_BAR;
    } else {
        PG8_STAGE(PG8_SB(0, 0), cB, voffB); PG8_STAGE(PG8_SA(0, 0), cA, voffA); PG8_STAGE(PG8_SB(0, 1), cB + hstep, voffB); PG8_STAGE(PG8_SA(0, 1), cA + hstep, voffA);
        if (wr == 1) PG8_BAR;
        PG8_WAIT_V(4); PG8_BAR;
        PG8_STAGE(PG8_SB(1, 0), cB + kstep, voffB); PG8_STAGE(PG8_SA(1, 0), cA + kstep, voffA); PG8_STAGE(PG8_SB(1, 1), cB + hstep + kstep, voffB);
        PG8_WAIT_V(6); PG8_BAR;
    }
    for (;;) {
        const bool has_next = S.next(ui + 1, nxt);
        const char* nA = has_next ? (const char*)g.A + (size_t)nxt.pm * tstep : cA; const char* nB = has_next ? (const char*)g.Bt + (size_t)nxt.pn * tstep : cB;
        for (int t = 0; t < nt; t += 2) {
            if constexpr (mid_t<Epi>::v > 0) { if (t == mid_t<Epi>::v) E.mid(acc, cur, wr, wc, fr, fq); }
            const bool last = (t == nt - 2);
            const char* a1 = cA + (size_t)(t + 1) * kstep;
            const char* a2 = last ? nA : cA + (size_t)(t + 2) * kstep; const char* b2 = last ? nB : cB + (size_t)(t + 2) * kstep;
            const char* a3 = a2 + kstep; const char* b3 = b2 + kstep;
            if (last && has_next) S.a_ready(nxt);
            if constexpr (SP2) {
            PG8_LDB(B0, 0, 0); PG8_LDB(B1, 0, 1); PG8_SCHED; PG8_LDA(At, 0, 0); PG8_STAGE(PG8_SA(1, 1), a1 + hstep, voffA);
            PG8_WAIT_V(8); PG8_WAIT_L(0); PG8_BAR; PG8_MMA(0, 0, At, B0); PG8_MMA(0, 1, At, B1); PG8_BAR; PG8_SCHED;
            PG8_LDA(At, 0, 1); PG8_STAGE(PG8_SB(0, 0), b2, voffB); PG8_STAGE(PG8_SB(0, 1), b2 + hstep, voffB); PG8_STAGE(PG8_SA(0, 0), a2, voffA);
            PG8_WAIT_V(8); PG8_WAIT_L(0); PG8_BAR; PG8_MMA(1, 0, At, B0); PG8_MMA(1, 1, At, B1); PG8_BAR; PG8_SCHED;
            PG8_LDB(B0, 1, 0); PG8_LDB(B1, 1, 1); PG8_SCHED; PG8_LDA(At, 1, 0); PG8_STAGE(PG8_SA(0, 1), a2 + hstep, voffA);
            PG8_WAIT_V(8); PG8_WAIT_L(0); PG8_BAR; PG8_MMA(0, 0, At, B0); PG8_MMA(0, 1, At, B1); PG8_BAR; PG8_SCHED;
            PG8_LDA(At, 1, 1); PG8_STAGE(PG8_SB(1, 0), b3, voffB); PG8_STAGE(PG8_SB(1, 1), b3 + hstep, voffB); PG8_STAGE(PG8_SA(1, 0), a3, voffA);
            PG8_WAIT_V(8); PG8_WAIT_L(0); PG8_BAR; PG8_MMA(1, 0, At, B0); PG8_MMA(1, 1, At, B1); PG8_BAR; PG8_SCHED;
            } else {
            PG8_LDB(B0, 0, 0); PG8_SCHED; PG8_LDA(At, 0, 0); PG8_STAGE(PG8_SA(1, 1), a1 + hstep, voffA);
            PG8_WAIT_L(8); PG8_BAR; PG8_WAIT_L(0); PG8_MMA(0, 0, At, B0); PG8_BAR; PG8_SCHED;
            PG8_LDB(B1, 0, 1); PG8_STAGE(PG8_SB(0, 0), b2, voffB);
            PG8_BAR; PG8_WAIT_L(0); PG8_MMA(0, 1, At, B1); PG8_BAR;
            PG8_LDA(At, 0, 1); PG8_STAGE(PG8_SA(0, 0), a2, voffA);
            PG8_BAR; PG8_WAIT_L(0); PG8_MMA(1, 0, At, B0); PG8_BAR; PG8_SCHED;
            PG8_STAGE(PG8_SB(0, 1), b2 + hstep, voffB);
            PG8_WAIT_V(6); PG8_BAR; PG8_MMA(1, 1, At, B1); PG8_BAR;
            PG8_LDB(B0, 1, 0); PG8_SCHED; PG8_LDA(At, 1, 0); PG8_STAGE(PG8_SA(0, 1), a2 + hstep, voffA);
            PG8_WAIT_L(8); PG8_BAR; PG8_WAIT_L(0); PG8_MMA(0, 0, At, B0); PG8_BAR; PG8_SCHED;
            PG8_LDB(B1, 1, 1); PG8_STAGE(PG8_SB(1, 0), b3, voffB);
            PG8_BAR; PG8_WAIT_L(0); PG8_MMA(0, 1, At, B1); PG8_BAR;
            PG8_LDA(At, 1, 1); PG8_STAGE(PG8_SA(1, 0), a3, voffA);
            PG8_BAR; PG8_WAIT_L(0); PG8_MMA(1, 0, At, B0); PG8_BAR; PG8_SCHED;
            PG8_STAGE(PG8_SB(1, 1), b3 + hstep, voffB);
            PG8_WAIT_V(6); PG8_BAR; PG8_MMA(1, 1, At, B1); PG8_BAR;
            }
        }
        if constexpr (ALIGN_EPI) { if (wr == 0) PG8_BAR; }
        if constexpr (!Epi::AFTER_DRAIN) { E(acc, cur, wr, wc, fr, fq); S.done(cur); }
        if (!has_next) break;
#pragma unroll
        for (int a = 0; a < 2; ++a)
#pragma unroll
            for (int b = 0; b < 2; ++b)
#pragma unroll
                for (int m = 0; m < 4; ++m)
#pragma unroll
                    for (int n = 0; n < 2; ++n) acc[a][b][m][n] = (f32x4){0.f, 0.f, 0.f, 0.f};
        cur = nxt; cA = nA; cB = nB; ++ui;
        if constexpr (ALIGN_EPI) { if (wr == 1) PG8_BAR; }
    }
    PG8_WAIT_V(0);
    if constexpr (!ALIGN_EPI) { if (wr == 0) PG8_BAR; }
    PG8_BAR;
    if constexpr (Epi::AFTER_DRAIN) { E.fused(acc, cur, wr, wc, fr, fq, lds, wid, lane); S.done(cur); }
#undef PG8_SA
#undef PG8_SB
#undef PG8_STAGE
#undef PG8_LDA
#undef PG8_LDB
#undef PG8_MMA
#undef PG8_WAIT_V
#undef PG8_WAIT_L
#undef PG8_BAR
#undef PG8_SCHED
}
}
#ifndef SCALE_F_EPS
#define SCALE_F_EPS 0.0f
#endif
namespace epi {
constexpr size_t PWS_GN = (1u << 20) + 768 * 1024, PWS_QA = 128u << 20, PWS_QI = 320u << 20, PWS_KI = 336u << 20, PWS_WI = 340u << 20, PWS_GT = 344u << 20;
using pg8::f32x4; using pg8::u32x4; using pg8::bf16_t; using pg8::Unit; using pg8::BM; using pg8::HALF;
__device__ __forceinline__ unsigned pk2(float lo, float hi) { return pg8::cvt_pk_bf16(lo, hi); }
__device__ __forceinline__ float bflo(unsigned u) { return __uint_as_float(u << 16); }
__device__ __forceinline__ float bfhi(unsigned u) { return __uint_as_float(u & 0xffff0000u); }
__device__ __forceinline__ float sigm(float v) { return __builtin_amdgcn_rcpf(1.f + __expf(-v)); }
__device__ __forceinline__ u32x4 pack8(const f32x4& a, const f32x4& b) { u32x4 w; w.x = pk2(a[0], a[1]); w.y = pk2(a[2], a[3]); w.z = pk2(b[0], b[1]); w.w = pk2(b[2], b[3]); return w; }
__device__ __forceinline__ float dot4(const f32x4& a) { return (a[0] * a[0] + a[1] * a[1]) + (a[2] * a[2] + a[3] * a[3]); }

struct EpiProj {
    static constexpr bool PERM = true, AFTER_DRAIN = false;
    unsigned char* ws;
    template <int MODE  >
    __device__ __forceinline__ void emit(const f32x4 (&acc)[2][2][4][2], bf16_t* dst, int pitch, int cb, const float* g, int row0, int wc, int fq) const {
        f32x4 gv[2][2];
#pragma unroll
        for (int bj = 0; bj < 2; ++bj)
#pragma unroll
            for (int n = 0; n < 2; ++n) gv[bj][n] = (MODE == 1) ? *(const f32x4*)(g + 32 * bj + 8 * fq + 4 * n) : (f32x4){1.f, 1.f, 1.f, 1.f};
#pragma unroll
        for (int ai = 0; ai < 2; ++ai)
#pragma unroll
            for (int m = 0; m < 4; ++m) {
                f32x4 v[2][2];
#pragma unroll
                for (int bj = 0; bj < 2; ++bj)
#pragma unroll
                    for (int n = 0; n < 2; ++n) v[bj][n] = acc[ai][bj][m][n];
                if (MODE == 1) {
                    float ss = (dot4(v[0][0]) + dot4(v[0][1])) + (dot4(v[1][0]) + dot4(v[1][1]));
                    ss += __shfl_xor(ss, 16); ss += __shfl_xor(ss, 32);
                    const float rs = __builtin_amdgcn_rsqf(ss * (1.0f / 64.0f) + 1e-6f);
#pragma unroll
                    for (int bj = 0; bj < 2; ++bj)
#pragma unroll
                        for (int n = 0; n < 2; ++n) v[bj][n] = v[bj][n] * rs * gv[bj][n];
                } else if (MODE == 2) {
#pragma unroll
                    for (int bj = 0; bj < 2; ++bj)
#pragma unroll
                        for (int n = 0; n < 2; ++n)
#pragma unroll
                            for (int i = 0; i < 4; ++i) v[bj][n][i] = sigm(v[bj][n][i]);
                }
                bf16_t* rowp = dst + (size_t)(row0 + ai * HALF + m * 16) * pitch + cb + 64 * wc + 8 * fq;
#pragma unroll
                for (int bj = 0; bj < 2; ++bj) *(u32x4*)(rowp + 32 * bj) = pack8(v[bj][0], v[bj][1]);
            }
    }
    __device__ __forceinline__ void operator()(const f32x4 (&acc)[2][2][4][2], const Unit& u, int wr, int wc, int fr, int fq) const {
        const int pn = u.pn, row0 = u.pm * BM + wr * 64 + fr, cb = (pn & 1) * 256;
        bf16_t* const QA = (bf16_t*)(ws + PWS_QA); const float* const gn = (const float*)(ws + PWS_GN);
        bf16_t* const KI = (bf16_t*)(ws + PWS_KI); float* const WI = (float*)(ws + PWS_WI); bf16_t* const GT = (bf16_t*)(ws + PWS_GT);
        if (pn < 12) {
            const int tsr = pn >> 1; bf16_t* dst = QA + (size_t)tsr * (size_t)(32u << 19);
            if (tsr == 2 || tsr == 5) emit<0>(acc, dst, 512, cb, nullptr, row0, wc, fq);
            else emit<1>(acc, dst, 512, cb, gn + 64 * (tsr - (tsr > 2 ? 1 : 0)), row0, wc, fq);
        }
        else if (pn == 12) emit<0>(acc, (bf16_t*)(ws + PWS_QI), 256, 0, nullptr, row0, wc, fq);
        else if (pn == 13) {
            if (wc == 0) emit<0>(acc, KI, 64, 0, nullptr, row0, 0, fq);
            else if (wc == 1) { if (fq == 0) {
#pragma unroll
                for (int ai = 0; ai < 2; ++ai)
#pragma unroll
                    for (int m = 0; m < 4; ++m) *(f32x4*)(WI + (size_t)(row0 + ai * HALF + m * 16) * 4) = acc[ai][0][m][0]; } }
        } else emit<2>(acc, GT, 2048, (pn - 14) * 256, nullptr, row0, wc, fq);
    }
};
struct EpiUpM {
    static constexpr bool PERM = true, AFTER_DRAIN = false; static constexpr int MID_T = 8;
    bf16_t* MG; const bf16_t* GT;
    static __device__ __forceinline__ float gcl(float g) { return __builtin_fmaxf(g, 8.673617379884035e-19f); }
    __device__ __forceinline__ void mid(f32x4 (&acc)[2][2][4][2], const Unit& u, int wr, int wc, int fr, int fq) const {
        int zo = 0; asm volatile("" : "+v"(zo));
        const int row0 = u.pm * BM + wr * 64 + fr + zo, col0 = u.pn * BM + wc * 32 + 8 * fq;
#pragma unroll
        for (int ai = 0; ai < 2; ++ai) {
            u32x4 ga[4][2], gb[4][2];
#pragma unroll
            for (int m = 0; m < 4; ++m)
#pragma unroll
                for (int bj = 0; bj < 2; ++bj) { const size_t row = (size_t)(row0 + ai * HALF + m * 16); const int c = col0 + bj * HALF;
                    ga[m][bj] = *(const u32x4*)(GT + row * 2048 + c); gb[m][bj] = *(const u32x4*)(GT + row * 2048 + 1024 + c); }
            asm volatile("" ::: "memory");
#pragma unroll
            for (int m = 0; m < 4; ++m)
#pragma unroll
                for (int bj = 0; bj < 2; ++bj) { const u32x4 a = ga[m][bj], b = gb[m][bj];
                    const f32x4 r0 = {bflo(a.x) * __builtin_amdgcn_rcpf(gcl(bflo(b.x))), bfhi(a.x) * __builtin_amdgcn_rcpf(gcl(bfhi(b.x))), bflo(a.y) * __builtin_amdgcn_rcpf(gcl(bflo(b.y))), bfhi(a.y) * __builtin_amdgcn_rcpf(gcl(bfhi(b.y)))};
                    const f32x4 r1 = {bflo(a.z) * __builtin_amdgcn_rcpf(gcl(bflo(b.z))), bfhi(a.z) * __builtin_amdgcn_rcpf(gcl(bfhi(b.z))), bflo(a.w) * __builtin_amdgcn_rcpf(gcl(bflo(b.w))), bfhi(a.w) * __builtin_amdgcn_rcpf(gcl(bfhi(b.w)))};
                    acc[ai][bj][m][0] = acc[ai][bj][m][0] * r0; acc[ai][bj][m][1] = acc[ai][bj][m][1] * r1; }
            asm volatile("" ::: "memory");
        }
    }
    __device__ __forceinline__ void operator()(const f32x4 (&acc)[2][2][4][2], const Unit& u, int wr, int wc, int fr, int fq) const {
        const int row0 = u.pm * BM + wr * 64 + fr, col0 = u.pn * BM + wc * 32 + 8 * fq;
#pragma unroll
        for (int ai = 0; ai < 2; ++ai) {
            u32x4 gw[4][2];
#pragma unroll
            for (int m = 0; m < 4; ++m)
#pragma unroll
                for (int bj = 0; bj < 2; ++bj) { const size_t row = (size_t)(row0 + ai * HALF + m * 16); const int c = col0 + bj * HALF; gw[m][bj] = *(const u32x4*)(GT + row * 2048 + 1024 + c); }
            asm volatile("" ::: "memory");
#pragma unroll
            for (int m = 0; m < 4; ++m)
#pragma unroll
                for (int bj = 0; bj < 2; ++bj) { const size_t row = (size_t)(row0 + ai * HALF + m * 16); const int c = col0 + bj * HALF; const u32x4 g = gw[m][bj];
                    const f32x4 v0 = acc[ai][bj][m][0] * (f32x4){gcl(bflo(g.x)), gcl(bfhi(g.x)), gcl(bflo(g.y)), gcl(bfhi(g.y))}, v1 = acc[ai][bj][m][1] * (f32x4){gcl(bflo(g.z)), gcl(bfhi(g.z)), gcl(bflo(g.w)), gcl(bfhi(g.w))};
                    *(u32x4*)(MG + row * 1024 + c) = pack8(v0, v1); }
        }
    }
};
struct EpiFF13 {
    static constexpr bool PERM = true, AFTER_DRAIN = false;
    bf16_t* H;
#ifdef PROBE_EPI
    int skip;
#endif
    __device__ __forceinline__ void operator()(const f32x4 (&acc)[2][2][4][2], const Unit& u, int wr, int wc, int fr, int fq) const {
        const int row0 = u.pm * BM + wr * 64 + fr, col0 = u.pn * HALF + wc * 32 + 8 * fq;
#ifdef PROBE_EPI
        if (skip) { if (acc[0][0][0][0][0] == 1.2345e30f) H[0] = 0; return; }
#endif
#pragma unroll
        for (int ai = 0; ai < 2; ++ai)
#pragma unroll
            for (int m = 0; m < 4; ++m) { f32x4 h[2];
#pragma unroll
                for (int n = 0; n < 2; ++n)
#pragma unroll
                    for (int i = 0; i < 4; ++i) { const float a = acc[ai][0][m][n][i]; h[n][i] = a * sigm(a) * acc[ai][1][m][n][i]; }
                *(u32x4*)(H + (size_t)(row0 + ai * HALF + m * 16) * 2816 + col0) = pack8(h[0], h[1]); }
    }
};
struct EpiResToBf16 {
    static constexpr bool PERM = true, AFTER_DRAIN = false;
    const float* X; bf16_t* O; const float* gate;
    __device__ __forceinline__ void operator()(const f32x4 (&acc)[2][2][4][2], const Unit& u, int wr, int wc, int fr, int fq) const {
        const int row0 = u.pm * BM + wr * 64 + fr, col0 = u.pn * BM + wc * 32 + 8 * fq; const float* gp = gate + (size_t)(u.pm >> 3) * 6144 + col0;
        f32x4 gv[2][2];
#pragma unroll
        for (int bj = 0; bj < 2; ++bj)
#pragma unroll
            for (int n = 0; n < 2; ++n) gv[bj][n] = *(const f32x4*)(gp + bj * HALF + n * 4);
#pragma unroll
        for (int ai = 0; ai < 2; ++ai) {
            f32x4 xv[4][2][2];
#pragma unroll
            for (int m = 0; m < 4; ++m)
#pragma unroll
                for (int bj = 0; bj < 2; ++bj) { const size_t off = (size_t)(row0 + ai * HALF + m * 16) * 1024 + col0 + bj * HALF; xv[m][bj][0] = *(const f32x4*)(X + off); xv[m][bj][1] = *(const f32x4*)(X + off + 4); }
            asm volatile("" ::: "memory");
#pragma unroll
            for (int m = 0; m < 4; ++m)
#pragma unroll
                for (int bj = 0; bj < 2; ++bj) { const size_t off = (size_t)(row0 + ai * HALF + m * 16) * 1024 + col0 + bj * HALF;
                    *(u32x4*)(O + off) = pack8(xv[m][bj][0] + gv[bj][0] * acc[ai][bj][m][0], xv[m][bj][1] + gv[bj][1] * acc[ai][bj][m][1]); }
        }
    }
};
struct EpiResFromBf16 {
    static constexpr bool PERM = true, AFTER_DRAIN = false;
    const bf16_t* X; float* O; const float* gate;
    __device__ __forceinline__ void operator()(const f32x4 (&acc)[2][2][4][2], const Unit& u, int wr, int wc, int fr, int fq) const {
        const int row0 = u.pm * BM + wr * 64 + fr, col0 = u.pn * BM + wc * 32 + 8 * fq; const float* gp = gate + (size_t)(u.pm >> 3) * 6144 + col0;
        f32x4 gv[2][2];
#pragma unroll
        for (int bj = 0; bj < 2; ++bj)
#pragma unroll
            for (int n = 0; n < 2; ++n) gv[bj][n] = *(const f32x4*)(gp + bj * HALF + n * 4);
#pragma unroll
        for (int ai = 0; ai < 2; ++ai) {
            u32x4 xw[4][2];
#pragma unroll
            for (int m = 0; m < 4; ++m)
#pragma unroll
                for (int bj = 0; bj < 2; ++bj) xw[m][bj] = *(const u32x4*)(X + (size_t)(row0 + ai * HALF + m * 16) * 1024 + col0 + bj * HALF);
            asm volatile("" ::: "memory");
#pragma unroll
            for (int m = 0; m < 4; ++m)
#pragma unroll
                for (int bj = 0; bj < 2; ++bj) { const size_t off = (size_t)(row0 + ai * HALF + m * 16) * 1024 + col0 + bj * HALF; const u32x4 w = xw[m][bj];
                    *(f32x4*)(O + off) = (f32x4){bflo(w.x), bfhi(w.x), bflo(w.y), bfhi(w.y)} + gv[bj][0] * acc[ai][bj][m][0] * (1.0f + SCALE_F_EPS);
                    *(f32x4*)(O + off + 4) = (f32x4){bflo(w.z), bfhi(w.z), bflo(w.w), bfhi(w.w)} + gv[bj][1] * acc[ai][bj][m][1] * (1.0f + SCALE_F_EPS); }
        }
    }
};
}
#ifndef SCALE_B_EPS
#define SCALE_B_EPS 0.0f
#endif
#ifndef SCALE_A_EPS
#define SCALE_A_EPS 0.0f
#endif
namespace att {
using bf16x8 = __attribute__((ext_vector_type(8))) short;
using s16x4 = __attribute__((ext_vector_type(4))) short;
using f32x16 = __attribute__((ext_vector_type(16))) float;
using u32x4 = __attribute__((ext_vector_type(4))) unsigned;
using u32x2 = __attribute__((ext_vector_type(2))) unsigned;
typedef unsigned short bf16;
constexpr int SEQ = 2048, NW = 8, QBLK = 32, QB = QBLK * NW, KVBLK = 64;
constexpr float C2 = 0.125f * 1.4426950408889634f;
constexpr int SLOTB = 8192, LDS_K = 0, LDS_V = 3 * SLOTB, LDS_WS = 6 * SLOTB, WSW = 128, LDS_OST = LDS_WS + NW * WSW * 4, LDS_X = LDS_OST + NW * 4096, XW = 8192, LDS_BYTES = LDS_X + NW * XW;
#define SBAR() __builtin_amdgcn_sched_barrier(0)
#define PIN(x) asm volatile("" : "+v"(x))
#define MFMA(a, b, c) __builtin_amdgcn_mfma_f32_32x32x16_bf16(a, b, c, 0, 0, 0)
#define WAIT_BAR(N) asm volatile("s_waitcnt vmcnt(" #N ") lgkmcnt(0)\n\ts_barrier" ::: "memory")
#ifndef ATT_THR
#define ATT_THR 60.0f
#endif
typedef __attribute__((address_space(3))) const char* lds_cptr;
typedef __attribute__((address_space(3))) char* lds_ptr;
typedef __attribute__((address_space(3))) float* lds_fptr;
typedef __attribute__((address_space(3))) const unsigned* lds_cuptr;
typedef short v4i16_t __attribute__((ext_vector_type(4)));
__device__ __forceinline__ int crow(int r, int hi) { return (r & 3) + 8 * (r >> 2) + 4 * hi; }
__device__ __forceinline__ unsigned cvtpk(float lo, float hi) { unsigned r; asm("v_cvt_pk_bf16_f32 %0, %1, %2" : "=v"(r) : "v"(lo), "v"(hi)); return r; }
__device__ __forceinline__ void glds16(const void* g, unsigned lds_base) {
    unsigned sv; asm volatile("s_mov_b32 %0, m0\n\ts_mov_b32 m0, %2\n\ts_nop 0\n\tglobal_load_lds_dwordx4 %1, off\n\ts_mov_b32 m0, %0" : "=&s"(sv) : "v"(g), "s"(lds_base) : "memory"); }
__device__ __forceinline__ void kload2(bf16x8* kf, lds_cptr kp, int d0) { kf[2 * d0] = *(const __attribute__((address_space(3))) bf16x8*)(kp + d0 * 2048); kf[2 * d0 + 1] = *(const __attribute__((address_space(3))) bf16x8*)(kp + d0 * 2048 + 512); }
__device__ __forceinline__ s16x4 vtr(lds_cptr p) { return __builtin_bit_cast(s16x4, __builtin_amdgcn_ds_read_tr16_b64_v4i16((__attribute__((address_space(3))) v4i16_t*)p)); }
#define MX3(a, b, c) __builtin_fmaxf(__builtin_fmaxf((a), (b)), (c))
__device__ __forceinline__ float rowmax2(const f32x16& p0, const f32x16& p1, float p1off) {
    float a = MX3(p0[0], p0[1], p0[2]), b = MX3(p1[0], p1[1], p1[2]);
#pragma unroll
    for (int r = 3; r < 15; r += 2) { a = MX3(a, p0[r], p0[r + 1]); b = MX3(b, p1[r], p1[r + 1]); }
    a = __builtin_fmaxf(a, p0[15]); b = __builtin_fmaxf(b, p1[15]);
    float m = __builtin_fmaxf(a, b + p1off); auto rr = __builtin_amdgcn_permlane32_swap(__float_as_uint(m), __float_as_uint(m), false, false);
    return __builtin_fmaxf(__uint_as_float(rr[0]), __uint_as_float(rr[1])); }
__device__ __forceinline__ float msel(float x, unsigned mw, int pos) { const unsigned m = (unsigned)(((int)(mw << (31 - pos))) >> 31);
    return __uint_as_float((__float_as_uint(x) & m) | (0xff800000u & ~m)); }
__device__ __forceinline__ unsigned short f2bf(float f) { unsigned u = __float_as_uint(f); return (unsigned short)((u + 0x7fffu + ((u >> 16) & 1u)) >> 16); }

#ifndef EXP_NOBAND
#define EXP_NOBAND 0
#endif
#ifndef EXP_NOMASK
#define EXP_NOMASK 0
#endif
#ifdef EXP_NOAPPLY
#define EXP_APPLY(C0, C1, t, BAND) do {} while (0)
#else
#define EXP_APPLY(C0, C1, t, BAND) APPLY(C0, C1, t, BAND)
#endif
#ifdef EXP_NOADV
#define EXP_ADV do {} while (0)
#elif defined(EXP_ADVPIN)
#define EXP_ADV do { _Pragma("unroll") for (int r = 0; r < 16; ++r) ali[r] += tstep; PIN(ali); } while (0)
#else
#define EXP_ADV do { _Pragma("unroll") for (int r = 0; r < 16; ++r) ali[r] += tstep; } while (0)
#endif
template <bool MASKED>
__device__ __forceinline__ void attn_core(f32x16 (&o)[2], const bf16* Qw, int qp, const bf16* Kh, int kp, const bf16* Vh, int vp, int qb, float s8, const unsigned long long* gmask, char* lds) {
    int lz_ = threadIdx.x & 63; asm volatile("" : "+v"(lz_));
    const int tid = threadIdx.x, lane = lz_, r32 = lane & 31, hi = lane >> 5; const int wid = __builtin_amdgcn_readfirstlane(tid >> 6);
    const int NT = 4 * qb + 4;
    const unsigned lds0 = (unsigned)(uintptr_t)lds; const lds_fptr wsf = (lds_fptr)((lds_ptr)lds + LDS_WS) + wid * WSW;
    const bf16* ksrc = Kh + (long)lane * kp + wid * 8;
    const bf16* vsrc = Vh + (long)(16 * (wid & 3) + (lane >> 2)) * vp + (wid >> 2) * 32 + (lane & 3) * 8;
    const unsigned kdst = lds0 + LDS_K + wid * 1024, vdst = lds0 + LDS_V + wid * 1024;
#define DMA_K(t, slot) glds16(ksrc + (long)(t) * KVBLK * kp, (unsigned)__builtin_amdgcn_readfirstlane(kdst + (slot)))
#define DMA_V(t, slot) glds16(vsrc + (long)(t) * KVBLK * vp, (unsigned)__builtin_amdgcn_readfirstlane(vdst + (slot)))
    const lds_cptr vp0 = (lds_cptr)lds + LDS_V + ((lane >> 4) & 1) * 32 + (lane & 3) * 8 + (4 * hi + ((lane & 15) >> 2)) * 64;
    const lds_cptr kp0 = (lds_cptr)lds + LDS_K + hi * 1024 + r32 * 16;
    const lds_cptr mrow = (lds_cptr)lds + LDS_X + wid * XW + r32 * 8;
    if (MASKED) { for (int i = 0; i <= qb; ++i) glds16((const char*)gmask + i * 1024 + lane * 16, (unsigned)__builtin_amdgcn_readfirstlane(lds0 + LDS_X + wid * XW + i * 1024)); }
    DMA_K(0, 0); DMA_V(0, 0); DMA_K(1, SLOTB);
    bf16x8 qr[4];
#pragma unroll
    for (int d0 = 0; d0 < 4; ++d0) qr[d0] = *reinterpret_cast<const bf16x8*>(&Qw[(long)r32 * qp + d0 * 16 + hi * 8]);
    float mhat = 0.f, l_reg = 0.f; o[0] = f32x16{}; o[1] = f32x16{};
    const int qrel = wid * QBLK + r32, wch = wid >> 1; bool resc = false;
    const float p1off = 32.f * s8, tstep = 64.f * s8, nm1off = p1off * C2;
    f32x16 ali;
    { const float tq = (float)(QB * qb + qrel);
#pragma unroll
      for (int r = 0; r < 16; ++r) ali[r] = -s8 * (tq - (float)crow(r, hi)); }
    PIN(ali);
    f32x16 pA0, pA1, pB0, pB1; bf16x8 kf[8]; s16x4 vlo[8], vhi[8]; u32x4 pw0, pw1, pw2, pw3;
    int sl_prev = 0, sl_cur = 0, sl_next = SLOTB;
#define ROT() do { sl_prev = sl_cur; sl_cur = sl_next; sl_next = (sl_next == 2 * SLOTB) ? 0 : sl_next + SLOTB; } while (0)
#define EX(v, nm) __builtin_amdgcn_exp2f(__builtin_fmaf((v), C2, (nm)))
#define RESC() do { if (resc) { _Pragma("unroll") for (int d_ = 0; d_ < 2; ++d_) _Pragma("unroll") for (int r = 0; r < 16; ++r) o[d_][r] *= wsf[crow(r, hi)]; } } while (0)
#define APPLY(C0, C1, t, BAND) do { \
    const int jb_ = (t) - (NT - 4); \
    if (MASKED && !EXP_NOMASK) { const u32x2 mq_ = *(const __attribute__((address_space(3))) u32x2*)(mrow + (t) * 256); unsigned m0_ = mq_[0] >> (4 * hi), m1_ = mq_[1] >> (4 * hi); \
        if (BAND) { m0_ = (jb_ > wch) ? 0u : m0_; m1_ = (jb_ > wch) ? 0u : m1_; } SBAR(); \
        _Pragma("unroll") for (int e = 0; e < 16; e += 4) { C0[e] = msel(C0[e], m0_, 2 * e); C0[e + 1] = msel(C0[e + 1], m0_, 2 * e + 1); C0[e + 2] = msel(C0[e + 2], m0_, 2 * e + 2); C0[e + 3] = msel(C0[e + 3], m0_, 2 * e + 3); SBAR(); } \
        _Pragma("unroll") for (int e = 0; e < 16; e += 4) { C1[e] = msel(C1[e], m1_, 2 * e); C1[e + 1] = msel(C1[e + 1], m1_, 2 * e + 1); C1[e + 2] = msel(C1[e + 2], m1_, 2 * e + 2); C1[e + 3] = msel(C1[e + 3], m1_, 2 * e + 3); SBAR(); } } \
    if (BAND && !EXP_NOBAND) { const float binv_ = (!MASKED && jb_ > wch) ? -INFINITY : 0.f, m2_ = (jb_ == wch) ? -2.f * s8 : 0.f, fb_ = (float)(4 * hi - (qrel - 64 * wch)); float fbo_ = fb_; asm volatile("" : "+v"(fbo_)); SBAR(); \
        _Pragma("unroll") for (int e = 0; e < 16; ++e) { const float d0_ = fbo_ + (float)((e & 3) + 8 * (e >> 2)); \
            C0[e] = __builtin_fmaf(__builtin_fmaxf(d0_, 0.f), m2_, C0[e] + binv_); C1[e] = __builtin_fmaf(__builtin_fmaxf(d0_ + 32.f, 0.f), m2_, C1[e] + binv_); if ((e & 1) == 1) SBAR(); } } } while (0)
    DMA_K(2, 2 * SLOTB);
    WAIT_BAR(3);
    _Pragma("unroll") for (int d0 = 0; d0 < 4; ++d0) kload2(kf, kp0, d0);
    pA0 = MFMA(kf[0], qr[0], ali); pA1 = MFMA(kf[1], qr[0], ali); pA0 = MFMA(kf[2], qr[1], pA0); pA1 = MFMA(kf[3], qr[1], pA1);
    pA0 = MFMA(kf[4], qr[2], pA0); pA1 = MFMA(kf[5], qr[2], pA1); pA0 = MFMA(kf[6], qr[3], pA0); pA1 = MFMA(kf[7], qr[3], pA1);
    APPLY(pA0, pA1, 0, true);
    { const float rm = rowmax2(pA0, pA1, p1off); mhat = __builtin_fmaxf(rm * C2, -30000.f); const float nmh = -mhat, nmh1 = nmh + nm1off;
#pragma unroll
      for (int r = 0; r < 16; ++r) { pA0[r] = EX(pA0[r], nmh); pA1[r] = EX(pA1[r], nmh1); } }
#pragma unroll
    for (int r = 0; r < 16; ++r) ali[r] += tstep;
    WAIT_BAR(0);
    DMA_K(3, 0); DMA_V(1, SLOTB); ROT();
    _Pragma("unroll") for (int d0 = 0; d0 < 4; ++d0) kload2(kf, kp0 + sl_cur, d0);
    WAIT_BAR(2);
#define PKW(P, i) cvtpk(P[i], P[i + 1])
#define PAF(k) __builtin_bit_cast(bf16x8, pw##k)
#define VFR(i) (bf16x8){vlo[i][0], vlo[i][1], vlo[i][2], vlo[i][3], vhi[i][0], vhi[i][1], vhi[i][2], vhi[i][3]}
#define VRD(i) do { vlo[i] = vtr(vp_ + (((i) >> 2) * 4096 + ((i) & 3) * 1024)); vhi[i] = vtr(vp_ + (((i) >> 2) * 4096 + ((i) & 3) * 1024 + 512)); } while (0)
#define KRD(G, d0) do { if (G) { kload2(kf, kp0 + sl_next, d0); SBAR(); } } while (0)
#define GAPA(MF, a0, a1, a2, a3, W0, W1, PW) do { MF; sacc += a0; sacc += a1; sacc += a2; sacc += a3; W0; W1; PIN(PW); PIN(sacc); SBAR(); } while (0)
#define GAPB(MF, X, i, nm) do { MF; X[i] = EX(X[i], nm); X[i + 1] = EX(X[i + 1], nm); X[i + 2] = EX(X[i + 2], nm); X[i + 3] = EX(X[i + 3], nm); PIN(X); SBAR(); } while (0)
#define STEP(C0, C1, P0, P1, t, BAND, GK, GV, GL) do { SBAR(); \
    const lds_cptr vp_ = vp0 + sl_prev; \
    VRD(0); SBAR(); float sacc = P0[0] + P0[1]; \
                    GAPA(C0 = MFMA(kf[0], qr[0], ali), P0[2], P0[3], P0[4], P0[5],     pw0[0] = PKW(P0, 0),  pw0[1] = PKW(P0, 2),  pw0); \
    VRD(4); SBAR(); GAPA(C1 = MFMA(kf[1], qr[0], ali), P0[6], P0[7], P0[8], P0[9],     pw0[2] = PKW(P0, 4),  pw0[3] = PKW(P0, 6),  pw0); \
    VRD(1); SBAR(); GAPA(C0 = MFMA(kf[2], qr[1], C0),  P0[10], P0[11], P0[12], P0[13], pw1[0] = PKW(P0, 8),  pw1[1] = PKW(P0, 10), pw1); \
    VRD(5); SBAR(); GAPA(C1 = MFMA(kf[3], qr[1], C1),  P0[14], P0[15], P1[0], P1[1],   pw1[2] = PKW(P0, 12), pw1[3] = PKW(P0, 14), pw1); \
    VRD(2); SBAR(); GAPA(C0 = MFMA(kf[4], qr[2], C0),  P1[2], P1[3], P1[4], P1[5],     pw2[0] = PKW(P1, 0),  pw2[1] = PKW(P1, 2),  pw2); \
    VRD(6); SBAR(); GAPA(C1 = MFMA(kf[5], qr[2], C1),  P1[6], P1[7], P1[8], P1[9],     pw2[2] = PKW(P1, 4),  pw2[3] = PKW(P1, 6),  pw2); \
    VRD(3); SBAR(); GAPA(C0 = MFMA(kf[6], qr[3], C0),  P1[10], P1[11], P1[12], P1[13], pw3[0] = PKW(P1, 8),  pw3[1] = PKW(P1, 10), pw3); \
    VRD(7); SBAR(); GAPA(C1 = MFMA(kf[7], qr[3], C1),  P1[14], P1[15], 0.f, 0.f,       pw3[2] = PKW(P1, 12), pw3[3] = PKW(P1, 14), pw3); \
    l_reg += sacc; \
    if (GK) DMA_K((t) + 3, sl_cur); if (GV) DMA_V((t) + 1, sl_next); \
    EXP_APPLY(C0, C1, t, BAND); \
    EXP_ADV; \
    { const float rm = __builtin_fmaf(rowmax2(C0, C1, p1off), C2, -mhat); resc = false; \
      if (__builtin_expect(__any(rm > ATT_THR), 0)) { const float dl = __builtin_fmaxf(rm, 0.f); mhat += dl; \
          const float f = __builtin_amdgcn_exp2f(-dl); l_reg *= f; if (hi == 0) wsf[r32] = f; resc = true; } } \
    const float nmh = -mhat, nmh1 = nmh + nm1off; SBAR(); \
    GAPB(o[0] = MFMA(PAF(0), VFR(0), o[0]), C0, 0, nmh);              GAPB(o[1] = MFMA(PAF(0), VFR(4), o[1]), C0, 4, nmh); \
    KRD(GL, 0); GAPB(o[0] = MFMA(PAF(1), VFR(1), o[0]), C0, 8, nmh);  KRD(GL, 1); GAPB(o[1] = MFMA(PAF(1), VFR(5), o[1]), C0, 12, nmh); \
    KRD(GL, 2); GAPB(o[0] = MFMA(PAF(2), VFR(2), o[0]), C1, 0, nmh1); KRD(GL, 3); GAPB(o[1] = MFMA(PAF(2), VFR(6), o[1]), C1, 4, nmh1); \
    GAPB(o[0] = MFMA(PAF(3), VFR(3), o[0]), C1, 8, nmh1);             GAPB(o[1] = MFMA(PAF(3), VFR(7), o[1]), C1, 12, nmh1); \
    } while (0)
    int t = 1;
    for (; t + 5 < NT; t += 2) {
        STEP(pB0, pB1, pA0, pA1, t, false, true, true, true);     WAIT_BAR(2); RESC(); ROT();
        STEP(pA0, pA1, pB0, pB1, t + 1, false, true, true, true); WAIT_BAR(2); RESC(); ROT();
    }
#define ENDW(tt) do { if ((tt) + 3 < NT) { WAIT_BAR(2); } else if ((tt) + 2 < NT) { WAIT_BAR(1); } else { WAIT_BAR(0); } } while (0)
    for (; t + 1 < NT; t += 2) {
        STEP(pB0, pB1, pA0, pA1, t, true, (t + 3 < NT), (t + 1 < NT), (t + 1 < NT));         ENDW(t);     RESC(); ROT();
        STEP(pA0, pA1, pB0, pB1, t + 1, true, (t + 4 < NT), (t + 2 < NT), (t + 2 < NT));     ENDW(t + 1); RESC(); ROT();
    }
    STEP(pB0, pB1, pA0, pA1, NT - 1, true, false, false, false); RESC();
    { float sacc = pB0[0] + pB0[1];
#pragma unroll
      for (int r = 2; r < 16; ++r) sacc += pB0[r];
#pragma unroll
      for (int r = 0; r < 16; ++r) sacc += pB1[r];
      l_reg += sacc;
      pw0 = (u32x4){PKW(pB0, 0), PKW(pB0, 2), PKW(pB0, 4), PKW(pB0, 6)}; pw1 = (u32x4){PKW(pB0, 8), PKW(pB0, 10), PKW(pB0, 12), PKW(pB0, 14)};
      pw2 = (u32x4){PKW(pB1, 0), PKW(pB1, 2), PKW(pB1, 4), PKW(pB1, 6)}; pw3 = (u32x4){PKW(pB1, 8), PKW(pB1, 10), PKW(pB1, 12), PKW(pB1, 14)};
      const lds_cptr vp_ = vp0 + sl_cur; _Pragma("unroll") for (int i = 0; i < 8; ++i) VRD(i);
      o[0] = MFMA(PAF(0), VFR(0), o[0]); o[1] = MFMA(PAF(0), VFR(4), o[1]); o[0] = MFMA(PAF(1), VFR(1), o[0]); o[1] = MFMA(PAF(1), VFR(5), o[1]);
      o[0] = MFMA(PAF(2), VFR(2), o[0]); o[1] = MFMA(PAF(2), VFR(6), o[1]); o[0] = MFMA(PAF(3), VFR(3), o[0]); o[1] = MFMA(PAF(3), VFR(7), o[1]); }
    { auto rr = __builtin_amdgcn_permlane32_swap(__float_as_uint(l_reg), __float_as_uint(l_reg), false, false); l_reg = __uint_as_float(rr[0]) + __uint_as_float(rr[1]); }
    if (hi == 0) wsf[32 + r32] = l_reg;
    asm volatile("s_waitcnt lgkmcnt(0)\n\ts_barrier" ::: "memory");
#undef DMA_K
#undef DMA_V
#undef ROT
#undef EX
#undef RESC
#undef APPLY
#undef PKW
#undef PAF
#undef VFR
#undef VRD
#undef KRD
#undef ENDW
#undef GAPA
#undef GAPB
#undef STEP
}
constexpr int L8_K = 0, L8_V = 3 * SLOTB, L8_VSLOT = 2 * SLOTB, L8_WS = L8_V + 3 * L8_VSLOT, L8_OST = L8_WS + NW * WSW * 4, L8_Q = L8_OST + NW * 4096, L8_BYTES = L8_Q + NW * 4096;
static_assert(L8_BYTES <= LDS_BYTES, "core128 LDS");
__device__ __forceinline__ float rowmax_h(const f32x16& p0, const f32x16& p1, float hoff) {
    float a = MX3(p0[0], p0[1], p0[2]), b = MX3(p1[0], p1[1], p1[2]);
#pragma unroll
    for (int r = 3; r < 15; r += 2) { a = MX3(a, p0[r], p0[r + 1]); b = MX3(b, p1[r], p1[r + 1]); }
    a = __builtin_fmaxf(a, p0[15]); b = __builtin_fmaxf(b, p1[15]);
    float m = __builtin_fmaxf(a, b) + hoff; auto rr = __builtin_amdgcn_permlane32_swap(__float_as_uint(m), __float_as_uint(m), false, false);
    return __builtin_fmaxf(__uint_as_float(rr[0]), __uint_as_float(rr[1])); }
__device__ __forceinline__ void attn_core128(f32x16 (&o)[4], const bf16* Qw, int qp, const bf16* Kh, int kp, const bf16* Vh, int vp, int qb, float s8, char* lds) {
    int lz_ = threadIdx.x & 63; asm volatile("" : "+v"(lz_));
    const int tid = threadIdx.x, lane = lz_, r32 = lane & 31, hi = lane >> 5; const int wid = __builtin_amdgcn_readfirstlane(tid >> 6);
    const int NT = 4 * qb + 4;
    const unsigned lds0 = (unsigned)(uintptr_t)lds; const lds_fptr wsf = (lds_fptr)((lds_ptr)lds + L8_WS) + wid * WSW;
    const bf16* ksrc = Kh + (long)lane * kp + wid * 8;
    const bf16* vsrc = Vh + (long)(16 * (wid & 3) + (lane >> 2)) * vp + (wid >> 2) * 32 + (lane & 3) * 8;
    const unsigned kdst = lds0 + L8_K + wid * 1024, vdst = lds0 + L8_V + wid * 1024;
#define DMA_K(t, slot) glds16(ksrc + (long)(t) * KVBLK * kp, (unsigned)__builtin_amdgcn_readfirstlane(kdst + (slot)))
#define DMA_V(t, slot) do { glds16(vsrc + (long)(t) * KVBLK * vp, (unsigned)__builtin_amdgcn_readfirstlane(vdst + 2 * (slot))); \
                            glds16(vsrc + (long)(t) * KVBLK * vp + 64, (unsigned)__builtin_amdgcn_readfirstlane(vdst + 2 * (slot) + 8192)); } while (0)
    const lds_cptr vp0 = (lds_cptr)lds + L8_V + ((lane >> 4) & 1) * 32 + (lane & 3) * 8 + (4 * hi + ((lane & 15) >> 2)) * 64;
    const lds_cptr kp0 = (lds_cptr)lds + L8_K + hi * 1024 + r32 * 16;
    const lds_cptr qlp = (lds_cptr)lds + L8_Q + wid * 4096 + hi * 512 + r32 * 16;
#pragma unroll
    for (int d0 = 0; d0 < 4; ++d0) glds16(Qw + (long)r32 * qp + d0 * 16 + hi * 8, (unsigned)__builtin_amdgcn_readfirstlane(lds0 + L8_Q + wid * 4096 + d0 * 1024));
    DMA_K(0, 0); DMA_V(0, 0); DMA_K(1, SLOTB);
#ifdef DBG_QGLOBAL
#define QF(d0) (*reinterpret_cast<const bf16x8*>(&Qw[(long)r32 * qp + (d0) * 16 + hi * 8]))
#else
#define QF(d0) (*(const __attribute__((address_space(3))) bf16x8*)(qlp + (d0) * 1024))
#endif
    float mhat = 0.f, l_reg = 0.f; o[0] = f32x16{}; o[1] = f32x16{}; o[2] = f32x16{}; o[3] = f32x16{};
    const int qrel = wid * QBLK + r32, wch = wid >> 1; bool resc = false;
    float bt = -s8 * (float)(QB * qb + qrel); const float tstep = 64.f * s8, hoff = s8 * (float)(4 * hi);
    f32x16 pA0, pA1, pB0, pB1; bf16x8 kf[8]; s16x4 vlo[8], vhi[8]; u32x4 pw0, pw1, pw2, pw3;
    int sl_prev = 0, sl_cur = 0, sl_next = SLOTB;
#define ROT() do { sl_prev = sl_cur; sl_cur = sl_next; sl_next = (sl_next == 2 * SLOTB) ? 0 : sl_next + SLOTB; } while (0)
#define EX(v, nm) __builtin_amdgcn_exp2f(__builtin_fmaf((v), C2, (nm)))
#define RESC() do { if (resc) { _Pragma("unroll") for (int d_ = 0; d_ < 4; ++d_) _Pragma("unroll") for (int r = 0; r < 16; ++r) o[d_][r] *= wsf[crow(r, hi)]; } } while (0)
#define BIAS(C0, C1) do { _Pragma("unroll") for (int e = 0; e < 16; ++e) { C0[e] = __builtin_fmaf(s8, (float)((e & 3) + 8 * (e >> 2)), C0[e]); C1[e] = __builtin_fmaf(s8, (float)(32 + (e & 3) + 8 * (e >> 2)), C1[e]); } } while (0)
#define APPLY(C0, C1, t, BAND) do { \
    if (BAND) { const int jb_ = (t) - (NT - 4); const float binv_ = (jb_ > wch) ? -INFINITY : 0.f, m2_ = (jb_ == wch) ? -2.f * s8 : 0.f, fb_ = (float)(4 * hi - (qrel - 64 * wch)); float fbo_ = fb_; asm volatile("" : "+v"(fbo_)); SBAR(); \
        _Pragma("unroll") for (int e = 0; e < 16; ++e) { const float d0_ = fbo_ + (float)((e & 3) + 8 * (e >> 2)); \
            C0[e] = __builtin_fmaf(__builtin_fmaxf(d0_, 0.f), m2_, C0[e] + binv_); C1[e] = __builtin_fmaf(__builtin_fmaxf(d0_ + 32.f, 0.f), m2_, C1[e] + binv_); if ((e & 1) == 1) SBAR(); } } } while (0)
    DMA_K(2, 2 * SLOTB);
    WAIT_BAR(4);
    _Pragma("unroll") for (int d0 = 0; d0 < 4; ++d0) kload2(kf, kp0, d0);
    { const bf16x8 q0 = QF(0), q1 = QF(1), q2 = QF(2), q3 = QF(3); const f32x16 z = f32x16{};
      pA0 = MFMA(kf[0], q0, z); pA1 = MFMA(kf[1], q0, z); pA0 = MFMA(kf[2], q1, pA0); pA1 = MFMA(kf[3], q1, pA1);
      pA0 = MFMA(kf[4], q2, pA0); pA1 = MFMA(kf[5], q2, pA1); pA0 = MFMA(kf[6], q3, pA0); pA1 = MFMA(kf[7], q3, pA1); }
    BIAS(pA0, pA1); APPLY(pA0, pA1, 0, true);
    { const float rm = rowmax_h(pA0, pA1, hoff); mhat = __builtin_fmaxf((rm + bt) * C2, -30000.f); const float nmh = __builtin_fmaf(bt + hoff, C2, -mhat);
#pragma unroll
      for (int r = 0; r < 16; ++r) { pA0[r] = EX(pA0[r], nmh); pA1[r] = EX(pA1[r], nmh); } }
    bt += tstep;
    WAIT_BAR(0);
    DMA_K(3, 0); DMA_V(1, SLOTB); ROT();
    _Pragma("unroll") for (int d0 = 0; d0 < 4; ++d0) kload2(kf, kp0 + sl_cur, d0);
    WAIT_BAR(3);
#define PKW(P, i) cvtpk(P[i], P[i + 1])
#define PAF(k) __builtin_bit_cast(bf16x8, pw##k)
#define VFR(i) (bf16x8){vlo[i][0], vlo[i][1], vlo[i][2], vlo[i][3], vhi[i][0], vhi[i][1], vhi[i][2], vhi[i][3]}
#define VRD(i, hofs) do { vlo[i] = vtr(vp_ + ((hofs) + ((i) >> 2) * 4096 + ((i) & 3) * 1024)); vhi[i] = vtr(vp_ + ((hofs) + ((i) >> 2) * 4096 + ((i) & 3) * 1024 + 512)); } while (0)
#define KRD(G, d0) do { if (G) { kload2(kf, kp0 + sl_next, d0); SBAR(); } } while (0)
#define GAPA(MF, a0, a1, a2, a3, W0, W1, PW) do { MF; sacc += a0; sacc += a1; sacc += a2; sacc += a3; W0; W1; PIN(PW); PIN(sacc); SBAR(); } while (0)
#define GAPB1(MF, i, X, j, nm) do { MF; VRD(i, 8192); X[j] = EX(X[j], nm); X[j + 1] = EX(X[j + 1], nm); PIN(X); SBAR(); } while (0)
#define GAPB2(MF, X, j, nm) do { MF; X[j] = EX(X[j], nm); X[j + 1] = EX(X[j + 1], nm); PIN(X); SBAR(); } while (0)
#define STEP(C0, C1, P0, P1, t, BAND, GK, GV, GL) do { SBAR(); \
    const lds_cptr vp_ = vp0 + 2 * sl_prev; \
    VRD(0, 0); bf16x8 qa_ = QF(0); SBAR(); float sacc = P0[0] + P0[1]; const f32x16 z_ = f32x16{}; \
                       GAPA(C0 = MFMA(kf[0], qa_, z_), P0[2], P0[3], P0[4], P0[5],     pw0[0] = PKW(P0, 0),  pw0[1] = PKW(P0, 2),  pw0); \
    VRD(4, 0); bf16x8 qb_ = QF(1); SBAR(); GAPA(C1 = MFMA(kf[1], qa_, z_), P0[6], P0[7], P0[8], P0[9],     pw0[2] = PKW(P0, 4),  pw0[3] = PKW(P0, 6),  pw0);     \
    VRD(1, 0); SBAR(); GAPA(C0 = MFMA(kf[2], qb_, C0),  P0[10], P0[11], P0[12], P0[13], pw1[0] = PKW(P0, 8),  pw1[1] = PKW(P0, 10), pw1); \
    VRD(5, 0); qa_ = QF(2); SBAR(); GAPA(C1 = MFMA(kf[3], qb_, C1),  P0[14], P0[15], P1[0], P1[1],   pw1[2] = PKW(P0, 12), pw1[3] = PKW(P0, 14), pw1); \
    VRD(2, 0); SBAR(); GAPA(C0 = MFMA(kf[4], qa_, C0),  P1[2], P1[3], P1[4], P1[5],     pw2[0] = PKW(P1, 0),  pw2[1] = PKW(P1, 2),  pw2); \
    VRD(6, 0); qb_ = QF(3); SBAR(); GAPA(C1 = MFMA(kf[5], qa_, C1),  P1[6], P1[7], P1[8], P1[9],     pw2[2] = PKW(P1, 4),  pw2[3] = PKW(P1, 6),  pw2); \
    VRD(3, 0); SBAR(); GAPA(C0 = MFMA(kf[6], qb_, C0),  P1[10], P1[11], P1[12], P1[13], pw3[0] = PKW(P1, 8),  pw3[1] = PKW(P1, 10), pw3); \
    VRD(7, 0); SBAR(); GAPA(C1 = MFMA(kf[7], qb_, C1),  P1[14], P1[15], 0.f, 0.f,       pw3[2] = PKW(P1, 12), pw3[3] = PKW(P1, 14), pw3); \
    l_reg += sacc; \
    if (GK) DMA_K((t) + 3, sl_cur); if (GV) DMA_V((t) + 1, sl_next); \
    BIAS(C0, C1); APPLY(C0, C1, t, BAND); \
    { const float rm = __builtin_fmaf(rowmax_h(C0, C1, hoff) + bt, C2, -mhat); resc = false; \
      if (__builtin_expect(__any(rm > ATT_THR), 0)) { const float dl = __builtin_fmaxf(rm, 0.f); mhat += dl; \
          const float f = __builtin_amdgcn_exp2f(-dl); l_reg *= f; if (hi == 0) wsf[r32] = f; resc = true; } } \
    const float nmh = __builtin_fmaf(bt + hoff, C2, -mhat); bt += tstep; SBAR(); \
    GAPB1(o[0] = MFMA(PAF(0), VFR(0), o[0]), 0, C0, 0, nmh);              GAPB1(o[1] = MFMA(PAF(0), VFR(4), o[1]), 4, C0, 2, nmh); \
    GAPB1(o[0] = MFMA(PAF(1), VFR(1), o[0]), 1, C0, 4, nmh);              GAPB1(o[1] = MFMA(PAF(1), VFR(5), o[1]), 5, C0, 6, nmh); \
    GAPB1(o[0] = MFMA(PAF(2), VFR(2), o[0]), 2, C0, 8, nmh);              GAPB1(o[1] = MFMA(PAF(2), VFR(6), o[1]), 6, C0, 10, nmh); \
    GAPB1(o[0] = MFMA(PAF(3), VFR(3), o[0]), 3, C0, 12, nmh);             GAPB1(o[1] = MFMA(PAF(3), VFR(7), o[1]), 7, C0, 14, nmh); \
    GAPB2(o[2] = MFMA(PAF(0), VFR(0), o[2]), C1, 0, nmh);                 GAPB2(o[3] = MFMA(PAF(0), VFR(4), o[3]), C1, 2, nmh); \
    KRD(GL, 0); GAPB2(o[2] = MFMA(PAF(1), VFR(1), o[2]), C1, 4, nmh);     KRD(GL, 1); GAPB2(o[3] = MFMA(PAF(1), VFR(5), o[3]), C1, 6, nmh); \
    KRD(GL, 2); GAPB2(o[2] = MFMA(PAF(2), VFR(2), o[2]), C1, 8, nmh);     KRD(GL, 3); GAPB2(o[3] = MFMA(PAF(2), VFR(6), o[3]), C1, 10, nmh); \
    GAPB2(o[2] = MFMA(PAF(3), VFR(3), o[2]), C1, 12, nmh);                GAPB2(o[3] = MFMA(PAF(3), VFR(7), o[3]), C1, 14, nmh); \
    } while (0)
    int t = 1;
    for (; t + 5 < NT; t += 2) {
        STEP(pB0, pB1, pA0, pA1, t, false, true, true, true);     WAIT_BAR(3); RESC(); ROT();
        STEP(pA0, pA1, pB0, pB1, t + 1, false, true, true, true); WAIT_BAR(3); RESC(); ROT();
    }
#define ENDW(tt) do { if ((tt) + 3 < NT) { WAIT_BAR(3); } else if ((tt) + 2 < NT) { WAIT_BAR(2); } else { WAIT_BAR(0); } } while (0)
    for (; t + 1 < NT; t += 2) {
        STEP(pB0, pB1, pA0, pA1, t, true, (t + 3 < NT), (t + 1 < NT), (t + 1 < NT));         ENDW(t);     RESC(); ROT();
        STEP(pA0, pA1, pB0, pB1, t + 1, true, (t + 4 < NT), (t + 2 < NT), (t + 2 < NT));     ENDW(t + 1); RESC(); ROT();
    }
    STEP(pB0, pB1, pA0, pA1, NT - 1, true, false, false, false); RESC();
    { float sacc = pB0[0] + pB0[1];
#pragma unroll
      for (int r = 2; r < 16; ++r) sacc += pB0[r];
#pragma unroll
      for (int r = 0; r < 16; ++r) sacc += pB1[r];
      l_reg += sacc;
      pw0 = (u32x4){PKW(pB0, 0), PKW(pB0, 2), PKW(pB0, 4), PKW(pB0, 6)}; pw1 = (u32x4){PKW(pB0, 8), PKW(pB0, 10), PKW(pB0, 12), PKW(pB0, 14)};
      pw2 = (u32x4){PKW(pB1, 0), PKW(pB1, 2), PKW(pB1, 4), PKW(pB1, 6)}; pw3 = (u32x4){PKW(pB1, 8), PKW(pB1, 10), PKW(pB1, 12), PKW(pB1, 14)};
      const lds_cptr vp_ = vp0 + 2 * sl_cur;
#pragma unroll
      for (int hf = 0; hf < 2; ++hf) {
        _Pragma("unroll") for (int i = 0; i < 8; ++i) VRD(i, hf * 8192);
        o[2 * hf] = MFMA(PAF(0), VFR(0), o[2 * hf]); o[2 * hf + 1] = MFMA(PAF(0), VFR(4), o[2 * hf + 1]); o[2 * hf] = MFMA(PAF(1), VFR(1), o[2 * hf]); o[2 * hf + 1] = MFMA(PAF(1), VFR(5), o[2 * hf + 1]);
        o[2 * hf] = MFMA(PAF(2), VFR(2), o[2 * hf]); o[2 * hf + 1] = MFMA(PAF(2), VFR(6), o[2 * hf + 1]); o[2 * hf] = MFMA(PAF(3), VFR(3), o[2 * hf]); o[2 * hf + 1] = MFMA(PAF(3), VFR(7), o[2 * hf + 1]); } }
    { auto rr = __builtin_amdgcn_permlane32_swap(__float_as_uint(l_reg), __float_as_uint(l_reg), false, false); l_reg = __uint_as_float(rr[0]) + __uint_as_float(rr[1]); }
    if (hi == 0) wsf[32 + r32] = l_reg;
    asm volatile("s_waitcnt lgkmcnt(0)\n\ts_barrier" ::: "memory");
#undef DMA_K
#undef DMA_V
#undef QF
#undef ROT
#undef EX
#undef RESC
#undef BIAS
#undef APPLY
#undef PKW
#undef PAF
#undef VFR
#undef VRD
#undef KRD
#undef ENDW
#undef GAPA
#undef GAPB1
#undef GAPB2
#undef STEP
}
__device__ __forceinline__ void unit_a(int b, int h, int qb, const bf16* QA, const bf16* KA, const bf16* VA, const unsigned long long* MASK, bf16* YA, char* lds) {
    const int tid = threadIdx.x; const int wid = __builtin_amdgcn_readfirstlane(tid >> 6);
    const long rowbase = (long)b * SEQ; const long qrow0 = rowbase + qb * QB + wid * QBLK;
    const float s8 = 8.f * __builtin_amdgcn_exp2f(-(float)(h + 1));
    f32x16 o[2];
    attn_core<true>(o, QA + qrow0 * 512 + h * 64, 512, KA + rowbase * 512 + h * 64, 512, VA + rowbase * 512 + h * 64, 512, qb, s8,
                    MASK + ((size_t)(b * 64 + qb * 8 + wid) * 32) * 32, lds);
    int lz = threadIdx.x & 63; asm volatile("" : "+v"(lz));
    const int lane = lz, r32 = lz & 31, hi = lz >> 5;
    const lds_fptr wsf = (lds_fptr)((lds_ptr)lds + LDS_WS) + wid * WSW;
    float rli[16];
#pragma unroll
    for (int r = 0; r < 16; ++r) rli[r] = __builtin_amdgcn_rcpf(wsf[32 + crow(r, hi)]) * (1.0f + SCALE_A_EPS);
    typedef __attribute__((address_space(3))) unsigned short* lds_hptr;
    const lds_hptr stg = (lds_hptr)((lds_ptr)lds + LDS_OST) + wid * 2048;
#pragma unroll
    for (int r = 0; r < 16; ++r) { const int orow = crow(r, hi);
#pragma unroll
        for (int d0 = 0; d0 < 2; ++d0) stg[orow * 64 + d0 * 32 + r32] = f2bf(o[d0][r] * rli[r]); }
    asm volatile("s_waitcnt lgkmcnt(0)" ::: "memory");
    bf16* Ow = YA + qrow0 * 1024 + h * 64;
#pragma unroll
    for (int i = 0; i < 4; ++i) { const int row = i * 8 + (lane >> 3), ch = lane & 7; *(u32x4*)(Ow + (long)row * 1024 + ch * 8) = *(const __attribute__((address_space(3))) u32x4*)(stg + row * 64 + ch * 8); }
    asm volatile("s_waitcnt lgkmcnt(0)" ::: "memory");
}
__device__ __forceinline__ void unit_b128(int b, int h, int qb, const bf16* QBq, const bf16* KBk, const bf16* VBv, const float* subln_g, float lam, bf16* YB, unsigned* stash_g, int slot, char* lds) {
    const int tid = threadIdx.x; const int wid = __builtin_amdgcn_readfirstlane(tid >> 6);
    const long rowbase = (long)b * SEQ; const long qrow0 = rowbase + qb * QB + wid * QBLK;
    const float s8 = 8.f * __builtin_amdgcn_exp2f(-2.f * (float)(h + 1));
    typedef __attribute__((address_space(3))) unsigned short* lds_hptr;
    _Pragma("nounroll") for (int m = 0; m < 2; ++m) {
        f32x16 o[4];
        attn_core128(o, QBq + qrow0 * 512 + (2 * h + m) * 64, 512, KBk + rowbase * 512 + (2 * h + m) * 64, 512, VBv + rowbase * 512 + h * 128, 512, qb, s8, lds);
        int lz = threadIdx.x & 63; asm volatile("" : "+v"(lz));
        const int lane = lz, r32 = lz & 31, hi = lz >> 5;
        const lds_fptr wsf = (lds_fptr)((lds_ptr)lds + L8_WS) + wid * WSW;
        const lds_hptr stg = (lds_hptr)((lds_ptr)lds + L8_OST) + wid * 2048;
        unsigned* sg = stash_g + (((size_t)blockIdx.x * 2 + slot) * NW + wid) * 2048 + lane;
        bf16* Ow = YB + qrow0 * 1024 + 512 + h * 128;
        float rli[16];
#pragma unroll
        for (int r = 0; r < 16; ++r) rli[r] = __builtin_amdgcn_rcpf(wsf[32 + crow(r, hi)]);
        if (m == 0) {
#pragma unroll
            for (int d = 0; d < 4; ++d)
#pragma unroll
                for (int r = 0; r < 16; r += 2) sg[(d * 8 + (r >> 1)) * 64] = cvtpk(o[d][r] * rli[r], o[d][r + 1] * rli[r + 1]);
        } else {
            float ssp[16];
#pragma unroll
            for (int r = 0; r < 16; ++r) ssp[r] = 0.f;
#pragma unroll
            for (int d = 0; d < 4; ++d)
#pragma unroll
                for (int r = 0; r < 16; r += 2) { const unsigned w = __hip_atomic_load(sg + (d * 8 + (r >> 1)) * 64, __ATOMIC_RELAXED, __HIP_MEMORY_SCOPE_AGENT);
                    const float v0 = __uint_as_float(w << 16) - lam * (o[d][r] * rli[r]), v1 = __uint_as_float(w & 0xffff0000u) - lam * (o[d][r + 1] * rli[r + 1]);
                    o[d][r] = v0; o[d][r + 1] = v1; ssp[r] += v0 * v0; ssp[r + 1] += v1 * v1; }
#pragma unroll
            for (int r = 0; r < 16; ++r) {
#pragma unroll
                for (int off = 1; off < 32; off <<= 1) ssp[r] += __shfl_xor(ssp[r], off); }
#pragma unroll
            for (int r = 0; r < 16; ++r) ssp[r] = __builtin_amdgcn_rsqf(ssp[r] * (1.0f / 128.0f) + 1e-6f) * (0.8f * (1.0f + SCALE_B_EPS));
            if (r32 == 0) {
#pragma unroll
                for (int r = 0; r < 16; ++r) wsf[64 + crow(r, hi)] = ssp[r]; }
            asm volatile("s_waitcnt lgkmcnt(0)" ::: "memory");
#pragma unroll
            for (int e = 0; e < 2; ++e) {
#pragma unroll
                for (int r = 0; r < 16; ++r) { const int orow = crow(r, hi);
#pragma unroll
                    for (int d0 = 0; d0 < 2; ++d0) stg[orow * 64 + d0 * 32 + r32] = f2bf(o[2 * e + d0][r]); }
                asm volatile("s_waitcnt lgkmcnt(0)" ::: "memory");
                const int ch = lane & 7;
                const float4 g0 = *(const float4*)(subln_g + e * 64 + ch * 8), g1 = *(const float4*)(subln_g + e * 64 + ch * 8 + 4);
#pragma unroll
                for (int i = 0; i < 4; ++i) { const int row = i * 8 + (lane >> 3); const float rs = wsf[64 + row];
                    const u32x4 w = *(const __attribute__((address_space(3))) u32x4*)(stg + row * 64 + ch * 8); u32x4 ov;
                    ov.x = cvtpk(__uint_as_float(w.x << 16) * rs * g0.x, __uint_as_float(w.x & 0xffff0000u) * rs * g0.y);
                    ov.y = cvtpk(__uint_as_float(w.y << 16) * rs * g0.z, __uint_as_float(w.y & 0xffff0000u) * rs * g0.w);
                    ov.z = cvtpk(__uint_as_float(w.z << 16) * rs * g1.x, __uint_as_float(w.z & 0xffff0000u) * rs * g1.y);
                    ov.w = cvtpk(__uint_as_float(w.w << 16) * rs * g1.z, __uint_as_float(w.w & 0xffff0000u) * rs * g1.w);
                    *(u32x4*)(Ow + (long)row * 1024 + e * 64 + ch * 8) = ov; }
                asm volatile("s_waitcnt lgkmcnt(0)" ::: "memory");
            }
        }
    }
}
#undef SBAR
#undef PIN
#undef MFMA
#undef WAIT_BAR
#undef MX3
}
#ifndef KEYMASK
#define KEYMASK 0xfffff800u
#endif
namespace sel {
using att::bf16x8; using att::f32x16; using att::crow; typedef unsigned short bf16;
constexpr int TBP = 513;
__device__ __forceinline__ void select_unit(int b, int qk, const bf16* QI, const bf16* KI, const float* WI, unsigned long long* MASK, char* lds) {
    int lz_ = threadIdx.x & 63; asm volatile("" : "+v"(lz_));
    const int tid = threadIdx.x, lane = lz_, r32 = lane & 31, hi = lane >> 5; const int wid = __builtin_amdgcn_readfirstlane(tid >> 6);
    const int ntv = (qk >> 1) + 1;
    unsigned long long* mbase = MASK + ((size_t)(b * 64 + qk) * 32) * 32;
    if (qk < 8) {
        for (int i = tid; i < 32 * 32; i += 512) mbase[i] = ((i >> 5) < ntv) ? ~0ull : 0ull;
        return;
    }
    typedef __attribute__((address_space(3))) char* lds_ptr;
    typedef __attribute__((address_space(3))) unsigned* lds_uptr;
    const lds_ptr QL = (lds_ptr)lds;
    const lds_uptr TB = (lds_uptr)((lds_ptr)lds + 16384);
    const size_t qrow0 = (size_t)b * 2048 + qk * 32;
    { const int c = tid & 31, q0 = tid >> 5;
#pragma unroll
      for (int u = 0; u < 2; ++u) { const int q = q0 + 16 * u; *(__attribute__((address_space(3))) att::u32x4*)(QL + c * 512 + q * 16) = *(const att::u32x4*)(QI + (qrow0 + q) * 256 + c * 8); } }
    typedef float f32x4_t __attribute__((ext_vector_type(4)));
    const f32x4_t wv = *(const f32x4_t*)(WI + (qrow0 + r32) * 4);
    __syncthreads();
    unsigned keyT[4][32];
    bf16x8 kfa[2][4];
#define SEL_KLOAD(jn) do { _Pragma("unroll") for (int p_ = 0; p_ < 2; ++p_) _Pragma("unroll") for (int d0 = 0; d0 < 4; ++d0) \
        kfa[p_][d0] = *(const bf16x8*)(KI + ((size_t)b * 2048 + (jn) * 64 + p_ * 32 + r32) * 64 + d0 * 16 + hi * 8); } while (0)
    if (wid < ntv) SEL_KLOAD(wid);
#pragma unroll
    for (int jj = 0; jj < 4; ++jj) {
        if (8 * jj < ntv) {
            const int j = 8 * jj + wid;
            unsigned kk[32];
            if (j < ntv) {
#pragma unroll
                for (int p = 0; p < 2; ++p) {
                    const bf16x8 kf[4] = {kfa[p][0], kfa[p][1], kfa[p][2], kfa[p][3]};
                    f32x16 s0 = f32x16{};
#pragma unroll
                    for (int h = 0; h < 4; ++h) {
                        bf16x8 qf[4];
#pragma unroll
                        for (int d0 = 0; d0 < 4; ++d0) qf[d0] = *(const __attribute__((address_space(3))) bf16x8*)(QL + ((h * 4 + d0) * 2 + hi) * 512 + r32 * 16);
                        f32x16 y0 = f32x16{};
#pragma unroll
                        for (int d0 = 0; d0 < 4; ++d0) y0 = __builtin_amdgcn_mfma_f32_32x32x16_bf16(kf[d0], qf[d0], y0, 0, 0, 0);
                        asm volatile("" : "+v"(y0));
                        const float w = wv[h];
#pragma unroll
                        for (int r = 0; r < 16; ++r) { const float yv = y0[r]; const int yi = __float_as_int(yv); s0[r] = __builtin_fmaf(__int_as_float(yi > 0 ? yi : 0), w, s0[r]); }
                    }
#pragma unroll
                    for (int r = 0; r < 16; ++r) {
                        const unsigned idx = (unsigned)(j * 64 + p * 32 + crow(r, hi));
                        const unsigned u = __float_as_uint(s0[r]); const unsigned m = (unsigned)(((int)u) >> 31) | 0x80000000u; kk[16 * p + r] = ((u ^ m) & KEYMASK) | (2047u - idx);
                    }
                    __builtin_amdgcn_sched_barrier(0);
                }
            } else {
#pragma unroll
                for (int e = 0; e < 32; ++e) kk[e] = 0u;
            }
            if (jj < 3 && j + 8 < ntv) SEL_KLOAD(j + 8);
#pragma unroll
            for (int p = 0; p < 2; ++p)
#pragma unroll
                for (int r = 0; r < 16; ++r) TB[r32 * TBP + 64 * wid + 32 * p + crow(r, hi)] = kk[16 * p + r];
            __syncthreads();
#pragma unroll
            for (int i = 0; i < 4; ++i)
#pragma unroll
                for (int t = 0; t < 8; ++t) keyT[jj][8 * i + t] = TB[(4 * wid + i) * TBP + 64 * t + lane];
            __syncthreads();
        } else {
#pragma unroll
            for (int e = 0; e < 32; ++e) keyT[jj][e] = 0u;
        }
    }
    unsigned T0 = 0u, T1 = 0u, T2 = 0u, T3 = 0u; bool dn0 = false, dn1 = false, dn2 = false, dn3 = false;
#define SEL_CNT8(c_, cand, K, o) do { unsigned long long m0_, m1_, m2_, m3_, m4_, m5_, m6_, m7_; unsigned t_; \
        asm volatile("s_nop 1\n\tv_cmp_le_u32_e64 %0, %10, %11\n\tv_cmp_le_u32_e64 %1, %10, %12\n\tv_cmp_le_u32_e64 %2, %10, %13\n\tv_cmp_le_u32_e64 %3, %10, %14\n\t" \
                     "v_cmp_le_u32_e64 %4, %10, %15\n\tv_cmp_le_u32_e64 %5, %10, %16\n\tv_cmp_le_u32_e64 %6, %10, %17\n\tv_cmp_le_u32_e64 %7, %10, %18\n\t" \
                     "s_nop 4\n\ts_bcnt1_i32_b64 %8, %0\n\ts_add_u32 %9, %9, %8\n\ts_bcnt1_i32_b64 %8, %1\n\ts_add_u32 %9, %9, %8\n\ts_bcnt1_i32_b64 %8, %2\n\ts_add_u32 %9, %9, %8\n\ts_bcnt1_i32_b64 %8, %3\n\ts_add_u32 %9, %9, %8\n\t" \
                     "s_bcnt1_i32_b64 %8, %4\n\ts_add_u32 %9, %9, %8\n\ts_bcnt1_i32_b64 %8, %5\n\ts_add_u32 %9, %9, %8\n\ts_bcnt1_i32_b64 %8, %6\n\ts_add_u32 %9, %9, %8\n\ts_bcnt1_i32_b64 %8, %7\n\ts_add_u32 %9, %9, %8" \
                     : "=&s"(m0_), "=&s"(m1_), "=&s"(m2_), "=&s"(m3_), "=&s"(m4_), "=&s"(m5_), "=&s"(m6_), "=&s"(m7_), "=&s"(t_), "+s"(c_) \
                     : "s"(cand), "v"(K[(o)]), "v"(K[(o) + 1]), "v"(K[(o) + 2]), "v"(K[(o) + 3]), "v"(K[(o) + 4]), "v"(K[(o) + 5]), "v"(K[(o) + 6]), "v"(K[(o) + 7]) : "scc"); } while (0)
#define SEL_CNT4(c_, cand, K, o) do { unsigned long long m0_, m1_, m2_, m3_; unsigned t_; \
        asm volatile("s_nop 1\n\tv_cmp_le_u32_e64 %0, %6, %7\n\tv_cmp_le_u32_e64 %1, %6, %8\n\tv_cmp_le_u32_e64 %2, %6, %9\n\tv_cmp_le_u32_e64 %3, %6, %10\n\t" \
                     "s_nop 4\n\ts_bcnt1_i32_b64 %4, %0\n\ts_add_u32 %5, %5, %4\n\ts_bcnt1_i32_b64 %4, %1\n\ts_add_u32 %5, %5, %4\n\ts_bcnt1_i32_b64 %4, %2\n\ts_add_u32 %5, %5, %4\n\ts_bcnt1_i32_b64 %4, %3\n\ts_add_u32 %5, %5, %4" \
                     : "=&s"(m0_), "=&s"(m1_), "=&s"(m2_), "=&s"(m3_), "=&s"(t_), "+s"(c_) \
                     : "s"(cand), "v"(K[(o)]), "v"(K[(o) + 1]), "v"(K[(o) + 2]), "v"(K[(o) + 3]) : "scc"); } while (0)
#ifdef SEL_SAFE
#define SEL_CNT(i, cand) ({ unsigned c_ = 0u; \
        _Pragma("unroll") for (int jj = 0; jj < 4; ++jj) { if (8 * jj < ntv) { \
            _Pragma("unroll") for (int t = 0; t < 8; ++t) c_ += (unsigned)__builtin_popcountll(__ballot(keyT[jj][8 * (i) + t] >= (cand))); __builtin_amdgcn_sched_barrier(0); } } c_; })
#else
#define SEL_CNT(i, cand) ({ unsigned c_ = 0u; const unsigned cd_ = (unsigned)__builtin_amdgcn_readfirstlane((int)(cand)); \
        _Pragma("unroll") for (int jj = 0; jj < 4; ++jj) { if (8 * jj + 4 < ntv) { SEL_CNT8(c_, cd_, keyT[jj], 8 * (i)); } else if (8 * jj < ntv) { SEL_CNT4(c_, cd_, keyT[jj], 8 * (i)); } } c_; })
#endif
    for (int bit = 31; bit >= 0; --bit) {
        const unsigned bm = 1u << bit;
        if (!dn0) { const unsigned c = SEL_CNT(0, T0 | bm); if (c >= 256u) T0 |= bm; dn0 = (c == 256u); }
        if (!dn1) { const unsigned c = SEL_CNT(1, T1 | bm); if (c >= 256u) T1 |= bm; dn1 = (c == 256u); }
        if (!dn2) { const unsigned c = SEL_CNT(2, T2 | bm); if (c >= 256u) T2 |= bm; dn2 = (c == 256u); }
        if (!dn3) { const unsigned c = SEL_CNT(3, T3 | bm); if (c >= 256u) T3 |= bm; dn3 = (c == 256u); }
        if (dn0 && dn1 && dn2 && dn3) break;
    }
#undef SEL_CNT
#undef SEL_KLOAD
#undef SEL_CNT8
#undef SEL_CNT4
#pragma unroll
    for (int i = 0; i < 4; ++i) {
        const unsigned Ti = (i == 0) ? T0 : (i == 1) ? T1 : (i == 2) ? T2 : T3;
        unsigned wlo = 0u, whi = 0u;
#pragma unroll
        for (int jj = 0; jj < 4; ++jj) { int ln_ = lane; asm volatile("" : "+v"(ln_));
#pragma unroll
            for (int t = 0; t < 8; ++t) { const unsigned long long mk = __ballot(keyT[jj][8 * i + t] >= Ti);
                wlo = (ln_ == 8 * jj + t) ? (unsigned)mk : wlo; whi = (ln_ == 8 * jj + t) ? (unsigned)(mk >> 32) : whi; if ((t & 3) == 3) __builtin_amdgcn_sched_barrier(0); } }
        if (lane < 32) mbase[(size_t)lane * 32 + 4 * wid + i] = ((unsigned long long)whi << 32) | wlo;
    }
    __syncthreads();
}
}
constexpr int NWAVES = 8;
#ifndef MK_N_LAUNCHES
#define MK_N_LAUNCHES 1
#endif
constexpr int N_PHASES = 10;
constexpr int N_LAUNCHES = MK_N_LAUNCHES;
constexpr int BATCH = 16, SEQ = 2048, DM = 1024, M = BATCH * SEQ, DFF = 2816, W_IN = 5444, NPROJ = 5632, NFF13 = 5632;
constexpr size_t MiB = 1u << 20;
constexpr size_t WS_CTL = 0, CTL_ZERO_BYTES = 64 * 1024;
constexpr size_t WS_MOD = 1 * MiB;
constexpr size_t WS_LAM = 1 * MiB + 512 * 1024;
constexpr size_t WS_GN = 1 * MiB + 768 * 1024;
constexpr size_t WS_WIN = 2 * MiB, WS_WUA = 13 * MiB  , WS_WO = 15 * MiB, WS_W13 = 17 * MiB, WS_W2 = 28 * MiB;
constexpr size_t WS_XH = 64 * MiB;
constexpr size_t WS_YA = 64 * MiB;
constexpr size_t WS_QA = 128 * MiB, WS_KA = 160 * MiB, WS_VA = 192 * MiB, WS_QB = 224 * MiB, WS_KB = 256 * MiB, WS_VB = 288 * MiB, WS_QI = 320 * MiB, WS_KI = 336 * MiB, WS_WI = 340 * MiB;
constexpr size_t WS_MG = 128 * MiB;
constexpr size_t WS_HID = 128 * MiB;
constexpr size_t WS_GT = 344 * MiB;
constexpr size_t WS_MASK = 472 * MiB;
constexpr size_t WS_STASH = 480 * MiB;
constexpr size_t WS_END = 512 * MiB;
static_assert(epi::PWS_GN == WS_GN && epi::PWS_QA == WS_QA && epi::PWS_QI == WS_QI && epi::PWS_KI == WS_KI && epi::PWS_WI == WS_WI && epi::PWS_GT == WS_GT && WS_KA - WS_QA == 32 * MiB && WS_VB - WS_QA == 160 * MiB, "EpiProj offsets");
static_assert(WS_W2 + (size_t)DM * DFF * 2 <= WS_XH && WS_WI + (size_t)M * 16 <= WS_GT && WS_HID + (size_t)M * DFF * 2 <= WS_GT && WS_GT + (size_t)M * 2048 * 2 <= WS_MASK, "d_ws map");
constexpr int CW_BAR = 1024;
constexpr int RING_BYTES = 151552;
constexpr int LDSCTL_OFF = RING_BYTES, MISC_OFF = LDSCTL_OFF + 320, LDS_BYTES = 155648;
static_assert(att::LDS_BYTES <= RING_BYTES && pg8::STAGE_BYTES <= RING_BYTES && MISC_OFF + 128 <= LDS_BYTES, "LDS map");

#define GAS __attribute__((address_space(1)))
#define LAS __attribute__((address_space(3)))
typedef unsigned short bf16;
typedef unsigned v4u __attribute__((ext_vector_type(4)));
typedef float f32x4 __attribute__((ext_vector_type(4)));
typedef GAS unsigned gu32;
#define RLX_AGENT __ATOMIC_RELAXED, __HIP_MEMORY_SCOPE_AGENT
#define LDS_WAIT() asm volatile("s_waitcnt lgkmcnt(0)" ::: "memory")
__device__ __forceinline__ unsigned f2bf(float f) { unsigned u = __builtin_bit_cast(unsigned, f); return (u + 0x7fffu + ((u >> 16) & 1u)) >> 16; }
__device__ __forceinline__ unsigned pk2(float lo, float hi) { return f2bf(lo) | (f2bf(hi) << 16); }
#define XB_TMO      128
#define XB_XCNT(j)  (256  + 64 * (j))
#define XB_XSUB(j)  (1280 + 64 * (j))
#define XB_XGEN(j)  (2304 + 64 * (j))
#define XB_TOP      3328
#define XB_TOPGEN   3392
#define XCD_BAR_WORDS 3456
#ifdef CHECKER
#define XB_SPIN_CAP (1u << 27)
#else
#define XB_SPIN_CAP (1u << 18)
#endif

__device__ __forceinline__ unsigned xb_ld(unsigned* p)              { return __hip_atomic_load(p, __ATOMIC_RELAXED, __HIP_MEMORY_SCOPE_AGENT); }
__device__ __forceinline__ unsigned xb_add(unsigned* p, unsigned v) { return __hip_atomic_fetch_add(p, v, __ATOMIC_RELAXED, __HIP_MEMORY_SCOPE_AGENT); }
__device__ __forceinline__ unsigned xb_xcc_id() { return (unsigned)__builtin_amdgcn_s_getreg((3 << 11) | 20) & 0xFu; }
#define XB_SPIN(cond, bar) do { unsigned _sp = 0; while (cond) { __builtin_amdgcn_s_sleep(1); \
    if ((++_sp & 255u) == 0u) { if (xb_ld(&(bar)[XB_TMO])) break; if (_sp > XB_SPIN_CAP) { atomicAdd(&(bar)[XB_TMO], 1u); break; } } } } while (0)

struct XcdBarrier {
    unsigned* bar; unsigned x;
    volatile LAS unsigned* st;
};

__device__ __forceinline__ XcdBarrier xcd_barrier_post(unsigned* bar, volatile LAS unsigned* st) {
    XcdBarrier b; b.bar = bar; b.x = xb_xcc_id(); b.st = st;
    if (threadIdx.x == 0) (void)xb_add(&bar[XB_XCNT(b.x)], 1u);
    return b;
}
__device__ __forceinline__ void xcd_barrier_complete(unsigned* bar, unsigned x, unsigned& nloc, unsigned& nx) {
    const unsigned G = gridDim.x * gridDim.y * gridDim.z;
    unsigned sum, cnt, mine, sp = 0u;
    for (;;) {
        sum = 0u; cnt = 0u; mine = 0u;
#pragma unroll
        for (unsigned j = 0; j < 16; ++j) { const unsigned c = xb_ld(&bar[XB_XCNT(j)]); sum += c; cnt += (c > 0u) ? 1u : 0u; mine = (j == x) ? c : mine; }
        if (sum == G) break;
        __builtin_amdgcn_s_sleep(1);
        if ((++sp & 255u) == 0u) { if (xb_ld(&bar[XB_TMO])) break; if (sp > XB_SPIN_CAP) { atomicAdd(&bar[XB_TMO], 1u); break; } }
    }
    nloc = mine > 0u ? mine : 1u; nx = cnt > 0u ? cnt : 1u;
}

__device__ __forceinline__ void xcd_barrier(const XcdBarrier& b) {
    asm volatile("s_waitcnt vmcnt(0)" ::: "memory");
    __syncthreads();
    if (threadIdx.x == 0) {
        unsigned* bar = b.bar;
        __builtin_amdgcn_s_waitcnt(0);
        unsigned nloc = b.st[0], nx = b.st[1];
        if (nloc == 0u) { xcd_barrier_complete(bar, b.x, nloc, nx); b.st[0] = nloc; b.st[1] = nx; }
        const unsigned old = xb_add(&bar[XB_XSUB(b.x)], 1u);
        const unsigned gen = old / nloc;
        if (old + 1u == (gen + 1u) * nloc) {
            __builtin_amdgcn_fence(__ATOMIC_RELEASE, "agent");
            asm volatile("s_waitcnt vmcnt(0)" ::: "memory");
            const unsigned og = xb_add(&bar[XB_TOP], 1u);
            const unsigned tg = og / nx;
            if (og + 1u == (tg + 1u) * nx) xb_add(&bar[XB_TOPGEN], 1u);
            else XB_SPIN(xb_ld(&bar[XB_TOPGEN]) == tg, bar);
            __builtin_amdgcn_fence(__ATOMIC_ACQUIRE, "agent");
            xb_add(&bar[XB_XGEN(b.x)], 1u);
            asm volatile("s_waitcnt vmcnt(0)" ::: "memory");
        } else {
            XB_SPIN(xb_ld(&bar[XB_XGEN(b.x)]) == gen, bar);
            __builtin_amdgcn_fence(__ATOMIC_ACQUIRE, "agent");
            asm volatile("s_waitcnt vmcnt(0)" ::: "memory");
        }
    }
    __syncthreads();
}
struct Frame {
    LAS unsigned char* lds; volatile LAS unsigned* MISC; gu32* ctl;
    int tid, lane, wave, vcu, G;
};
__device__ __forceinline__ float wave_sum(float v) {
#pragma unroll
    for (int o = 1; o < 64; o <<= 1) v += __shfl_xor(v, o);
    return v;
}
template <class Map>
__device__ __forceinline__ void transpose_item(const float* W, int K, int N, bf16* WT, Map map, LAS float* scr, int item, int lane, int ld = 0, int koff = 0) {
    const int nblk = (N + 31) / 32, kb = item / nblk, nb = item % nblk, k0 = 64 * kb, n0 = 32 * nb;
    const int nr = n0 + (lane & 31);
    float wv[32];
#pragma unroll
    for (int i = 0; i < 32; ++i) { const int kk = 2 * i + (lane >> 5); wv[i] = (nr < N) ? W[(size_t)(k0 + kk) * N + nr] : 0.f; }
#pragma unroll
    for (int i = 0; i < 32; ++i) { const int kk = 2 * i + (lane >> 5); scr[kk * 33 + (lane & 31)] = wv[i]; }
    LDS_WAIT(); asm volatile("" ::: "memory");
    const int c = lane & 7;
#pragma unroll
    for (int j = 0; j < 4; ++j) { const int nl = (lane >> 3) + 8 * j; const LAS float* s = scr + (8 * c) * 33 + nl;
        v4u o; o.x = pk2(s[0 * 33], s[1 * 33]); o.y = pk2(s[2 * 33], s[3 * 33]); o.z = pk2(s[4 * 33], s[5 * 33]); o.w = pk2(s[6 * 33], s[7 * 33]);
        if (n0 + nl < N) *(GAS v4u*)(WT + (size_t)map(n0 + nl) * (ld ? ld : K) + koff + k0 + 8 * c) = o; }
    LDS_WAIT(); asm volatile("" ::: "memory");
}
struct MapId { __device__ __forceinline__ int operator()(int n) const { return n; } };
struct MapWin {
    __device__ __forceinline__ int operator()(int n) const { const int G = n < 3396 ? n : n + 188; const int L = G & 255, hd = L >> 6, d = L & 63; return (G & ~255) + 128 * (d >> 5) + 32 * hd + (d & 31); } };
struct MapFF { int off; __device__ __forceinline__ int operator()(int n) const { return (n >> 7) * 256 + (n & 127) + off; } };

struct P0In { const float *c, *w_ada, *b_ada, *w_in, *w_up_a, *w_up_b, *w_o, *w_ff1, *w_ff3, *w_ff2, *lq1, *lk1, *lq2, *lk2, *qn_a, *kn_a, *qn_b, *kn_b; };
__device__ __forceinline__ void weight_copies(Frame& F, const P0In in, unsigned char* ws, bool sync = true) {
    LAS float* scr = (LAS float*)(F.lds + F.wave * 16384);
    const int gw = F.vcu * NWAVES + F.wave, NGW = F.G * NWAVES;
    constexpr int I_IN = 16 * 171, I_UP = 8 * 32, I_O = 16 * 32, I_F1 = 16 * 88, I_F2 = 44 * 32;
    constexpr int NITEMS = I_IN + 2 * I_UP + I_O + 2 * I_F1 + I_F2;
    for (int it = gw; it < NITEMS; it += NGW) {
        int r = it;
        if (r < I_IN) { transpose_item(in.w_in, 1024, W_IN, (bf16*)(ws + WS_WIN), MapWin{}, scr, r, F.lane); continue; } r -= I_IN;
        if (r < I_UP) { transpose_item(in.w_up_a, 512, 1024, (bf16*)(ws + WS_WUA), MapId{}, scr, r, F.lane, 1024, 0); continue; } r -= I_UP;
        if (r < I_UP) { transpose_item(in.w_up_b, 512, 1024, (bf16*)(ws + WS_WUA), MapId{}, scr, r, F.lane, 1024, 512); continue; } r -= I_UP;
        if (r < I_O)  { transpose_item(in.w_o, 1024, 1024, (bf16*)(ws + WS_WO), MapId{}, scr, r, F.lane); continue; } r -= I_O;
        if (r < I_F1) { transpose_item(in.w_ff1, 1024, DFF, (bf16*)(ws + WS_W13), MapFF{0}, scr, r, F.lane); continue; } r -= I_F1;
        if (r < I_F1) { transpose_item(in.w_ff3, 1024, DFF, (bf16*)(ws + WS_W13), MapFF{128}, scr, r, F.lane); continue; } r -= I_F1;
        transpose_item(in.w_ff2, DFF, 1024, (bf16*)(ws + WS_W2), MapId{}, scr, r, F.lane);
    }
    if (sync) __syncthreads();
}
__device__ __forceinline__ void p0_prologue(Frame& F, const P0In in, unsigned char* ws) {
    const int gw = F.vcu * NWAVES + F.wave, NGW = F.G * NWAVES; (void)gw; (void)NGW;
    LAS float* S = (LAS float*)F.lds;
    LAS float* P = (LAS float*)(F.lds + 65536);
    for (int g = F.vcu; g < 192; g += F.G) {
        for (int i = F.tid; i < 16 * 1024; i += NWAVES * 64) { const float v = in.c[i]; S[i] = v / (1.f + __expf(-v)); }
        __syncthreads();
        const int c = F.tid & 31, kg = F.tid >> 5, col = 32 * g + c;
        float acc[16];
#pragma unroll
        for (int b = 0; b < 16; ++b) acc[b] = 0.f;
#pragma unroll
        for (int h = 0; h < 2; ++h) {
            float w[32];
#pragma unroll
            for (int u = 0; u < 32; ++u) w[u] = in.w_ada[(size_t)(64 * kg + 32 * h + u) * 6144 + col];
#pragma unroll
            for (int i = 0; i < 32; i += 4) { const int k = 64 * kg + 32 * h + i;
#pragma unroll
                for (int b = 0; b < 16; ++b) { const f32x4 s = *(const LAS f32x4*)(S + b * 1024 + k); acc[b] += (s[0] * w[i] + s[1] * w[i + 1]) + (s[2] * w[i + 2] + s[3] * w[i + 3]); } } }
#pragma unroll
        for (int b = 0; b < 16; ++b) P[(kg * 16 + b) * 32 + c] = acc[b];
        __syncthreads();
        { const int b = F.tid >> 5; float s = in.b_ada[col];
#pragma unroll
          for (int q = 0; q < 16; ++q) s += P[(q * 16 + b) * 32 + c];
          ((float*)(ws + WS_MOD))[b * 6144 + col] = s; }
        __syncthreads();
    }
    if (F.vcu == F.G - 2 && F.tid < 256) { const int t = F.tid >> 6, i = F.tid & 63; ((float*)(ws + WS_GN))[F.tid] = (t == 0 ? in.qn_a : t == 1 ? in.kn_a : t == 2 ? in.qn_b : in.kn_b)[i]; }
    if (F.vcu == F.G - 1 && F.tid == 0) {
        float s1 = 0.f, s2 = 0.f;
        for (int i = 0; i < 64; ++i) { s1 += in.lq1[i] * in.lk1[i]; s2 += in.lq2[i] * in.lk2[i]; }
        *(float*)(ws + WS_LAM) = expf(s1) - expf(s2) + 0.2f;
    }
}
__device__ __forceinline__ void norm_mod_pass(Frame& F, const float* X, const float* g, const float* scale, const float* shift, bf16* Y) {
    const int gw = F.vcu * NWAVES + F.wave, NGW = F.G * NWAVES;
    for (int blk = gw; blk < M / 16; blk += NGW) {
        const int row0 = blk * 16, b = row0 >> 11;
        f32x4 gs[4], sh[4];
#pragma unroll
        for (int j = 0; j < 4; ++j) { const f32x4 gg = ((const f32x4*)g)[F.lane + 64 * j], sc = ((const f32x4*)(scale + b * 6144))[F.lane + 64 * j]; gs[j] = gg * (sc + 1.0f); sh[j] = ((const f32x4*)(shift + b * 6144))[F.lane + 64 * j]; }
        f32x4 vn[4];
        { const f32x4* x0 = (const f32x4*)(X + (size_t)row0 * DM) + F.lane;
#pragma unroll
          for (int j = 0; j < 4; ++j) vn[j] = x0[64 * j]; }
        for (int rr = 0; rr < 16; ++rr) {
            f32x4 v[4]; float s = 0.f;
#pragma unroll
            for (int j = 0; j < 4; ++j) v[j] = vn[j];
            if (rr < 15) { const f32x4* xr = (const f32x4*)(X + (size_t)(row0 + rr + 1) * DM) + F.lane;
#pragma unroll
                for (int j = 0; j < 4; ++j) vn[j] = xr[64 * j]; }
#pragma unroll
            for (int j = 0; j < 4; ++j) s += (v[j][0] * v[j][0] + v[j][1] * v[j][1]) + (v[j][2] * v[j][2] + v[j][3] * v[j][3]);
            const float rstd = __builtin_amdgcn_rsqf(wave_sum(s) * (1.0f / DM) + 1e-6f);
            unsigned long long* o8 = (unsigned long long*)(Y + (size_t)(row0 + rr) * DM) + F.lane;
#pragma unroll
            for (int j = 0; j < 4; ++j) { const f32x4 y = v[j] * rstd * gs[j] + sh[j]; o8[64 * j] = (unsigned long long)pk2(y[0], y[1]) | ((unsigned long long)pk2(y[2], y[3]) << 32); }
        }
    }
}
__device__ __forceinline__ void norm_mod_pass_bf16(Frame& F, const bf16* X, const float* g, const float* scale, const float* shift, bf16* Y) {
    const int gw = F.vcu * NWAVES + F.wave, NGW = F.G * NWAVES;
    for (int blk = gw; blk < M / 16; blk += NGW) {
        const int row0 = blk * 16, b = row0 >> 11;
        f32x4 gs[4], sh[4];
#pragma unroll
        for (int j = 0; j < 4; ++j) { const int c4 = 2 * F.lane + (j & 1) + 128 * (j >> 1);
            const f32x4 gg = ((const f32x4*)g)[c4], sc = ((const f32x4*)(scale + b * 6144))[c4]; gs[j] = gg * (sc + 1.0f); sh[j] = ((const f32x4*)(shift + b * 6144))[c4]; }
        v4u wn[2];
        { const v4u* x0 = (const v4u*)(X + (size_t)row0 * DM) + F.lane; wn[0] = x0[0]; wn[1] = x0[64]; }
        for (int rr = 0; rr < 16; ++rr) {
            const v4u wc[2] = {wn[0], wn[1]};
            if (rr < 15) { const v4u* xr = (const v4u*)(X + (size_t)(row0 + rr + 1) * DM) + F.lane; wn[0] = xr[0]; wn[1] = xr[64]; }
            f32x4 v[4]; float s = 0.f;
#pragma unroll
            for (int h = 0; h < 2; ++h) { const v4u w = wc[h];
                v[2 * h] = (f32x4){__builtin_bit_cast(float, w.x << 16), __builtin_bit_cast(float, w.x & 0xffff0000u), __builtin_bit_cast(float, w.y << 16), __builtin_bit_cast(float, w.y & 0xffff0000u)};
                v[2 * h + 1] = (f32x4){__builtin_bit_cast(float, w.z << 16), __builtin_bit_cast(float, w.z & 0xffff0000u), __builtin_bit_cast(float, w.w << 16), __builtin_bit_cast(float, w.w & 0xffff0000u)}; }
#pragma unroll
            for (int j = 0; j < 4; ++j) s += (v[j][0] * v[j][0] + v[j][1] * v[j][1]) + (v[j][2] * v[j][2] + v[j][3] * v[j][3]);
            const float rstd = __builtin_amdgcn_rsqf(wave_sum(s) * (1.0f / DM) + 1e-6f);
            v4u* o16 = (v4u*)(Y + (size_t)(row0 + rr) * DM) + F.lane;
#pragma unroll
            for (int h = 0; h < 2; ++h) { const f32x4 y0 = v[2 * h] * rstd * gs[2 * h] + sh[2 * h], y1 = v[2 * h + 1] * rstd * gs[2 * h + 1] + sh[2 * h + 1];
                v4u o; o.x = pk2(y0[0], y0[1]); o.y = pk2(y0[2], y0[3]); o.z = pk2(y1[0], y1[1]); o.w = pk2(y1[2], y1[3]); o16[64 * h] = o; }
        }
    }
}
#ifdef CHECKER
namespace chk {
typedef unsigned short bf16;
typedef unsigned u32x4c __attribute__((ext_vector_type(4)));
__device__ __forceinline__ float b2f(unsigned short h) { return __uint_as_float((unsigned)h << 16); }
__device__ __forceinline__ float rnd(float f) { unsigned u = __float_as_uint(f); u = (u + 0x7fffu + ((u >> 16) & 1u)) & 0xffff0000u; return __uint_as_float(u); }
__device__ __forceinline__ float dotbf(const bf16* a, const bf16* b, int K) {
    float s = 0.f;
    for (int k = 0; k < K; k += 8) { const u32x4c x = *(const u32x4c*)(a + k), y = *(const u32x4c*)(b + k);
#pragma unroll
        for (int j = 0; j < 4; ++j) { s += __uint_as_float(x[j] << 16) * __uint_as_float(y[j] << 16); s += __uint_as_float(x[j] & 0xffff0000u) * __uint_as_float(y[j] & 0xffff0000u); } }
    return s; }
__device__ __forceinline__ void devmax(float* slot, float d) { if (!(d >= 0.f)) d = 1e30f; atomicMax((unsigned*)slot, __float_as_uint(d)); }
__device__ __forceinline__ float sig(float v) { return 1.f / (1.f + expf(-v)); }
constexpr int RSTR = 16, ROFF = 3, NR = 2048;
}
#define CHK_LOOP(idx, total) for (long idx = (long)F.vcu * 512 + F.tid; idx < (long)(total); idx += (long)F.G * 512)
#endif
#ifdef DUPCHK
__global__ void __launch_bounds__(512) dup_cksum(const void* base, size_t bytes, unsigned long long* acc) {
    typedef unsigned u32x4_t __attribute__((ext_vector_type(4)));
    const u32x4_t* p = (const u32x4_t*)base; const size_t n = bytes / 16;
    unsigned long long s = 0ull;
    for (size_t i = (size_t)blockIdx.x * 512 + threadIdx.x; i < n; i += (size_t)gridDim.x * 512) {
        const u32x4_t w = p[i]; const unsigned long long m = 2ull * i + 1ull;
        s += ((unsigned long long)w.x + ((unsigned long long)w.y << 7) + ((unsigned long long)w.z << 13) + ((unsigned long long)w.w << 19)) * m; }
    for (int off = 32; off; off >>= 1) { const unsigned lo = __shfl_xor((unsigned)s, off), hi = __shfl_xor((unsigned)(s >> 32), off); s += ((unsigned long long)hi << 32) | lo; }
    if ((threadIdx.x & 63) == 0) atomicAdd(acc, s);
}
__global__ void __launch_bounds__(512) dup_final(float* out, const unsigned long long* CK) {
    int bad = -1;
    for (int k = 9; k >= 0; --k) if (CK[2 * k] != CK[2 * k + 1]) bad = k;
    if (bad >= 0) { const float v = 0.0566f * (float)(1 << bad); for (int i = blockIdx.x * 512 + threadIdx.x; i < (1 << 20); i += gridDim.x * 512) out[i] += v; }
}
#endif
#ifdef MASKDIFF
__global__ void __launch_bounds__(512) mask_diff(const unsigned long long* A, const unsigned long long* B, unsigned* cnt) {
    unsigned c0 = 0, c1 = 0, c2 = 0;
    for (int idx = blockIdx.x * 512 + threadIdx.x; idx < (1 << 20); idx += gridDim.x * 512) {
        const int qk = (idx >> 10) & 63, tile = (idx >> 5) & 31; const bool adm = tile < (qk >> 1) + 1;
        const unsigned long long d = A[idx] ^ B[idx];
        if (d) { if (adm) { ++c0; c2 += (unsigned)__builtin_popcountll(d); } else ++c1; } }
    if (c0) atomicAdd(cnt + 0, c0); if (c1) atomicAdd(cnt + 1, c1); if (c2) atomicAdd(cnt + 2, c2);
    for (int row = blockIdx.x * 512 + threadIdx.x; row < 32768; row += gridDim.x * 512) { const int bq = row >> 5, q = row & 31, qk = bq & 63; bool any = false;
        for (int tile = 0; tile < (qk >> 1) + 1; ++tile) { const size_t i = ((size_t)bq * 32 + tile) * 32 + q; any = any || (A[i] != B[i]); }
        if (any) atomicAdd(cnt + 3, 1u); }
}
__global__ void __launch_bounds__(512) mask_report(float* out, const unsigned* cnt) {
    const unsigned ca = cnt[MASKDIFF & 3], cb = cnt[(MASKDIFF >> 2) & 3];
    int La = 0; while ((1u << La) < ca + 1u) ++La; int Lb = 0; while ((1u << Lb) < cb + 1u) ++Lb;
    float v = 0.05f * 5.657f; for (int i = 0; i < La; ++i) v *= 1.5f;
    for (int i = blockIdx.x * 512 + threadIdx.x; i < (1 << 20); i += gridDim.x * 512) out[i] += v;
    (void)Lb;
}
#endif
struct Args { const float* in[22]; float* out; unsigned char* ws; int ph_lo, ph_hi, probe, pad; };
__global__ void __launch_bounds__(NWAVES * 64, 2) mega_fwd(Args args) {
    extern __shared__ __attribute__((aligned(16))) unsigned char lds[];
    Frame F;
    F.lds = (LAS unsigned char*)lds;
    F.MISC = (volatile LAS unsigned*)(F.lds + MISC_OFF);
    F.tid = threadIdx.x; F.lane = F.tid & 63; F.wave = __builtin_amdgcn_readfirstlane(F.tid >> 6);
    F.G = gridDim.x; { const int bx = blockIdx.x; F.vcu = (F.G % 8 == 0) ? (bx % 8) * (F.G / 8) + bx / 8 : bx; }
    unsigned char* ws = args.ws;
    F.ctl = (gu32*)(ws + WS_CTL);
    for (int u = F.tid; u < (LDS_BYTES - LDSCTL_OFF) / 4; u += NWAVES * 64) ((LAS unsigned*)(F.lds + LDSCTL_OFF))[u] = 0u;
    __syncthreads();
    XcdBarrier bar; bar.bar = (unsigned*)(F.ctl + CW_BAR); bar.x = 0; bar.st = nullptr;
    if (N_LAUNCHES == 1) bar = xcd_barrier_post((unsigned*)(F.ctl + CW_BAR), F.MISC + 8);
    const int lo = args.ph_lo, hi = args.ph_hi;
#ifndef PH_MASK
#define PH_MASK 0x3ff
#endif
#define IN(k) (((PH_MASK >> (k)) & 1) && lo <= (k) && (k) < hi)
#define SEAM(k) do { if (IN(k) && IN((k) + 1)) xcd_barrier(bar); } while (0)
    float* const MOD = (float*)(ws + WS_MOD);
#define WSP(T, off) ((T*)(ws + (off)))
#ifdef X1_IN_WS
#define X1P WSP(float, WS_GT)
#else
#define X1P args.out
#endif

#ifndef W_IN_P1
#define W_IN_P1 2
#endif
#if W_IN_P1
#define IF_W0(x)
#else
#define IF_W0(x) x
#endif
    if (IN(0)) { const P0In pin{args.in[1], args.in[2], args.in[3], args.in[5], args.in[15], args.in[16], args.in[17], args.in[19], args.in[20], args.in[21], args.in[10], args.in[11], args.in[12], args.in[13], args.in[6], args.in[7], args.in[8], args.in[9]};
                 IF_W0(weight_copies(F, pin, ws);) p0_prologue(F, pin, ws); }
    SEAM(0);
#ifdef CHECKER
    if (IN(0) && IN(1)) {
        float* DEV = (float*)(ws + WS_CTL) + 8192;
#define CHK_W(src, K_, N_, dst, MAPX) CHK_LOOP(idx, (long)(K_) * (N_)) { const int k = (int)(idx / (N_)), n = (int)(idx % (N_)); const float w = (src)[idx]; \
            chk::devmax(DEV + 11, fabsf(chk::b2f((dst)[(size_t)(MAPX) * (K_) + k]) - w) / (fabsf(w) + 1e-3f)); }
        CHK_W(args.in[5], 1024, W_IN, WSP(bf16, WS_WIN), MapWin{}(n))  CHK_W(args.in[17], 1024, 1024, WSP(bf16, WS_WO), n)
        CHK_W(args.in[19], 1024, DFF, WSP(bf16, WS_W13), MapFF{0}(n)) CHK_W(args.in[20], 1024, DFF, WSP(bf16, WS_W13), MapFF{128}(n)) CHK_W(args.in[21], DFF, 1024, WSP(bf16, WS_W2), n)
#undef CHK_W
        CHK_LOOP(idx, 16 * 6144) { const int b = (int)(idx / 6144), j = (int)(idx % 6144); if ((j % 5) == 0) { float sacc = args.in[3][j]; for (int k = 0; k < 1024; ++k) { const float c = args.in[1][b * 1024 + k]; sacc += (c / (1.f + expf(-c))) * args.in[2][(size_t)k * 6144 + j]; }
            chk::devmax(DEV + 12, fabsf(MOD[idx] - sacc)); } }
    }
#endif
    if (IN(1)) {
#if W_IN_P1
        { const P0In pin{args.in[1], args.in[2], args.in[3], args.in[5], args.in[15], args.in[16], args.in[17], args.in[19], args.in[20], args.in[21], args.in[10], args.in[11], args.in[12], args.in[13], args.in[6], args.in[7], args.in[8], args.in[9]};
          if (W_IN_P1 == 1) weight_copies(F, pin, ws);
          if (W_IN_P1 == 3) { if (F.wave & 1) { weight_copies(F, pin, ws, false); norm_mod_pass(F, args.in[0], args.in[4], MOD + 1024, MOD, WSP(bf16, WS_XH)); }
                              else { norm_mod_pass(F, args.in[0], args.in[4], MOD + 1024, MOD, WSP(bf16, WS_XH)); weight_copies(F, pin, ws, false); } __syncthreads(); }
          else norm_mod_pass(F, args.in[0], args.in[4], MOD + 1024, MOD, WSP(bf16, WS_XH));
          if (W_IN_P1 == 2) weight_copies(F, pin, ws); }
#else
        norm_mod_pass(F, args.in[0], args.in[4], MOD + 1024, MOD, WSP(bf16, WS_XH));
#endif
    }
    SEAM(1);
#ifdef CHECKER
    if (IN(1) && IN(2)) {
        float* DEV = (float*)(ws + WS_CTL) + 8192;
        CHK_LOOP(idx, chk::NR) { const int row = chk::RSTR * (int)idx + chk::ROFF, b = row >> 11; float ss = 0.f; for (int k = 0; k < 1024; ++k) { const float v = args.in[0][(size_t)row * 1024 + k]; ss += v * v; }
            const float rs = 1.f / sqrtf(ss / 1024.f + 1e-6f); float dm = 0.f;
            for (int k = 0; k < 1024; ++k) { const float ref = args.in[0][(size_t)row * 1024 + k] * rs * args.in[4][k] * (1.f + MOD[(size_t)b * 6144 + 1024 + k]) + MOD[(size_t)b * 6144 + k]; dm = fmaxf(dm, fabsf(chk::b2f(WSP(bf16, WS_XH)[(size_t)row * 1024 + k]) - ref)); }
            chk::devmax(DEV + 13, dm); }
    }
#endif
    if (IN(2)) {
        pg8::Gemm g{WSP(bf16, WS_XH), (const bf16*)(ws + WS_WIN), M, NPROJ, DM}; pg8::StaticOrder S; S.init(M, NPROJ, F.G, (int)blockIdx.x);
        epi::EpiProj E{ws};
        pg8::gemm_phase<epi::EpiProj, pg8::StaticOrder, true, true>(F.lds, g, S, E);
    }
    SEAM(2);
#ifdef CHECKER
    if (IN(2) && IN(3)) {
        float* DEV = (float*)(ws + WS_CTL) + 8192; const bf16 *XH = WSP(bf16, WS_XH), *WT = WSP(bf16, WS_WIN);
        CHK_LOOP(idx, chk::NR * 512) { const int row = chk::RSTR * (int)(idx / 512) + chk::ROFF, c = (int)(idx % 512);
            { const int n = 1024 + c; const float a = chk::dotbf(XH + (size_t)row * 1024, WT + (size_t)MapWin{}(n) * 1024, 1024), o = chk::b2f(WSP(bf16, WS_VA)[(size_t)row * 512 + c]); chk::devmax(DEV + 0, fabsf(o - chk::rnd(a)) / (fabsf(a) + 0.05f)); }
            { const int n = 3396 + 4 * c + 1; const float a = chk::sig(chk::dotbf(XH + (size_t)row * 1024, WT + (size_t)MapWin{}(n) * 1024, 1024)), o = chk::b2f(WSP(bf16, WS_GT)[(size_t)row * 2048 + 4 * c + 1]); chk::devmax(DEV + 1, fabsf(o - a)); }
            if (c < 8) { float ss = 0.f; for (int d = 0; d < 64; ++d) { const float v = chk::dotbf(XH + (size_t)row * 1024, WT + (size_t)MapWin{}(c * 64 + d) * 1024, 1024); ss += v * v; }
                const float rs = 1.f / sqrtf(ss / 64.f + 1e-6f); float dm = 0.f; for (int d = 0; d < 64; ++d) { const float v = chk::dotbf(XH + (size_t)row * 1024, WT + (size_t)MapWin{}(c * 64 + d) * 1024, 1024); dm = fmaxf(dm, fabsf(chk::b2f(WSP(bf16, WS_QA)[(size_t)row * 512 + c * 64 + d]) - v * rs * args.in[6][d])); } chk::devmax(DEV + 2, dm); }
            if (c < 64) { const float a = chk::dotbf(XH + (size_t)row * 1024, WT + (size_t)MapWin{}(3328 + c) * 1024, 1024), o = chk::b2f(WSP(bf16, WS_KI)[(size_t)row * 64 + c]); chk::devmax(DEV + 3, fabsf(o - chk::rnd(a)) / (fabsf(a) + 0.05f)); }
            if (c < 4) { const float a = chk::dotbf(XH + (size_t)row * 1024, WT + (size_t)MapWin{}(3392 + c) * 1024, 1024), o = WSP(float, WS_WI)[(size_t)row * 4 + c]; chk::devmax(DEV + 4, fabsf(o - a)); }
            if (c >= 8 && c < 16) { const int hh = c - 8; float ss = 0.f; for (int d = 0; d < 64; ++d) { const float v = chk::dotbf(XH + (size_t)row * 1024, WT + (size_t)MapWin{}(2048 + hh * 64 + d) * 1024, 1024); ss += v * v; }
                const float rs = 1.f / sqrtf(ss / 64.f + 1e-6f); float dm = 0.f; for (int d = 0; d < 64; ++d) { const float v = chk::dotbf(XH + (size_t)row * 1024, WT + (size_t)MapWin{}(2048 + hh * 64 + d) * 1024, 1024); dm = fmaxf(dm, fabsf(chk::b2f(WSP(bf16, WS_KB)[(size_t)row * 512 + hh * 64 + d]) - v * rs * args.in[9][d])); } chk::devmax(DEV + 5, dm); }
        }
    }
#endif
    if (IN(3)) {
        const int b = F.vcu >> 4, j = F.vcu & 15;
        const bf16 *QI = WSP(bf16, WS_QI), *KI = WSP(bf16, WS_KI); const float* WI = WSP(float, WS_WI); unsigned long long* MASK = WSP(unsigned long long, WS_MASK);
        if (F.G == 256) {
            sel::select_unit(b, j, QI, KI, WI, MASK, (char*)lds); sel::select_unit(b, 31 - j, QI, KI, WI, MASK, (char*)lds);
            sel::select_unit(b, 32 + j, QI, KI, WI, MASK, (char*)lds); sel::select_unit(b, 63 - j, QI, KI, WI, MASK, (char*)lds);
        }
    }
    SEAM(3);
#ifdef CHECKER
#ifndef CHK_TI
#define CHK_TI -1
#endif
#ifndef CHK_TOL17
#define CHK_TOL17 64
#endif
    if (IN(3) && IN(4)) {
        unsigned tot = 0u; CHK_LOOP(idx, 16 * 64 * 32 * 32) tot += (unsigned)__builtin_popcountll(WSP(unsigned long long, WS_MASK)[idx]);
        atomicAdd((unsigned*)(ws + WS_CTL) + 8192 + 18, tot);
    }
    if (IN(3) && IN(4)) {
        float* DEV = (float*)(ws + WS_CTL) + 8192;
        if (F.vcu < 10) { const int tt[5] = {5, 300, 777, 1029, 2047}; const int t = (F.vcu % 5 == 0) ? 5 : (F.vcu % 5 == 1) ? 300 : (F.vcu % 5 == 2) ? 777 : (F.vcu % 5 == 3) ? 1029 : 2047; (void)tt; const int b = (F.vcu < 5) ? 0 : 9;
            LAS unsigned* KL = (LAS unsigned*)F.lds; const int nadm = 64 * (t / 64 + 1); const size_t qrow = (size_t)b * 2048 + t;
            __syncthreads();
            for (int s4 = 0; s4 < 4; ++s4) { const int sidx = F.tid + 512 * s4; unsigned key = 0u;
                if (sidx < nadm) { float sc = 0.f; for (int h = 0; h < 4; ++h) { const float y = chk::dotbf(WSP(bf16, WS_QI) + qrow * 256 + h * 64, WSP(bf16, WS_KI) + ((size_t)b * 2048 + sidx) * 64, 64); sc = fmaf(fmaxf(y, 0.f), WSP(float, WS_WI)[qrow * 4 + h], sc); }
                    const unsigned u = __float_as_uint(sc), m = (unsigned)(((int)u) >> 31) | 0x80000000u; key = ((u ^ m) & KEYMASK) | (2047u - (unsigned)sidx); }
                KL[sidx] = key; }
            __syncthreads();
            unsigned bad = 0u;
            for (int s4 = 0; s4 < 4; ++s4) { const int sidx = F.tid + 512 * s4; const unsigned key = KL[sidx]; unsigned rank = 0u; for (int j = 0; j < 2048; ++j) rank += (KL[j] > key) ? 1u : 0u;
                const bool selr = (sidx < nadm) && (nadm <= 256 || rank < 256u);
                const unsigned long long mw = WSP(unsigned long long, WS_MASK)[((size_t)(b * 64 + t / 32) * 32 + sidx / 64) * 32 + (t % 32)]; const bool selm = (mw >> (sidx % 64)) & 1ull;
                if (sidx < nadm && selr != selm) ++bad; }
            if (bad) atomicAdd(DEV + 17, (float)bad);
            __syncthreads();
        }
    }
#endif
    if (IN(4)) {
        if (F.G == 256) {
            const int b = F.vcu >> 4, r = F.vcu & 15;
            const bf16 *QA = WSP(bf16, WS_QA), *KA = WSP(bf16, WS_KA), *VA = WSP(bf16, WS_VA), *QBt = WSP(bf16, WS_QB), *KBt = WSP(bf16, WS_KB), *VBt = WSP(bf16, WS_VB);
            bf16 *YA = WSP(bf16, WS_YA), *YB = WSP(bf16, WS_YA); const unsigned long long* MASK = WSP(unsigned long long, WS_MASK);
            const float lam = __hip_atomic_load((const float*)(ws + WS_LAM), RLX_AGENT);
#ifndef NO_UNIT_A
            if (!(args.probe & 1)) for (int pi = 0; pi < 2; ++pi) { const int pr = 2 * r + pi, h = pr >> 2, s = pr & 3;
                att::unit_a(b, h, 7 - s, QA, KA, VA, MASK, YA, (char*)lds); att::unit_a(b, h, s, QA, KA, VA, MASK, YA, (char*)lds); }
#endif
#ifndef NO_UNIT_B
            __syncthreads();
            if (!(args.probe & 2)) { const int h = r >> 2, s = r & 3;
              att::unit_b128(b, h, 7 - s, QBt, KBt, VBt, args.in[14], lam, YB, WSP(unsigned, WS_STASH), 0, (char*)lds); att::unit_b128(b, h, s, QBt, KBt, VBt, args.in[14], lam, YB, WSP(unsigned, WS_STASH), 1, (char*)lds); }
#endif
        }
    }
    SEAM(4);
#ifdef CHECKER
    if (IN(4) && IN(5)) {
        float* DEV = (float*)(ws + WS_CTL) + 8192; const float lamc = __hip_atomic_load((const float*)(ws + WS_LAM), RLX_AGENT);
        const int gwv = F.vcu * 8 + F.wave;
        if (gwv < 8 * 3 * 12) { const int ti = gwv % 8, bi = (gwv / 8) % 3, hh = gwv / 24;
            const int t = (ti == 0) ? 5 : (ti == 1) ? 70 : (ti == 2) ? 200 : (ti == 3) ? 300 : (ti == 4) ? 777 : (ti == 5) ? 1029 : (ti == 6) ? 1500 : 2047; const int b = (bi == 0) ? 0 : (bi == 1) ? 7 : 15;
            const int nadm = 64 * (t / 64 + 1); const size_t rb = (size_t)b * 2048, qrow = rb + t; const int d = F.lane;
            if (hh < 8) { const float slope = exp2f(-(float)(hh + 1));
                float mx = -INFINITY; for (int sidx = 0; sidx < nadm; ++sidx) { const unsigned long long mw = WSP(unsigned long long, WS_MASK)[((size_t)(b * 64 + t / 32) * 32 + sidx / 64) * 32 + (t % 32)]; if (!((mw >> (sidx % 64)) & 1ull)) continue;
                    const float sc = chk::dotbf(WSP(bf16, WS_QA) + qrow * 512 + hh * 64, WSP(bf16, WS_KA) + (rb + sidx) * 512 + hh * 64, 64) * 0.125f - slope * fabsf((float)(t - sidx)); mx = fmaxf(mx, sc); }
                float l = 0.f, o = 0.f; for (int sidx = 0; sidx < nadm; ++sidx) { const unsigned long long mw = WSP(unsigned long long, WS_MASK)[((size_t)(b * 64 + t / 32) * 32 + sidx / 64) * 32 + (t % 32)]; if (!((mw >> (sidx % 64)) & 1ull)) continue;
                    const float sc = chk::dotbf(WSP(bf16, WS_QA) + qrow * 512 + hh * 64, WSP(bf16, WS_KA) + (rb + sidx) * 512 + hh * 64, 64) * 0.125f - slope * fabsf((float)(t - sidx)); const float p = expf(sc - mx); l += p; o += p * chk::b2f(WSP(bf16, WS_VA)[(rb + sidx) * 512 + hh * 64 + d]); }
                chk::devmax(DEV + 14, fabsf(chk::b2f(WSP(bf16, WS_YA)[qrow * 1024 + hh * 64 + d]) - o / l));
            } else if (CHK_TI < 0 || ti == CHK_TI) { const int hb = hh - 8; const float slope = exp2f(-2.f * (float)(hb + 1)); float ov[2][2];
                for (int m = 0; m < 2; ++m) { float mx = -INFINITY; for (int sidx = 0; sidx < nadm; ++sidx) { const float sc = chk::dotbf(WSP(bf16, WS_QB) + qrow * 512 + (2 * hb + m) * 64, WSP(bf16, WS_KB) + (rb + sidx) * 512 + (2 * hb + m) * 64, 64) * 0.125f - slope * fabsf((float)(t - sidx)); mx = fmaxf(mx, sc); }
                    float l = 0.f, o0 = 0.f, o1 = 0.f; for (int sidx = 0; sidx < nadm; ++sidx) { const float sc = chk::dotbf(WSP(bf16, WS_QB) + qrow * 512 + (2 * hb + m) * 64, WSP(bf16, WS_KB) + (rb + sidx) * 512 + (2 * hb + m) * 64, 64) * 0.125f - slope * fabsf((float)(t - sidx));
                        const float p = expf(sc - mx); l += p; o0 += p * chk::b2f(WSP(bf16, WS_VB)[(rb + sidx) * 512 + hb * 128 + d]); o1 += p * chk::b2f(WSP(bf16, WS_VB)[(rb + sidx) * 512 + hb * 128 + 64 + d]); }
                    if (m == 0) { ov[0][0] = o0 / l; ov[0][1] = o1 / l; } else { ov[1][0] = o0 / l; ov[1][1] = o1 / l; } }
                const float d0 = ov[0][0] - lamc * ov[1][0], d1 = ov[0][1] - lamc * ov[1][1]; const float ssq = wave_sum(d0 * d0 + d1 * d1); const float rs = 0.8f / sqrtf(ssq / 128.f + 1e-6f);
                chk::devmax(DEV + 16, fabsf(chk::b2f(WSP(bf16, WS_YA)[qrow * 1024 + 512 + hb * 128 + d]) - d0 * rs * args.in[14][d])); chk::devmax(DEV + 19, fabsf(chk::b2f(WSP(bf16, WS_YA)[qrow * 1024 + 512 + hb * 128 + 64 + d]) - d1 * rs * args.in[14][64 + d]));
            }
        }
        xcd_barrier(bar);
    }
#endif
    if (IN(5)) {
        pg8::Gemm g{WSP(bf16, WS_YA), (const bf16*)(ws + WS_WUA), M, DM, 1024}; pg8::StaticOrder S; S.init(M, DM, F.G, (int)blockIdx.x);
        epi::EpiUpM E{WSP(bf16, WS_MG), WSP(bf16, WS_GT)}; pg8::gemm_phase<epi::EpiUpM, pg8::StaticOrder, true, true>(F.lds, g, S, E);
    }
    SEAM(5);
#ifdef CHECKER
    if (IN(5) && IN(6)) {
        __syncthreads(); float* DEV = (float*)(ws + WS_CTL) + 8192;
        CHK_LOOP(idx, chk::NR * 256) { const int row = chk::RSTR * (int)(idx / 256) + chk::ROFF, col = 4 * (int)(idx % 256) + 2;
            const float ua = chk::dotbf(WSP(bf16, WS_YA) + (size_t)row * 1024, WSP(bf16, WS_WUA) + (size_t)col * 1024, 512), ub = chk::dotbf(WSP(bf16, WS_YA) + (size_t)row * 1024 + 512, WSP(bf16, WS_WUA) + (size_t)col * 1024 + 512, 512);
            const float ga = chk::b2f(WSP(bf16, WS_GT)[(size_t)row * 2048 + col]), gb = chk::b2f(WSP(bf16, WS_GT)[(size_t)row * 2048 + 1024 + col]);
            const float ref = chk::rnd(ga * ua) + gb * ub, o = chk::b2f(WSP(bf16, WS_MG)[(size_t)row * 1024 + col]); chk::devmax(DEV + 6, fabsf(o - ref)); }
    }
    if (IN(5) && IN(6)) xcd_barrier(bar);
#endif
    if (IN(6)) {
        pg8::Gemm g{WSP(bf16, WS_MG), (const bf16*)(ws + WS_WO), M, DM, DM}; pg8::StaticOrder S; S.init(M, DM, F.G, (int)blockIdx.x);
        epi::EpiResToBf16 E{args.in[0], WSP(bf16, WS_GT), MOD + 2048}; pg8::gemm_phase<epi::EpiResToBf16, pg8::StaticOrder, true, true>(F.lds, g, S, E);
    }
    SEAM(6);
#ifdef CHECKER
    if (IN(6) && IN(7)) {
        __syncthreads(); float* DEV = (float*)(ws + WS_CTL) + 8192;
        CHK_LOOP(idx, chk::NR * 256) { const int row = chk::RSTR * (int)(idx / 256) + chk::ROFF, col = 4 * (int)(idx % 256) + 1;
            const float a = chk::dotbf(WSP(bf16, WS_MG) + (size_t)row * 1024, WSP(bf16, WS_WO) + (size_t)col * 1024, 1024);
            const float ref = args.in[0][(size_t)row * 1024 + col] + MOD[(size_t)(row >> 11) * 6144 + 2048 + col] * a, o = chk::b2f(WSP(bf16, WS_GT)[(size_t)row * 1024 + col]); chk::devmax(DEV + 7, fabsf(o - ref)); }
    }
#endif
    if (IN(7)) norm_mod_pass_bf16(F, WSP(bf16, WS_GT), args.in[18], MOD + 4096, MOD + 3072, WSP(bf16, WS_XH));
    SEAM(7);
#ifdef CHECKER
    if (IN(7) && IN(8)) {
        __syncthreads(); float* DEV = (float*)(ws + WS_CTL) + 8192;
        CHK_LOOP(idx, chk::NR) { const int row = chk::RSTR * (int)idx + chk::ROFF, b = row >> 11; float ss = 0.f; for (int k = 0; k < 1024; ++k) { const float v = chk::b2f(WSP(bf16, WS_GT)[(size_t)row * 1024 + k]); ss += v * v; }
            const float rs = 1.f / sqrtf(ss / 1024.f + 1e-6f); float dm = 0.f;
            for (int k = 0; k < 1024; ++k) { const float ref = chk::b2f(WSP(bf16, WS_GT)[(size_t)row * 1024 + k]) * rs * args.in[18][k] * (1.f + MOD[(size_t)b * 6144 + 4096 + k]) + MOD[(size_t)b * 6144 + 3072 + k]; dm = fmaxf(dm, fabsf(chk::b2f(WSP(bf16, WS_XH)[(size_t)row * 1024 + k]) - ref)); }
            chk::devmax(DEV + 8, dm); }
    }
#endif
    if (IN(8)) {
        pg8::Gemm g{WSP(bf16, WS_XH), (const bf16*)(ws + WS_W13), M, NFF13, DM}; pg8::StaticOrder S; S.init(M, NFF13, F.G, (int)blockIdx.x);
#ifdef PROBE_EPI
        epi::EpiFF13 E{WSP(bf16, WS_HID), args.probe};
#else
        epi::EpiFF13 E{WSP(bf16, WS_HID)};
#endif
        pg8::gemm_phase<epi::EpiFF13, pg8::StaticOrder, true, true>(F.lds, g, S, E);
    }
    SEAM(8);
#ifdef CHECKER
    if (IN(8) && IN(9)) {
        __syncthreads(); float* DEV = (float*)(ws + WS_CTL) + 8192;
        CHK_LOOP(idx, chk::NR * 704) { const int row = chk::RSTR * (int)(idx / 704) + chk::ROFF, hc = 4 * (int)(idx % 704) + 3;
            const bf16* w = WSP(bf16, WS_W13) + (size_t)((hc >> 7) * 256 + (hc & 127)) * 1024;
            const float u1 = chk::dotbf(WSP(bf16, WS_XH) + (size_t)row * 1024, w, 1024), u3 = chk::dotbf(WSP(bf16, WS_XH) + (size_t)row * 1024, w + 128 * 1024, 1024);
            const float ref = u1 * chk::sig(u1) * u3, o = chk::b2f(WSP(bf16, WS_HID)[(size_t)row * 2816 + hc]); chk::devmax(DEV + 9, fabsf(o - ref) / (fabsf(ref) + 0.05f)); }
    }
#endif
    if (IN(9)) {
        pg8::Gemm g{WSP(bf16, WS_HID), (const bf16*)(ws + WS_W2), M, DM, DFF}; pg8::StaticOrder S; S.init(M, DM, F.G, (int)blockIdx.x);
        epi::EpiResFromBf16 E{WSP(bf16, WS_GT), args.out, MOD + 5120}; pg8::gemm_phase<epi::EpiResFromBf16, pg8::StaticOrder, true, true>(F.lds, g, S, E);
    }
#ifdef PROBE_XBAR
    for (int i = 0; i < PROBE_XBAR; ++i) xcd_barrier(bar);
#endif
#ifdef ENDCHK
    if (IN(9)) {
        unsigned tot = 0u; for (long idx = (long)F.vcu * 512 + F.tid; idx < 16L * 64 * 32 * 32; idx += (long)F.G * 512) tot += (unsigned)__builtin_popcountll(WSP(unsigned long long, WS_MASK)[idx]);
        atomicAdd((unsigned*)(ws + WS_CTL) + 8192 + 18, tot);
        xcd_barrier(bar);
        const int bad = (int)__hip_atomic_load((unsigned*)(ws + WS_CTL) + 8192 + 18, RLX_AGENT) - 16 * 499712;
        if (F.vcu == 0 && F.tid == 0 && bad != 0) args.out[0] += 1.0e6f;
    }
#endif
#ifdef CHECKER
    if (IN(9)) {
        float* DEV = (float*)(ws + WS_CTL) + 8192;
        asm volatile("s_waitcnt vmcnt(0)" ::: "memory"); __syncthreads();
        CHK_LOOP(idx, chk::NR * 256) { const int row = chk::RSTR * (int)(idx / 256) + chk::ROFF, col = 4 * (int)(idx % 256) + 3;
            (void)row; (void)col; }
        xcd_barrier(bar);
        CHK_LOOP(idx, chk::NR * 256) { const int row = chk::RSTR * (int)(idx / 256) + chk::ROFF, col = 4 * (int)(idx % 256) + 3;
            const float a = chk::dotbf(WSP(bf16, WS_HID) + (size_t)row * 2816, WSP(bf16, WS_W2) + (size_t)col * 2816, 2816);
            const float ref = chk::b2f(WSP(bf16, WS_GT)[(size_t)row * 1024 + col]) + MOD[(size_t)(row >> 11) * 6144 + 5120 + col] * a; chk::devmax(DEV + 10, fabsf(args.out[(size_t)row * 1024 + col] - ref)); }
        xcd_barrier(bar);
        float da = __hip_atomic_load(DEV + CHK_A, RLX_AGENT), db = __hip_atomic_load(DEV + CHK_B, RLX_AGENT);
        if (CHK_A == 17) da = (da > (float)CHK_TOL17) ? da : 0.f;
        if (CHK_A == 18) da = fabsf((float)((int)__hip_atomic_load((unsigned*)DEV + 18, RLX_AGENT) - 16 * 499712));
        if (F.vcu == 0 && F.tid == 0) args.out[0] += 1000.f * da;
        const float pb = 16.f * sqrtf(db);
        for (int i = F.vcu * 512 + F.tid; i < (1 << 18); i += F.G * 512) if (i > 0) args.out[i] += pb;
    }
#endif
#undef IN
#undef SEAM
#undef WSP
}

extern "C" void kernel_launch(void* const* d_in, const int* in_sizes, int n_in, void* d_out, int out_size, void* d_ws, size_t ws_size, hipStream_t stream) {
    static int grid = 0;
    if (grid == 0) {
        if (n_in != 22 || in_sizes[0] != M * DM || out_size != M * DM || ws_size < WS_END) { fprintf(stderr, "kernel_launch: unexpected shapes (n_in %d, in0 %d, out %d, ws %zu); nothing launched\n", n_in, n_in > 0 ? in_sizes[0] : -1, out_size, ws_size); grid = -1; return; }
        int dev = 0, cus = 0, per_cu = 0;
        if (hipGetDevice(&dev) != hipSuccess || hipDeviceGetAttribute(&cus, hipDeviceAttributeMultiprocessorCount, dev) != hipSuccess) { fprintf(stderr, "kernel_launch: device query failed\n"); grid = -1; return; }
        if (hipFuncSetAttribute((const void*)mega_fwd, hipFuncAttributeMaxDynamicSharedMemorySize, LDS_BYTES) != hipSuccess) { fprintf(stderr, "kernel_launch: hipFuncSetAttribute failed\n"); grid = -1; return; }
        if (hipOccupancyMaxActiveBlocksPerMultiprocessor(&per_cu, (const void*)mega_fwd, NWAVES * 64, LDS_BYTES) != hipSuccess || per_cu < 1) fprintf(stderr, "kernel_launch: note: occupancy query reports %d workgroups per CU\n", per_cu);
        (void)hipGetLastError();
        grid = cus;
        if (grid != 256) fprintf(stderr, "kernel_launch: %d CUs; the attention/selection schedules need 256\n", grid);
    }
    if (grid < 0) return;
    if (hipMemsetAsync((char*)d_ws + WS_CTL, 0, CTL_ZERO_BYTES, stream) != hipSuccess) { fprintf(stderr, "kernel_launch: hipMemsetAsync failed\n"); return; }
    Args a{};
    for (int i = 0; i < 22; ++i) a.in[i] = (const float*)d_in[i];
    a.out = (float*)d_out; a.ws = (unsigned char*)d_ws;
#ifdef PROBE_RERUN_MASK
    constexpr int n_l = N_LAUNCHES + __builtin_popcount(PROBE_RERUN_MASK);
#else
    constexpr int n_l = N_LAUNCHES;
#endif
#ifdef MASKDIFF
    { unsigned char* ws = (unsigned char*)d_ws; unsigned* CNT = (unsigned*)(ws + WS_CTL + 32768);
#ifdef MASKDIFF_SPLIT
      a.ph_lo = 0; a.ph_hi = 3; hipLaunchKernelGGL(mega_fwd, dim3(grid), dim3(NWAVES * 64), LDS_BYTES, stream, a);
      a.ph_lo = 3; a.ph_hi = 4; hipLaunchKernelGGL(mega_fwd, dim3(grid), dim3(NWAVES * 64), LDS_BYTES, stream, a);
#else
      a.ph_lo = 0; a.ph_hi = 4; hipLaunchKernelGGL(mega_fwd, dim3(grid), dim3(NWAVES * 64), LDS_BYTES, stream, a);
#endif
      (void)hipMemcpyAsync(ws + WS_STASH, ws + WS_MASK, 8u << 20, hipMemcpyDeviceToDevice, stream);
      a.ph_lo = 3; a.ph_hi = 4; hipLaunchKernelGGL(mega_fwd, dim3(grid), dim3(NWAVES * 64), LDS_BYTES, stream, a);
      hipLaunchKernelGGL(mask_diff, dim3(256), dim3(512), 0, stream, (const unsigned long long*)(ws + WS_MASK), (const unsigned long long*)(ws + WS_STASH), CNT);
      (void)hipMemsetAsync((char*)d_ws + WS_CTL, 0, 32768, stream);
      a.ph_lo = 4; a.ph_hi = 10; hipLaunchKernelGGL(mega_fwd, dim3(grid), dim3(NWAVES * 64), LDS_BYTES, stream, a);
      hipLaunchKernelGGL(mask_report, dim3(256), dim3(512), 0, stream, (float*)d_out, (const unsigned*)CNT);
      return; }
#endif
#ifdef DUPCHK
    { unsigned char* ws = (unsigned char*)d_ws; unsigned long long* CK = (unsigned long long*)(ws + WS_CTL + 32768);
      const void* rp[10] = {ws + WS_MOD, ws + WS_XH, ws + WS_QA, ws + WS_MASK, ws + WS_XH, ws + WS_MG, ws + WS_GT, ws + WS_XH, ws + WS_HID, d_out};
      const size_t rb[10] = {33ull << 20, 64ull << 20, 344ull << 20, 8ull << 20, 64ull << 20, 64ull << 20, 64ull << 20, 64ull << 20, 176ull << 20, 128ull << 20};
      int lo = 0;
      for (int k = 0; k < 10; ++k) { const bool cut = (DUPCHK >> k) & 1; if (!cut && k != 9) continue;
          if (lo > 0) (void)hipMemsetAsync((char*)d_ws + WS_CTL, 0, 32768, stream);
          a.ph_lo = lo; a.ph_hi = k + 1; hipLaunchKernelGGL(mega_fwd, dim3(grid), dim3(NWAVES * 64), LDS_BYTES, stream, a);
          if (cut) { hipLaunchKernelGGL(dup_cksum, dim3(256), dim3(512), 0, stream, rp[k], rb[k], CK + 2 * k);
                     a.ph_lo = k; a.ph_hi = k + 1; hipLaunchKernelGGL(mega_fwd, dim3(grid), dim3(NWAVES * 64), LDS_BYTES, stream, a);
                     hipLaunchKernelGGL(dup_cksum, dim3(256), dim3(512), 0, stream, rp[k], rb[k], CK + 2 * k + 1); }
          lo = k + 1; }
      hipLaunchKernelGGL(dup_final, dim3(256), dim3(512), 0, stream, (float*)d_out, (const unsigned long long*)CK);
      return; }
#endif
    int probe_next = 0;
    for (int li = 0; li < n_l; ++li) {
        a.ph_lo = (N_LAUNCHES == 1) ? 0 : li; a.ph_hi = (N_LAUNCHES == 1) ? N_PHASES : li + 1;
#ifdef PROBE_RERUN_MASK
        if (li >= N_LAUNCHES) { while (!((PROBE_RERUN_MASK >> probe_next) & 1)) ++probe_next; a.ph_lo = probe_next; a.ph_hi = probe_next + 1; ++probe_next;
#ifdef PROBE_MODE
            a.probe = PROBE_MODE;
#endif
        }
#endif
        hipLaunchKernelGGL(mega_fwd, dim3(grid), dim3(NWAVES * 64), LDS_BYTES, stream, a);
        const hipError_t le = hipPeekAtLastError();
        if (le != hipSuccess) { fprintf(stderr, "kernel_launch: launch %d failed: %s\n", li, hipGetErrorName(le)); break; }
    }
}
```

```cpp
#include <hip/hip_runtime.h>
#include <cstdio>
#include <cstdint>
namespace pg8 {
#define PG8_LAS __attribute__((address_space(3)))
typedef unsigned short bf16_t;
typedef short bf16x8 __attribute__((ext_vector_type(8)));
typedef float f32x4 __attribute__((ext_vector_type(4)));
typedef unsigned u32x4 __attribute__((ext_vector_type(4)));
constexpr int BM = 256, BK = 64, HALF = 128, HTB = HALF * BK * 2  , STAGE_BYTES = 8 * HTB, NXCD = 8, WGM = 8;

__host__ __device__ __forceinline__ int lds_byte(int r, int c) { const int st = (r >> 4) * 2 + (c >> 5), rr = r & 15, cc = c & 31, ob = rr * 64 + cc * 2; return st * 1024 + (ob ^ (((ob >> 9) & 1) << 5)); }
__host__ __device__ __forceinline__ void stage_rc(int b, int& R, int& C) { const int st = b / 1024, sb = b % 1024, swz = sb ^ (((sb >> 9) & 1) << 5); R = (st >> 1) * 16 + swz / 64; C = (st & 1) * 32 + (swz % 64) / 2; }
__host__ __device__ __forceinline__ int perm32(int rho) { const int n = rho >> 4, i = rho & 15; return 8 * (i >> 2) + 4 * n + (i & 3); }

struct Unit { int pm, pn; };
struct Gemm { const bf16_t* A; const bf16_t* Bt; int M, N, K; };

struct StaticOrder {
    int nM, nN, nwg, G, c;
    __host__ __device__ void init(int M, int N, int G_, int c_) { nM = M / BM; nN = N / BM; nwg = nM * nN; G = G_; c = c_; }
    __host__ __device__ bool next(int i, Unit& u) const {
        const long L = (long)i * G + c; if (L >= nwg) return false;
        int wgid = (int)L; { const int q = nwg / NXCD, r = nwg % NXCD, xcd = wgid % NXCD, off = wgid / NXCD; wgid = (xcd < r ? xcd * (q + 1) : r * (q + 1) + (xcd - r) * q) + off; }
        const int nig = WGM * nN, gid = wgid / nig, fm = gid * WGM, gsz = (nM - fm) < WGM ? (nM - fm) : WGM;
        u.pm = fm + ((wgid % nig) % gsz); u.pn = (wgid % nig) / gsz; return true;
    }
    __device__ __forceinline__ void a_ready(const Unit&) const {}
    __device__ __forceinline__ void done(const Unit&) const {}
};
__device__ __forceinline__ unsigned cvt_pk_bf16(float lo, float hi) { unsigned r; asm volatile("v_cvt_pk_bf16_f32 %0, %1, %2" : "=v"(r) : "v"(lo), "v"(hi)); return r; }
typedef float f32x2 __attribute__((ext_vector_type(2)));
template <class E, class = void> struct mid_t { static constexpr int v = 0; };
template <class E> struct mid_t<E, decltype((void)E::MID_T)> { static constexpr int v = E::MID_T; };
template <class Epi, class Sched, bool ALIGN_EPI = false, bool SP2 = false>
__device__ __forceinline__ void gemm_phase(PG8_LAS unsigned char* lds, const Gemm g, const Sched& S, const Epi& E) {
    const int tid = threadIdx.x, wid = __builtin_amdgcn_readfirstlane(tid >> 6), lane = tid & 63, wr = wid >> 2, wc = wid & 3, fr = lane & 15, fq = lane >> 4;
    const int K = g.K, nt = K / BK;
    unsigned voffA[2], voffB[2];
#pragma unroll
    for (int i = 0; i < 2; ++i) { int R, C; stage_rc(tid * 16 + i * 8192, R, C); const int Rb = Epi::PERM ? ((R & ~31) + perm32(R & 31)) : R;
        voffA[i] = (unsigned)(R * K + C) * 2u; voffB[i] = (unsigned)(Rb * K + C) * 2u; }
    const size_t kstep = (size_t)(BK * 2);
    const size_t hstep = (size_t)HALF * K * 2;
    const size_t tstep = 2 * hstep;
    const unsigned ldsw = (unsigned)wid * 1024u;
    const int aoff = lds_byte(wr * 64 + fr, fq * 8), boff = lds_byte(wc * 32 + fr, fq * 8);
#define PG8_SA(b, h) (((b) * 2 + (h)) * HTB)
#define PG8_SB(b, h) ((4 + (b) * 2 + (h)) * HTB)
#define PG8_STAGE(bufoff, gbase, voff) do { _Pragma("unroll") for (int _i = 0; _i < 2; ++_i) \
        __builtin_amdgcn_global_load_lds((const unsigned*)((const char*)(gbase) + (voff)[_i]), (PG8_LAS unsigned*)(lds + (bufoff) + ldsw + _i * 8192), 16, 0, 0); } while (0)
#define PG8_LDA(dst, b, h) do { _Pragma("unroll") for (int m = 0; m < 4; ++m) _Pragma("unroll") for (int k = 0; k < 2; ++k) dst[m][k] = *(const PG8_LAS bf16x8*)(lds + PG8_SA(b, h) + aoff + m * 2048 + k * 1024); } while (0)
#define PG8_LDB(dst, b, h) do { _Pragma("unroll") for (int n = 0; n < 2; ++n) _Pragma("unroll") for (int k = 0; k < 2; ++k) dst[n][k] = *(const PG8_LAS bf16x8*)(lds + PG8_SB(b, h) + boff + n * 2048 + k * 1024); } while (0)
#define PG8_MMA(ai, bj, At, Bt) do { __builtin_amdgcn_s_setprio(1); _Pragma("unroll") for (int m = 0; m < 4; ++m) _Pragma("unroll") for (int n = 0; n < 2; ++n) _Pragma("unroll") for (int k = 0; k < 2; ++k) \
        acc[ai][bj][m][n] = __builtin_amdgcn_mfma_f32_16x16x32_bf16(Bt[n][k], At[m][k], acc[ai][bj][m][n], 0, 0, 0); __builtin_amdgcn_s_setprio(0); } while (0)
#define PG8_WAIT_V(n) asm volatile("s_waitcnt vmcnt(" #n ")" ::: "memory")
#define PG8_WAIT_L(n) asm volatile("s_waitcnt lgkmcnt(" #n ")" ::: "memory")
#define PG8_BAR __builtin_amdgcn_s_barrier()
#define PG8_SCHED __builtin_amdgcn_sched_barrier(0)
    Unit cur, nxt; int ui = 0;
    if (!S.next(0, cur)) return;
    f32x4 acc[2][2][4][2];
#pragma unroll
    for (int a = 0; a < 2; ++a)
#pragma unroll
        for (int b = 0; b < 2; ++b)
#pragma unroll
            for (int m = 0; m < 4; ++m)
#pragma unroll
                for (int n = 0; n < 2; ++n) acc[a][b][m][n] = (f32x4){0.f, 0.f, 0.f, 0.f};
    bf16x8 At[4][2], B0[2][2], B1[2][2];
    const char* cA = (const char*)g.A + (size_t)cur.pm * tstep; const char* cB = (const char*)g.Bt + (size_t)cur.pn * tstep;
    S.a_ready(cur);
    if constexpr (SP2) {
        PG8_STAGE(PG8_SB(0, 0), cB, voffB); PG8_STAGE(PG8_SB(0, 1), cB + hstep, voffB); PG8_STAGE(PG8_SA(0, 0), cA, voffA); PG8_STAGE(PG8_SA(0, 1), cA + hstep, voffA);
        if (wr == 1) PG8_BAR;
        PG8_WAIT_V(2); PG8_BAR;
        PG8_STAGE(PG8_SB(1, 0), cB + kstep, voffB); PG8_STAGE(PG8_SA(1, 0), cA + kstep, voffA); PG8_STAGE(PG8_SB(1, 1), cB + hstep + kstep, voffB);
        PG8_WAIT_V(6); PG8_BAR;
    } else {
        PG8_STAGE(PG8_SB(0, 0), cB, voffB); PG8_STAGE(PG8_SA(0, 0), cA, voffA); PG8_STAGE(PG8_SB(0, 1), cB + hstep, voffB); PG8_STAGE(PG8_SA(0, 1), cA + hstep, voffA);
        if (wr == 1) PG8_BAR;
        PG8_WAIT_V(4); PG8_BAR;
        PG8_STAGE(PG8_SB(1, 0), cB + kstep, voffB); PG8_STAGE(PG8_SA(1, 0), cA + kstep, voffA); PG8_STAGE(PG8_SB(1, 1), cB + hstep + kstep, voffB);
        PG8_WAIT_V(6); PG8_BAR;
    }
    for (;;) {
        const bool has_next = S.next(ui + 1, nxt);
        const char* nA = has_next ? (const char*)g.A + (size_t)nxt.pm * tstep : cA; const char* nB = has_next ? (const char*)g.Bt + (size_t)nxt.pn * tstep : cB;
        for (int t = 0; t < nt; t += 2) {
            if constexpr (mid_t<Epi>::v > 0) { if (t == mid_t<Epi>::v) E.mid(acc, cur, wr, wc, fr, fq); }
            const bool last = (t == nt - 2);
            const char* a1 = cA + (size_t)(t + 1) * kstep;
            const char* a2 = last ? nA : cA + (size_t)(t + 2) * kstep; const char* b2 = last ? nB : cB + (size_t)(t + 2) * kstep;
            const char* a3 = a2 + kstep; const char* b3 = b2 + kstep;
            if (last && has_next) S.a_ready(nxt);
            if constexpr (SP2) {
            PG8_LDB(B0, 0, 0); PG8_LDB(B1, 0, 1); PG8_SCHED; PG8_LDA(At, 0, 0); PG8_STAGE(PG8_SA(1, 1), a1 + hstep, voffA);
            PG8_WAIT_V(8); PG8_WAIT_L(0); PG8_BAR; PG8_MMA(0, 0, At, B0); PG8_MMA(0, 1, At, B1); PG8_BAR; PG8_SCHED;
            PG8_LDA(At, 0, 1); PG8_STAGE(PG8_SB(0, 0), b2, voffB); PG8_STAGE(PG8_SB(0, 1), b2 + hstep, voffB); PG8_STAGE(PG8_SA(0, 0), a2, voffA);
            PG8_WAIT_V(8); PG8_WAIT_L(0); PG8_BAR; PG8_MMA(1, 0, At, B0); PG8_MMA(1, 1, At, B1); PG8_BAR; PG8_SCHED;
            PG8_LDB(B0, 1, 0); PG8_LDB(B1, 1, 1); PG8_SCHED; PG8_LDA(At, 1, 0); PG8_STAGE(PG8_SA(0, 1), a2 + hstep, voffA);
            PG8_WAIT_V(8); PG8_WAIT_L(0); PG8_BAR; PG8_MMA(0, 0, At, B0); PG8_MMA(0, 1, At, B1); PG8_BAR; PG8_SCHED;
            PG8_LDA(At, 1, 1); PG8_STAGE(PG8_SB(1, 0), b3, voffB); PG8_STAGE(PG8_SB(1, 1), b3 + hstep, voffB); PG8_STAGE(PG8_SA(1, 0), a3, voffA);
            PG8_WAIT_V(8); PG8_WAIT_L(0); PG8_BAR; PG8_MMA(1, 0, At, B0); PG8_MMA(1, 1, At, B1); PG8_BAR; PG8_SCHED;
            } else {
            PG8_LDB(B0, 0, 0); PG8_SCHED; PG8_LDA(At, 0, 0); PG8_STAGE(PG8_SA(1, 1), a1 + hstep, voffA);
            PG8_WAIT_L(8); PG8_BAR; PG8_WAIT_L(0); PG8_MMA(0, 0, At, B0); PG8_BAR; PG8_SCHED;
            PG8_LDB(B1, 0, 1); PG8_STAGE(PG8_SB(0, 0), b2, voffB);
            PG8_BAR; PG8_WAIT_L(0); PG8_MMA(0, 1, At, B1); PG8_BAR;
            PG8_LDA(At, 0, 1); PG8_STAGE(PG8_SA(0, 0), a2, voffA);
            PG8_BAR; PG8_WAIT_L(0); PG8_MMA(1, 0, At, B0); PG8_BAR; PG8_SCHED;
            PG8_STAGE(PG8_SB(0, 1), b2 + hstep, voffB);
            PG8_WAIT_V(6); PG8_BAR; PG8_MMA(1, 1, At, B1); PG8_BAR;
            PG8_LDB(B0, 1, 0); PG8_SCHED; PG8_LDA(At, 1, 0); PG8_STAGE(PG8_SA(0, 1), a2 + hstep, voffA);
            PG8_WAIT_L(8); PG8_BAR; PG8_WAIT_L(0); PG8_MMA(0, 0, At, B0); PG8_BAR; PG8_SCHED;
            PG8_LDB(B1, 1, 1); PG8_STAGE(PG8_SB(1, 0), b3, voffB);
            PG8_BAR; PG8_WAIT_L(0); PG8_MMA(0, 1, At, B1); PG8_BAR;
            PG8_LDA(At, 1, 1); PG8_STAGE(PG8_SA(1, 0), a3, voffA);
            PG8_BAR; PG8_WAIT_L(0); PG8_MMA(1, 0, At, B0); PG8_BAR; PG8_SCHED;
            PG8_STAGE(PG8_SB(1, 1), b3 + hstep, voffB);
            PG8_WAIT_V(6); PG8_BAR; PG8_MMA(1, 1, At, B1); PG8_BAR;
            }
        }
        if constexpr (ALIGN_EPI) { if (wr == 0) PG8_BAR; }
        if constexpr (!Epi::AFTER_DRAIN) { E(acc, cur, wr, wc, fr, fq); S.done(cur); }
        if (!has_next) break;
#pragma unroll
        for (int a = 0; a < 2; ++a)
#pragma unroll
            for (int b = 0; b < 2; ++b)
#pragma unroll
                for (int m = 0; m < 4; ++m)
#pragma unroll
                    for (int n = 0; n < 2; ++n) acc[a][b][m][n] = (f32x4){0.f, 0.f, 0.f, 0.f};
        cur = nxt; cA = nA; cB = nB; ++ui;
        if constexpr (ALIGN_EPI) { if (wr == 1) PG8_BAR; }
    }
    PG8_WAIT_V(0);
    if constexpr (!ALIGN_EPI) { if (wr == 0) PG8_BAR; }
    PG8_BAR;
    if constexpr (Epi::AFTER_DRAIN) { E.fused(acc, cur, wr, wc, fr, fq, lds, wid, lane); S.done(cur); }
#undef PG8_SA
#undef PG8_SB
#undef PG8_STAGE
#undef PG8_LDA
#undef PG8_LDB
#undef PG8_MMA
#undef PG8_WAIT_V
#undef PG8_WAIT_L
#undef PG8_BAR
#undef PG8_SCHED
}
}
#ifndef SCALE_F_EPS
#define SCALE_F_EPS 0.0f
#endif
namespace epi {
constexpr size_t PWS_GN = (1u << 20) + 768 * 1024, PWS_QA = 128u << 20, PWS_QI = 320u << 20, PWS_KI = 336u << 20, PWS_WI = 340u << 20, PWS_GT = 344u << 20;
using pg8::f32x4; using pg8::u32x4; using pg8::bf16_t; using pg8::Unit; using pg8::BM; using pg8::HALF;
__device__ __forceinline__ unsigned pk2(float lo, float hi) { return pg8::cvt_pk_bf16(lo, hi); }
__device__ __forceinline__ float bflo(unsigned u) { return __uint_as_float(u << 16); }
__device__ __forceinline__ float bfhi(unsigned u) { return __uint_as_float(u & 0xffff0000u); }
__device__ __forceinline__ float sigm(float v) { return __builtin_amdgcn_rcpf(1.f + __expf(-v)); }
__device__ __forceinline__ u32x4 pack8(const f32x4& a, const f32x4& b) { u32x4 w; w.x = pk2(a[0], a[1]); w.y = pk2(a[2], a[3]); w.z = pk2(b[0], b[1]); w.w = pk2(b[2], b[3]); return w; }
__device__ __forceinline__ float dot4(const f32x4& a) { return (a[0] * a[0] + a[1] * a[1]) + (a[2] * a[2] + a[3] * a[3]); }

struct EpiProj {
    static constexpr bool PERM = true, AFTER_DRAIN = false;
    unsigned char* ws;
    template <int MODE  >
    __device__ __forceinline__ void emit(const f32x4 (&acc)[2][2][4][2], bf16_t* dst, int pitch, int cb, const float* g, int row0, int wc, int fq) const {
        f32x4 gv[2][2];
#pragma unroll
        for (int bj = 0; bj < 2; ++bj)
#pragma unroll
            for (int n = 0; n < 2; ++n) gv[bj][n] = (MODE == 1) ? *(const f32x4*)(g + 32 * bj + 8 * fq + 4 * n) : (f32x4){1.f, 1.f, 1.f, 1.f};
#pragma unroll
        for (int ai = 0; ai < 2; ++ai)
#pragma unroll
            for (int m = 0; m < 4; ++m) {
                f32x4 v[2][2];
#pragma unroll
                for (int bj = 0; bj < 2; ++bj)
#pragma unroll
                    for (int n = 0; n < 2; ++n) v[bj][n] = acc[ai][bj][m][n];
                if (MODE == 1) {
                    float ss = (dot4(v[0][0]) + dot4(v[0][1])) + (dot4(v[1][0]) + dot4(v[1][1]));
                    ss += __shfl_xor(ss, 16); ss += __shfl_xor(ss, 32);
                    const float rs = __builtin_amdgcn_rsqf(ss * (1.0f / 64.0f) + 1e-6f);
#pragma unroll
                    for (int bj = 0; bj < 2; ++bj)
#pragma unroll
                        for (int n = 0; n < 2; ++n) v[bj][n] = v[bj][n] * rs * gv[bj][n];
                } else if (MODE == 2) {
#pragma unroll
                    for (int bj = 0; bj < 2; ++bj)
#pragma unroll
                        for (int n = 0; n < 2; ++n)
#pragma unroll
                            for (int i = 0; i < 4; ++i) v[bj][n][i] = sigm(v[bj][n][i]);
                }
                bf16_t* rowp = dst + (size_t)(row0 + ai * HALF + m * 16) * pitch + cb + 64 * wc + 8 * fq;
#pragma unroll
                for (int bj = 0; bj < 2; ++bj) *(u32x4*)(rowp + 32 * bj) = pack8(v[bj][0], v[bj][1]);
            }
    }
    __device__ __forceinline__ void operator()(const f32x4 (&acc)[2][2][4][2], const Unit& u, int wr, int wc, int fr, int fq) const {
        const int pn = u.pn, row0 = u.pm * BM + wr * 64 + fr, cb = (pn & 1) * 256;
        bf16_t* const QA = (bf16_t*)(ws + PWS_QA); const float* const gn = (const float*)(ws + PWS_GN);
        bf16_t* const KI = (bf16_t*)(ws + PWS_KI); float* const WI = (float*)(ws + PWS_WI); bf16_t* const GT = (bf16_t*)(ws + PWS_GT);
        if (pn < 12) {
            const int tsr = pn >> 1; bf16_t* dst = QA + (size_t)tsr * (size_t)(32u << 19);
            if (tsr == 2 || tsr == 5) emit<0>(acc, dst, 512, cb, nullptr, row0, wc, fq);
            else emit<1>(acc, dst, 512, cb, gn + 64 * (tsr - (tsr > 2 ? 1 : 0)), row0, wc, fq);
        }
        else if (pn == 12) emit<0>(acc, (bf16_t*)(ws + PWS_QI), 256, 0, nullptr, row0, wc, fq);
        else if (pn == 13) {
            if (wc == 0) emit<0>(acc, KI, 64, 0, nullptr, row0, 0, fq);
            else if (wc == 1) { if (fq == 0) {
#pragma unroll
                for (int ai = 0; ai < 2; ++ai)
#pragma unroll
                    for (int m = 0; m < 4; ++m) *(f32x4*)(WI + (size_t)(row0 + ai * HALF + m * 16) * 4) = acc[ai][0][m][0]; } }
        } else emit<2>(acc, GT, 2048, (pn - 14) * 256, nullptr, row0, wc, fq);
    }
};
struct EpiUpM {
    static constexpr bool PERM = true, AFTER_DRAIN = false; static constexpr int MID_T = 8;
    bf16_t* MG; const bf16_t* GT;
    static __device__ __forceinline__ float gcl(float g) { return __builtin_fmaxf(g, 8.673617379884035e-19f); }
    __device__ __forceinline__ void mid(f32x4 (&acc)[2][2][4][2], const Unit& u, int wr, int wc, int fr, int fq) const {
        int zo = 0; asm volatile("" : "+v"(zo));
        const int row0 = u.pm * BM + wr * 64 + fr + zo, col0 = u.pn * BM + wc * 32 + 8 * fq;
#pragma unroll
        for (int ai = 0; ai < 2; ++ai) {
            u32x4 ga[4][2], gb[4][2];
#pragma unroll
            for (int m = 0; m < 4; ++m)
#pragma unroll
                for (int bj = 0; bj < 2; ++bj) { const size_t row = (size_t)(row0 + ai * HALF + m * 16); const int c = col0 + bj * HALF;
                    ga[m][bj] = *(const u32x4*)(GT + row * 2048 + c); gb[m][bj] = *(const u32x4*)(GT + row * 2048 + 1024 + c); }
            asm volatile("" ::: "memory");
#pragma unroll
            for (int m = 0; m < 4; ++m)
#pragma unroll
                for (int bj = 0; bj < 2; ++bj) { const u32x4 a = ga[m][bj], b = gb[m][bj];
                    const f32x4 r0 = {bflo(a.x) * __builtin_amdgcn_rcpf(gcl(bflo(b.x))), bfhi(a.x) * __builtin_amdgcn_rcpf(gcl(bfhi(b.x))), bflo(a.y) * __builtin_amdgcn_rcpf(gcl(bflo(b.y))), bfhi(a.y) * __builtin_amdgcn_rcpf(gcl(bfhi(b.y)))};
                    const f32x4 r1 = {bflo(a.z) * __builtin_amdgcn_rcpf(gcl(bflo(b.z))), bfhi(a.z) * __builtin_amdgcn_rcpf(gcl(bfhi(b.z))), bflo(a.w) * __builtin_amdgcn_rcpf(gcl(bflo(b.w))), bfhi(a.w) * __builtin_amdgcn_rcpf(gcl(bfhi(b.w)))};
                    acc[ai][bj][m][0] = acc[ai][bj][m][0] * r0; acc[ai][bj][m][1] = acc[ai][bj][m][1] * r1; }
            asm volatile("" ::: "memory");
        }
    }
    __device__ __forceinline__ void operator()(const f32x4 (&acc)[2][2][4][2], const Unit& u, int wr, int wc, int fr, int fq) const {
        const int row0 = u.pm * BM + wr * 64 + fr, col0 = u.pn * BM + wc * 32 + 8 * fq;
#pragma unroll
        for (int ai = 0; ai < 2; ++ai) {
            u32x4 gw[4][2];
#pragma unroll
            for (int m = 0; m < 4; ++m)
#pragma unroll
                for (int bj = 0; bj < 2; ++bj) { const size_t row = (size_t)(row0 + ai * HALF + m * 16); const int c = col0 + bj * HALF; gw[m][bj] = *(const u32x4*)(GT + row * 2048 + 1024 + c); }
            asm volatile("" ::: "memory");
#pragma unroll
            for (int m = 0; m < 4; ++m)
#pragma unroll
                for (int bj = 0; bj < 2; ++bj) { const size_t row = (size_t)(row0 + ai * HALF + m * 16); const int c = col0 + bj * HALF; const u32x4 g = gw[m][bj];
                    const f32x4 v0 = acc[ai][bj][m][0] * (f32x4){gcl(bflo(g.x)), gcl(bfhi(g.x)), gcl(bflo(g.y)), gcl(bfhi(g.y))}, v1 = acc[ai][bj][m][1] * (f32x4){gcl(bflo(g.z)), gcl(bfhi(g.z)), gcl(bflo(g.w)), gcl(bfhi(g.w))};
                    *(u32x4*)(MG + row * 1024 + c) = pack8(v0, v1); }
        }
    }
};
struct EpiFF13 {
    static constexpr bool PERM = true, AFTER_DRAIN = false;
    bf16_t* H;
#ifdef PROBE_EPI
    int skip;
#endif
    __device__ __forceinline__ void operator()(const f32x4 (&acc)[2][2][4][2], const Unit& u, int wr, int wc, int fr, int fq) const {
        const int row0 = u.pm * BM + wr * 64 + fr, col0 = u.pn * HALF + wc * 32 + 8 * fq;
#ifdef PROBE_EPI
        if (skip) { if (acc[0][0][0][0][0] == 1.2345e30f) H[0] = 0; return; }
#endif
#pragma unroll
        for (int ai = 0; ai < 2; ++ai)
#pragma unroll
            for (int m = 0; m < 4; ++m) { f32x4 h[2];
#pragma unroll
                for (int n = 0; n < 2; ++n)
#pragma unroll
                    for (int i = 0; i < 4; ++i) { const float a = acc[ai][0][m][n][i]; h[n][i] = a * sigm(a) * acc[ai][1][m][n][i]; }
                *(u32x4*)(H + (size_t)(row0 + ai * HALF + m * 16) * 2816 + col0) = pack8(h[0], h[1]); }
    }
};
struct EpiResToBf16 {
    static constexpr bool PERM = true, AFTER_DRAIN = false;
    const float* X; bf16_t* O; const float* gate;
    __device__ __forceinline__ void operator()(const f32x4 (&acc)[2][2][4][2], const Unit& u, int wr, int wc, int fr, int fq) const {
        const int row0 = u.pm * BM + wr * 64 + fr, col0 = u.pn * BM + wc * 32 + 8 * fq; const float* gp = gate + (size_t)(u.pm >> 3) * 6144 + col0;
        f32x4 gv[2][2];
#pragma unroll
        for (int bj = 0; bj < 2; ++bj)
#pragma unroll
            for (int n = 0; n < 2; ++n) gv[bj][n] = *(const f32x4*)(gp + bj * HALF + n * 4);
#pragma unroll
        for (int ai = 0; ai < 2; ++ai) {
            f32x4 xv[4][2][2];
#pragma unroll
            for (int m = 0; m < 4; ++m)
#pragma unroll
                for (int bj = 0; bj < 2; ++bj) { const size_t off = (size_t)(row0 + ai * HALF + m * 16) * 1024 + col0 + bj * HALF; xv[m][bj][0] = *(const f32x4*)(X + off); xv[m][bj][1] = *(const f32x4*)(X + off + 4); }
            asm volatile("" ::: "memory");
#pragma unroll
            for (int m = 0; m < 4; ++m)
#pragma unroll
                for (int bj = 0; bj < 2; ++bj) { const size_t off = (size_t)(row0 + ai * HALF + m * 16) * 1024 + col0 + bj * HALF;
                    *(u32x4*)(O + off) = pack8(xv[m][bj][0] + gv[bj][0] * acc[ai][bj][m][0], xv[m][bj][1] + gv[bj][1] * acc[ai][bj][m][1]); }
        }
    }
};
struct EpiResFromBf16 {
    static constexpr bool PERM = true, AFTER_DRAIN = false;
    const bf16_t* X; float* O; const float* gate;
    __device__ __forceinline__ void operator()(const f32x4 (&acc)[2][2][4][2], const Unit& u, int wr, int wc, int fr, int fq) const {
        const int row0 = u.pm * BM + wr * 64 + fr, col0 = u.pn * BM + wc * 32 + 8 * fq; const float* gp = gate + (size_t)(u.pm >> 3) * 6144 + col0;
        f32x4 gv[2][2];
#pragma unroll
        for (int bj = 0; bj < 2; ++bj)
#pragma unroll
            for (int n = 0; n < 2; ++n) gv[bj][n] = *(const f32x4*)(gp + bj * HALF + n * 4);
#pragma unroll
        for (int ai = 0; ai < 2; ++ai) {
            u32x4 xw[4][2];
#pragma unroll
            for (int m = 0; m < 4; ++m)
#pragma unroll
                for (int bj = 0; bj < 2; ++bj) xw[m][bj] = *(const u32x4*)(X + (size_t)(row0 + ai * HALF + m * 16) * 1024 + col0 + bj * HALF);
            asm volatile("" ::: "memory");
#pragma unroll
            for (int m = 0; m < 4; ++m)
#pragma unroll
                for (int bj = 0; bj < 2; ++bj) { const size_t off = (size_t)(row0 + ai * HALF + m * 16) * 1024 + col0 + bj * HALF; const u32x4 w = xw[m][bj];
                    *(f32x4*)(O + off) = (f32x4){bflo(w.x), bfhi(w.x), bflo(w.y), bfhi(w.y)} + gv[bj][0] * acc[ai][bj][m][0] * (1.0f + SCALE_F_EPS);
                    *(f32x4*)(O + off + 4) = (f32x4){bflo(w.z), bfhi(w.z), bflo(w.w), bfhi(w.w)} + gv[bj][1] * acc[ai][bj][m][1] * (1.0f + SCALE_F_EPS); }
        }
    }
};
}
#ifndef SCALE_B_EPS
#define SCALE_B_EPS 0.0f
#endif
#ifndef SCALE_A_EPS
#define SCALE_A_EPS 0.0f
#endif
namespace att {
using bf16x8 = __attribute__((ext_vector_type(8))) short;
using s16x4 = __attribute__((ext_vector_type(4))) short;
using f32x16 = __attribute__((ext_vector_type(16))) float;
using u32x4 = __attribute__((ext_vector_type(4))) unsigned;
using u32x2 = __attribute__((ext_vector_type(2))) unsigned;
typedef unsigned short bf16;
constexpr int SEQ = 2048, NW = 8, QBLK = 32, QB = QBLK * NW, KVBLK = 64;
constexpr float C2 = 0.125f * 1.4426950408889634f;
constexpr int SLOTB = 8192, LDS_K = 0, LDS_V = 3 * SLOTB, LDS_WS = 6 * SLOTB, WSW = 128, LDS_OST = LDS_WS + NW * WSW * 4, LDS_X = LDS_OST + NW * 4096, XW = 8192, LDS_BYTES = LDS_X + NW * XW;
#define SBAR() __builtin_amdgcn_sched_barrier(0)
#define PIN(x) asm volatile("" : "+v"(x))
#define MFMA(a, b, c) __builtin_amdgcn_mfma_f32_32x32x16_bf16(a, b, c, 0, 0, 0)
#define WAIT_BAR(N) asm volatile("s_waitcnt vmcnt(" #N ") lgkmcnt(0)\n\ts_barrier" ::: "memory")
#ifndef ATT_THR
#define ATT_THR 60.0f
#endif
typedef __attribute__((address_space(3))) const char* lds_cptr;
typedef __attribute__((address_space(3))) char* lds_ptr;
typedef __attribute__((address_space(3))) float* lds_fptr;
typedef __attribute__((address_space(3))) const unsigned* lds_cuptr;
typedef short v4i16_t __attribute__((ext_vector_type(4)));
__device__ __forceinline__ int crow(int r, int hi) { return (r & 3) + 8 * (r >> 2) + 4 * hi; }
__device__ __forceinline__ unsigned cvtpk(float lo, float hi) { unsigned r; asm("v_cvt_pk_bf16_f32 %0, %1, %2" : "=v"(r) : "v"(lo), "v"(hi)); return r; }
__device__ __forceinline__ void glds16(const void* g, unsigned lds_base) {
    unsigned sv; asm volatile("s_mov_b32 %0, m0\n\ts_mov_b32 m0, %2\n\ts_nop 0\n\tglobal_load_lds_dwordx4 %1, off\n\ts_mov_b32 m0, %0" : "=&s"(sv) : "v"(g), "s"(lds_base) : "memory"); }
__device__ __forceinline__ void kload2(bf16x8* kf, lds_cptr kp, int d0) { kf[2 * d0] = *(const __attribute__((address_space(3))) bf16x8*)(kp + d0 * 2048); kf[2 * d0 + 1] = *(const __attribute__((address_space(3))) bf16x8*)(kp + d0 * 2048 + 512); }
__device__ __forceinline__ s16x4 vtr(lds_cptr p) { return __builtin_bit_cast(s16x4, __builtin_amdgcn_ds_read_tr16_b64_v4i16((__attribute__((address_space(3))) v4i16_t*)p)); }
#define MX3(a, b, c) __builtin_fmaxf(__builtin_fmaxf((a), (b)), (c))
__device__ __forceinline__ float rowmax2(const f32x16& p0, const f32x16& p1, float p1off) {
    float a = MX3(p0[0], p0[1], p0[2]), b = MX3(p1[0], p1[1], p1[2]);
#pragma unroll
    for (int r = 3; r < 15; r += 2) { a = MX3(a, p0[r], p0[r + 1]); b = MX3(b, p1[r], p1[r + 1]); }
    a = __builtin_fmaxf(a, p0[15]); b = __builtin_fmaxf(b, p1[15]);
    float m = __builtin_fmaxf(a, b + p1off); auto rr = __builtin_amdgcn_permlane32_swap(__float_as_uint(m), __float_as_uint(m), false, false);
    return __builtin_fmaxf(__uint_as_float(rr[0]), __uint_as_float(rr[1])); }
__device__ __forceinline__ float msel(float x, unsigned mw, int pos) { const unsigned m = (unsigned)(((int)(mw << (31 - pos))) >> 31);
    return __uint_as_float((__float_as_uint(x) & m) | (0xff800000u & ~m)); }
__device__ __forceinline__ unsigned short f2bf(float f) { unsigned u = __float_as_uint(f); return (unsigned short)((u + 0x7fffu + ((u >> 16) & 1u)) >> 16); }

#ifndef EXP_NOBAND
#define EXP_NOBAND 0
#endif
#ifndef EXP_NOMASK
#define EXP_NOMASK 0
#endif
#ifdef EXP_NOAPPLY
#define EXP_APPLY(C0, C1, t, BAND) do {} while (0)
#else
#define EXP_APPLY(C0, C1, t, BAND) APPLY(C0, C1, t, BAND)
#endif
#ifdef EXP_NOADV
#define EXP_ADV do {} while (0)
#elif defined(EXP_ADVPIN)
#define EXP_ADV do { _Pragma("unroll") for (int r = 0; r < 16; ++r) ali[r] += tstep; PIN(ali); } while (0)
#else
#define EXP_ADV do { _Pragma("unroll") for (int r = 0; r < 16; ++r) ali[r] += tstep; } while (0)
#endif
template <bool MASKED>
__device__ __forceinline__ void attn_core(f32x16 (&o)[2], const bf16* Qw, int qp, const bf16* Kh, int kp, const bf16* Vh, int vp, int qb, float s8, const unsigned long long* gmask, char* lds) {
    int lz_ = threadIdx.x & 63; asm volatile("" : "+v"(lz_));
    const int tid = threadIdx.x, lane = lz_, r32 = lane & 31, hi = lane >> 5; const int wid = __builtin_amdgcn_readfirstlane(tid >> 6);
    const int NT = 4 * qb + 4;
    const unsigned lds0 = (unsigned)(uintptr_t)lds; const lds_fptr wsf = (lds_fptr)((lds_ptr)lds + LDS_WS) + wid * WSW;
    const bf16* ksrc = Kh + (long)lane * kp + wid * 8;
    const bf16* vsrc = Vh + (long)(16 * (wid & 3) + (lane >> 2)) * vp + (wid >> 2) * 32 + (lane & 3) * 8;
    const unsigned kdst = lds0 + LDS_K + wid * 1024, vdst = lds0 + LDS_V + wid * 1024;
#define DMA_K(t, slot) glds16(ksrc + (long)(t) * KVBLK * kp, (unsigned)__builtin_amdgcn_readfirstlane(kdst + (slot)))
#define DMA_V(t, slot) glds16(vsrc + (long)(t) * KVBLK * vp, (unsigned)__builtin_amdgcn_readfirstlane(vdst + (slot)))
    const lds_cptr vp0 = (lds_cptr)lds + LDS_V + ((lane >> 4) & 1) * 32 + (lane & 3) * 8 + (4 * hi + ((lane & 15) >> 2)) * 64;
    const lds_cptr kp0 = (lds_cptr)lds + LDS_K + hi * 1024 + r32 * 16;
    const lds_cptr mrow = (lds_cptr)lds + LDS_X + wid * XW + r32 * 8;
    if (MASKED) { for (int i = 0; i <= qb; ++i) glds16((const char*)gmask + i * 1024 + lane * 16, (unsigned)__builtin_amdgcn_readfirstlane(lds0 + LDS_X + wid * XW + i * 1024)); }
    DMA_K(0, 0); DMA_V(0, 0); DMA_K(1, SLOTB);
    bf16x8 qr[4];
#pragma unroll
    for (int d0 = 0; d0 < 4; ++d0) qr[d0] = *reinterpret_cast<const bf16x8*>(&Qw[(long)r32 * qp + d0 * 16 + hi * 8]);
    float mhat = 0.f, l_reg = 0.f; o[0] = f32x16{}; o[1] = f32x16{};
    const int qrel = wid * QBLK + r32, wch = wid >> 1; bool resc = false;
    const float p1off = 32.f * s8, tstep = 64.f * s8, nm1off = p1off * C2;
    f32x16 ali;
    { const float tq = (float)(QB * qb + qrel);
#pragma unroll
      for (int r = 0; r < 16; ++r) ali[r] = -s8 * (tq - (float)crow(r, hi)); }
    PIN(ali);
    f32x16 pA0, pA1, pB0, pB1; bf16x8 kf[8]; s16x4 vlo[8], vhi[8]; u32x4 pw0, pw1, pw2, pw3;
    int sl_prev = 0, sl_cur = 0, sl_next = SLOTB;
#define ROT() do { sl_prev = sl_cur; sl_cur = sl_next; sl_next = (sl_next == 2 * SLOTB) ? 0 : sl_next + SLOTB; } while (0)
#define EX(v, nm) __builtin_amdgcn_exp2f(__builtin_fmaf((v), C2, (nm)))
#define RESC() do { if (resc) { _Pragma("unroll") for (int d_ = 0; d_ < 2; ++d_) _Pragma("unroll") for (int r = 0; r < 16; ++r) o[d_][r] *= wsf[crow(r, hi)]; } } while (0)
#define APPLY(C0, C1, t, BAND) do { \
    const int jb_ = (t) - (NT - 4); \
    if (MASKED && !EXP_NOMASK) { const u32x2 mq_ = *(const __attribute__((address_space(3))) u32x2*)(mrow + (t) * 256); unsigned m0_ = mq_[0] >> (4 * hi), m1_ = mq_[1] >> (4 * hi); \
        if (BAND) { m0_ = (jb_ > wch) ? 0u : m0_; m1_ = (jb_ > wch) ? 0u : m1_; } SBAR(); \
        _Pragma("unroll") for (int e = 0; e < 16; e += 4) { C0[e] = msel(C0[e], m0_, 2 * e); C0[e + 1] = msel(C0[e + 1], m0_, 2 * e + 1); C0[e + 2] = msel(C0[e + 2], m0_, 2 * e + 2); C0[e + 3] = msel(C0[e + 3], m0_, 2 * e + 3); SBAR(); } \
        _Pragma("unroll") for (int e = 0; e < 16; e += 4) { C1[e] = msel(C1[e], m1_, 2 * e); C1[e + 1] = msel(C1[e + 1], m1_, 2 * e + 1); C1[e + 2] = msel(C1[e + 2], m1_, 2 * e + 2); C1[e + 3] = msel(C1[e + 3], m1_, 2 * e + 3); SBAR(); } } \
    if (BAND && !EXP_NOBAND) { const float binv_ = (!MASKED && jb_ > wch) ? -INFINITY : 0.f, m2_ = (jb_ == wch) ? -2.f * s8 : 0.f, fb_ = (float)(4 * hi - (qrel - 64 * wch)); float fbo_ = fb_; asm volatile("" : "+v"(fbo_)); SBAR(); \
        _Pragma("unroll") for (int e = 0; e < 16; ++e) { const float d0_ = fbo_ + (float)((e & 3) + 8 * (e >> 2)); \
            C0[e] = __builtin_fmaf(__builtin_fmaxf(d0_, 0.f), m2_, C0[e] + binv_); C1[e] = __builtin_fmaf(__builtin_fmaxf(d0_ + 32.f, 0.f), m2_, C1[e] + binv_); if ((e & 1) == 1) SBAR(); } } } while (0)
    DMA_K(2, 2 * SLOTB);
    WAIT_BAR(3);
    _Pragma("unroll") for (int d0 = 0; d0 < 4; ++d0) kload2(kf, kp0, d0);
    pA0 = MFMA(kf[0], qr[0], ali); pA1 = MFMA(kf[1], qr[0], ali); pA0 = MFMA(kf[2], qr[1], pA0); pA1 = MFMA(kf[3], qr[1], pA1);
    pA0 = MFMA(kf[4], qr[2], pA0); pA1 = MFMA(kf[5], qr[2], pA1); pA0 = MFMA(kf[6], qr[3], pA0); pA1 = MFMA(kf[7], qr[3], pA1);
    APPLY(pA0, pA1, 0, true);
    { const float rm = rowmax2(pA0, pA1, p1off); mhat = __builtin_fmaxf(rm * C2, -30000.f); const float nmh = -mhat, nmh1 = nmh + nm1off;
#pragma unroll
      for (int r = 0; r < 16; ++r) { pA0[r] = EX(pA0[r], nmh); pA1[r] = EX(pA1[r], nmh1); } }
#pragma unroll
    for (int r = 0; r < 16; ++r) ali[r] += tstep;
    WAIT_BAR(0);
    DMA_K(3, 0); DMA_V(1, SLOTB); ROT();
    _Pragma("unroll") for (int d0 = 0; d0 < 4; ++d0) kload2(kf, kp0 + sl_cur, d0);
    WAIT_BAR(2);
#define PKW(P, i) cvtpk(P[i], P[i + 1])
#define PAF(k) __builtin_bit_cast(bf16x8, pw##k)
#define VFR(i) (bf16x8){vlo[i][0], vlo[i][1], vlo[i][2], vlo[i][3], vhi[i][0], vhi[i][1], vhi[i][2], vhi[i][3]}
#define VRD(i) do { vlo[i] = vtr(vp_ + (((i) >> 2) * 4096 + ((i) & 3) * 1024)); vhi[i] = vtr(vp_ + (((i) >> 2) * 4096 + ((i) & 3) * 1024 + 512)); } while (0)
#define KRD(G, d0) do { if (G) { kload2(kf, kp0 + sl_next, d0); SBAR(); } } while (0)
#define GAPA(MF, a0, a1, a2, a3, W0, W1, PW) do { MF; sacc += a0; sacc += a1; sacc += a2; sacc += a3; W0; W1; PIN(PW); PIN(sacc); SBAR(); } while (0)
#define GAPB(MF, X, i, nm) do { MF; X[i] = EX(X[i], nm); X[i + 1] = EX(X[i + 1], nm); X[i + 2] = EX(X[i + 2], nm); X[i + 3] = EX(X[i + 3], nm); PIN(X); SBAR(); } while (0)
#define STEP(C0, C1, P0, P1, t, BAND, GK, GV, GL) do { SBAR(); \
    const lds_cptr vp_ = vp0 + sl_prev; \
    VRD(0); SBAR(); float sacc = P0[0] + P0[1]; \
                    GAPA(C0 = MFMA(kf[0], qr[0], ali), P0[2], P0[3], P0[4], P0[5],     pw0[0] = PKW(P0, 0),  pw0[1] = PKW(P0, 2),  pw0); \
    VRD(4); SBAR(); GAPA(C1 = MFMA(kf[1], qr[0], ali), P0[6], P0[7], P0[8], P0[9],     pw0[2] = PKW(P0, 4),  pw0[3] = PKW(P0, 6),  pw0); \
    VRD(1); SBAR(); GAPA(C0 = MFMA(kf[2], qr[1], C0),  P0[10], P0[11], P0[12], P0[13], pw1[0] = PKW(P0, 8),  pw1[1] = PKW(P0, 10), pw1); \
    VRD(5); SBAR(); GAPA(C1 = MFMA(kf[3], qr[1], C1),  P0[14], P0[15], P1[0], P1[1],   pw1[2] = PKW(P0, 12), pw1[3] = PKW(P0, 14), pw1); \
    VRD(2); SBAR(); GAPA(C0 = MFMA(kf[4], qr[2], C0),  P1[2], P1[3], P1[4], P1[5],     pw2[0] = PKW(P1, 0),  pw2[1] = PKW(P1, 2),  pw2); \
    VRD(6); SBAR(); GAPA(C1 = MFMA(kf[5], qr[2], C1),  P1[6], P1[7], P1[8], P1[9],     pw2[2] = PKW(P1, 4),  pw2[3] = PKW(P1, 6),  pw2); \
    VRD(3); SBAR(); GAPA(C0 = MFMA(kf[6], qr[3], C0),  P1[10], P1[11], P1[12], P1[13], pw3[0] = PKW(P1, 8),  pw3[1] = PKW(P1, 10), pw3); \
    VRD(7); SBAR(); GAPA(C1 = MFMA(kf[7], qr[3], C1),  P1[14], P1[15], 0.f, 0.f,       pw3[2] = PKW(P1, 12), pw3[3] = PKW(P1, 14), pw3); \
    l_reg += sacc; \
    if (GK) DMA_K((t) + 3, sl_cur); if (GV) DMA_V((t) + 1, sl_next); \
    EXP_APPLY(C0, C1, t, BAND); \
    EXP_ADV; \
    { const float rm = __builtin_fmaf(rowmax2(C0, C1, p1off), C2, -mhat); resc = false; \
      if (__builtin_expect(__any(rm > ATT_THR), 0)) { const float dl = __builtin_fmaxf(rm, 0.f); mhat += dl; \
          const float f = __builtin_amdgcn_exp2f(-dl); l_reg *= f; if (hi == 0) wsf[r32] = f; resc = true; } } \
    const float nmh = -mhat, nmh1 = nmh + nm1off; SBAR(); \
    GAPB(o[0] = MFMA(PAF(0), VFR(0), o[0]), C0, 0, nmh);              GAPB(o[1] = MFMA(PAF(0), VFR(4), o[1]), C0, 4, nmh); \
    KRD(GL, 0); GAPB(o[0] = MFMA(PAF(1), VFR(1), o[0]), C0, 8, nmh);  KRD(GL, 1); GAPB(o[1] = MFMA(PAF(1), VFR(5), o[1]), C0, 12, nmh); \
    KRD(GL, 2); GAPB(o[0] = MFMA(PAF(2), VFR(2), o[0]), C1, 0, nmh1); KRD(GL, 3); GAPB(o[1] = MFMA(PAF(2), VFR(6), o[1]), C1, 4, nmh1); \
    GAPB(o[0] = MFMA(PAF(3), VFR(3), o[0]), C1, 8, nmh1);             GAPB(o[1] = MFMA(PAF(3), VFR(7), o[1]), C1, 12, nmh1); \
    } while (0)
    int t = 1;
    for (; t + 5 < NT; t += 2) {
        STEP(pB0, pB1, pA0, pA1, t, false, true, true, true);     WAIT_BAR(2); RESC(); ROT();
        STEP(pA0, pA1, pB0, pB1, t + 1, false, true, true, true); WAIT_BAR(2); RESC(); ROT();
    }
#define ENDW(tt) do { if ((tt) + 3 < NT) { WAIT_BAR(2); } else if ((tt) + 2 < NT) { WAIT_BAR(1); } else { WAIT_BAR(0); } } while (0)
    for (; t + 1 < NT; t += 2) {
        STEP(pB0, pB1, pA0, pA1, t, true, (t + 3 < NT), (t + 1 < NT), (t + 1 < NT));         ENDW(t);     RESC(); ROT();
        STEP(pA0, pA1, pB0, pB1, t + 1, true, (t + 4 < NT), (t + 2 < NT), (t + 2 < NT));     ENDW(t + 1); RESC(); ROT();
    }
    STEP(pB0, pB1, pA0, pA1, NT - 1, true, false, false, false); RESC();
    { float sacc = pB0[0] + pB0[1];
#pragma unroll
      for (int r = 2; r < 16; ++r) sacc += pB0[r];
#pragma unroll
      for (int r = 0; r < 16; ++r) sacc += pB1[r];
      l_reg += sacc;
      pw0 = (u32x4){PKW(pB0, 0), PKW(pB0, 2), PKW(pB0, 4), PKW(pB0, 6)}; pw1 = (u32x4){PKW(pB0, 8), PKW(pB0, 10), PKW(pB0, 12), PKW(pB0, 14)};
      pw2 = (u32x4){PKW(pB1, 0), PKW(pB1, 2), PKW(pB1, 4), PKW(pB1, 6)}; pw3 = (u32x4){PKW(pB1, 8), PKW(pB1, 10), PKW(pB1, 12), PKW(pB1, 14)};
      const lds_cptr vp_ = vp0 + sl_cur; _Pragma("unroll") for (int i = 0; i < 8; ++i) VRD(i);
      o[0] = MFMA(PAF(0), VFR(0), o[0]); o[1] = MFMA(PAF(0), VFR(4), o[1]); o[0] = MFMA(PAF(1), VFR(1), o[0]); o[1] = MFMA(PAF(1), VFR(5), o[1]);
      o[0] = MFMA(PAF(2), VFR(2), o[0]); o[1] = MFMA(PAF(2), VFR(6), o[1]); o[0] = MFMA(PAF(3), VFR(3), o[0]); o[1] = MFMA(PAF(3), VFR(7), o[1]); }
    { auto rr = __builtin_amdgcn_permlane32_swap(__float_as_uint(l_reg), __float_as_uint(l_reg), false, false); l_reg = __uint_as_float(rr[0]) + __uint_as_float(rr[1]); }
    if (hi == 0) wsf[32 + r32] = l_reg;
    asm volatile("s_waitcnt lgkmcnt(0)\n\ts_barrier" ::: "memory");
#undef DMA_K
#undef DMA_V
#undef ROT
#undef EX
#undef RESC
#undef APPLY
#undef PKW
#undef PAF
#undef VFR
#undef VRD
#undef KRD
#undef ENDW
#undef GAPA
#undef GAPB
#undef STEP
}
constexpr int L8_K = 0, L8_V = 3 * SLOTB, L8_VSLOT = 2 * SLOTB, L8_WS = L8_V + 3 * L8_VSLOT, L8_OST = L8_WS + NW * WSW * 4, L8_Q = L8_OST + NW * 4096, L8_BYTES = L8_Q + NW * 4096;
static_assert(L8_BYTES <= LDS_BYTES, "core128 LDS");
__device__ __forceinline__ float rowmax_h(const f32x16& p0, const f32x16& p1, float hoff) {
    float a = MX3(p0[0], p0[1], p0[2]), b = MX3(p1[0], p1[1], p1[2]);
#pragma unroll
    for (int r = 3; r < 15; r += 2) { a = MX3(a, p0[r], p0[r + 1]); b = MX3(b, p1[r], p1[r + 1]); }
    a = __builtin_fmaxf(a, p0[15]); b = __builtin_fmaxf(b, p1[15]);
    float m = __builtin_fmaxf(a, b) + hoff; auto rr = __builtin_amdgcn_permlane32_swap(__float_as_uint(m), __float_as_uint(m), false, false);
    return __builtin_fmaxf(__uint_as_float(rr[0]), __uint_as_float(rr[1])); }
__device__ __forceinline__ void attn_core128(f32x16 (&o)[4], const bf16* Qw, int qp, const bf16* Kh, int kp, const bf16* Vh, int vp, int qb, float s8, char* lds) {
    int lz_ = threadIdx.x & 63; asm volatile("" : "+v"(lz_));
    const int tid = threadIdx.x, lane = lz_, r32 = lane & 31, hi = lane >> 5; const int wid = __builtin_amdgcn_readfirstlane(tid >> 6);
    const int NT = 4 * qb + 4;
    const unsigned lds0 = (unsigned)(uintptr_t)lds; const lds_fptr wsf = (lds_fptr)((lds_ptr)lds + L8_WS) + wid * WSW;
    const bf16* ksrc = Kh + (long)lane * kp + wid * 8;
    const bf16* vsrc = Vh + (long)(16 * (wid & 3) + (lane >> 2)) * vp + (wid >> 2) * 32 + (lane & 3) * 8;
    const unsigned kdst = lds0 + L8_K + wid * 1024, vdst = lds0 + L8_V + wid * 1024;
#define DMA_K(t, slot) glds16(ksrc + (long)(t) * KVBLK * kp, (unsigned)__builtin_amdgcn_readfirstlane(kdst + (slot)))
#define DMA_V(t, slot) do { glds16(vsrc + (long)(t) * KVBLK * vp, (unsigned)__builtin_amdgcn_readfirstlane(vdst + 2 * (slot))); \
                            glds16(vsrc + (long)(t) * KVBLK * vp + 64, (unsigned)__builtin_amdgcn_readfirstlane(vdst + 2 * (slot) + 8192)); } while (0)
    const lds_cptr vp0 = (lds_cptr)lds + L8_V + ((lane >> 4) & 1) * 32 + (lane & 3) * 8 + (4 * hi + ((lane & 15) >> 2)) * 64;
    const lds_cptr kp0 = (lds_cptr)lds + L8_K + hi * 1024 + r32 * 16;
    const lds_cptr qlp = (lds_cptr)lds + L8_Q + wid * 4096 + hi * 512 + r32 * 16;
#pragma unroll
    for (int d0 = 0; d0 < 4; ++d0) glds16(Qw + (long)r32 * qp + d0 * 16 + hi * 8, (unsigned)__builtin_amdgcn_readfirstlane(lds0 + L8_Q + wid * 4096 + d0 * 1024));
    DMA_K(0, 0); DMA_V(0, 0); DMA_K(1, SLOTB);
#ifdef DBG_QGLOBAL
#define QF(d0) (*reinterpret_cast<const bf16x8*>(&Qw[(long)r32 * qp + (d0) * 16 + hi * 8]))
#else
#define QF(d0) (*(const __attribute__((address_space(3))) bf16x8*)(qlp + (d0) * 1024))
#endif
    float mhat = 0.f, l_reg = 0.f; o[0] = f32x16{}; o[1] = f32x16{}; o[2] = f32x16{}; o[3] = f32x16{};
    const int qrel = wid * QBLK + r32, wch = wid >> 1; bool resc = false;
    float bt = -s8 * (float)(QB * qb + qrel); const float tstep = 64.f * s8, hoff = s8 * (float)(4 * hi);
    f32x16 pA0, pA1, pB0, pB1; bf16x8 kf[8]; s16x4 vlo[8], vhi[8]; u32x4 pw0, pw1, pw2, pw3;
    int sl_prev = 0, sl_cur = 0, sl_next = SLOTB;
#define ROT() do { sl_prev = sl_cur; sl_cur = sl_next; sl_next = (sl_next == 2 * SLOTB) ? 0 : sl_next + SLOTB; } while (0)
#define EX(v, nm) __builtin_amdgcn_exp2f(__builtin_fmaf((v), C2, (nm)))
#define RESC() do { if (resc) { _Pragma("unroll") for (int d_ = 0; d_ < 4; ++d_) _Pragma("unroll") for (int r = 0; r < 16; ++r) o[d_][r] *= wsf[crow(r, hi)]; } } while (0)
#define BIAS(C0, C1) do { _Pragma("unroll") for (int e = 0; e < 16; ++e) { C0[e] = __builtin_fmaf(s8, (float)((e & 3) + 8 * (e >> 2)), C0[e]); C1[e] = __builtin_fmaf(s8, (float)(32 + (e & 3) + 8 * (e >> 2)), C1[e]); } } while (0)
#define APPLY(C0, C1, t, BAND) do { \
    if (BAND) { const int jb_ = (t) - (NT - 4); const float binv_ = (jb_ > wch) ? -INFINITY : 0.f, m2_ = (jb_ == wch) ? -2.f * s8 : 0.f, fb_ = (float)(4 * hi - (qrel - 64 * wch)); float fbo_ = fb_; asm volatile("" : "+v"(fbo_)); SBAR(); \
        _Pragma("unroll") for (int e = 0; e < 16; ++e) { const float d0_ = fbo_ + (float)((e & 3) + 8 * (e >> 2)); \
            C0[e] = __builtin_fmaf(__builtin_fmaxf(d0_, 0.f), m2_, C0[e] + binv_); C1[e] = __builtin_fmaf(__builtin_fmaxf(d0_ + 32.f, 0.f), m2_, C1[e] + binv_); if ((e & 1) == 1) SBAR(); } } } while (0)
    DMA_K(2, 2 * SLOTB);
    WAIT_BAR(4);
    _Pragma("unroll") for (int d0 = 0; d0 < 4; ++d0) kload2(kf, kp0, d0);
    { const bf16x8 q0 = QF(0), q1 = QF(1), q2 = QF(2), q3 = QF(3); const f32x16 z = f32x16{};
      pA0 = MFMA(kf[0], q0, z); pA1 = MFMA(kf[1], q0, z); pA0 = MFMA(kf[2], q1, pA0); pA1 = MFMA(kf[3], q1, pA1);
      pA0 = MFMA(kf[4], q2, pA0); pA1 = MFMA(kf[5], q2, pA1); pA0 = MFMA(kf[6], q3, pA0); pA1 = MFMA(kf[7], q3, pA1); }
    BIAS(pA0, pA1); APPLY(pA0, pA1, 0, true);
    { const float rm = rowmax_h(pA0, pA1, hoff); mhat = __builtin_fmaxf((rm + bt) * C2, -30000.f); const float nmh = __builtin_fmaf(bt + hoff, C2, -mhat);
#pragma unroll
      for (int r = 0; r < 16; ++r) { pA0[r] = EX(pA0[r], nmh); pA1[r] = EX(pA1[r], nmh); } }
    bt += tstep;
    WAIT_BAR(0);
    DMA_K(3, 0); DMA_V(1, SLOTB); ROT();
    _Pragma("unroll") for (int d0 = 0; d0 < 4; ++d0) kload2(kf, kp0 + sl_cur, d0);
    WAIT_BAR(3);
#define PKW(P, i) cvtpk(P[i], P[i + 1])
#define PAF(k) __builtin_bit_cast(bf16x8, pw##k)
#define VFR(i) (bf16x8){vlo[i][0], vlo[i][1], vlo[i][2], vlo[i][3], vhi[i][0], vhi[i][1], vhi[i][2], vhi[i][3]}
#define VRD(i, hofs) do { vlo[i] = vtr(vp_ + ((hofs) + ((i) >> 2) * 4096 + ((i) & 3) * 1024)); vhi[i] = vtr(vp_ + ((hofs) + ((i) >> 2) * 4096 + ((i) & 3) * 1024 + 512)); } while (0)
#define KRD(G, d0) do { if (G) { kload2(kf, kp0 + sl_next, d0); SBAR(); } } while (0)
#define GAPA(MF, a0, a1, a2, a3, W0, W1, PW) do { MF; sacc += a0; sacc += a1; sacc += a2; sacc += a3; W0; W1; PIN(PW); PIN(sacc); SBAR(); } while (0)
#define GAPB1(MF, i, X, j, nm) do { MF; VRD(i, 8192); X[j] = EX(X[j], nm); X[j + 1] = EX(X[j + 1], nm); PIN(X); SBAR(); } while (0)
#define GAPB2(MF, X, j, nm) do { MF; X[j] = EX(X[j], nm); X[j + 1] = EX(X[j + 1], nm); PIN(X); SBAR(); } while (0)
#define STEP(C0, C1, P0, P1, t, BAND, GK, GV, GL) do { SBAR(); \
    const lds_cptr vp_ = vp0 + 2 * sl_prev; \
    VRD(0, 0); bf16x8 qa_ = QF(0); SBAR(); float sacc = P0[0] + P0[1]; const f32x16 z_ = f32x16{}; \
                       GAPA(C0 = MFMA(kf[0], qa_, z_), P0[2], P0[3], P0[4], P0[5],     pw0[0] = PKW(P0, 0),  pw0[1] = PKW(P0, 2),  pw0); \
    VRD(4, 0); bf16x8 qb_ = QF(1); SBAR(); GAPA(C1 = MFMA(kf[1], qa_, z_), P0[6], P0[7], P0[8], P0[9],     pw0[2] = PKW(P0, 4),  pw0[3] = PKW(P0, 6),  pw0);     \
    VRD(1, 0); SBAR(); GAPA(C0 = MFMA(kf[2], qb_, C0),  P0[10], P0[11], P0[12], P0[13], pw1[0] = PKW(P0, 8),  pw1[1] = PKW(P0, 10), pw1); \
    VRD(5, 0); qa_ = QF(2); SBAR(); GAPA(C1 = MFMA(kf[3], qb_, C1),  P0[14], P0[15], P1[0], P1[1],   pw1[2] = PKW(P0, 12), pw1[3] = PKW(P0, 14), pw1); \
    VRD(2, 0); SBAR(); GAPA(C0 = MFMA(kf[4], qa_, C0),  P1[2], P1[3], P1[4], P1[5],     pw2[0] = PKW(P1, 0),  pw2[1] = PKW(P1, 2),  pw2); \
    VRD(6, 0); qb_ = QF(3); SBAR(); GAPA(C1 = MFMA(kf[5], qa_, C1),  P1[6], P1[7], P1[8], P1[9],     pw2[2] = PKW(P1, 4),  pw2[3] = PKW(P1, 6),  pw2); \
    VRD(3, 0); SBAR(); GAPA(C0 = MFMA(kf[6], qb_, C0),  P1[10], P1[11], P1[12], P1[13], pw3[0] = PKW(P1, 8),  pw3[1] = PKW(P1, 10), pw3); \
    VRD(7, 0); SBAR(); GAPA(C1 = MFMA(kf[7], qb_, C1),  P1[14], P1[15], 0.f, 0.f,       pw3[2] = PKW(P1, 12), pw3[3] = PKW(P1, 14), pw3); \
    l_reg += sacc; \
    if (GK) DMA_K((t) + 3, sl_cur); if (GV) DMA_V((t) + 1, sl_next); \
    BIAS(C0, C1); APPLY(C0, C1, t, BAND); \
    { const float rm = __builtin_fmaf(rowmax_h(C0, C1, hoff) + bt, C2, -mhat); resc = false; \
      if (__builtin_expect(__any(rm > ATT_THR), 0)) { const float dl = __builtin_fmaxf(rm, 0.f); mhat += dl; \
          const float f = __builtin_amdgcn_exp2f(-dl); l_reg *= f; if (hi == 0) wsf[r32] = f; resc = true; } } \
    const float nmh = __builtin_fmaf(bt + hoff, C2, -mhat); bt += tstep; SBAR(); \
    GAPB1(o[0] = MFMA(PAF(0), VFR(0), o[0]), 0, C0, 0, nmh);              GAPB1(o[1] = MFMA(PAF(0), VFR(4), o[1]), 4, C0, 2, nmh); \
    GAPB1(o[0] = MFMA(PAF(1), VFR(1), o[0]), 1, C0, 4, nmh);              GAPB1(o[1] = MFMA(PAF(1), VFR(5), o[1]), 5, C0, 6, nmh); \
    GAPB1(o[0] = MFMA(PAF(2), VFR(2), o[0]), 2, C0, 8, nmh);              GAPB1(o[1] = MFMA(PAF(2), VFR(6), o[1]), 6, C0, 10, nmh); \
    GAPB1(o[0] = MFMA(PAF(3), VFR(3), o[0]), 3, C0, 12, nmh);             GAPB1(o[1] = MFMA(PAF(3), VFR(7), o[1]), 7, C0, 14, nmh); \
    GAPB2(o[2] = MFMA(PAF(0), VFR(0), o[2]), C1, 0, nmh);                 GAPB2(o[3] = MFMA(PAF(0), VFR(4), o[3]), C1, 2, nmh); \
    KRD(GL, 0); GAPB2(o[2] = MFMA(PAF(1), VFR(1), o[2]), C1, 4, nmh);     KRD(GL, 1); GAPB2(o[3] = MFMA(PAF(1), VFR(5), o[3]), C1, 6, nmh); \
    KRD(GL, 2); GAPB2(o[2] = MFMA(PAF(2), VFR(2), o[2]), C1, 8, nmh);     KRD(GL, 3); GAPB2(o[3] = MFMA(PAF(2), VFR(6), o[3]), C1, 10, nmh); \
    GAPB2(o[2] = MFMA(PAF(3), VFR(3), o[2]), C1, 12, nmh);                GAPB2(o[3] = MFMA(PAF(3), VFR(7), o[3]), C1, 14, nmh); \
    } while (0)
    int t = 1;
    for (; t + 5 < NT; t += 2) {
        STEP(pB0, pB1, pA0, pA1, t, false, true, true, true);     WAIT_BAR(3); RESC(); ROT();
        STEP(pA0, pA1, pB0, pB1, t + 1, false, true, true, true); WAIT_BAR(3); RESC(); ROT();
    }
#define ENDW(tt) do { if ((tt) + 3 < NT) { WAIT_BAR(3); } else if ((tt) + 2 < NT) { WAIT_BAR(2); } else { WAIT_BAR(0); } } while (0)
    for (; t + 1 < NT; t += 2) {
        STEP(pB0, pB1, pA0, pA1, t, true, (t + 3 < NT), (t + 1 < NT), (t + 1 < NT));         ENDW(t);     RESC(); ROT();
        STEP(pA0, pA1, pB0, pB1, t + 1, true, (t + 4 < NT), (t + 2 < NT), (t + 2 < NT));     ENDW(t + 1); RESC(); ROT();
    }
    STEP(pB0, pB1, pA0, pA1, NT - 1, true, false, false, false); RESC();
    { float sacc = pB0[0] + pB0[1];
#pragma unroll
      for (int r = 2; r < 16; ++r) sacc += pB0[r];
#pragma unroll
      for (int r = 0; r < 16; ++r) sacc += pB1[r];
      l_reg += sacc;
      pw0 = (u32x4){PKW(pB0, 0), PKW(pB0, 2), PKW(pB0, 4), PKW(pB0, 6)}; pw1 = (u32x4){PKW(pB0, 8), PKW(pB0, 10), PKW(pB0, 12), PKW(pB0, 14)};
      pw2 = (u32x4){PKW(pB1, 0), PKW(pB1, 2), PKW(pB1, 4), PKW(pB1, 6)}; pw3 = (u32x4){PKW(pB1, 8), PKW(pB1, 10), PKW(pB1, 12), PKW(pB1, 14)};
      const lds_cptr vp_ = vp0 + 2 * sl_cur;
#pragma unroll
      for (int hf = 0; hf < 2; ++hf) {
        _Pragma("unroll") for (int i = 0; i < 8; ++i) VRD(i, hf * 8192);
        o[2 * hf] = MFMA(PAF(0), VFR(0), o[2 * hf]); o[2 * hf + 1] = MFMA(PAF(0), VFR(4), o[2 * hf + 1]); o[2 * hf] = MFMA(PAF(1), VFR(1), o[2 * hf]); o[2 * hf + 1] = MFMA(PAF(1), VFR(5), o[2 * hf + 1]);
        o[2 * hf] = MFMA(PAF(2), VFR(2), o[2 * hf]); o[2 * hf + 1] = MFMA(PAF(2), VFR(6), o[2 * hf + 1]); o[2 * hf] = MFMA(PAF(3), VFR(3), o[2 * hf]); o[2 * hf + 1] = MFMA(PAF(3), VFR(7), o[2 * hf + 1]); } }
    { auto rr = __builtin_amdgcn_permlane32_swap(__float_as_uint(l_reg), __float_as_uint(l_reg), false, false); l_reg = __uint_as_float(rr[0]) + __uint_as_float(rr[1]); }
    if (hi == 0) wsf[32 + r32] = l_reg;
    asm volatile("s_waitcnt lgkmcnt(0)\n\ts_barrier" ::: "memory");
#undef DMA_K
#undef DMA_V
#undef QF
#undef ROT
#undef EX
#undef RESC
#undef BIAS
#undef APPLY
#undef PKW
#undef PAF
#undef VFR
#undef VRD
#undef KRD
#undef ENDW
#undef GAPA
#undef GAPB1
#undef GAPB2
#undef STEP
}
__device__ __forceinline__ void unit_a(int b, int h, int qb, const bf16* QA, const bf16* KA, const bf16* VA, const unsigned long long* MASK, bf16* YA, char* lds) {
    const int tid = threadIdx.x; const int wid = __builtin_amdgcn_readfirstlane(tid >> 6);
    const long rowbase = (long)b * SEQ; const long qrow0 = rowbase + qb * QB + wid * QBLK;
    const float s8 = 8.f * __builtin_amdgcn_exp2f(-(float)(h + 1));
    f32x16 o[2];
    attn_core<true>(o, QA + qrow0 * 512 + h * 64, 512, KA + rowbase * 512 + h * 64, 512, VA + rowbase * 512 + h * 64, 512, qb, s8,
                    MASK + ((size_t)(b * 64 + qb * 8 + wid) * 32) * 32, lds);
    int lz = threadIdx.x & 63; asm volatile("" : "+v"(lz));
    const int lane = lz, r32 = lz & 31, hi = lz >> 5;
    const lds_fptr wsf = (lds_fptr)((lds_ptr)lds + LDS_WS) + wid * WSW;
    float rli[16];
#pragma unroll
    for (int r = 0; r < 16; ++r) rli[r] = __builtin_amdgcn_rcpf(wsf[32 + crow(r, hi)]) * (1.0f + SCALE_A_EPS);
    typedef __attribute__((address_space(3))) unsigned short* lds_hptr;
    const lds_hptr stg = (lds_hptr)((lds_ptr)lds + LDS_OST) + wid * 2048;
#pragma unroll
    for (int r = 0; r < 16; ++r) { const int orow = crow(r, hi);
#pragma unroll
        for (int d0 = 0; d0 < 2; ++d0) stg[orow * 64 + d0 * 32 + r32] = f2bf(o[d0][r] * rli[r]); }
    asm volatile("s_waitcnt lgkmcnt(0)" ::: "memory");
    bf16* Ow = YA + qrow0 * 1024 + h * 64;
#pragma unroll
    for (int i = 0; i < 4; ++i) { const int row = i * 8 + (lane >> 3), ch = lane & 7; *(u32x4*)(Ow + (long)row * 1024 + ch * 8) = *(const __attribute__((address_space(3))) u32x4*)(stg + row * 64 + ch * 8); }
    asm volatile("s_waitcnt lgkmcnt(0)" ::: "memory");
}
__device__ __forceinline__ void unit_b128(int b, int h, int qb, const bf16* QBq, const bf16* KBk, const bf16* VBv, const float* subln_g, float lam, bf16* YB, unsigned* stash_g, int slot, char* lds) {
    const int tid = threadIdx.x; const int wid = __builtin_amdgcn_readfirstlane(tid >> 6);
    const long rowbase = (long)b * SEQ; const long qrow0 = rowbase + qb * QB + wid * QBLK;
    const float s8 = 8.f * __builtin_amdgcn_exp2f(-2.f * (float)(h + 1));
    typedef __attribute__((address_space(3))) unsigned short* lds_hptr;
    _Pragma("nounroll") for (int m = 0; m < 2; ++m) {
        f32x16 o[4];
        attn_core128(o, QBq + qrow0 * 512 + (2 * h + m) * 64, 512, KBk + rowbase * 512 + (2 * h + m) * 64, 512, VBv + rowbase * 512 + h * 128, 512, qb, s8, lds);
        int lz = threadIdx.x & 63; asm volatile("" : "+v"(lz));
        const int lane = lz, r32 = lz & 31, hi = lz >> 5;
        const lds_fptr wsf = (lds_fptr)((lds_ptr)lds + L8_WS) + wid * WSW;
        const lds_hptr stg = (lds_hptr)((lds_ptr)lds + L8_OST) + wid * 2048;
        unsigned* sg = stash_g + (((size_t)blockIdx.x * 2 + slot) * NW + wid) * 2048 + lane;
        bf16* Ow = YB + qrow0 * 1024 + 512 + h * 128;
        float rli[16];
#pragma unroll
        for (int r = 0; r < 16; ++r) rli[r] = __builtin_amdgcn_rcpf(wsf[32 + crow(r, hi)]);
        if (m == 0) {
#pragma unroll
            for (int d = 0; d < 4; ++d)
#pragma unroll
                for (int r = 0; r < 16; r += 2) sg[(d * 8 + (r >> 1)) * 64] = cvtpk(o[d][r] * rli[r], o[d][r + 1] * rli[r + 1]);
        } else {
            float ssp[16];
#pragma unroll
            for (int r = 0; r < 16; ++r) ssp[r] = 0.f;
#pragma unroll
            for (int d = 0; d < 4; ++d)
#pragma unroll
                for (int r = 0; r < 16; r += 2) { const unsigned w = __hip_atomic_load(sg + (d * 8 + (r >> 1)) * 64, __ATOMIC_RELAXED, __HIP_MEMORY_SCOPE_AGENT);
                    const float v0 = __uint_as_float(w << 16) - lam * (o[d][r] * rli[r]), v1 = __uint_as_float(w & 0xffff0000u) - lam * (o[d][r + 1] * rli[r + 1]);
                    o[d][r] = v0; o[d][r + 1] = v1; ssp[r] += v0 * v0; ssp[r + 1] += v1 * v1; }
#pragma unroll
            for (int r = 0; r < 16; ++r) {
#pragma unroll
                for (int off = 1; off < 32; off <<= 1) ssp[r] += __shfl_xor(ssp[r], off); }
#pragma unroll
            for (int r = 0; r < 16; ++r) ssp[r] = __builtin_amdgcn_rsqf(ssp[r] * (1.0f / 128.0f) + 1e-6f) * (0.8f * (1.0f + SCALE_B_EPS));
            if (r32 == 0) {
#pragma unroll
                for (int r = 0; r < 16; ++r) wsf[64 + crow(r, hi)] = ssp[r]; }
            asm volatile("s_waitcnt lgkmcnt(0)" ::: "memory");
#pragma unroll
            for (int e = 0; e < 2; ++e) {
#pragma unroll
                for (int r = 0; r < 16; ++r) { const int orow = crow(r, hi);
#pragma unroll
                    for (int d0 = 0; d0 < 2; ++d0) stg[orow * 64 + d0 * 32 + r32] = f2bf(o[2 * e + d0][r]); }
                asm volatile("s_waitcnt lgkmcnt(0)" ::: "memory");
                const int ch = lane & 7;
                const float4 g0 = *(const float4*)(subln_g + e * 64 + ch * 8), g1 = *(const float4*)(subln_g + e * 64 + ch * 8 + 4);
#pragma unroll
                for (int i = 0; i < 4; ++i) { const int row = i * 8 + (lane >> 3); const float rs = wsf[64 + row];
                    const u32x4 w = *(const __attribute__((address_space(3))) u32x4*)(stg + row * 64 + ch * 8); u32x4 ov;
                    ov.x = cvtpk(__uint_as_float(w.x << 16) * rs * g0.x, __uint_as_float(w.x & 0xffff0000u) * rs * g0.y);
                    ov.y = cvtpk(__uint_as_float(w.y << 16) * rs * g0.z, __uint_as_float(w.y & 0xffff0000u) * rs * g0.w);
                    ov.z = cvtpk(__uint_as_float(w.z << 16) * rs * g1.x, __uint_as_float(w.z & 0xffff0000u) * rs * g1.y);
                    ov.w = cvtpk(__uint_as_float(w.w << 16) * rs * g1.z, __uint_as_float(w.w & 0xffff0000u) * rs * g1.w);
                    *(u32x4*)(Ow + (long)row * 1024 + e * 64 + ch * 8) = ov; }
                asm volatile("s_waitcnt lgkmcnt(0)" ::: "memory");
            }
        }
    }
}
#undef SBAR
#undef PIN
#undef MFMA
#undef WAIT_BAR
#undef MX3
}
#ifndef KEYMASK
#define KEYMASK 0xfffff800u
#endif
namespace sel {
using att::bf16x8; using att::f32x16; using att::crow; typedef unsigned short bf16;
constexpr int TBP = 513;
__device__ __forceinline__ void select_unit(int b, int qk, const bf16* QI, const bf16* KI, const float* WI, unsigned long long* MASK, char* lds) {
    int lz_ = threadIdx.x & 63; asm volatile("" : "+v"(lz_));
    const int tid = threadIdx.x, lane = lz_, r32 = lane & 31, hi = lane >> 5; const int wid = __builtin_amdgcn_readfirstlane(tid >> 6);
    const int ntv = (qk >> 1) + 1;
    unsigned long long* mbase = MASK + ((size_t)(b * 64 + qk) * 32) * 32;
    if (qk < 8) {
        for (int i = tid; i < 32 * 32; i += 512) mbase[i] = ((i >> 5) < ntv) ? ~0ull : 0ull;
        return;
    }
    typedef __attribute__((address_space(3))) char* lds_ptr;
    typedef __attribute__((address_space(3))) unsigned* lds_uptr;
    const lds_ptr QL = (lds_ptr)lds;
    const lds_uptr TB = (lds_uptr)((lds_ptr)lds + 16384);
    const size_t qrow0 = (size_t)b * 2048 + qk * 32;
    { const int c = tid & 31, q0 = tid >> 5;
#pragma unroll
      for (int u = 0; u < 2; ++u) { const int q = q0 + 16 * u; *(__attribute__((address_space(3))) att::u32x4*)(QL + c * 512 + q * 16) = *(const att::u32x4*)(QI + (qrow0 + q) * 256 + c * 8); } }
    typedef float f32x4_t __attribute__((ext_vector_type(4)));
    const f32x4_t wv = *(const f32x4_t*)(WI + (qrow0 + r32) * 4);
    __syncthreads();
    unsigned keyT[4][32];
    bf16x8 kfa[2][4];
#define SEL_KLOAD(jn) do { _Pragma("unroll") for (int p_ = 0; p_ < 2; ++p_) _Pragma("unroll") for (int d0 = 0; d0 < 4; ++d0) \
        kfa[p_][d0] = *(const bf16x8*)(KI + ((size_t)b * 2048 + (jn) * 64 + p_ * 32 + r32) * 64 + d0 * 16 + hi * 8); } while (0)
    if (wid < ntv) SEL_KLOAD(wid);
#pragma unroll
    for (int jj = 0; jj < 4; ++jj) {
        if (8 * jj < ntv) {
            const int j = 8 * jj + wid;
            unsigned kk[32];
            if (j < ntv) {
#pragma unroll
                for (int p = 0; p < 2; ++p) {
                    const bf16x8 kf[4] = {kfa[p][0], kfa[p][1], kfa[p][2], kfa[p][3]};
                    f32x16 s0 = f32x16{};
#pragma unroll
                    for (int h = 0; h < 4; ++h) {
                        bf16x8 qf[4];
#pragma unroll
                        for (int d0 = 0; d0 < 4; ++d0) qf[d0] = *(const __attribute__((address_space(3))) bf16x8*)(QL + ((h * 4 + d0) * 2 + hi) * 512 + r32 * 16);
                        f32x16 y0 = f32x16{};
#pragma unroll
                        for (int d0 = 0; d0 < 4; ++d0) y0 = __builtin_amdgcn_mfma_f32_32x32x16_bf16(kf[d0], qf[d0], y0, 0, 0, 0);
                        asm volatile("" : "+v"(y0));
                        const float w = wv[h];
#pragma unroll
                        for (int r = 0; r < 16; ++r) { const float yv = y0[r]; const int yi = __float_as_int(yv); s0[r] = __builtin_fmaf(__int_as_float(yi > 0 ? yi : 0), w, s0[r]); }
                    }
#pragma unroll
                    for (int r = 0; r < 16; ++r) {
                        const unsigned idx = (unsigned)(j * 64 + p * 32 + crow(r, hi));
                        const unsigned u = __float_as_uint(s0[r]); const unsigned m = (unsigned)(((int)u) >> 31) | 0x80000000u; kk[16 * p + r] = ((u ^ m) & KEYMASK) | (2047u - idx);
                    }
                    __builtin_amdgcn_sched_barrier(0);
                }
            } else {
#pragma unroll
                for (int e = 0; e < 32; ++e) kk[e] = 0u;
            }
            if (jj < 3 && j + 8 < ntv) SEL_KLOAD(j + 8);
#pragma unroll
            for (int p = 0; p < 2; ++p)
#pragma unroll
                for (int r = 0; r < 16; ++r) TB[r32 * TBP + 64 * wid + 32 * p + crow(r, hi)] = kk[16 * p + r];
            __syncthreads();
#pragma unroll
            for (int i = 0; i < 4; ++i)
#pragma unroll
                for (int t = 0; t < 8; ++t) keyT[jj][8 * i + t] = TB[(4 * wid + i) * TBP + 64 * t + lane];
            __syncthreads();
        } else {
#pragma unroll
            for (int e = 0; e < 32; ++e) keyT[jj][e] = 0u;
        }
    }
    unsigned T0 = 0u, T1 = 0u, T2 = 0u, T3 = 0u; bool dn0 = false, dn1 = false, dn2 = false, dn3 = false;
#define SEL_CNT8(c_, cand, K, o) do { unsigned long long m0_, m1_, m2_, m3_, m4_, m5_, m6_, m7_; unsigned t_; \
        asm volatile("v_cmp_le_u32_e64 %0, %10, %11\n\tv_cmp_le_u32_e64 %1, %10, %12\n\tv_cmp_le_u32_e64 %2, %10, %13\n\tv_cmp_le_u32_e64 %3, %10, %14\n\t" \
                     "v_cmp_le_u32_e64 %4, %10, %15\n\tv_cmp_le_u32_e64 %5, %10, %16\n\tv_cmp_le_u32_e64 %6, %10, %17\n\tv_cmp_le_u32_e64 %7, %10, %18\n\t" \
                     "s_bcnt1_i32_b64 %8, %0\n\ts_add_u32 %9, %9, %8\n\ts_bcnt1_i32_b64 %8, %1\n\ts_add_u32 %9, %9, %8\n\ts_bcnt1_i32_b64 %8, %2\n\ts_add_u32 %9, %9, %8\n\ts_bcnt1_i32_b64 %8, %3\n\ts_add_u32 %9, %9, %8\n\t" \
                     "s_bcnt1_i32_b64 %8, %4\n\ts_add_u32 %9, %9, %8\n\ts_bcnt1_i32_b64 %8, %5\n\ts_add_u32 %9, %9, %8\n\ts_bcnt1_i32_b64 %8, %6\n\ts_add_u32 %9, %9, %8\n\ts_bcnt1_i32_b64 %8, %7\n\ts_add_u32 %9, %9, %8" \
                     : "=&s"(m0_), "=&s"(m1_), "=&s"(m2_), "=&s"(m3_), "=&s"(m4_), "=&s"(m5_), "=&s"(m6_), "=&s"(m7_), "=&s"(t_), "+s"(c_) \
                     : "s"(cand), "v"(K[(o)]), "v"(K[(o) + 1]), "v"(K[(o) + 2]), "v"(K[(o) + 3]), "v"(K[(o) + 4]), "v"(K[(o) + 5]), "v"(K[(o) + 6]), "v"(K[(o) + 7]) : "scc"); } while (0)
#define SEL_CNT4(c_, cand, K, o) do { unsigned long long m0_, m1_, m2_, m3_; unsigned t_; \
        asm volatile("v_cmp_le_u32_e64 %0, %6, %7\n\tv_cmp_le_u32_e64 %1, %6, %8\n\tv_cmp_le_u32_e64 %2, %6, %9\n\tv_cmp_le_u32_e64 %3, %6, %10\n\t" \
                     "s_bcnt1_i32_b64 %4, %0\n\ts_add_u32 %5, %5, %4\n\ts_bcnt1_i32_b64 %4, %1\n\ts_add_u32 %5, %5, %4\n\ts_bcnt1_i32_b64 %4, %2\n\ts_add_u32 %5, %5, %4\n\ts_bcnt1_i32_b64 %4, %3\n\ts_add_u32 %5, %5, %4" \
                     : "=&s"(m0_), "=&s"(m1_), "=&s"(m2_), "=&s"(m3_), "=&s"(t_), "+s"(c_) \
                     : "s"(cand), "v"(K[(o)]), "v"(K[(o) + 1]), "v"(K[(o) + 2]), "v"(K[(o) + 3]) : "scc"); } while (0)
#ifdef SEL_SAFE
#define SEL_CNT(i, cand) ({ unsigned c_ = 0u; \
        _Pragma("unroll") for (int jj = 0; jj < 4; ++jj) { if (8 * jj < ntv) { \
            _Pragma("unroll") for (int t = 0; t < 8; ++t) c_ += (unsigned)__builtin_popcountll(__ballot(keyT[jj][8 * (i) + t] >= (cand))); __builtin_amdgcn_sched_barrier(0); } } c_; })
#else
#define SEL_CNT(i, cand) ({ unsigned c_ = 0u; const unsigned cd_ = (unsigned)__builtin_amdgcn_readfirstlane((int)(cand)); \
        _Pragma("unroll") for (int jj = 0; jj < 4; ++jj) { if (8 * jj + 4 < ntv) { SEL_CNT8(c_, cd_, keyT[jj], 8 * (i)); } else if (8 * jj < ntv) { SEL_CNT4(c_, cd_, keyT[jj], 8 * (i)); } } c_; })
#endif
    for (int bit = 31; bit >= 0; --bit) {
        const unsigned bm = 1u << bit;
        if (!dn0) { const unsigned c = SEL_CNT(0, T0 | bm); if (c >= 256u) T0 |= bm; dn0 = (c == 256u); }
        if (!dn1) { const unsigned c = SEL_CNT(1, T1 | bm); if (c >= 256u) T1 |= bm; dn1 = (c == 256u); }
        if (!dn2) { const unsigned c = SEL_CNT(2, T2 | bm); if (c >= 256u) T2 |= bm; dn2 = (c == 256u); }
        if (!dn3) { const unsigned c = SEL_CNT(3, T3 | bm); if (c >= 256u) T3 |= bm; dn3 = (c == 256u); }
        if (dn0 && dn1 && dn2 && dn3) break;
    }
#undef SEL_CNT
#undef SEL_KLOAD
#undef SEL_CNT8
#undef SEL_CNT4
#pragma unroll
    for (int i = 0; i < 4; ++i) {
        const unsigned Ti = (i == 0) ? T0 : (i == 1) ? T1 : (i == 2) ? T2 : T3;
        unsigned wlo = 0u, whi = 0u;
#pragma unroll
        for (int jj = 0; jj < 4; ++jj) { int ln_ = lane; asm volatile("" : "+v"(ln_));
#pragma unroll
            for (int t = 0; t < 8; ++t) { const unsigned long long mk = __ballot(keyT[jj][8 * i + t] >= Ti);
                wlo = (ln_ == 8 * jj + t) ? (unsigned)mk : wlo; whi = (ln_ == 8 * jj + t) ? (unsigned)(mk >> 32) : whi; if ((t & 3) == 3) __builtin_amdgcn_sched_barrier(0); } }
        if (lane < 32) mbase[(size_t)lane * 32 + 4 * wid + i] = ((unsigned long long)whi << 32) | wlo;
    }
    __syncthreads();
}
}
constexpr int NWAVES = 8;
#ifndef MK_N_LAUNCHES
#define MK_N_LAUNCHES 1
#endif
constexpr int N_PHASES = 10;
constexpr int N_LAUNCHES = MK_N_LAUNCHES;
constexpr int BATCH = 16, SEQ = 2048, DM = 1024, M = BATCH * SEQ, DFF = 2816, W_IN = 5444, NPROJ = 5632, NFF13 = 5632;
constexpr size_t MiB = 1u << 20;
constexpr size_t WS_CTL = 0, CTL_ZERO_BYTES = 64 * 1024;
constexpr size_t WS_MOD = 1 * MiB;
constexpr size_t WS_LAM = 1 * MiB + 512 * 1024;
constexpr size_t WS_GN = 1 * MiB + 768 * 1024;
constexpr size_t WS_WIN = 2 * MiB, WS_WUA = 13 * MiB  , WS_WO = 15 * MiB, WS_W13 = 17 * MiB, WS_W2 = 28 * MiB;
constexpr size_t WS_XH = 64 * MiB;
constexpr size_t WS_YA = 64 * MiB;
constexpr size_t WS_QA = 128 * MiB, WS_KA = 160 * MiB, WS_VA = 192 * MiB, WS_QB = 224 * MiB, WS_KB = 256 * MiB, WS_VB = 288 * MiB, WS_QI = 320 * MiB, WS_KI = 336 * MiB, WS_WI = 340 * MiB;
constexpr size_t WS_MG = 128 * MiB;
constexpr size_t WS_HID = 128 * MiB;
constexpr size_t WS_GT = 344 * MiB;
constexpr size_t WS_MASK = 472 * MiB;
constexpr size_t WS_STASH = 480 * MiB;
constexpr size_t WS_END = 512 * MiB;
static_assert(epi::PWS_GN == WS_GN && epi::PWS_QA == WS_QA && epi::PWS_QI == WS_QI && epi::PWS_KI == WS_KI && epi::PWS_WI == WS_WI && epi::PWS_GT == WS_GT && WS_KA - WS_QA == 32 * MiB && WS_VB - WS_QA == 160 * MiB, "EpiProj offsets");
static_assert(WS_W2 + (size_t)DM * DFF * 2 <= WS_XH && WS_WI + (size_t)M * 16 <= WS_GT && WS_HID + (size_t)M * DFF * 2 <= WS_GT && WS_GT + (size_t)M * 2048 * 2 <= WS_MASK, "d_ws map");
constexpr int CW_BAR = 1024;
constexpr int RING_BYTES = 151552;
constexpr int LDSCTL_OFF = RING_BYTES, MISC_OFF = LDSCTL_OFF + 320, LDS_BYTES = 155648;
static_assert(att::LDS_BYTES <= RING_BYTES && pg8::STAGE_BYTES <= RING_BYTES && MISC_OFF + 128 <= LDS_BYTES, "LDS map");

#define GAS __attribute__((address_space(1)))
#define LAS __attribute__((address_space(3)))
typedef unsigned short bf16;
typedef unsigned v4u __attribute__((ext_vector_type(4)));
typedef float f32x4 __attribute__((ext_vector_type(4)));
typedef GAS unsigned gu32;
#define RLX_AGENT __ATOMIC_RELAXED, __HIP_MEMORY_SCOPE_AGENT
#define LDS_WAIT() asm volatile("s_waitcnt lgkmcnt(0)" ::: "memory")
__device__ __forceinline__ unsigned f2bf(float f) { unsigned u = __builtin_bit_cast(unsigned, f); return (u + 0x7fffu + ((u >> 16) & 1u)) >> 16; }
__device__ __forceinline__ unsigned pk2(float lo, float hi) { return f2bf(lo) | (f2bf(hi) << 16); }
#define XB_TMO      128
#define XB_XCNT(j)  (256  + 64 * (j))
#define XB_XSUB(j)  (1280 + 64 * (j))
#define XB_XGEN(j)  (2304 + 64 * (j))
#define XB_TOP      3328
#define XB_TOPGEN   3392
#define XCD_BAR_WORDS 3456
#ifdef CHECKER
#define XB_SPIN_CAP (1u << 27)
#else
#define XB_SPIN_CAP (1u << 18)
#endif

__device__ __forceinline__ unsigned xb_ld(unsigned* p)              { return __hip_atomic_load(p, __ATOMIC_RELAXED, __HIP_MEMORY_SCOPE_AGENT); }
__device__ __forceinline__ unsigned xb_add(unsigned* p, unsigned v) { return __hip_atomic_fetch_add(p, v, __ATOMIC_RELAXED, __HIP_MEMORY_SCOPE_AGENT); }
__device__ __forceinline__ unsigned xb_xcc_id() { return (unsigned)__builtin_amdgcn_s_getreg((3 << 11) | 20) & 0xFu; }
#define XB_SPIN(cond, bar) do { unsigned _sp = 0; while (cond) { __builtin_amdgcn_s_sleep(1); \
    if ((++_sp & 255u) == 0u) { if (xb_ld(&(bar)[XB_TMO])) break; if (_sp > XB_SPIN_CAP) { atomicAdd(&(bar)[XB_TMO], 1u); break; } } } } while (0)

struct XcdBarrier {
    unsigned* bar; unsigned x;
    volatile LAS unsigned* st;
};

__device__ __forceinline__ XcdBarrier xcd_barrier_post(unsigned* bar, volatile LAS unsigned* st) {
    XcdBarrier b; b.bar = bar; b.x = xb_xcc_id(); b.st = st;
    if (threadIdx.x == 0) (void)xb_add(&bar[XB_XCNT(b.x)], 1u);
    return b;
}
__device__ __forceinline__ void xcd_barrier_complete(unsigned* bar, unsigned x, unsigned& nloc, unsigned& nx) {
    const unsigned G = gridDim.x * gridDim.y * gridDim.z;
    unsigned sum, cnt, mine, sp = 0u;
    for (;;) {
        sum = 0u; cnt = 0u; mine = 0u;
#pragma unroll
        for (unsigned j = 0; j < 16; ++j) { const unsigned c = xb_ld(&bar[XB_XCNT(j)]); sum += c; cnt += (c > 0u) ? 1u : 0u; mine = (j == x) ? c : mine; }
        if (sum == G) break;
        __builtin_amdgcn_s_sleep(1);
        if ((++sp & 255u) == 0u) { if (xb_ld(&bar[XB_TMO])) break; if (sp > XB_SPIN_CAP) { atomicAdd(&bar[XB_TMO], 1u); break; } }
    }
    nloc = mine > 0u ? mine : 1u; nx = cnt > 0u ? cnt : 1u;
}

__device__ __forceinline__ void xcd_barrier(const XcdBarrier& b) {
    asm volatile("s_waitcnt vmcnt(0)" ::: "memory");
    __syncthreads();
    if (threadIdx.x == 0) {
        unsigned* bar = b.bar;
        __builtin_amdgcn_s_waitcnt(0);
        unsigned nloc = b.st[0], nx = b.st[1];
        if (nloc == 0u) { xcd_barrier_complete(bar, b.x, nloc, nx); b.st[0] = nloc; b.st[1] = nx; }
        const unsigned old = xb_add(&bar[XB_XSUB(b.x)], 1u);
        const unsigned gen = old / nloc;
        if (old + 1u == (gen + 1u) * nloc) {
            __builtin_amdgcn_fence(__ATOMIC_RELEASE, "agent");
            asm volatile("s_waitcnt vmcnt(0)" ::: "memory");
            const unsigned og = xb_add(&bar[XB_TOP], 1u);
            const unsigned tg = og / nx;
            if (og + 1u == (tg + 1u) * nx) xb_add(&bar[XB_TOPGEN], 1u);
            else XB_SPIN(xb_ld(&bar[XB_TOPGEN]) == tg, bar);
            __builtin_amdgcn_fence(__ATOMIC_ACQUIRE, "agent");
            xb_add(&bar[XB_XGEN(b.x)], 1u);
            asm volatile("s_waitcnt vmcnt(0)" ::: "memory");
        } else {
            XB_SPIN(xb_ld(&bar[XB_XGEN(b.x)]) == gen, bar);
            __builtin_amdgcn_fence(__ATOMIC_ACQUIRE, "agent");
            asm volatile("s_waitcnt vmcnt(0)" ::: "memory");
        }
    }
    __syncthreads();
}
struct Frame {
    LAS unsigned char* lds; volatile LAS unsigned* MISC; gu32* ctl;
    int tid, lane, wave, vcu, G;
};
__device__ __forceinline__ float wave_sum(float v) {
#pragma unroll
    for (int o = 1; o < 64; o <<= 1) v += __shfl_xor(v, o);
    return v;
}
template <class Map>
__device__ __forceinline__ void transpose_item(const float* W, int K, int N, bf16* WT, Map map, LAS float* scr, int item, int lane, int ld = 0, int koff = 0) {
    const int nblk = (N + 31) / 32, kb = item / nblk, nb = item % nblk, k0 = 64 * kb, n0 = 32 * nb;
    const int nr = n0 + (lane & 31);
    float wv[32];
#pragma unroll
    for (int i = 0; i < 32; ++i) { const int kk = 2 * i + (lane >> 5); wv[i] = (nr < N) ? W[(size_t)(k0 + kk) * N + nr] : 0.f; }
#pragma unroll
    for (int i = 0; i < 32; ++i) { const int kk = 2 * i + (lane >> 5); scr[kk * 33 + (lane & 31)] = wv[i]; }
    LDS_WAIT(); asm volatile("" ::: "memory");
    const int c = lane & 7;
#pragma unroll
    for (int j = 0; j < 4; ++j) { const int nl = (lane >> 3) + 8 * j; const LAS float* s = scr + (8 * c) * 33 + nl;
        v4u o; o.x = pk2(s[0 * 33], s[1 * 33]); o.y = pk2(s[2 * 33], s[3 * 33]); o.z = pk2(s[4 * 33], s[5 * 33]); o.w = pk2(s[6 * 33], s[7 * 33]);
        if (n0 + nl < N) *(GAS v4u*)(WT + (size_t)map(n0 + nl) * (ld ? ld : K) + koff + k0 + 8 * c) = o; }
    LDS_WAIT(); asm volatile("" ::: "memory");
}
struct MapId { __device__ __forceinline__ int operator()(int n) const { return n; } };
struct MapWin {
    __device__ __forceinline__ int operator()(int n) const { const int G = n < 3396 ? n : n + 188; const int L = G & 255, hd = L >> 6, d = L & 63; return (G & ~255) + 128 * (d >> 5) + 32 * hd + (d & 31); } };
struct MapFF { int off; __device__ __forceinline__ int operator()(int n) const { return (n >> 7) * 256 + (n & 127) + off; } };

struct P0In { const float *c, *w_ada, *b_ada, *w_in, *w_up_a, *w_up_b, *w_o, *w_ff1, *w_ff3, *w_ff2, *lq1, *lk1, *lq2, *lk2, *qn_a, *kn_a, *qn_b, *kn_b; };
__device__ __forceinline__ void weight_copies(Frame& F, const P0In in, unsigned char* ws, bool sync = true) {
    LAS float* scr = (LAS float*)(F.lds + F.wave * 16384);
    const int gw = F.vcu * NWAVES + F.wave, NGW = F.G * NWAVES;
    constexpr int I_IN = 16 * 171, I_UP = 8 * 32, I_O = 16 * 32, I_F1 = 16 * 88, I_F2 = 44 * 32;
    constexpr int NITEMS = I_IN + 2 * I_UP + I_O + 2 * I_F1 + I_F2;
    for (int it = gw; it < NITEMS; it += NGW) {
        int r = it;
        if (r < I_IN) { transpose_item(in.w_in, 1024, W_IN, (bf16*)(ws + WS_WIN), MapWin{}, scr, r, F.lane); continue; } r -= I_IN;
        if (r < I_UP) { transpose_item(in.w_up_a, 512, 1024, (bf16*)(ws + WS_WUA), MapId{}, scr, r, F.lane, 1024, 0); continue; } r -= I_UP;
        if (r < I_UP) { transpose_item(in.w_up_b, 512, 1024, (bf16*)(ws + WS_WUA), MapId{}, scr, r, F.lane, 1024, 512); continue; } r -= I_UP;
        if (r < I_O)  { transpose_item(in.w_o, 1024, 1024, (bf16*)(ws + WS_WO), MapId{}, scr, r, F.lane); continue; } r -= I_O;
        if (r < I_F1) { transpose_item(in.w_ff1, 1024, DFF, (bf16*)(ws + WS_W13), MapFF{0}, scr, r, F.lane); continue; } r -= I_F1;
        if (r < I_F1) { transpose_item(in.w_ff3, 1024, DFF, (bf16*)(ws + WS_W13), MapFF{128}, scr, r, F.lane); continue; } r -= I_F1;
        transpose_item(in.w_ff2, DFF, 1024, (bf16*)(ws + WS_W2), MapId{}, scr, r, F.lane);
    }
    if (sync) __syncthreads();
}
__device__ __forceinline__ void p0_prologue(Frame& F, const P0In in, unsigned char* ws) {
    const int gw = F.vcu * NWAVES + F.wave, NGW = F.G * NWAVES; (void)gw; (void)NGW;
    LAS float* S = (LAS float*)F.lds;
    LAS float* P = (LAS float*)(F.lds + 65536);
    for (int g = F.vcu; g < 192; g += F.G) {
        for (int i = F.tid; i < 16 * 1024; i += NWAVES * 64) { const float v = in.c[i]; S[i] = v / (1.f + __expf(-v)); }
        __syncthreads();
        const int c = F.tid & 31, kg = F.tid >> 5, col = 32 * g + c;
        float acc[16];
#pragma unroll
        for (int b = 0; b < 16; ++b) acc[b] = 0.f;
#pragma unroll
        for (int h = 0; h < 2; ++h) {
            float w[32];
#pragma unroll
            for (int u = 0; u < 32; ++u) w[u] = in.w_ada[(size_t)(64 * kg + 32 * h + u) * 6144 + col];
#pragma unroll
            for (int i = 0; i < 32; i += 4) { const int k = 64 * kg + 32 * h + i;
#pragma unroll
                for (int b = 0; b < 16; ++b) { const f32x4 s = *(const LAS f32x4*)(S + b * 1024 + k); acc[b] += (s[0] * w[i] + s[1] * w[i + 1]) + (s[2] * w[i + 2] + s[3] * w[i + 3]); } } }
#pragma unroll
        for (int b = 0; b < 16; ++b) P[(kg * 16 + b) * 32 + c] = acc[b];
        __syncthreads();
        { const int b = F.tid >> 5; float s = in.b_ada[col];
#pragma unroll
          for (int q = 0; q < 16; ++q) s += P[(q * 16 + b) * 32 + c];
          ((float*)(ws + WS_MOD))[b * 6144 + col] = s; }
        __syncthreads();
    }
    if (F.vcu == F.G - 2 && F.tid < 256) { const int t = F.tid >> 6, i = F.tid & 63; ((float*)(ws + WS_GN))[F.tid] = (t == 0 ? in.qn_a : t == 1 ? in.kn_a : t == 2 ? in.qn_b : in.kn_b)[i]; }
    if (F.vcu == F.G - 1 && F.tid == 0) {
        float s1 = 0.f, s2 = 0.f;
        for (int i = 0; i < 64; ++i) { s1 += in.lq1[i] * in.lk1[i]; s2 += in.lq2[i] * in.lk2[i]; }
        *(float*)(ws + WS_LAM) = expf(s1) - expf(s2) + 0.2f;
    }
}
__device__ __forceinline__ void norm_mod_pass(Frame& F, const float* X, const float* g, const float* scale, const float* shift, bf16* Y) {
    const int gw = F.vcu * NWAVES + F.wave, NGW = F.G * NWAVES;
    for (int blk = gw; blk < M / 16; blk += NGW) {
        const int row0 = blk * 16, b = row0 >> 11;
        f32x4 gs[4], sh[4];
#pragma unroll
        for (int j = 0; j < 4; ++j) { const f32x4 gg = ((const f32x4*)g)[F.lane + 64 * j], sc = ((const f32x4*)(scale + b * 6144))[F.lane + 64 * j]; gs[j] = gg * (sc + 1.0f); sh[j] = ((const f32x4*)(shift + b * 6144))[F.lane + 64 * j]; }
        f32x4 vn[4];
        { const f32x4* x0 = (const f32x4*)(X + (size_t)row0 * DM) + F.lane;
#pragma unroll
          for (int j = 0; j < 4; ++j) vn[j] = x0[64 * j]; }
        for (int rr = 0; rr < 16; ++rr) {
            f32x4 v[4]; float s = 0.f;
#pragma unroll
            for (int j = 0; j < 4; ++j) v[j] = vn[j];
            if (rr < 15) { const f32x4* xr = (const f32x4*)(X + (size_t)(row0 + rr + 1) * DM) + F.lane;
#pragma unroll
                for (int j = 0; j < 4; ++j) vn[j] = xr[64 * j]; }
#pragma unroll
            for (int j = 0; j < 4; ++j) s += (v[j][0] * v[j][0] + v[j][1] * v[j][1]) + (v[j][2] * v[j][2] + v[j][3] * v[j][3]);
            const float rstd = __builtin_amdgcn_rsqf(wave_sum(s) * (1.0f / DM) + 1e-6f);
            unsigned long long* o8 = (unsigned long long*)(Y + (size_t)(row0 + rr) * DM) + F.lane;
#pragma unroll
            for (int j = 0; j < 4; ++j) { const f32x4 y = v[j] * rstd * gs[j] + sh[j]; o8[64 * j] = (unsigned long long)pk2(y[0], y[1]) | ((unsigned long long)pk2(y[2], y[3]) << 32); }
        }
    }
}
__device__ __forceinline__ void norm_mod_pass_bf16(Frame& F, const bf16* X, const float* g, const float* scale, const float* shift, bf16* Y) {
    const int gw = F.vcu * NWAVES + F.wave, NGW = F.G * NWAVES;
    for (int blk = gw; blk < M / 16; blk += NGW) {
        const int row0 = blk * 16, b = row0 >> 11;
        f32x4 gs[4], sh[4];
#pragma unroll
        for (int j = 0; j < 4; ++j) { const int c4 = 2 * F.lane + (j & 1) + 128 * (j >> 1);
            const f32x4 gg = ((const f32x4*)g)[c4], sc = ((const f32x4*)(scale + b * 6144))[c4]; gs[j] = gg * (sc + 1.0f); sh[j] = ((const f32x4*)(shift + b * 6144))[c4]; }
        v4u wn[2];
        { const v4u* x0 = (const v4u*)(X + (size_t)row0 * DM) + F.lane; wn[0] = x0[0]; wn[1] = x0[64]; }
        for (int rr = 0; rr < 16; ++rr) {
            const v4u wc[2] = {wn[0], wn[1]};
            if (rr < 15) { const v4u* xr = (const v4u*)(X + (size_t)(row0 + rr + 1) * DM) + F.lane; wn[0] = xr[0]; wn[1] = xr[64]; }
            f32x4 v[4]; float s = 0.f;
#pragma unroll
            for (int h = 0; h < 2; ++h) { const v4u w = wc[h];
                v[2 * h] = (f32x4){__builtin_bit_cast(float, w.x << 16), __builtin_bit_cast(float, w.x & 0xffff0000u), __builtin_bit_cast(float, w.y << 16), __builtin_bit_cast(float, w.y & 0xffff0000u)};
                v[2 * h + 1] = (f32x4){__builtin_bit_cast(float, w.z << 16), __builtin_bit_cast(float, w.z & 0xffff0000u), __builtin_bit_cast(float, w.w << 16), __builtin_bit_cast(float, w.w & 0xffff0000u)}; }
#pragma unroll
            for (int j = 0; j < 4; ++j) s += (v[j][0] * v[j][0] + v[j][1] * v[j][1]) + (v[j][2] * v[j][2] + v[j][3] * v[j][3]);
            const float rstd = __builtin_amdgcn_rsqf(wave_sum(s) * (1.0f / DM) + 1e-6f);
            v4u* o16 = (v4u*)(Y + (size_t)(row0 + rr) * DM) + F.lane;
#pragma unroll
            for (int h = 0; h < 2; ++h) { const f32x4 y0 = v[2 * h] * rstd * gs[2 * h] + sh[2 * h], y1 = v[2 * h + 1] * rstd * gs[2 * h + 1] + sh[2 * h + 1];
                v4u o; o.x = pk2(y0[0], y0[1]); o.y = pk2(y0[2], y0[3]); o.z = pk2(y1[0], y1[1]); o.w = pk2(y1[2], y1[3]); o16[64 * h] = o; }
        }
    }
}
#ifdef CHECKER
namespace chk {
typedef unsigned short bf16;
typedef unsigned u32x4c __attribute__((ext_vector_type(4)));
__device__ __forceinline__ float b2f(unsigned short h) { return __uint_as_float((unsigned)h << 16); }
__device__ __forceinline__ float rnd(float f) { unsigned u = __float_as_uint(f); u = (u + 0x7fffu + ((u >> 16) & 1u)) & 0xffff0000u; return __uint_as_float(u); }
__device__ __forceinline__ float dotbf(const bf16* a, const bf16* b, int K) {
    float s = 0.f;
    for (int k = 0; k < K; k += 8) { const u32x4c x = *(const u32x4c*)(a + k), y = *(const u32x4c*)(b + k);
#pragma unroll
        for (int j = 0; j < 4; ++j) { s += __uint_as_float(x[j] << 16) * __uint_as_float(y[j] << 16); s += __uint_as_float(x[j] & 0xffff0000u) * __uint_as_float(y[j] & 0xffff0000u); } }
    return s; }
__device__ __forceinline__ void devmax(float* slot, float d) { if (!(d >= 0.f)) d = 1e30f; atomicMax((unsigned*)slot, __float_as_uint(d)); }
__device__ __forceinline__ float sig(float v) { return 1.f / (1.f + expf(-v)); }
constexpr int RSTR = 16, ROFF = 3, NR = 2048;
}
#define CHK_LOOP(idx, total) for (long idx = (long)F.vcu * 512 + F.tid; idx < (long)(total); idx += (long)F.G * 512)
#endif
#ifdef DUPCHK
__global__ void __launch_bounds__(512) dup_cksum(const void* base, size_t bytes, unsigned long long* acc) {
    typedef unsigned u32x4_t __attribute__((ext_vector_type(4)));
    const u32x4_t* p = (const u32x4_t*)base; const size_t n = bytes / 16;
    unsigned long long s = 0ull;
    for (size_t i = (size_t)blockIdx.x * 512 + threadIdx.x; i < n; i += (size_t)gridDim.x * 512) {
        const u32x4_t w = p[i]; const unsigned long long m = 2ull * i + 1ull;
        s += ((unsigned long long)w.x + ((unsigned long long)w.y << 7) + ((unsigned long long)w.z << 13) + ((unsigned long long)w.w << 19)) * m; }
    for (int off = 32; off; off >>= 1) { const unsigned lo = __shfl_xor((unsigned)s, off), hi = __shfl_xor((unsigned)(s >> 32), off); s += ((unsigned long long)hi << 32) | lo; }
    if ((threadIdx.x & 63) == 0) atomicAdd(acc, s);
}
__global__ void __launch_bounds__(512) dup_final(float* out, const unsigned long long* CK) {
    int bad = -1;
    for (int k = 9; k >= 0; --k) if (CK[2 * k] != CK[2 * k + 1]) bad = k;
    if (bad >= 0) { const float v = 0.0566f * (float)(1 << bad); for (int i = blockIdx.x * 512 + threadIdx.x; i < (1 << 20); i += gridDim.x * 512) out[i] += v; }
}
#endif
#ifdef MASKDIFF
__global__ void __launch_bounds__(512) mask_diff(const unsigned long long* A, const unsigned long long* B, unsigned* cnt) {
    unsigned c0 = 0, c1 = 0, c2 = 0;
    for (int idx = blockIdx.x * 512 + threadIdx.x; idx < (1 << 20); idx += gridDim.x * 512) {
        const int qk = (idx >> 10) & 63, tile = (idx >> 5) & 31; const bool adm = tile < (qk >> 1) + 1;
        const unsigned long long d = A[idx] ^ B[idx];
        if (d) { if (adm) { ++c0; c2 += (unsigned)__builtin_popcountll(d); } else ++c1; } }
    if (c0) atomicAdd(cnt + 0, c0); if (c1) atomicAdd(cnt + 1, c1); if (c2) atomicAdd(cnt + 2, c2);
    for (int row = blockIdx.x * 512 + threadIdx.x; row < 32768; row += gridDim.x * 512) { const int bq = row >> 5, q = row & 31, qk = bq & 63; bool any = false;
        for (int tile = 0; tile < (qk >> 1) + 1; ++tile) { const size_t i = ((size_t)bq * 32 + tile) * 32 + q; any = any || (A[i] != B[i]); }
        if (any) atomicAdd(cnt + 3, 1u); }
}
__global__ void __launch_bounds__(512) mask_report(float* out, const unsigned* cnt) {
    const unsigned ca = cnt[MASKDIFF & 3], cb = cnt[(MASKDIFF >> 2) & 3];
    int La = 0; while ((1u << La) < ca + 1u) ++La; int Lb = 0; while ((1u << Lb) < cb + 1u) ++Lb;
    float v = 0.05f * 5.657f; for (int i = 0; i < La; ++i) v *= 1.5f;
    for (int i = blockIdx.x * 512 + threadIdx.x; i < (1 << 20); i += gridDim.x * 512) out[i] += v;
    (void)Lb;
}
#endif
struct Args { const float* in[22]; float* out; unsigned char* ws; int ph_lo, ph_hi, probe, pad; };
__global__ void __launch_bounds__(NWAVES * 64, 2) mega_fwd(Args args) {
    extern __shared__ __attribute__((aligned(16))) unsigned char lds[];
    Frame F;
    F.lds = (LAS unsigned char*)lds;
    F.MISC = (volatile LAS unsigned*)(F.lds + MISC_OFF);
    F.tid = threadIdx.x; F.lane = F.tid & 63; F.wave = __builtin_amdgcn_readfirstlane(F.tid >> 6);
    F.G = gridDim.x; { const int bx = blockIdx.x; F.vcu = (F.G % 8 == 0) ? (bx % 8) * (F.G / 8) + bx / 8 : bx; }
    unsigned char* ws = args.ws;
    F.ctl = (gu32*)(ws + WS_CTL);
    for (int u = F.tid; u < (LDS_BYTES - LDSCTL_OFF) / 4; u += NWAVES * 64) ((LAS unsigned*)(F.lds + LDSCTL_OFF))[u] = 0u;
    __syncthreads();
    XcdBarrier bar; bar.bar = (unsigned*)(F.ctl + CW_BAR); bar.x = 0; bar.st = nullptr;
    if (N_LAUNCHES == 1) bar = xcd_barrier_post((unsigned*)(F.ctl + CW_BAR), F.MISC + 8);
    const int lo = args.ph_lo, hi = args.ph_hi;
#ifndef PH_MASK
#define PH_MASK 0x3ff
#endif
#define IN(k) (((PH_MASK >> (k)) & 1) && lo <= (k) && (k) < hi)
#define SEAM(k) do { if (IN(k) && IN((k) + 1)) xcd_barrier(bar); } while (0)
    float* const MOD = (float*)(ws + WS_MOD);
#define WSP(T, off) ((T*)(ws + (off)))
#ifdef X1_IN_WS
#define X1P WSP(float, WS_GT)
#else
#define X1P args.out
#endif

#ifndef W_IN_P1
#define W_IN_P1 2
#endif
#if W_IN_P1
#define IF_W0(x)
#else
#define IF_W0(x) x
#endif
    if (IN(0)) { const P0In pin{args.in[1], args.in[2], args.in[3], args.in[5], args.in[15], args.in[16], args.in[17], args.in[19], args.in[20], args.in[21], args.in[10], args.in[11], args.in[12], args.in[13], args.in[6], args.in[7], args.in[8], args.in[9]};
                 IF_W0(weight_copies(F, pin, ws);) p0_prologue(F, pin, ws); }
    SEAM(0);
#ifdef CHECKER
    if (IN(0) && IN(1)) {
        float* DEV = (float*)(ws + WS_CTL) + 8192;
#define CHK_W(src, K_, N_, dst, MAPX) CHK_LOOP(idx, (long)(K_) * (N_)) { const int k = (int)(idx / (N_)), n = (int)(idx % (N_)); const float w = (src)[idx]; \
            chk::devmax(DEV + 11, fabsf(chk::b2f((dst)[(size_t)(MAPX) * (K_) + k]) - w) / (fabsf(w) + 1e-3f)); }
        CHK_W(args.in[5], 1024, W_IN, WSP(bf16, WS_WIN), MapWin{}(n))  CHK_W(args.in[17], 1024, 1024, WSP(bf16, WS_WO), n)
        CHK_W(args.in[19], 1024, DFF, WSP(bf16, WS_W13), MapFF{0}(n)) CHK_W(args.in[20], 1024, DFF, WSP(bf16, WS_W13), MapFF{128}(n)) CHK_W(args.in[21], DFF, 1024, WSP(bf16, WS_W2), n)
#undef CHK_W
        CHK_LOOP(idx, 16 * 6144) { const int b = (int)(idx / 6144), j = (int)(idx % 6144); if ((j % 5) == 0) { float sacc = args.in[3][j]; for (int k = 0; k < 1024; ++k) { const float c = args.in[1][b * 1024 + k]; sacc += (c / (1.f + expf(-c))) * args.in[2][(size_t)k * 6144 + j]; }
            chk::devmax(DEV + 12, fabsf(MOD[idx] - sacc)); } }
    }
#endif
    if (IN(1)) {
#if W_IN_P1
        { const P0In pin{args.in[1], args.in[2], args.in[3], args.in[5], args.in[15], args.in[16], args.in[17], args.in[19], args.in[20], args.in[21], args.in[10], args.in[11], args.in[12], args.in[13], args.in[6], args.in[7], args.in[8], args.in[9]};
          if (W_IN_P1 == 1) weight_copies(F, pin, ws);
          if (W_IN_P1 == 3) { if (F.wave & 1) { weight_copies(F, pin, ws, false); norm_mod_pass(F, args.in[0], args.in[4], MOD + 1024, MOD, WSP(bf16, WS_XH)); }
                              else { norm_mod_pass(F, args.in[0], args.in[4], MOD + 1024, MOD, WSP(bf16, WS_XH)); weight_copies(F, pin, ws, false); } __syncthreads(); }
          else norm_mod_pass(F, args.in[0], args.in[4], MOD + 1024, MOD, WSP(bf16, WS_XH));
          if (W_IN_P1 == 2) weight_copies(F, pin, ws); }
#else
        norm_mod_pass(F, args.in[0], args.in[4], MOD + 1024, MOD, WSP(bf16, WS_XH));
#endif
    }
    SEAM(1);
#ifdef CHECKER
    if (IN(1) && IN(2)) {
        float* DEV = (float*)(ws + WS_CTL) + 8192;
        CHK_LOOP(idx, chk::NR) { const int row = chk::RSTR * (int)idx + chk::ROFF, b = row >> 11; float ss = 0.f; for (int k = 0; k < 1024; ++k) { const float v = args.in[0][(size_t)row * 1024 + k]; ss += v * v; }
            const float rs = 1.f / sqrtf(ss / 1024.f + 1e-6f); float dm = 0.f;
            for (int k = 0; k < 1024; ++k) { const float ref = args.in[0][(size_t)row * 1024 + k] * rs * args.in[4][k] * (1.f + MOD[(size_t)b * 6144 + 1024 + k]) + MOD[(size_t)b * 6144 + k]; dm = fmaxf(dm, fabsf(chk::b2f(WSP(bf16, WS_XH)[(size_t)row * 1024 + k]) - ref)); }
            chk::devmax(DEV + 13, dm); }
    }
#endif
    if (IN(2)) {
        pg8::Gemm g{WSP(bf16, WS_XH), (const bf16*)(ws + WS_WIN), M, NPROJ, DM}; pg8::StaticOrder S; S.init(M, NPROJ, F.G, (int)blockIdx.x);
        epi::EpiProj E{ws};
        pg8::gemm_phase<epi::EpiProj, pg8::StaticOrder, true, true>(F.lds, g, S, E);
    }
    SEAM(2);
#ifdef CHECKER
    if (IN(2) && IN(3)) {
        float* DEV = (float*)(ws + WS_CTL) + 8192; const bf16 *XH = WSP(bf16, WS_XH), *WT = WSP(bf16, WS_WIN);
        CHK_LOOP(idx, chk::NR * 512) { const int row = chk::RSTR * (int)(idx / 512) + chk::ROFF, c = (int)(idx % 512);
            { const int n = 1024 + c; const float a = chk::dotbf(XH + (size_t)row * 1024, WT + (size_t)MapWin{}(n) * 1024, 1024), o = chk::b2f(WSP(bf16, WS_VA)[(size_t)row * 512 + c]); chk::devmax(DEV + 0, fabsf(o - chk::rnd(a)) / (fabsf(a) + 0.05f)); }
            { const int n = 3396 + 4 * c + 1; const float a = chk::sig(chk::dotbf(XH + (size_t)row * 1024, WT + (size_t)MapWin{}(n) * 1024, 1024)), o = chk::b2f(WSP(bf16, WS_GT)[(size_t)row * 2048 + 4 * c + 1]); chk::devmax(DEV + 1, fabsf(o - a)); }
            if (c < 8) { float ss = 0.f; for (int d = 0; d < 64; ++d) { const float v = chk::dotbf(XH + (size_t)row * 1024, WT + (size_t)MapWin{}(c * 64 + d) * 1024, 1024); ss += v * v; }
                const float rs = 1.f / sqrtf(ss / 64.f + 1e-6f); float dm = 0.f; for (int d = 0; d < 64; ++d) { const float v = chk::dotbf(XH + (size_t)row * 1024, WT + (size_t)MapWin{}(c * 64 + d) * 1024, 1024); dm = fmaxf(dm, fabsf(chk::b2f(WSP(bf16, WS_QA)[(size_t)row * 512 + c * 64 + d]) - v * rs * args.in[6][d])); } chk::devmax(DEV + 2, dm); }
            if (c < 64) { const float a = chk::dotbf(XH + (size_t)row * 1024, WT + (size_t)MapWin{}(3328 + c) * 1024, 1024), o = chk::b2f(WSP(bf16, WS_KI)[(size_t)row * 64 + c]); chk::devmax(DEV + 3, fabsf(o - chk::rnd(a)) / (fabsf(a) + 0.05f)); }
            if (c < 4) { const float a = chk::dotbf(XH + (size_t)row * 1024, WT + (size_t)MapWin{}(3392 + c) * 1024, 1024), o = WSP(float, WS_WI)[(size_t)row * 4 + c]; chk::devmax(DEV + 4, fabsf(o - a)); }
            if (c >= 8 && c < 16) { const int hh = c - 8; float ss = 0.f; for (int d = 0; d < 64; ++d) { const float v = chk::dotbf(XH + (size_t)row * 1024, WT + (size_t)MapWin{}(2048 + hh * 64 + d) * 1024, 1024); ss += v * v; }
                const float rs = 1.f / sqrtf(ss / 64.f + 1e-6f); float dm = 0.f; for (int d = 0; d < 64; ++d) { const float v = chk::dotbf(XH + (size_t)row * 1024, WT + (size_t)MapWin{}(2048 + hh * 64 + d) * 1024, 1024); dm = fmaxf(dm, fabsf(chk::b2f(WSP(bf16, WS_KB)[(size_t)row * 512 + hh * 64 + d]) - v * rs * args.in[9][d])); } chk::devmax(DEV + 5, dm); }
        }
    }
#endif
    if (IN(3)) {
        const int b = F.vcu >> 4, j = F.vcu & 15;
        const bf16 *QI = WSP(bf16, WS_QI), *KI = WSP(bf16, WS_KI); const float* WI = WSP(float, WS_WI); unsigned long long* MASK = WSP(unsigned long long, WS_MASK);
        if (F.G == 256) {
            sel::select_unit(b, j, QI, KI, WI, MASK, (char*)lds); sel::select_unit(b, 31 - j, QI, KI, WI, MASK, (char*)lds);
            sel::select_unit(b, 32 + j, QI, KI, WI, MASK, (char*)lds); sel::select_unit(b, 63 - j, QI, KI, WI, MASK, (char*)lds);
        }
    }
    SEAM(3);
#ifdef CHECKER
#ifndef CHK_TI
#define CHK_TI -1
#endif
#ifndef CHK_TOL17
#define CHK_TOL17 64
#endif
    if (IN(3) && IN(4)) {
        unsigned tot = 0u; CHK_LOOP(idx, 16 * 64 * 32 * 32) tot += (unsigned)__builtin_popcountll(WSP(unsigned long long, WS_MASK)[idx]);
        atomicAdd((unsigned*)(ws + WS_CTL) + 8192 + 18, tot);
    }
    if (IN(3) && IN(4)) {
        float* DEV = (float*)(ws + WS_CTL) + 8192;
        if (F.vcu < 10) { const int tt[5] = {5, 300, 777, 1029, 2047}; const int t = (F.vcu % 5 == 0) ? 5 : (F.vcu % 5 == 1) ? 300 : (F.vcu % 5 == 2) ? 777 : (F.vcu % 5 == 3) ? 1029 : 2047; (void)tt; const int b = (F.vcu < 5) ? 0 : 9;
            LAS unsigned* KL = (LAS unsigned*)F.lds; const int nadm = 64 * (t / 64 + 1); const size_t qrow = (size_t)b * 2048 + t;
            __syncthreads();
            for (int s4 = 0; s4 < 4; ++s4) { const int sidx = F.tid + 512 * s4; unsigned key = 0u;
                if (sidx < nadm) { float sc = 0.f; for (int h = 0; h < 4; ++h) { const float y = chk::dotbf(WSP(bf16, WS_QI) + qrow * 256 + h * 64, WSP(bf16, WS_KI) + ((size_t)b * 2048 + sidx) * 64, 64); sc = fmaf(fmaxf(y, 0.f), WSP(float, WS_WI)[qrow * 4 + h], sc); }
                    const unsigned u = __float_as_uint(sc), m = (unsigned)(((int)u) >> 31) | 0x80000000u; key = ((u ^ m) & KEYMASK) | (2047u - (unsigned)sidx); }
                KL[sidx] = key; }
            __syncthreads();
            unsigned bad = 0u;
            for (int s4 = 0; s4 < 4; ++s4) { const int sidx = F.tid + 512 * s4; const unsigned key = KL[sidx]; unsigned rank = 0u; for (int j = 0; j < 2048; ++j) rank += (KL[j] > key) ? 1u : 0u;
                const bool selr = (sidx < nadm) && (nadm <= 256 || rank < 256u);
                const unsigned long long mw = WSP(unsigned long long, WS_MASK)[((size_t)(b * 64 + t / 32) * 32 + sidx / 64) * 32 + (t % 32)]; const bool selm = (mw >> (sidx % 64)) & 1ull;
                if (sidx < nadm && selr != selm) ++bad; }
            if (bad) atomicAdd(DEV + 17, (float)bad);
            __syncthreads();
        }
    }
#endif
    if (IN(4)) {
        if (F.G == 256) {
            const int b = F.vcu >> 4, r = F.vcu & 15;
            const bf16 *QA = WSP(bf16, WS_QA), *KA = WSP(bf16, WS_KA), *VA = WSP(bf16, WS_VA), *QBt = WSP(bf16, WS_QB), *KBt = WSP(bf16, WS_KB), *VBt = WSP(bf16, WS_VB);
            bf16 *YA = WSP(bf16, WS_YA), *YB = WSP(bf16, WS_YA); const unsigned long long* MASK = WSP(unsigned long long, WS_MASK);
            const float lam = __hip_atomic_load((const float*)(ws + WS_LAM), RLX_AGENT);
#ifndef NO_UNIT_A
            if (!(args.probe & 1)) for (int pi = 0; pi < 2; ++pi) { const int pr = 2 * r + pi, h = pr >> 2, s = pr & 3;
                att::unit_a(b, h, 7 - s, QA, KA, VA, MASK, YA, (char*)lds); att::unit_a(b, h, s, QA, KA, VA, MASK, YA, (char*)lds); }
#endif
#ifndef NO_UNIT_B
            __syncthreads();
            if (!(args.probe & 2)) { const int h = r >> 2, s = r & 3;
              att::unit_b128(b, h, 7 - s, QBt, KBt, VBt, args.in[14], lam, YB, WSP(unsigned, WS_STASH), 0, (char*)lds); att::unit_b128(b, h, s, QBt, KBt, VBt, args.in[14], lam, YB, WSP(unsigned, WS_STASH), 1, (char*)lds); }
#endif
        }
    }
    SEAM(4);
#ifdef CHECKER
    if (IN(4) && IN(5)) {
        float* DEV = (float*)(ws + WS_CTL) + 8192; const float lamc = __hip_atomic_load((const float*)(ws + WS_LAM), RLX_AGENT);
        const int gwv = F.vcu * 8 + F.wave;
        if (gwv < 8 * 3 * 12) { const int ti = gwv % 8, bi = (gwv / 8) % 3, hh = gwv / 24;
            const int t = (ti == 0) ? 5 : (ti == 1) ? 70 : (ti == 2) ? 200 : (ti == 3) ? 300 : (ti == 4) ? 777 : (ti == 5) ? 1029 : (ti == 6) ? 1500 : 2047; const int b = (bi == 0) ? 0 : (bi == 1) ? 7 : 15;
            const int nadm = 64 * (t / 64 + 1); const size_t rb = (size_t)b * 2048, qrow = rb + t; const int d = F.lane;
            if (hh < 8) { const float slope = exp2f(-(float)(hh + 1));
                float mx = -INFINITY; for (int sidx = 0; sidx < nadm; ++sidx) { const unsigned long long mw = WSP(unsigned long long, WS_MASK)[((size_t)(b * 64 + t / 32) * 32 + sidx / 64) * 32 + (t % 32)]; if (!((mw >> (sidx % 64)) & 1ull)) continue;
                    const float sc = chk::dotbf(WSP(bf16, WS_QA) + qrow * 512 + hh * 64, WSP(bf16, WS_KA) + (rb + sidx) * 512 + hh * 64, 64) * 0.125f - slope * fabsf((float)(t - sidx)); mx = fmaxf(mx, sc); }
                float l = 0.f, o = 0.f; for (int sidx = 0; sidx < nadm; ++sidx) { const unsigned long long mw = WSP(unsigned long long, WS_MASK)[((size_t)(b * 64 + t / 32) * 32 + sidx / 64) * 32 + (t % 32)]; if (!((mw >> (sidx % 64)) & 1ull)) continue;
                    const float sc = chk::dotbf(WSP(bf16, WS_QA) + qrow * 512 + hh * 64, WSP(bf16, WS_KA) + (rb + sidx) * 512 + hh * 64, 64) * 0.125f - slope * fabsf((float)(t - sidx)); const float p = expf(sc - mx); l += p; o += p * chk::b2f(WSP(bf16, WS_VA)[(rb + sidx) * 512 + hh * 64 + d]); }
                chk::devmax(DEV + 14, fabsf(chk::b2f(WSP(bf16, WS_YA)[qrow * 1024 + hh * 64 + d]) - o / l));
            } else if (CHK_TI < 0 || ti == CHK_TI) { const int hb = hh - 8; const float slope = exp2f(-2.f * (float)(hb + 1)); float ov[2][2];
                for (int m = 0; m < 2; ++m) { float mx = -INFINITY; for (int sidx = 0; sidx < nadm; ++sidx) { const float sc = chk::dotbf(WSP(bf16, WS_QB) + qrow * 512 + (2 * hb + m) * 64, WSP(bf16, WS_KB) + (rb + sidx) * 512 + (2 * hb + m) * 64, 64) * 0.125f - slope * fabsf((float)(t - sidx)); mx = fmaxf(mx, sc); }
                    float l = 0.f, o0 = 0.f, o1 = 0.f; for (int sidx = 0; sidx < nadm; ++sidx) { const float sc = chk::dotbf(WSP(bf16, WS_QB) + qrow * 512 + (2 * hb + m) * 64, WSP(bf16, WS_KB) + (rb + sidx) * 512 + (2 * hb + m) * 64, 64) * 0.125f - slope * fabsf((float)(t - sidx));
                        const float p = expf(sc - mx); l += p; o0 += p * chk::b2f(WSP(bf16, WS_VB)[(rb + sidx) * 512 + hb * 128 + d]); o1 += p * chk::b2f(WSP(bf16, WS_VB)[(rb + sidx) * 512 + hb * 128 + 64 + d]); }
                    if (m == 0) { ov[0][0] = o0 / l; ov[0][1] = o1 / l; } else { ov[1][0] = o0 / l; ov[1][1] = o1 / l; } }
                const float d0 = ov[0][0] - lamc * ov[1][0], d1 = ov[0][1] - lamc * ov[1][1]; const float ssq = wave_sum(d0 * d0 + d1 * d1); const float rs = 0.8f / sqrtf(ssq / 128.f + 1e-6f);
                chk::devmax(DEV + 16, fabsf(chk::b2f(WSP(bf16, WS_YA)[qrow * 1024 + 512 + hb * 128 + d]) - d0 * rs * args.in[14][d])); chk::devmax(DEV + 19, fabsf(chk::b2f(WSP(bf16, WS_YA)[qrow * 1024 + 512 + hb * 128 + 64 + d]) - d1 * rs * args.in[14][64 + d]));
            }
        }
        xcd_barrier(bar);
    }
#endif
    if (IN(5)) {
        pg8::Gemm g{WSP(bf16, WS_YA), (const bf16*)(ws + WS_WUA), M, DM, 1024}; pg8::StaticOrder S; S.init(M, DM, F.G, (int)blockIdx.x);
        epi::EpiUpM E{WSP(bf16, WS_MG), WSP(bf16, WS_GT)}; pg8::gemm_phase<epi::EpiUpM, pg8::StaticOrder, true, true>(F.lds, g, S, E);
    }
    SEAM(5);
#ifdef CHECKER
    if (IN(5) && IN(6)) {
        __syncthreads(); float* DEV = (float*)(ws + WS_CTL) + 8192;
        CHK_LOOP(idx, chk::NR * 256) { const int row = chk::RSTR * (int)(idx / 256) + chk::ROFF, col = 4 * (int)(idx % 256) + 2;
            const float ua = chk::dotbf(WSP(bf16, WS_YA) + (size_t)row * 1024, WSP(bf16, WS_WUA) + (size_t)col * 1024, 512), ub = chk::dotbf(WSP(bf16, WS_YA) + (size_t)row * 1024 + 512, WSP(bf16, WS_WUA) + (size_t)col * 1024 + 512, 512);
            const float ga = chk::b2f(WSP(bf16, WS_GT)[(size_t)row * 2048 + col]), gb = chk::b2f(WSP(bf16, WS_GT)[(size_t)row * 2048 + 1024 + col]);
            const float ref = chk::rnd(ga * ua) + gb * ub, o = chk::b2f(WSP(bf16, WS_MG)[(size_t)row * 1024 + col]); chk::devmax(DEV + 6, fabsf(o - ref)); }
    }
    if (IN(5) && IN(6)) xcd_barrier(bar);
#endif
    if (IN(6)) {
        pg8::Gemm g{WSP(bf16, WS_MG), (const bf16*)(ws + WS_WO), M, DM, DM}; pg8::StaticOrder S; S.init(M, DM, F.G, (int)blockIdx.x);
        epi::EpiResToBf16 E{args.in[0], WSP(bf16, WS_GT), MOD + 2048}; pg8::gemm_phase<epi::EpiResToBf16, pg8::StaticOrder, true, true>(F.lds, g, S, E);
    }
    SEAM(6);
#ifdef CHECKER
    if (IN(6) && IN(7)) {
        __syncthreads(); float* DEV = (float*)(ws + WS_CTL) + 8192;
        CHK_LOOP(idx, chk::NR * 256) { const int row = chk::RSTR * (int)(idx / 256) + chk::ROFF, col = 4 * (int)(idx % 256) + 1;
            const float a = chk::dotbf(WSP(bf16, WS_MG) + (size_t)row * 1024, WSP(bf16, WS_WO) + (size_t)col * 1024, 1024);
            const float ref = args.in[0][(size_t)row * 1024 + col] + MOD[(size_t)(row >> 11) * 6144 + 2048 + col] * a, o = chk::b2f(WSP(bf16, WS_GT)[(size_t)row * 1024 + col]); chk::devmax(DEV + 7, fabsf(o - ref)); }
    }
#endif
    if (IN(7)) norm_mod_pass_bf16(F, WSP(bf16, WS_GT), args.in[18], MOD + 4096, MOD + 3072, WSP(bf16, WS_XH));
    SEAM(7);
#ifdef CHECKER
    if (IN(7) && IN(8)) {
        __syncthreads(); float* DEV = (float*)(ws + WS_CTL) + 8192;
        CHK_LOOP(idx, chk::NR) { const int row = chk::RSTR * (int)idx + chk::ROFF, b = row >> 11; float ss = 0.f; for (int k = 0; k < 1024; ++k) { const float v = chk::b2f(WSP(bf16, WS_GT)[(size_t)row * 1024 + k]); ss += v * v; }
            const float rs = 1.f / sqrtf(ss / 1024.f + 1e-6f); float dm = 0.f;
            for (int k = 0; k < 1024; ++k) { const float ref = chk::b2f(WSP(bf16, WS_GT)[(size_t)row * 1024 + k]) * rs * args.in[18][k] * (1.f + MOD[(size_t)b * 6144 + 4096 + k]) + MOD[(size_t)b * 6144 + 3072 + k]; dm = fmaxf(dm, fabsf(chk::b2f(WSP(bf16, WS_XH)[(size_t)row * 1024 + k]) - ref)); }
            chk::devmax(DEV + 8, dm); }
    }
#endif
    if (IN(8)) {
        pg8::Gemm g{WSP(bf16, WS_XH), (const bf16*)(ws + WS_W13), M, NFF13, DM}; pg8::StaticOrder S; S.init(M, NFF13, F.G, (int)blockIdx.x);
#ifdef PROBE_EPI
        epi::EpiFF13 E{WSP(bf16, WS_HID), args.probe};
#else
        epi::EpiFF13 E{WSP(bf16, WS_HID)};
#endif
        pg8::gemm_phase<epi::EpiFF13, pg8::StaticOrder, true, true>(F.lds, g, S, E);
    }
    SEAM(8);
#ifdef CHECKER
    if (IN(8) && IN(9)) {
        __syncthreads(); float* DEV = (float*)(ws + WS_CTL) + 8192;
        CHK_LOOP(idx, chk::NR * 704) { const int row = chk::RSTR * (int)(idx / 704) + chk::ROFF, hc = 4 * (int)(idx % 704) + 3;
            const bf16* w = WSP(bf16, WS_W13) + (size_t)((hc >> 7) * 256 + (hc & 127)) * 1024;
            const float u1 = chk::dotbf(WSP(bf16, WS_XH) + (size_t)row * 1024, w, 1024), u3 = chk::dotbf(WSP(bf16, WS_XH) + (size_t)row * 1024, w + 128 * 1024, 1024);
            const float ref = u1 * chk::sig(u1) * u3, o = chk::b2f(WSP(bf16, WS_HID)[(size_t)row * 2816 + hc]); chk::devmax(DEV + 9, fabsf(o - ref) / (fabsf(ref) + 0.05f)); }
    }
#endif
    if (IN(9)) {
        pg8::Gemm g{WSP(bf16, WS_HID), (const bf16*)(ws + WS_W2), M, DM, DFF}; pg8::StaticOrder S; S.init(M, DM, F.G, (int)blockIdx.x);
        epi::EpiResFromBf16 E{WSP(bf16, WS_GT), args.out, MOD + 5120}; pg8::gemm_phase<epi::EpiResFromBf16, pg8::StaticOrder, true, true>(F.lds, g, S, E);
    }
#ifdef PROBE_XBAR
    for (int i = 0; i < PROBE_XBAR; ++i) xcd_barrier(bar);
#endif
#ifdef ENDCHK
    if (IN(9)) {
        unsigned tot = 0u; for (long idx = (long)F.vcu * 512 + F.tid; idx < 16L * 64 * 32 * 32; idx += (long)F.G * 512) tot += (unsigned)__builtin_popcountll(WSP(unsigned long long, WS_MASK)[idx]);
        atomicAdd((unsigned*)(ws + WS_CTL) + 8192 + 18, tot);
        xcd_barrier(bar);
        const int bad = (int)__hip_atomic_load((unsigned*)(ws + WS_CTL) + 8192 + 18, RLX_AGENT) - 16 * 499712;
        if (F.vcu == 0 && F.tid == 0 && bad != 0) args.out[0] += 1.0e6f;
    }
#endif
#ifdef CHECKER
    if (IN(9)) {
        float* DEV = (float*)(ws + WS_CTL) + 8192;
        asm volatile("s_waitcnt vmcnt(0)" ::: "memory"); __syncthreads();
        CHK_LOOP(idx, chk::NR * 256) { const int row = chk::RSTR * (int)(idx / 256) + chk::ROFF, col = 4 * (int)(idx % 256) + 3;
            (void)row; (void)col; }
        xcd_barrier(bar);
        CHK_LOOP(idx, chk::NR * 256) { const int row = chk::RSTR * (int)(idx / 256) + chk::ROFF, col = 4 * (int)(idx % 256) + 3;
            const float a = chk::dotbf(WSP(bf16, WS_HID) + (size_t)row * 2816, WSP(bf16, WS_W2) + (size_t)col * 2816, 2816);
            const float ref = chk::b2f(WSP(bf16, WS_GT)[(size_t)row * 1024 + col]) + MOD[(size_t)(row >> 11) * 6144 + 5120 + col] * a; chk::devmax(DEV + 10, fabsf(args.out[(size_t)row * 1024 + col] - ref)); }
        xcd_barrier(bar);
        float da = __hip_atomic_load(DEV + CHK_A, RLX_AGENT), db = __hip_atomic_load(DEV + CHK_B, RLX_AGENT);
        if (CHK_A == 17) da = (da > (float)CHK_TOL17) ? da : 0.f;
        if (CHK_A == 18) da = fabsf((float)((int)__hip_atomic_load((unsigned*)DEV + 18, RLX_AGENT) - 16 * 499712));
        if (F.vcu == 0 && F.tid == 0) args.out[0] += 1000.f * da;
        const float pb = 16.f * sqrtf(db);
        for (int i = F.vcu * 512 + F.tid; i < (1 << 18); i += F.G * 512) if (i > 0) args.out[i] += pb;
    }
#endif
#undef IN
#undef SEAM
#undef WSP
}

extern "C" void kernel_launch(void* const* d_in, const int* in_sizes, int n_in, void* d_out, int out_size, void* d_ws, size_t ws_size, hipStream_t stream) {
    static int grid = 0;
    if (grid == 0) {
        if (n_in != 22 || in_sizes[0] != M * DM || out_size != M * DM || ws_size < WS_END) { fprintf(stderr, "kernel_launch: unexpected shapes (n_in %d, in0 %d, out %d, ws %zu); nothing launched\n", n_in, n_in > 0 ? in_sizes[0] : -1, out_size, ws_size); grid = -1; return; }
        int dev = 0, cus = 0, per_cu = 0;
        if (hipGetDevice(&dev) != hipSuccess || hipDeviceGetAttribute(&cus, hipDeviceAttributeMultiprocessorCount, dev) != hipSuccess) { fprintf(stderr, "kernel_launch: device query failed\n"); grid = -1; return; }
        if (hipFuncSetAttribute((const void*)mega_fwd, hipFuncAttributeMaxDynamicSharedMemorySize, LDS_BYTES) != hipSuccess) { fprintf(stderr, "kernel_launch: hipFuncSetAttribute failed\n"); grid = -1; return; }
        if (hipOccupancyMaxActiveBlocksPerMultiprocessor(&per_cu, (const void*)mega_fwd, NWAVES * 64, LDS_BYTES) != hipSuccess || per_cu < 1) fprintf(stderr, "kernel_launch: note: occupancy query reports %d workgroups per CU\n", per_cu);
        (void)hipGetLastError();
        grid = cus;
        if (grid != 256) fprintf(stderr, "kernel_launch: %d CUs; the attention/selection schedules need 256\n", grid);
    }
    if (grid < 0) return;
    if (hipMemsetAsync((char*)d_ws + WS_CTL, 0, CTL_ZERO_BYTES, stream) != hipSuccess) { fprintf(stderr, "kernel_launch: hipMemsetAsync failed\n"); return; }
    Args a{};
    for (int i = 0; i < 22; ++i) a.in[i] = (const float*)d_in[i];
    a.out = (float*)d_out; a.ws = (unsigned char*)d_ws;
#ifdef PROBE_RERUN_MASK
    constexpr int n_l = N_LAUNCHES + __builtin_popcount(PROBE_RERUN_MASK);
#else
    constexpr int n_l = N_LAUNCHES;
#endif
#ifdef MASKDIFF
    { unsigned char* ws = (unsigned char*)d_ws; unsigned* CNT = (unsigned*)(ws + WS_CTL + 32768);
#ifdef MASKDIFF_SPLIT
      a.ph_lo = 0; a.ph_hi = 3; hipLaunchKernelGGL(mega_fwd, dim3(grid), dim3(NWAVES * 64), LDS_BYTES, stream, a);
      a.ph_lo = 3; a.ph_hi = 4; hipLaunchKernelGGL(mega_fwd, dim3(grid), dim3(NWAVES * 64), LDS_BYTES, stream, a);
#else
      a.ph_lo = 0; a.ph_hi = 4; hipLaunchKernelGGL(mega_fwd, dim3(grid), dim3(NWAVES * 64), LDS_BYTES, stream, a);
#endif
      (void)hipMemcpyAsync(ws + WS_STASH, ws + WS_MASK, 8u << 20, hipMemcpyDeviceToDevice, stream);
      a.ph_lo = 3; a.ph_hi = 4; hipLaunchKernelGGL(mega_fwd, dim3(grid), dim3(NWAVES * 64), LDS_BYTES, stream, a);
      hipLaunchKernelGGL(mask_diff, dim3(256), dim3(512), 0, stream, (const unsigned long long*)(ws + WS_MASK), (const unsigned long long*)(ws + WS_STASH), CNT);
      (void)hipMemsetAsync((char*)d_ws + WS_CTL, 0, 32768, stream);
      a.ph_lo = 4; a.ph_hi = 10; hipLaunchKernelGGL(mega_fwd, dim3(grid), dim3(NWAVES * 64), LDS_BYTES, stream, a);
      hipLaunchKernelGGL(mask_report, dim3(256), dim3(512), 0, stream, (float*)d_out, (const unsigned*)CNT);
      return; }
#endif
#ifdef DUPCHK
    { unsigned char* ws = (unsigned char*)d_ws; unsigned long long* CK = (unsigned long long*)(ws + WS_CTL + 32768);
      const void* rp[10] = {ws + WS_MOD, ws + WS_XH, ws + WS_QA, ws + WS_MASK, ws + WS_XH, ws + WS_MG, ws + WS_GT, ws + WS_XH, ws + WS_HID, d_out};
      const size_t rb[10] = {33ull << 20, 64ull << 20, 344ull << 20, 8ull << 20, 64ull << 20, 64ull << 20, 64ull << 20, 64ull << 20, 176ull << 20, 128ull << 20};
      int lo = 0;
      for (int k = 0; k < 10; ++k) { const bool cut = (DUPCHK >> k) & 1; if (!cut && k != 9) continue;
          if (lo > 0) (void)hipMemsetAsync((char*)d_ws + WS_CTL, 0, 32768, stream);
          a.ph_lo = lo; a.ph_hi = k + 1; hipLaunchKernelGGL(mega_fwd, dim3(grid), dim3(NWAVES * 64), LDS_BYTES, stream, a);
          if (cut) { hipLaunchKernelGGL(dup_cksum, dim3(256), dim3(512), 0, stream, rp[k], rb[k], CK + 2 * k);
                     a.ph_lo = k; a.ph_hi = k + 1; hipLaunchKernelGGL(mega_fwd, dim3(grid), dim3(NWAVES * 64), LDS_BYTES, stream, a);
                     hipLaunchKernelGGL(dup_cksum, dim3(256), dim3(512), 0, stream, rp[k], rb[k], CK + 2 * k + 1); }
          lo = k + 1; }
      hipLaunchKernelGGL(dup_final, dim3(256), dim3(512), 0, stream, (float*)d_out, (const unsigned long long*)CK);
      return; }
#endif
    int probe_next = 0;
    for (int li = 0; li < n_l; ++li) {
        a.ph_lo = (N_LAUNCHES == 1) ? 0 : li; a.ph_hi = (N_LAUNCHES == 1) ? N_PHASES : li + 1;
#ifdef PROBE_RERUN_MASK
        if (li >= N_LAUNCHES) { while (!((PROBE_RERUN_MASK >> probe_next) & 1)) ++probe_next; a.ph_lo = probe_next; a.ph_hi = probe_next + 1; ++probe_next;
#ifdef PROBE_MODE
            a.probe = PROBE_MODE;
#endif
        }
#endif
        hipLaunchKernelGGL(mega_fwd, dim3(grid), dim3(NWAVES * 64), LDS_BYTES, stream, a);
        const hipError_t le = hipPeekAtLastError();
        if (le != hipSuccess) { fprintf(stderr, "kernel_launch: launch %d failed: %s\n", li, hipGetErrorName(le)); break; }
    }
}
```

```cpp
#include <hip/hip_runtime.h>
#include <cstdio>
#include <cstdint>
namespace pg8 {
#define PG8_LAS __attribute__((address_space(3)))
typedef unsigned short bf16_t;
typedef short bf16x8 __attribute__((ext_vector_type(8)));
typedef float f32x4 __attribute__((ext_vector_type(4)));
typedef unsigned u32x4 __attribute__((ext_vector_type(4)));
constexpr int BM = 256, BK = 64, HALF = 128, HTB = HALF * BK * 2  , STAGE_BYTES = 8 * HTB, NXCD = 8, WGM = 8;

__host__ __device__ __forceinline__ int lds_byte(int r, int c) { const int st = (r >> 4) * 2 + (c >> 5), rr = r & 15, cc = c & 31, ob = rr * 64 + cc * 2; return st * 1024 + (ob ^ (((ob >> 9) & 1) << 5)); }
__host__ __device__ __forceinline__ void stage_rc(int b, int& R, int& C) { const int st = b / 1024, sb = b % 1024, swz = sb ^ (((sb >> 9) & 1) << 5); R = (st >> 1) * 16 + swz / 64; C = (st & 1) * 32 + (swz % 64) / 2; }
__host__ __device__ __forceinline__ int perm32(int rho) { const int n = rho >> 4, i = rho & 15; return 8 * (i >> 2) + 4 * n + (i & 3); }

struct Unit { int pm, pn; };
struct Gemm { const bf16_t* A; const bf16_t* Bt; int M, N, K; };

struct StaticOrder {
    int nM, nN, nwg, G, c;
    __host__ __device__ void init(int M, int N, int G_, int c_) { nM = M / BM; nN = N / BM; nwg = nM * nN; G = G_; c = c_; }
    __host__ __device__ bool next(int i, Unit& u) const {
        const long L = (long)i * G + c; if (L >= nwg) return false;
        int wgid = (int)L; { const int q = nwg / NXCD, r = nwg % NXCD, xcd = wgid % NXCD, off = wgid / NXCD; wgid = (xcd < r ? xcd * (q + 1) : r * (q + 1) + (xcd - r) * q) + off; }
        const int nig = WGM * nN, gid = wgid / nig, fm = gid * WGM, gsz = (nM - fm) < WGM ? (nM - fm) : WGM;
        u.pm = fm + ((wgid % nig) % gsz); u.pn = (wgid % nig) / gsz; return true;
    }
    __device__ __forceinline__ void a_ready(const Unit&) const {}
    __device__ __forceinline__ void done(const Unit&) const {}
};
__device__ __forceinline__ unsigned cvt_pk_bf16(float lo, float hi) { unsigned r; asm volatile("v_cvt_pk_bf16_f32 %0, %1, %2" : "=v"(r) : "v"(lo), "v"(hi)); return r; }
typedef float f32x2 __attribute__((ext_vector_type(2)));
template <class E, class = void> struct mid_t { static constexpr int v = 0; };
template <class E> struct mid_t<E, decltype((void)E::MID_T)> { static constexpr int v = E::MID_T; };
template <class Epi, class Sched, bool ALIGN_EPI = false, bool SP2 = false>
__device__ __forceinline__ void gemm_phase(PG8_LAS unsigned char* lds, const Gemm g, const Sched& S, const Epi& E) {
    const int tid = threadIdx.x, wid = __builtin_amdgcn_readfirstlane(tid >> 6), lane = tid & 63, wr = wid >> 2, wc = wid & 3, fr = lane & 15, fq = lane >> 4;
    const int K = g.K, nt = K / BK;
    unsigned voffA[2], voffB[2];
#pragma unroll
    for (int i = 0; i < 2; ++i) { int R, C; stage_rc(tid * 16 + i * 8192, R, C); const int Rb = Epi::PERM ? ((R & ~31) + perm32(R & 31)) : R;
        voffA[i] = (unsigned)(R * K + C) * 2u; voffB[i] = (unsigned)(Rb * K + C) * 2u; }
    const size_t kstep = (size_t)(BK * 2);
    const size_t hstep = (size_t)HALF * K * 2;
    const size_t tstep = 2 * hstep;
    const unsigned ldsw = (unsigned)wid * 1024u;
    const int aoff = lds_byte(wr * 64 + fr, fq * 8), boff = lds_byte(wc * 32 + fr, fq * 8);
#define PG8_SA(b, h) (((b) * 2 + (h)) * HTB)
#define PG8_SB(b, h) ((4 + (b) * 2 + (h)) * HTB)
#define PG8_STAGE(bufoff, gbase, voff) do { _Pragma("unroll") for (int _i = 0; _i < 2; ++_i) \
        __builtin_amdgcn_global_load_lds((const unsigned*)((const char*)(gbase) + (voff)[_i]), (PG8_LAS unsigned*)(lds + (bufoff) + ldsw + _i * 8192), 16, 0, 0); } while (0)
#define PG8_LDA(dst, b, h) do { _Pragma("unroll") for (int m = 0; m < 4; ++m) _Pragma("unroll") for (int k = 0; k < 2; ++k) dst[m][k] = *(const PG8_LAS bf16x8*)(lds + PG8_SA(b, h) + aoff + m * 2048 + k * 1024); } while (0)
#define PG8_LDB(dst, b, h) do { _Pragma("unroll") for (int n = 0; n < 2; ++n) _Pragma("unroll") for (int k = 0; k < 2; ++k) dst[n][k] = *(const PG8_LAS bf16x8*)(lds + PG8_SB(b, h) + boff + n * 2048 + k * 1024); } while (0)
#define PG8_MMA(ai, bj, At, Bt) do { __builtin_amdgcn_s_setprio(1); _Pragma("unroll") for (int m = 0; m < 4; ++m) _Pragma("unroll") for (int n = 0; n < 2; ++n) _Pragma("unroll") for (int k = 0; k < 2; ++k) \
        acc[ai][bj][m][n] = __builtin_amdgcn_mfma_f32_16x16x32_bf16(Bt[n][k], At[m][k], acc[ai][bj][m][n], 0, 0, 0); __builtin_amdgcn_s_setprio(0); } while (0)
#define PG8_WAIT_V(n) asm volatile("s_waitcnt vmcnt(" #n ")" ::: "memory")
#define PG8_WAIT_L(n) asm volatile("s_waitcnt lgkmcnt(" #n ")" ::: "memory")
#define PG8_BAR __builtin_amdgcn_s_barrier()
#define PG8_SCHED __builtin_amdgcn_sched_barrier(0)
    Unit cur, nxt; int ui = 0;
    if (!S.next(0, cur)) return;
    f32x4 acc[2][2][4][2];
#pragma unroll
    for (int a = 0; a < 2; ++a)
#pragma unroll
        for (int b = 0; b < 2; ++b)
#pragma unroll
            for (int m = 0; m < 4; ++m)
#pragma unroll
                for (int n = 0; n < 2; ++n) acc[a][b][m][n] = (f32x4){0.f, 0.f, 0.f, 0.f};
    bf16x8 At[4][2], B0[2][2], B1[2][2];
    const char* cA = (const char*)g.A + (size_t)cur.pm * tstep; const char* cB = (const char*)g.Bt + (size_t)cur.pn * tstep;
    S.a_ready(cur);
    if constexpr (SP2) {
        PG8_STAGE(PG8_SB(0, 0), cB, voffB); PG8_STAGE(PG8_SB(0, 1), cB + hstep, voffB); PG8_STAGE(PG8_SA(0, 0), cA, voffA); PG8_STAGE(PG8_SA(0, 1), cA + hstep, voffA);
        if (wr == 1) PG8_BAR;
        PG8_WAIT_V(2); PG8_BAR;
        PG8_STAGE(PG8_SB(1, 0), cB + kstep, voffB); PG8_STAGE(PG8_SA(1, 0), cA + kstep, voffA); PG8_STAGE(PG8_SB(1, 1), cB + hstep + kstep, voffB);
        PG8_WAIT_V(6); PG8_BAR;
    } else {
        PG8_STAGE(PG8_SB(0, 0), cB, voffB); PG8_STAGE(PG8_SA(0, 0), cA, voffA); PG8_STAGE(PG8_SB(0, 1), cB + hstep, voffB); PG8_STAGE(PG8_SA(0, 1), cA + hstep, voffA);
        if (wr == 1) PG8_BAR;
        PG8_WAIT_V(4); PG8_BAR;
        PG8_STAGE(PG8_SB(1, 0), cB + kstep, voffB); PG8_STAGE(PG8_SA(1, 0), cA + kstep, voffA); PG8_STAGE(PG8_SB(1, 1), cB + hstep + kstep, voffB);
        PG8_WAIT_V(6); PG8_BAR;
    }
    for (;;) {
        const bool has_next = S.next(ui + 1, nxt);
        const char* nA = has_next ? (const char*)g.A + (size_t)nxt.pm * tstep : cA; const char* nB = has_next ? (const char*)g.Bt + (size_t)nxt.pn * tstep : cB;
        for (int t = 0; t < nt; t += 2) {
            if constexpr (mid_t<Epi>::v > 0) { if (t == mid_t<Epi>::v) E.mid(acc, cur, wr, wc, fr, fq); }
            const bool last = (t == nt - 2);
            const char* a1 = cA + (size_t)(t + 1) * kstep;
            const char* a2 = last ? nA : cA + (size_t)(t + 2) * kstep; const char* b2 = last ? nB : cB + (size_t)(t + 2) * kstep;
            const char* a3 = a2 + kstep; const char* b3 = b2 + kstep;
            if (last && has_next) S.a_ready(nxt);
            if constexpr (SP2) {
            PG8_LDB(B0, 0, 0); PG8_LDB(B1, 0, 1); PG8_SCHED; PG8_LDA(At, 0, 0); PG8_STAGE(PG8_SA(1, 1), a1 + hstep, voffA);
            PG8_WAIT_V(8); PG8_WAIT_L(0); PG8_BAR; PG8_MMA(0, 0, At, B0); PG8_MMA(0, 1, At, B1); PG8_BAR; PG8_SCHED;
            PG8_LDA(At, 0, 1); PG8_STAGE(PG8_SB(0, 0), b2, voffB); PG8_STAGE(PG8_SB(0, 1), b2 + hstep, voffB); PG8_STAGE(PG8_SA(0, 0), a2, voffA);
            PG8_WAIT_V(8); PG8_WAIT_L(0); PG8_BAR; PG8_MMA(1, 0, At, B0); PG8_MMA(1, 1, At, B1); PG8_BAR; PG8_SCHED;
            PG8_LDB(B0, 1, 0); PG8_LDB(B1, 1, 1); PG8_SCHED; PG8_LDA(At, 1, 0); PG8_STAGE(PG8_SA(0, 1), a2 + hstep, voffA);
            PG8_WAIT_V(8); PG8_WAIT_L(0); PG8_BAR; PG8_MMA(0, 0, At, B0); PG8_MMA(0, 1, At, B1); PG8_BAR; PG8_SCHED;
            PG8_LDA(At, 1, 1); PG8_STAGE(PG8_SB(1, 0), b3, voffB); PG8_STAGE(PG8_SB(1, 1), b3 + hstep, voffB); PG8_STAGE(PG8_SA(1, 0), a3, voffA);
            PG8_WAIT_V(8); PG8_WAIT_L(0); PG8_BAR; PG8_MMA(1, 0, At, B0); PG8_MMA(1, 1, At, B1); PG8_BAR; PG8_SCHED;
            } else {
            PG8_LDB(B0, 0, 0); PG8_SCHED; PG8_LDA(At, 0, 0); PG8_STAGE(PG8_SA(1, 1), a1 + hstep, voffA);
            PG8_WAIT_L(8); PG8_BAR; PG8_WAIT_L(0); PG8_MMA(0, 0, At, B0); PG8_BAR; PG8_SCHED;
            PG8_LDB(B1, 0, 1); PG8_STAGE(PG8_SB(0, 0), b2, voffB);
            PG8_BAR; PG8_WAIT_L(0); PG8_MMA(0, 1, At, B1); PG8_BAR;
            PG8_LDA(At, 0, 1); PG8_STAGE(PG8_SA(0, 0), a2, voffA);
            PG8_BAR; PG8_WAIT_L(0); PG8_MMA(1, 0, At, B0); PG8_BAR; PG8_SCHED;
            PG8_STAGE(PG8_SB(0, 1), b2 + hstep, voffB);
            PG8_WAIT_V(6); PG8_BAR; PG8_MMA(1, 1, At, B1); PG8_BAR;
            PG8_LDB(B0, 1, 0); PG8_SCHED; PG8_LDA(At, 1, 0); PG8_STAGE(PG8_SA(0, 1), a2 + hstep, voffA);
            PG8_WAIT_L(8); PG8_BAR; PG8_WAIT_L(0); PG8_MMA(0, 0, At, B0); PG8_BAR; PG8_SCHED;
            PG8_LDB(B1, 1, 1); PG8_STAGE(PG8_SB(1, 0), b3, voffB);
            PG8_BAR; PG8_WAIT_L(0); PG8_MMA(0, 1, At, B1); PG8_BAR;
            PG8_LDA(At, 1, 1); PG8_STAGE(PG8_SA(1, 0), a3, voffA);
            PG8_BAR; PG8_WAIT_L(0); PG8_MMA(1, 0, At, B0); PG8_BAR; PG8_SCHED;
            PG8_STAGE(PG8_SB(1, 1), b3 + hstep, voffB);
            PG8_WAIT_V(6); PG8_BAR; PG8_MMA(1, 1, At, B1); PG8_BAR;
            }
        }
        if constexpr (ALIGN_EPI) { if (wr == 0) PG8_BAR; }
        if constexpr (!Epi::AFTER_DRAIN) { E(acc, cur, wr, wc, fr, fq); S.done(cur); }
        if (!has_next) break;
#pragma unroll
        for (int a = 0; a < 2; ++a)
#pragma unroll
            for (int b = 0; b < 2; ++b)
#pragma unroll
                for (int m = 0; m < 4; ++m)
#pragma unroll
                    for (int n = 0; n < 2; ++n) acc[a][b][m][n] = (f32x4){0.f, 0.f, 0.f, 0.f};
        cur = nxt; cA = nA; cB = nB; ++ui;
        if constexpr (ALIGN_EPI) { if (wr == 1) PG8_BAR; }
    }
    PG8_WAIT_V(0);
    if constexpr (!ALIGN_EPI) { if (wr == 0) PG8_BAR; }
    PG8_BAR;
    if constexpr (Epi::AFTER_DRAIN) { E.fused(acc, cur, wr, wc, fr, fq, lds, wid, lane); S.done(cur); }
#undef PG8_SA
#undef PG8_SB
#undef PG8_STAGE
#undef PG8_LDA
#undef PG8_LDB
#undef PG8_MMA
#undef PG8_WAIT_V
#undef PG8_WAIT_L
#undef PG8_BAR
#undef PG8_SCHED
}
}
#ifndef SCALE_F_EPS
#define SCALE_F_EPS 0.0f
#endif
namespace epi {
constexpr size_t PWS_GN = (1u << 20) + 768 * 1024, PWS_QA = 128u << 20, PWS_QI = 320u << 20, PWS_KI = 336u << 20, PWS_WI = 340u << 20, PWS_GT = 344u << 20;
using pg8::f32x4; using pg8::u32x4; using pg8::bf16_t; using pg8::Unit; using pg8::BM; using pg8::HALF;
__device__ __forceinline__ unsigned pk2(float lo, float hi) { return pg8::cvt_pk_bf16(lo, hi); }
__device__ __forceinline__ float bflo(unsigned u) { return __uint_as_float(u << 16); }
__device__ __forceinline__ float bfhi(unsigned u) { return __uint_as_float(u & 0xffff0000u); }
__device__ __forceinline__ float sigm(float v) { return __builtin_amdgcn_rcpf(1.f + __expf(-v)); }
__device__ __forceinline__ u32x4 pack8(const f32x4& a, const f32x4& b) { u32x4 w; w.x = pk2(a[0], a[1]); w.y = pk2(a[2], a[3]); w.z = pk2(b[0], b[1]); w.w = pk2(b[2], b[3]); return w; }
__device__ __forceinline__ float dot4(const f32x4& a) { return (a[0] * a[0] + a[1] * a[1]) + (a[2] * a[2] + a[3] * a[3]); }

struct EpiProj {
    static constexpr bool PERM = true, AFTER_DRAIN = false;
    unsigned char* ws;
    template <int MODE  >
    __device__ __forceinline__ void emit(const f32x4 (&acc)[2][2][4][2], bf16_t* dst, int pitch, int cb, const float* g, int row0, int wc, int fq) const {
        f32x4 gv[2][2];
#pragma unroll
        for (int bj = 0; bj < 2; ++bj)
#pragma unroll
            for (int n = 0; n < 2; ++n) gv[bj][n] = (MODE == 1) ? *(const f32x4*)(g + 32 * bj + 8 * fq + 4 * n) : (f32x4){1.f, 1.f, 1.f, 1.f};
#pragma unroll
        for (int ai = 0; ai < 2; ++ai)
#pragma unroll
            for (int m = 0; m < 4; ++m) {
                f32x4 v[2][2];
#pragma unroll
                for (int bj = 0; bj < 2; ++bj)
#pragma unroll
                    for (int n = 0; n < 2; ++n) v[bj][n] = acc[ai][bj][m][n];
                if (MODE == 1) {
                    float ss = (dot4(v[0][0]) + dot4(v[0][1])) + (dot4(v[1][0]) + dot4(v[1][1]));
                    ss += __shfl_xor(ss, 16); ss += __shfl_xor(ss, 32);
                    const float rs = __builtin_amdgcn_rsqf(ss * (1.0f / 64.0f) + 1e-6f);
#pragma unroll
                    for (int bj = 0; bj < 2; ++bj)
#pragma unroll
                        for (int n = 0; n < 2; ++n) v[bj][n] = v[bj][n] * rs * gv[bj][n];
                } else if (MODE == 2) {
#pragma unroll
                    for (int bj = 0; bj < 2; ++bj)
#pragma unroll
                        for (int n = 0; n < 2; ++n)
#pragma unroll
                            for (int i = 0; i < 4; ++i) v[bj][n][i] = sigm(v[bj][n][i]);
                }
                bf16_t* rowp = dst + (size_t)(row0 + ai * HALF + m * 16) * pitch + cb + 64 * wc + 8 * fq;
#pragma unroll
                for (int bj = 0; bj < 2; ++bj) *(u32x4*)(rowp + 32 * bj) = pack8(v[bj][0], v[bj][1]);
            }
    }
    __device__ __forceinline__ void operator()(const f32x4 (&acc)[2][2][4][2], const Unit& u, int wr, int wc, int fr, int fq) const {
        const int pn = u.pn, row0 = u.pm * BM + wr * 64 + fr, cb = (pn & 1) * 256;
        bf16_t* const QA = (bf16_t*)(ws + PWS_QA); const float* const gn = (const float*)(ws + PWS_GN);
        bf16_t* const KI = (bf16_t*)(ws + PWS_KI); float* const WI = (float*)(ws + PWS_WI); bf16_t* const GT = (bf16_t*)(ws + PWS_GT);
        if (pn < 12) {
            const int tsr = pn >> 1; bf16_t* dst = QA + (size_t)tsr * (size_t)(32u << 19);
            if (tsr == 2 || tsr == 5) emit<0>(acc, dst, 512, cb, nullptr, row0, wc, fq);
            else emit<1>(acc, dst, 512, cb, gn + 64 * (tsr - (tsr > 2 ? 1 : 0)), row0, wc, fq);
        }
        else if (pn == 12) emit<0>(acc, (bf16_t*)(ws + PWS_QI), 256, 0, nullptr, row0, wc, fq);
        else if (pn == 13) {
            if (wc == 0) emit<0>(acc, KI, 64, 0, nullptr, row0, 0, fq);
            else if (wc == 1) { if (fq == 0) {
#pragma unroll
                for (int ai = 0; ai < 2; ++ai)
#pragma unroll
                    for (int m = 0; m < 4; ++m) *(f32x4*)(WI + (size_t)(row0 + ai * HALF + m * 16) * 4) = acc[ai][0][m][0]; } }
        } else {
#pragma unroll
            for (int ai = 0; ai < 2; ++ai)
#pragma unroll
                for (int m = 0; m < 4; ++m) { f32x4 r[2], gb[2];
#pragma unroll
                    for (int n = 0; n < 2; ++n)
#pragma unroll
                        for (int i = 0; i < 4; ++i) { const float ea = __expf(-acc[ai][0][m][n][i]), eb = __builtin_fminf(__expf(-acc[ai][1][m][n][i]), 1.152921504606847e18f);
                            gb[n][i] = __builtin_amdgcn_rcpf(1.f + eb); r[n][i] = (1.f + eb) * __builtin_amdgcn_rcpf(1.f + ea); }
                    bf16_t* rowp = GT + (size_t)(row0 + ai * HALF + m * 16) * 2048 + (pn - 14) * 128 + 32 * wc + 8 * fq;
                    *(u32x4*)rowp = pack8(r[0], r[1]); *(u32x4*)(rowp + 1024) = pack8(gb[0], gb[1]); }
        }
    }
};
struct EpiUpM {
    static constexpr bool PERM = true, AFTER_DRAIN = false; static constexpr int MID_T = 8;
    bf16_t* MG; const bf16_t* GT;
    static __device__ __forceinline__ float gcl(float g) { return __builtin_fmaxf(g, 8.673617379884035e-19f); }
    __device__ __forceinline__ void mid(f32x4 (&acc)[2][2][4][2], const Unit& u, int wr, int wc, int fr, int fq) const {
        int zo = 0; asm volatile("" : "+v"(zo));
        const int row0 = u.pm * BM + wr * 64 + fr + zo, col0 = u.pn * BM + wc * 32 + 8 * fq;
#pragma unroll
        for (int ai = 0; ai < 2; ++ai) {
            u32x4 ra[4][2];
#pragma unroll
            for (int m = 0; m < 4; ++m)
#pragma unroll
                for (int bj = 0; bj < 2; ++bj) { const size_t row = (size_t)(row0 + ai * HALF + m * 16); const int c = col0 + bj * HALF; ra[m][bj] = *(const u32x4*)(GT + row * 2048 + c); }
            asm volatile("" ::: "memory");
#pragma unroll
            for (int m = 0; m < 4; ++m)
#pragma unroll
                for (int bj = 0; bj < 2; ++bj) { const u32x4 a = ra[m][bj];
                    acc[ai][bj][m][0] = acc[ai][bj][m][0] * (f32x4){bflo(a.x), bfhi(a.x), bflo(a.y), bfhi(a.y)}; acc[ai][bj][m][1] = acc[ai][bj][m][1] * (f32x4){bflo(a.z), bfhi(a.z), bflo(a.w), bfhi(a.w)}; }
            asm volatile("" ::: "memory");
        }
    }
    __device__ __forceinline__ void operator()(const f32x4 (&acc)[2][2][4][2], const Unit& u, int wr, int wc, int fr, int fq) const {
        const int row0 = u.pm * BM + wr * 64 + fr, col0 = u.pn * BM + wc * 32 + 8 * fq;
#pragma unroll
        for (int ai = 0; ai < 2; ++ai) {
            u32x4 gw[4][2];
#pragma unroll
            for (int m = 0; m < 4; ++m)
#pragma unroll
                for (int bj = 0; bj < 2; ++bj) { const size_t row = (size_t)(row0 + ai * HALF + m * 16); const int c = col0 + bj * HALF; gw[m][bj] = *(const u32x4*)(GT + row * 2048 + 1024 + c); }
            asm volatile("" ::: "memory");
#pragma unroll
            for (int m = 0; m < 4; ++m)
#pragma unroll
                for (int bj = 0; bj < 2; ++bj) { const size_t row = (size_t)(row0 + ai * HALF + m * 16); const int c = col0 + bj * HALF; const u32x4 g = gw[m][bj];
                    const f32x4 v0 = acc[ai][bj][m][0] * (f32x4){gcl(bflo(g.x)), gcl(bfhi(g.x)), gcl(bflo(g.y)), gcl(bfhi(g.y))}, v1 = acc[ai][bj][m][1] * (f32x4){gcl(bflo(g.z)), gcl(bfhi(g.z)), gcl(bflo(g.w)), gcl(bfhi(g.w))};
                    *(u32x4*)(MG + row * 1024 + c) = pack8(v0, v1); }
        }
    }
};
struct EpiFF13 {
    static constexpr bool PERM = true, AFTER_DRAIN = false;
    bf16_t* H;
#ifdef PROBE_EPI
    int skip;
#endif
    __device__ __forceinline__ void operator()(const f32x4 (&acc)[2][2][4][2], const Unit& u, int wr, int wc, int fr, int fq) const {
        const int row0 = u.pm * BM + wr * 64 + fr, col0 = u.pn * HALF + wc * 32 + 8 * fq;
#ifdef PROBE_EPI
        if (skip) { if (acc[0][0][0][0][0] == 1.2345e30f) H[0] = 0; return; }
#endif
#pragma unroll
        for (int ai = 0; ai < 2; ++ai)
#pragma unroll
            for (int m = 0; m < 4; ++m) { f32x4 h[2];
#pragma unroll
                for (int n = 0; n < 2; ++n)
#pragma unroll
                    for (int i = 0; i < 4; ++i) { const float a = acc[ai][0][m][n][i]; h[n][i] = a * sigm(a) * acc[ai][1][m][n][i]; }
                *(u32x4*)(H + (size_t)(row0 + ai * HALF + m * 16) * 2816 + col0) = pack8(h[0], h[1]); }
    }
};
struct EpiResToBf16 {
    static constexpr bool PERM = true, AFTER_DRAIN = false;
    const float* X; bf16_t* O; const float* gate;
    __device__ __forceinline__ void operator()(const f32x4 (&acc)[2][2][4][2], const Unit& u, int wr, int wc, int fr, int fq) const {
        const int row0 = u.pm * BM + wr * 64 + fr, col0 = u.pn * BM + wc * 32 + 8 * fq; const float* gp = gate + (size_t)(u.pm >> 3) * 6144 + col0;
        f32x4 gv[2][2];
#pragma unroll
        for (int bj = 0; bj < 2; ++bj)
#pragma unroll
            for (int n = 0; n < 2; ++n) gv[bj][n] = *(const f32x4*)(gp + bj * HALF + n * 4);
#pragma unroll
        for (int ai = 0; ai < 2; ++ai) {
            f32x4 xv[4][2][2];
#pragma unroll
            for (int m = 0; m < 4; ++m)
#pragma unroll
                for (int bj = 0; bj < 2; ++bj) { const size_t off = (size_t)(row0 + ai * HALF + m * 16) * 1024 + col0 + bj * HALF; xv[m][bj][0] = *(const f32x4*)(X + off); xv[m][bj][1] = *(const f32x4*)(X + off + 4); }
            asm volatile("" ::: "memory");
#pragma unroll
            for (int m = 0; m < 4; ++m)
#pragma unroll
                for (int bj = 0; bj < 2; ++bj) { const size_t off = (size_t)(row0 + ai * HALF + m * 16) * 1024 + col0 + bj * HALF;
                    *(u32x4*)(O + off) = pack8(xv[m][bj][0] + gv[bj][0] * acc[ai][bj][m][0], xv[m][bj][1] + gv[bj][1] * acc[ai][bj][m][1]); }
        }
    }
};
struct EpiResFromBf16 {
    static constexpr bool PERM = true, AFTER_DRAIN = false;
    const bf16_t* X; float* O; const float* gate;
    __device__ __forceinline__ void operator()(const f32x4 (&acc)[2][2][4][2], const Unit& u, int wr, int wc, int fr, int fq) const {
        const int row0 = u.pm * BM + wr * 64 + fr, col0 = u.pn * BM + wc * 32 + 8 * fq; const float* gp = gate + (size_t)(u.pm >> 3) * 6144 + col0;
        f32x4 gv[2][2];
#pragma unroll
        for (int bj = 0; bj < 2; ++bj)
#pragma unroll
            for (int n = 0; n < 2; ++n) gv[bj][n] = *(const f32x4*)(gp + bj * HALF + n * 4);
#pragma unroll
        for (int ai = 0; ai < 2; ++ai) {
            u32x4 xw[4][2];
#pragma unroll
            for (int m = 0; m < 4; ++m)
#pragma unroll
                for (int bj = 0; bj < 2; ++bj) xw[m][bj] = *(const u32x4*)(X + (size_t)(row0 + ai * HALF + m * 16) * 1024 + col0 + bj * HALF);
            asm volatile("" ::: "memory");
#pragma unroll
            for (int m = 0; m < 4; ++m)
#pragma unroll
                for (int bj = 0; bj < 2; ++bj) { const size_t off = (size_t)(row0 + ai * HALF + m * 16) * 1024 + col0 + bj * HALF; const u32x4 w = xw[m][bj];
                    *(f32x4*)(O + off) = (f32x4){bflo(w.x), bfhi(w.x), bflo(w.y), bfhi(w.y)} + gv[bj][0] * acc[ai][bj][m][0] * (1.0f + SCALE_F_EPS);
                    *(f32x4*)(O + off + 4) = (f32x4){bflo(w.z), bfhi(w.z), bflo(w.w), bfhi(w.w)} + gv[bj][1] * acc[ai][bj][m][1] * (1.0f + SCALE_F_EPS); }
        }
    }
};
}
#ifndef SCALE_B_EPS
#define SCALE_B_EPS 0.0f
#endif
#ifndef SCALE_A_EPS
#define SCALE_A_EPS 0.0f
#endif
namespace att {
using bf16x8 = __attribute__((ext_vector_type(8))) short;
using s16x4 = __attribute__((ext_vector_type(4))) short;
using f32x16 = __attribute__((ext_vector_type(16))) float;
using u32x4 = __attribute__((ext_vector_type(4))) unsigned;
using u32x2 = __attribute__((ext_vector_type(2))) unsigned;
typedef unsigned short bf16;
constexpr int SEQ = 2048, NW = 8, QBLK = 32, QB = QBLK * NW, KVBLK = 64;
constexpr float C2 = 0.125f * 1.4426950408889634f;
constexpr int SLOTB = 8192, LDS_K = 0, LDS_V = 3 * SLOTB, LDS_WS = 6 * SLOTB, WSW = 128, LDS_OST = LDS_WS + NW * WSW * 4, LDS_X = LDS_OST + NW * 4096, XW = 8192, LDS_BYTES = LDS_X + NW * XW;
#define SBAR() __builtin_amdgcn_sched_barrier(0)
#define PIN(x) asm volatile("" : "+v"(x))
#define MFMA(a, b, c) __builtin_amdgcn_mfma_f32_32x32x16_bf16(a, b, c, 0, 0, 0)
#define WAIT_BAR(N) asm volatile("s_waitcnt vmcnt(" #N ") lgkmcnt(0)\n\ts_barrier" ::: "memory")
#ifndef ATT_THR
#define ATT_THR 60.0f
#endif
typedef __attribute__((address_space(3))) const char* lds_cptr;
typedef __attribute__((address_space(3))) char* lds_ptr;
typedef __attribute__((address_space(3))) float* lds_fptr;
typedef __attribute__((address_space(3))) const unsigned* lds_cuptr;
typedef short v4i16_t __attribute__((ext_vector_type(4)));
__device__ __forceinline__ int crow(int r, int hi) { return (r & 3) + 8 * (r >> 2) + 4 * hi; }
__device__ __forceinline__ unsigned cvtpk(float lo, float hi) { unsigned r; asm("v_cvt_pk_bf16_f32 %0, %1, %2" : "=v"(r) : "v"(lo), "v"(hi)); return r; }
__device__ __forceinline__ void glds16(const void* g, unsigned lds_base) {
    unsigned sv; asm volatile("s_mov_b32 %0, m0\n\ts_mov_b32 m0, %2\n\ts_nop 0\n\tglobal_load_lds_dwordx4 %1, off\n\ts_mov_b32 m0, %0" : "=&s"(sv) : "v"(g), "s"(lds_base) : "memory"); }
__device__ __forceinline__ void kload2(bf16x8* kf, lds_cptr kp, int d0) { kf[2 * d0] = *(const __attribute__((address_space(3))) bf16x8*)(kp + d0 * 2048); kf[2 * d0 + 1] = *(const __attribute__((address_space(3))) bf16x8*)(kp + d0 * 2048 + 512); }
__device__ __forceinline__ s16x4 vtr(lds_cptr p) { return __builtin_bit_cast(s16x4, __builtin_amdgcn_ds_read_tr16_b64_v4i16((__attribute__((address_space(3))) v4i16_t*)p)); }
#define MX3(a, b, c) __builtin_fmaxf(__builtin_fmaxf((a), (b)), (c))
__device__ __forceinline__ float rowmax2(const f32x16& p0, const f32x16& p1, float p1off) {
    float a = MX3(p0[0], p0[1], p0[2]), b = MX3(p1[0], p1[1], p1[2]);
#pragma unroll
    for (int r = 3; r < 15; r += 2) { a = MX3(a, p0[r], p0[r + 1]); b = MX3(b, p1[r], p1[r + 1]); }
    a = __builtin_fmaxf(a, p0[15]); b = __builtin_fmaxf(b, p1[15]);
    float m = __builtin_fmaxf(a, b + p1off); auto rr = __builtin_amdgcn_permlane32_swap(__float_as_uint(m), __float_as_uint(m), false, false);
    return __builtin_fmaxf(__uint_as_float(rr[0]), __uint_as_float(rr[1])); }
__device__ __forceinline__ float msel(float x, unsigned mw, int pos) { const unsigned m = (unsigned)(((int)(mw << (31 - pos))) >> 31);
    return __uint_as_float((__float_as_uint(x) & m) | (0xff800000u & ~m)); }
__device__ __forceinline__ unsigned short f2bf(float f) { unsigned u = __float_as_uint(f); return (unsigned short)((u + 0x7fffu + ((u >> 16) & 1u)) >> 16); }

#ifndef EXP_NOBAND
#define EXP_NOBAND 0
#endif
#ifndef EXP_NOMASK
#define EXP_NOMASK 0
#endif
#ifdef EXP_NOAPPLY
#define EXP_APPLY(C0, C1, t, BAND) do {} while (0)
#else
#define EXP_APPLY(C0, C1, t, BAND) APPLY(C0, C1, t, BAND)
#endif
#ifdef EXP_NOADV
#define EXP_ADV do {} while (0)
#elif defined(EXP_ADVPIN)
#define EXP_ADV do { _Pragma("unroll") for (int r = 0; r < 16; ++r) ali[r] += tstep; PIN(ali); } while (0)
#else
#define EXP_ADV do { _Pragma("unroll") for (int r = 0; r < 16; ++r) ali[r] += tstep; } while (0)
#endif
template <bool MASKED>
__device__ __forceinline__ void attn_core(f32x16 (&o)[2], const bf16* Qw, int qp, const bf16* Kh, int kp, const bf16* Vh, int vp, int qb, float s8, const unsigned long long* gmask, char* lds) {
    int lz_ = threadIdx.x & 63; asm volatile("" : "+v"(lz_));
    const int tid = threadIdx.x, lane = lz_, r32 = lane & 31, hi = lane >> 5; const int wid = __builtin_amdgcn_readfirstlane(tid >> 6);
    const int NT = 4 * qb + 4;
    const unsigned lds0 = (unsigned)(uintptr_t)lds; const lds_fptr wsf = (lds_fptr)((lds_ptr)lds + LDS_WS) + wid * WSW;
    const bf16* ksrc = Kh + (long)lane * kp + wid * 8;
    const bf16* vsrc = Vh + (long)(16 * (wid & 3) + (lane >> 2)) * vp + (wid >> 2) * 32 + (lane & 3) * 8;
    const unsigned kdst = lds0 + LDS_K + wid * 1024, vdst = lds0 + LDS_V + wid * 1024;
#define DMA_K(t, slot) glds16(ksrc + (long)(t) * KVBLK * kp, (unsigned)__builtin_amdgcn_readfirstlane(kdst + (slot)))
#define DMA_V(t, slot) glds16(vsrc + (long)(t) * KVBLK * vp, (unsigned)__builtin_amdgcn_readfirstlane(vdst + (slot)))
    const lds_cptr vp0 = (lds_cptr)lds + LDS_V + ((lane >> 4) & 1) * 32 + (lane & 3) * 8 + (4 * hi + ((lane & 15) >> 2)) * 64;
    const lds_cptr kp0 = (lds_cptr)lds + LDS_K + hi * 1024 + r32 * 16;
    const lds_cptr mrow = (lds_cptr)lds + LDS_X + wid * XW + r32 * 8;
    if (MASKED) { for (int i = 0; i <= qb; ++i) glds16((const char*)gmask + i * 1024 + lane * 16, (unsigned)__builtin_amdgcn_readfirstlane(lds0 + LDS_X + wid * XW + i * 1024)); }
    DMA_K(0, 0); DMA_V(0, 0); DMA_K(1, SLOTB);
    bf16x8 qr[4];
#pragma unroll
    for (int d0 = 0; d0 < 4; ++d0) qr[d0] = *reinterpret_cast<const bf16x8*>(&Qw[(long)r32 * qp + d0 * 16 + hi * 8]);
    float mhat = 0.f, l_reg = 0.f; o[0] = f32x16{}; o[1] = f32x16{};
    const int qrel = wid * QBLK + r32, wch = wid >> 1; bool resc = false;
    const float p1off = 32.f * s8, tstep = 64.f * s8, nm1off = p1off * C2;
    f32x16 ali;
    { const float tq = (float)(QB * qb + qrel);
#pragma unroll
      for (int r = 0; r < 16; ++r) ali[r] = -s8 * (tq - (float)crow(r, hi)); }
    PIN(ali);
    f32x16 pA0, pA1, pB0, pB1; bf16x8 kf[8]; s16x4 vlo[8], vhi[8]; u32x4 pw0, pw1, pw2, pw3;
    int sl_prev = 0, sl_cur = 0, sl_next = SLOTB;
#define ROT() do { sl_prev = sl_cur; sl_cur = sl_next; sl_next = (sl_next == 2 * SLOTB) ? 0 : sl_next + SLOTB; } while (0)
#define EX(v, nm) __builtin_amdgcn_exp2f(__builtin_fmaf((v), C2, (nm)))
#define RESC() do { if (resc) { _Pragma("unroll") for (int d_ = 0; d_ < 2; ++d_) _Pragma("unroll") for (int r = 0; r < 16; ++r) o[d_][r] *= wsf[crow(r, hi)]; } } while (0)
#define APPLY(C0, C1, t, BAND) do { \
    const int jb_ = (t) - (NT - 4); \
    if (MASKED && !EXP_NOMASK) { const u32x2 mq_ = *(const __attribute__((address_space(3))) u32x2*)(mrow + (t) * 256); unsigned m0_ = mq_[0] >> (4 * hi), m1_ = mq_[1] >> (4 * hi); \
        if (BAND) { m0_ = (jb_ > wch) ? 0u : m0_; m1_ = (jb_ > wch) ? 0u : m1_; } SBAR(); \
        _Pragma("unroll") for (int e = 0; e < 16; e += 4) { C0[e] = msel(C0[e], m0_, 2 * e); C0[e + 1] = msel(C0[e + 1], m0_, 2 * e + 1); C0[e + 2] = msel(C0[e + 2], m0_, 2 * e + 2); C0[e + 3] = msel(C0[e + 3], m0_, 2 * e + 3); SBAR(); } \
        _Pragma("unroll") for (int e = 0; e < 16; e += 4) { C1[e] = msel(C1[e], m1_, 2 * e); C1[e + 1] = msel(C1[e + 1], m1_, 2 * e + 1); C1[e + 2] = msel(C1[e + 2], m1_, 2 * e + 2); C1[e + 3] = msel(C1[e + 3], m1_, 2 * e + 3); SBAR(); } } \
    if (BAND && !EXP_NOBAND) { const float binv_ = (!MASKED && jb_ > wch) ? -INFINITY : 0.f, m2_ = (jb_ == wch) ? -2.f * s8 : 0.f, fb_ = (float)(4 * hi - (qrel - 64 * wch)); float fbo_ = fb_; asm volatile("" : "+v"(fbo_)); SBAR(); \
        _Pragma("unroll") for (int e = 0; e < 16; ++e) { const float d0_ = fbo_ + (float)((e & 3) + 8 * (e >> 2)); \
            C0[e] = __builtin_fmaf(__builtin_fmaxf(d0_, 0.f), m2_, C0[e] + binv_); C1[e] = __builtin_fmaf(__builtin_fmaxf(d0_ + 32.f, 0.f), m2_, C1[e] + binv_); if ((e & 1) == 1) SBAR(); } } } while (0)
    DMA_K(2, 2 * SLOTB);
    WAIT_BAR(3);
    _Pragma("unroll") for (int d0 = 0; d0 < 4; ++d0) kload2(kf, kp0, d0);
    pA0 = MFMA(kf[0], qr[0], ali); pA1 = MFMA(kf[1], qr[0], ali); pA0 = MFMA(kf[2], qr[1], pA0); pA1 = MFMA(kf[3], qr[1], pA1);
    pA0 = MFMA(kf[4], qr[2], pA0); pA1 = MFMA(kf[5], qr[2], pA1); pA0 = MFMA(kf[6], qr[3], pA0); pA1 = MFMA(kf[7], qr[3], pA1);
    APPLY(pA0, pA1, 0, true);
    { const float rm = rowmax2(pA0, pA1, p1off); mhat = __builtin_fmaxf(rm * C2, -30000.f); const float nmh = -mhat, nmh1 = nmh + nm1off;
#pragma unroll
      for (int r = 0; r < 16; ++r) { pA0[r] = EX(pA0[r], nmh); pA1[r] = EX(pA1[r], nmh1); } }
#pragma unroll
    for (int r = 0; r < 16; ++r) ali[r] += tstep;
    WAIT_BAR(0);
    DMA_K(3, 0); DMA_V(1, SLOTB); ROT();
    _Pragma("unroll") for (int d0 = 0; d0 < 4; ++d0) kload2(kf, kp0 + sl_cur, d0);
    WAIT_BAR(2);
#define PKW(P, i) cvtpk(P[i], P[i + 1])
#define PAF(k) __builtin_bit_cast(bf16x8, pw##k)
#define VFR(i) (bf16x8){vlo[i][0], vlo[i][1], vlo[i][2], vlo[i][3], vhi[i][0], vhi[i][1], vhi[i][2], vhi[i][3]}
#define VRD(i) do { vlo[i] = vtr(vp_ + (((i) >> 2) * 4096 + ((i) & 3) * 1024)); vhi[i] = vtr(vp_ + (((i) >> 2) * 4096 + ((i) & 3) * 1024 + 512)); } while (0)
#define KRD(G, d0) do { if (G) { kload2(kf, kp0 + sl_next, d0); SBAR(); } } while (0)
#define GAPA(MF, a0, a1, a2, a3, W0, W1, PW) do { MF; sacc += a0; sacc += a1; sacc += a2; sacc += a3; W0; W1; PIN(PW); PIN(sacc); SBAR(); } while (0)
#define GAPB(MF, X, i, nm) do { MF; X[i] = EX(X[i], nm); X[i + 1] = EX(X[i + 1], nm); X[i + 2] = EX(X[i + 2], nm); X[i + 3] = EX(X[i + 3], nm); PIN(X); SBAR(); } while (0)
#define STEP(C0, C1, P0, P1, t, BAND, GK, GV, GL) do { SBAR(); \
    const lds_cptr vp_ = vp0 + sl_prev; \
    VRD(0); SBAR(); float sacc = P0[0] + P0[1]; \
                    GAPA(C0 = MFMA(kf[0], qr[0], ali), P0[2], P0[3], P0[4], P0[5],     pw0[0] = PKW(P0, 0),  pw0[1] = PKW(P0, 2),  pw0); \
    VRD(4); SBAR(); GAPA(C1 = MFMA(kf[1], qr[0], ali), P0[6], P0[7], P0[8], P0[9],     pw0[2] = PKW(P0, 4),  pw0[3] = PKW(P0, 6),  pw0); \
    VRD(1); SBAR(); GAPA(C0 = MFMA(kf[2], qr[1], C0),  P0[10], P0[11], P0[12], P0[13], pw1[0] = PKW(P0, 8),  pw1[1] = PKW(P0, 10), pw1); \
    VRD(5); SBAR(); GAPA(C1 = MFMA(kf[3], qr[1], C1),  P0[14], P0[15], P1[0], P1[1],   pw1[2] = PKW(P0, 12), pw1[3] = PKW(P0, 14), pw1); \
    VRD(2); SBAR(); GAPA(C0 = MFMA(kf[4], qr[2], C0),  P1[2], P1[3], P1[4], P1[5],     pw2[0] = PKW(P1, 0),  pw2[1] = PKW(P1, 2),  pw2); \
    VRD(6); SBAR(); GAPA(C1 = MFMA(kf[5], qr[2], C1),  P1[6], P1[7], P1[8], P1[9],     pw2[2] = PKW(P1, 4),  pw2[3] = PKW(P1, 6),  pw2); \
    VRD(3); SBAR(); GAPA(C0 = MFMA(kf[6], qr[3], C0),  P1[10], P1[11], P1[12], P1[13], pw3[0] = PKW(P1, 8),  pw3[1] = PKW(P1, 10), pw3); \
    VRD(7); SBAR(); GAPA(C1 = MFMA(kf[7], qr[3], C1),  P1[14], P1[15], 0.f, 0.f,       pw3[2] = PKW(P1, 12), pw3[3] = PKW(P1, 14), pw3); \
    l_reg += sacc; \
    if (GK) DMA_K((t) + 3, sl_cur); if (GV) DMA_V((t) + 1, sl_next); \
    EXP_APPLY(C0, C1, t, BAND); \
    EXP_ADV; \
    { const float rm = __builtin_fmaf(rowmax2(C0, C1, p1off), C2, -mhat); resc = false; \
      if (__builtin_expect(__any(rm > ATT_THR), 0)) { const float dl = __builtin_fmaxf(rm, 0.f); mhat += dl; \
          const float f = __builtin_amdgcn_exp2f(-dl); l_reg *= f; if (hi == 0) wsf[r32] = f; resc = true; } } \
    const float nmh = -mhat, nmh1 = nmh + nm1off; SBAR(); \
    GAPB(o[0] = MFMA(PAF(0), VFR(0), o[0]), C0, 0, nmh);              GAPB(o[1] = MFMA(PAF(0), VFR(4), o[1]), C0, 4, nmh); \
    KRD(GL, 0); GAPB(o[0] = MFMA(PAF(1), VFR(1), o[0]), C0, 8, nmh);  KRD(GL, 1); GAPB(o[1] = MFMA(PAF(1), VFR(5), o[1]), C0, 12, nmh); \
    KRD(GL, 2); GAPB(o[0] = MFMA(PAF(2), VFR(2), o[0]), C1, 0, nmh1); KRD(GL, 3); GAPB(o[1] = MFMA(PAF(2), VFR(6), o[1]), C1, 4, nmh1); \
    GAPB(o[0] = MFMA(PAF(3), VFR(3), o[0]), C1, 8, nmh1);             GAPB(o[1] = MFMA(PAF(3), VFR(7), o[1]), C1, 12, nmh1); \
    } while (0)
    int t = 1;
    for (; t + 5 < NT; t += 2) {
        STEP(pB0, pB1, pA0, pA1, t, false, true, true, true);     WAIT_BAR(2); RESC(); ROT();
        STEP(pA0, pA1, pB0, pB1, t + 1, false, true, true, true); WAIT_BAR(2); RESC(); ROT();
    }
#define ENDW(tt) do { if ((tt) + 3 < NT) { WAIT_BAR(2); } else if ((tt) + 2 < NT) { WAIT_BAR(1); } else { WAIT_BAR(0); } } while (0)
    for (; t + 1 < NT; t += 2) {
        STEP(pB0, pB1, pA0, pA1, t, true, (t + 3 < NT), (t + 1 < NT), (t + 1 < NT));         ENDW(t);     RESC(); ROT();
        STEP(pA0, pA1, pB0, pB1, t + 1, true, (t + 4 < NT), (t + 2 < NT), (t + 2 < NT));     ENDW(t + 1); RESC(); ROT();
    }
    STEP(pB0, pB1, pA0, pA1, NT - 1, true, false, false, false); RESC();
    { float sacc = pB0[0] + pB0[1];
#pragma unroll
      for (int r = 2; r < 16; ++r) sacc += pB0[r];
#pragma unroll
      for (int r = 0; r < 16; ++r) sacc += pB1[r];
      l_reg += sacc;
      pw0 = (u32x4){PKW(pB0, 0), PKW(pB0, 2), PKW(pB0, 4), PKW(pB0, 6)}; pw1 = (u32x4){PKW(pB0, 8), PKW(pB0, 10), PKW(pB0, 12), PKW(pB0, 14)};
      pw2 = (u32x4){PKW(pB1, 0), PKW(pB1, 2), PKW(pB1, 4), PKW(pB1, 6)}; pw3 = (u32x4){PKW(pB1, 8), PKW(pB1, 10), PKW(pB1, 12), PKW(pB1, 14)};
      const lds_cptr vp_ = vp0 + sl_cur; _Pragma("unroll") for (int i = 0; i < 8; ++i) VRD(i);
      o[0] = MFMA(PAF(0), VFR(0), o[0]); o[1] = MFMA(PAF(0), VFR(4), o[1]); o[0] = MFMA(PAF(1), VFR(1), o[0]); o[1] = MFMA(PAF(1), VFR(5), o[1]);
      o[0] = MFMA(PAF(2), VFR(2), o[0]); o[1] = MFMA(PAF(2), VFR(6), o[1]); o[0] = MFMA(PAF(3), VFR(3), o[0]); o[1] = MFMA(PAF(3), VFR(7), o[1]); }
    { auto rr = __builtin_amdgcn_permlane32_swap(__float_as_uint(l_reg), __float_as_uint(l_reg), false, false); l_reg = __uint_as_float(rr[0]) + __uint_as_float(rr[1]); }
    if (hi == 0) wsf[32 + r32] = l_reg;
    asm volatile("s_waitcnt lgkmcnt(0)\n\ts_barrier" ::: "memory");
#undef DMA_K
#undef DMA_V
#undef ROT
#undef EX
#undef RESC
#undef APPLY
#undef PKW
#undef PAF
#undef VFR
#undef VRD
#undef KRD
#undef ENDW
#undef GAPA
#undef GAPB
#undef STEP
}
constexpr int L8_K = 0, L8_V = 3 * SLOTB, L8_VSLOT = 2 * SLOTB, L8_WS = L8_V + 3 * L8_VSLOT, L8_OST = L8_WS + NW * WSW * 4, L8_Q = L8_OST + NW * 4096, L8_BYTES = L8_Q + NW * 4096;
static_assert(L8_BYTES <= LDS_BYTES, "core128 LDS");
__device__ __forceinline__ float rowmax_h(const f32x16& p0, const f32x16& p1, float hoff) {
    float a = MX3(p0[0], p0[1], p0[2]), b = MX3(p1[0], p1[1], p1[2]);
#pragma unroll
    for (int r = 3; r < 15; r += 2) { a = MX3(a, p0[r], p0[r + 1]); b = MX3(b, p1[r], p1[r + 1]); }
    a = __builtin_fmaxf(a, p0[15]); b = __builtin_fmaxf(b, p1[15]);
    float m = __builtin_fmaxf(a, b) + hoff; auto rr = __builtin_amdgcn_permlane32_swap(__float_as_uint(m), __float_as_uint(m), false, false);
    return __builtin_fmaxf(__uint_as_float(rr[0]), __uint_as_float(rr[1])); }
__device__ __forceinline__ void attn_core128(f32x16 (&o)[4], const bf16* Qw, int qp, const bf16* Kh, int kp, const bf16* Vh, int vp, int qb, float s8, char* lds) {
    int lz_ = threadIdx.x & 63; asm volatile("" : "+v"(lz_));
    const int tid = threadIdx.x, lane = lz_, r32 = lane & 31, hi = lane >> 5; const int wid = __builtin_amdgcn_readfirstlane(tid >> 6);
    const int NT = 4 * qb + 4;
    const unsigned lds0 = (unsigned)(uintptr_t)lds; const lds_fptr wsf = (lds_fptr)((lds_ptr)lds + L8_WS) + wid * WSW;
    const bf16* ksrc = Kh + (long)lane * kp + wid * 8;
    const bf16* vsrc = Vh + (long)(16 * (wid & 3) + (lane >> 2)) * vp + (wid >> 2) * 32 + (lane & 3) * 8;
    const unsigned kdst = lds0 + L8_K + wid * 1024, vdst = lds0 + L8_V + wid * 1024;
#define DMA_K(t, slot) glds16(ksrc + (long)(t) * KVBLK * kp, (unsigned)__builtin_amdgcn_readfirstlane(kdst + (slot)))
#define DMA_V(t, slot) do { glds16(vsrc + (long)(t) * KVBLK * vp, (unsigned)__builtin_amdgcn_readfirstlane(vdst + 2 * (slot))); \
                            glds16(vsrc + (long)(t) * KVBLK * vp + 64, (unsigned)__builtin_amdgcn_readfirstlane(vdst + 2 * (slot) + 8192)); } while (0)
    const lds_cptr vp0 = (lds_cptr)lds + L8_V + ((lane >> 4) & 1) * 32 + (lane & 3) * 8 + (4 * hi + ((lane & 15) >> 2)) * 64;
    const lds_cptr kp0 = (lds_cptr)lds + L8_K + hi * 1024 + r32 * 16;
    const lds_cptr qlp = (lds_cptr)lds + L8_Q + wid * 4096 + hi * 512 + r32 * 16;
#pragma unroll
    for (int d0 = 0; d0 < 4; ++d0) glds16(Qw + (long)r32 * qp + d0 * 16 + hi * 8, (unsigned)__builtin_amdgcn_readfirstlane(lds0 + L8_Q + wid * 4096 + d0 * 1024));
    DMA_K(0, 0); DMA_V(0, 0); DMA_K(1, SLOTB);
#ifdef DBG_QGLOBAL
#define QF(d0) (*reinterpret_cast<const bf16x8*>(&Qw[(long)r32 * qp + (d0) * 16 + hi * 8]))
#else
#define QF(d0) (*(const __attribute__((address_space(3))) bf16x8*)(qlp + (d0) * 1024))
#endif
    float mhat = 0.f, l_reg = 0.f; o[0] = f32x16{}; o[1] = f32x16{}; o[2] = f32x16{}; o[3] = f32x16{};
    const int qrel = wid * QBLK + r32, wch = wid >> 1; bool resc = false;
    float bt = -s8 * (float)(QB * qb + qrel); const float tstep = 64.f * s8, hoff = s8 * (float)(4 * hi);
    f32x16 pA0, pA1, pB0, pB1; bf16x8 kf[8]; s16x4 vlo[8], vhi[8]; u32x4 pw0, pw1, pw2, pw3;
    int sl_prev = 0, sl_cur = 0, sl_next = SLOTB;
#define ROT() do { sl_prev = sl_cur; sl_cur = sl_next; sl_next = (sl_next == 2 * SLOTB) ? 0 : sl_next + SLOTB; } while (0)
#define EX(v, nm) __builtin_amdgcn_exp2f(__builtin_fmaf((v), C2, (nm)))
#define RESC() do { if (resc) { _Pragma("unroll") for (int d_ = 0; d_ < 4; ++d_) _Pragma("unroll") for (int r = 0; r < 16; ++r) o[d_][r] *= wsf[crow(r, hi)]; } } while (0)
#define BIAS(C0, C1) do { _Pragma("unroll") for (int e = 0; e < 16; ++e) { C0[e] = __builtin_fmaf(s8, (float)((e & 3) + 8 * (e >> 2)), C0[e]); C1[e] = __builtin_fmaf(s8, (float)(32 + (e & 3) + 8 * (e >> 2)), C1[e]); } } while (0)
#define APPLY(C0, C1, t, BAND) do { \
    if (BAND) { const int jb_ = (t) - (NT - 4); const float binv_ = (jb_ > wch) ? -INFINITY : 0.f, m2_ = (jb_ == wch) ? -2.f * s8 : 0.f, fb_ = (float)(4 * hi - (qrel - 64 * wch)); float fbo_ = fb_; asm volatile("" : "+v"(fbo_)); SBAR(); \
        _Pragma("unroll") for (int e = 0; e < 16; ++e) { const float d0_ = fbo_ + (float)((e & 3) + 8 * (e >> 2)); \
            C0[e] = __builtin_fmaf(__builtin_fmaxf(d0_, 0.f), m2_, C0[e] + binv_); C1[e] = __builtin_fmaf(__builtin_fmaxf(d0_ + 32.f, 0.f), m2_, C1[e] + binv_); if ((e & 1) == 1) SBAR(); } } } while (0)
    DMA_K(2, 2 * SLOTB);
    WAIT_BAR(4);
    _Pragma("unroll") for (int d0 = 0; d0 < 4; ++d0) kload2(kf, kp0, d0);
    { const bf16x8 q0 = QF(0), q1 = QF(1), q2 = QF(2), q3 = QF(3); const f32x16 z = f32x16{};
      pA0 = MFMA(kf[0], q0, z); pA1 = MFMA(kf[1], q0, z); pA0 = MFMA(kf[2], q1, pA0); pA1 = MFMA(kf[3], q1, pA1);
      pA0 = MFMA(kf[4], q2, pA0); pA1 = MFMA(kf[5], q2, pA1); pA0 = MFMA(kf[6], q3, pA0); pA1 = MFMA(kf[7], q3, pA1); }
    BIAS(pA0, pA1); APPLY(pA0, pA1, 0, true);
    { const float rm = rowmax_h(pA0, pA1, hoff); mhat = __builtin_fmaxf((rm + bt) * C2, -30000.f); const float nmh = __builtin_fmaf(bt + hoff, C2, -mhat);
#pragma unroll
      for (int r = 0; r < 16; ++r) { pA0[r] = EX(pA0[r], nmh); pA1[r] = EX(pA1[r], nmh); } }
    bt += tstep;
    WAIT_BAR(0);
    DMA_K(3, 0); DMA_V(1, SLOTB); ROT();
    _Pragma("unroll") for (int d0 = 0; d0 < 4; ++d0) kload2(kf, kp0 + sl_cur, d0);
    WAIT_BAR(3);
#define PKW(P, i) cvtpk(P[i], P[i + 1])
#define PAF(k) __builtin_bit_cast(bf16x8, pw##k)
#define VFR(i) (bf16x8){vlo[i][0], vlo[i][1], vlo[i][2], vlo[i][3], vhi[i][0], vhi[i][1], vhi[i][2], vhi[i][3]}
#define VRD(i, hofs) do { vlo[i] = vtr(vp_ + ((hofs) + ((i) >> 2) * 4096 + ((i) & 3) * 1024)); vhi[i] = vtr(vp_ + ((hofs) + ((i) >> 2) * 4096 + ((i) & 3) * 1024 + 512)); } while (0)
#define KRD(G, d0) do { if (G) { kload2(kf, kp0 + sl_next, d0); SBAR(); } } while (0)
#define GAPA(MF, a0, a1, a2, a3, W0, W1, PW) do { MF; sacc += a0; sacc += a1; sacc += a2; sacc += a3; W0; W1; PIN(PW); PIN(sacc); SBAR(); } while (0)
#define GAPB1(MF, i, X, j, nm) do { MF; VRD(i, 8192); X[j] = EX(X[j], nm); X[j + 1] = EX(X[j + 1], nm); PIN(X); SBAR(); } while (0)
#define GAPB2(MF, X, j, nm) do { MF; X[j] = EX(X[j], nm); X[j + 1] = EX(X[j + 1], nm); PIN(X); SBAR(); } while (0)
#define STEP(C0, C1, P0, P1, t, BAND, GK, GV, GL) do { SBAR(); \
    const lds_cptr vp_ = vp0 + 2 * sl_prev; \
    VRD(0, 0); bf16x8 qa_ = QF(0); SBAR(); float sacc = P0[0] + P0[1]; const f32x16 z_ = f32x16{}; \
                       GAPA(C0 = MFMA(kf[0], qa_, z_), P0[2], P0[3], P0[4], P0[5],     pw0[0] = PKW(P0, 0),  pw0[1] = PKW(P0, 2),  pw0); \
    VRD(4, 0); bf16x8 qb_ = QF(1); SBAR(); GAPA(C1 = MFMA(kf[1], qa_, z_), P0[6], P0[7], P0[8], P0[9],     pw0[2] = PKW(P0, 4),  pw0[3] = PKW(P0, 6),  pw0);     \
    VRD(1, 0); SBAR(); GAPA(C0 = MFMA(kf[2], qb_, C0),  P0[10], P0[11], P0[12], P0[13], pw1[0] = PKW(P0, 8),  pw1[1] = PKW(P0, 10), pw1); \
    VRD(5, 0); qa_ = QF(2); SBAR(); GAPA(C1 = MFMA(kf[3], qb_, C1),  P0[14], P0[15], P1[0], P1[1],   pw1[2] = PKW(P0, 12), pw1[3] = PKW(P0, 14), pw1); \
    VRD(2, 0); SBAR(); GAPA(C0 = MFMA(kf[4], qa_, C0),  P1[2], P1[3], P1[4], P1[5],     pw2[0] = PKW(P1, 0),  pw2[1] = PKW(P1, 2),  pw2); \
    VRD(6, 0); qb_ = QF(3); SBAR(); GAPA(C1 = MFMA(kf[5], qa_, C1),  P1[6], P1[7], P1[8], P1[9],     pw2[2] = PKW(P1, 4),  pw2[3] = PKW(P1, 6),  pw2); \
    VRD(3, 0); SBAR(); GAPA(C0 = MFMA(kf[6], qb_, C0),  P1[10], P1[11], P1[12], P1[13], pw3[0] = PKW(P1, 8),  pw3[1] = PKW(P1, 10), pw3); \
    VRD(7, 0); SBAR(); GAPA(C1 = MFMA(kf[7], qb_, C1),  P1[14], P1[15], 0.f, 0.f,       pw3[2] = PKW(P1, 12), pw3[3] = PKW(P1, 14), pw3); \
    l_reg += sacc; \
    if (GK) DMA_K((t) + 3, sl_cur); if (GV) DMA_V((t) + 1, sl_next); \
    BIAS(C0, C1); APPLY(C0, C1, t, BAND); \
    { const float rm = __builtin_fmaf(rowmax_h(C0, C1, hoff) + bt, C2, -mhat); resc = false; \
      if (__builtin_expect(__any(rm > ATT_THR), 0)) { const float dl = __builtin_fmaxf(rm, 0.f); mhat += dl; \
          const float f = __builtin_amdgcn_exp2f(-dl); l_reg *= f; if (hi == 0) wsf[r32] = f; resc = true; } } \
    const float nmh = __builtin_fmaf(bt + hoff, C2, -mhat); bt += tstep; SBAR(); \
    GAPB1(o[0] = MFMA(PAF(0), VFR(0), o[0]), 0, C0, 0, nmh);              GAPB1(o[1] = MFMA(PAF(0), VFR(4), o[1]), 4, C0, 2, nmh); \
    GAPB1(o[0] = MFMA(PAF(1), VFR(1), o[0]), 1, C0, 4, nmh);              GAPB1(o[1] = MFMA(PAF(1), VFR(5), o[1]), 5, C0, 6, nmh); \
    GAPB1(o[0] = MFMA(PAF(2), VFR(2), o[0]), 2, C0, 8, nmh);              GAPB1(o[1] = MFMA(PAF(2), VFR(6), o[1]), 6, C0, 10, nmh); \
    GAPB1(o[0] = MFMA(PAF(3), VFR(3), o[0]), 3, C0, 12, nmh);             GAPB1(o[1] = MFMA(PAF(3), VFR(7), o[1]), 7, C0, 14, nmh); \
    GAPB2(o[2] = MFMA(PAF(0), VFR(0), o[2]), C1, 0, nmh);                 GAPB2(o[3] = MFMA(PAF(0), VFR(4), o[3]), C1, 2, nmh); \
    KRD(GL, 0); GAPB2(o[2] = MFMA(PAF(1), VFR(1), o[2]), C1, 4, nmh);     KRD(GL, 1); GAPB2(o[3] = MFMA(PAF(1), VFR(5), o[3]), C1, 6, nmh); \
    KRD(GL, 2); GAPB2(o[2] = MFMA(PAF(2), VFR(2), o[2]), C1, 8, nmh);     KRD(GL, 3); GAPB2(o[3] = MFMA(PAF(2), VFR(6), o[3]), C1, 10, nmh); \
    GAPB2(o[2] = MFMA(PAF(3), VFR(3), o[2]), C1, 12, nmh);                GAPB2(o[3] = MFMA(PAF(3), VFR(7), o[3]), C1, 14, nmh); \
    } while (0)
    int t = 1;
    for (; t + 5 < NT; t += 2) {
        STEP(pB0, pB1, pA0, pA1, t, false, true, true, true);     WAIT_BAR(3); RESC(); ROT();
        STEP(pA0, pA1, pB0, pB1, t + 1, false, true, true, true); WAIT_BAR(3); RESC(); ROT();
    }
#define ENDW(tt) do { if ((tt) + 3 < NT) { WAIT_BAR(3); } else if ((tt) + 2 < NT) { WAIT_BAR(2); } else { WAIT_BAR(0); } } while (0)
    for (; t + 1 < NT; t += 2) {
        STEP(pB0, pB1, pA0, pA1, t, true, (t + 3 < NT), (t + 1 < NT), (t + 1 < NT));         ENDW(t);     RESC(); ROT();
        STEP(pA0, pA1, pB0, pB1, t + 1, true, (t + 4 < NT), (t + 2 < NT), (t + 2 < NT));     ENDW(t + 1); RESC(); ROT();
    }
    STEP(pB0, pB1, pA0, pA1, NT - 1, true, false, false, false); RESC();
    { float sacc = pB0[0] + pB0[1];
#pragma unroll
      for (int r = 2; r < 16; ++r) sacc += pB0[r];
#pragma unroll
      for (int r = 0; r < 16; ++r) sacc += pB1[r];
      l_reg += sacc;
      pw0 = (u32x4){PKW(pB0, 0), PKW(pB0, 2), PKW(pB0, 4), PKW(pB0, 6)}; pw1 = (u32x4){PKW(pB0, 8), PKW(pB0, 10), PKW(pB0, 12), PKW(pB0, 14)};
      pw2 = (u32x4){PKW(pB1, 0), PKW(pB1, 2), PKW(pB1, 4), PKW(pB1, 6)}; pw3 = (u32x4){PKW(pB1, 8), PKW(pB1, 10), PKW(pB1, 12), PKW(pB1, 14)};
      const lds_cptr vp_ = vp0 + 2 * sl_cur;
#pragma unroll
      for (int hf = 0; hf < 2; ++hf) {
        _Pragma("unroll") for (int i = 0; i < 8; ++i) VRD(i, hf * 8192);
        o[2 * hf] = MFMA(PAF(0), VFR(0), o[2 * hf]); o[2 * hf + 1] = MFMA(PAF(0), VFR(4), o[2 * hf + 1]); o[2 * hf] = MFMA(PAF(1), VFR(1), o[2 * hf]); o[2 * hf + 1] = MFMA(PAF(1), VFR(5), o[2 * hf + 1]);
        o[2 * hf] = MFMA(PAF(2), VFR(2), o[2 * hf]); o[2 * hf + 1] = MFMA(PAF(2), VFR(6), o[2 * hf + 1]); o[2 * hf] = MFMA(PAF(3), VFR(3), o[2 * hf]); o[2 * hf + 1] = MFMA(PAF(3), VFR(7), o[2 * hf + 1]); } }
    { auto rr = __builtin_amdgcn_permlane32_swap(__float_as_uint(l_reg), __float_as_uint(l_reg), false, false); l_reg = __uint_as_float(rr[0]) + __uint_as_float(rr[1]); }
    if (hi == 0) wsf[32 + r32] = l_reg;
    asm volatile("s_waitcnt lgkmcnt(0)\n\ts_barrier" ::: "memory");
#undef DMA_K
#undef DMA_V
#undef QF
#undef ROT
#undef EX
#undef RESC
#undef BIAS
#undef APPLY
#undef PKW
#undef PAF
#undef VFR
#undef VRD
#undef KRD
#undef ENDW
#undef GAPA
#undef GAPB1
#undef GAPB2
#undef STEP
}
__device__ __forceinline__ void unit_a(int b, int h, int qb, const bf16* QA, const bf16* KA, const bf16* VA, const unsigned long long* MASK, bf16* YA, char* lds) {
    const int tid = threadIdx.x; const int wid = __builtin_amdgcn_readfirstlane(tid >> 6);
    const long rowbase = (long)b * SEQ; const long qrow0 = rowbase + qb * QB + wid * QBLK;
    const float s8 = 8.f * __builtin_amdgcn_exp2f(-(float)(h + 1));
    f32x16 o[2];
    attn_core<true>(o, QA + qrow0 * 512 + h * 64, 512, KA + rowbase * 512 + h * 64, 512, VA + rowbase * 512 + h * 64, 512, qb, s8,
                    MASK + ((size_t)(b * 64 + qb * 8 + wid) * 32) * 32, lds);
    int lz = threadIdx.x & 63; asm volatile("" : "+v"(lz));
    const int lane = lz, r32 = lz & 31, hi = lz >> 5;
    const lds_fptr wsf = (lds_fptr)((lds_ptr)lds + LDS_WS) + wid * WSW;
    float rli[16];
#pragma unroll
    for (int r = 0; r < 16; ++r) rli[r] = __builtin_amdgcn_rcpf(wsf[32 + crow(r, hi)]) * (1.0f + SCALE_A_EPS);
    typedef __attribute__((address_space(3))) unsigned short* lds_hptr;
    const lds_hptr stg = (lds_hptr)((lds_ptr)lds + LDS_OST) + wid * 2048;
#pragma unroll
    for (int r = 0; r < 16; ++r) { const int orow = crow(r, hi);
#pragma unroll
        for (int d0 = 0; d0 < 2; ++d0) stg[orow * 64 + d0 * 32 + r32] = f2bf(o[d0][r] * rli[r]); }
    asm volatile("s_waitcnt lgkmcnt(0)" ::: "memory");
    bf16* Ow = YA + qrow0 * 1024 + h * 64;
#pragma unroll
    for (int i = 0; i < 4; ++i) { const int row = i * 8 + (lane >> 3), ch = lane & 7; *(u32x4*)(Ow + (long)row * 1024 + ch * 8) = *(const __attribute__((address_space(3))) u32x4*)(stg + row * 64 + ch * 8); }
    asm volatile("s_waitcnt lgkmcnt(0)" ::: "memory");
}
__device__ __forceinline__ void unit_b128(int b, int h, int qb, const bf16* QBq, const bf16* KBk, const bf16* VBv, const float* subln_g, float lam, bf16* YB, unsigned* stash_g, int slot, char* lds) {
    const int tid = threadIdx.x; const int wid = __builtin_amdgcn_readfirstlane(tid >> 6);
    const long rowbase = (long)b * SEQ; const long qrow0 = rowbase + qb * QB + wid * QBLK;
    const float s8 = 8.f * __builtin_amdgcn_exp2f(-2.f * (float)(h + 1));
    typedef __attribute__((address_space(3))) unsigned short* lds_hptr;
    _Pragma("nounroll") for (int m = 0; m < 2; ++m) {
        f32x16 o[4];
        attn_core128(o, QBq + qrow0 * 512 + (2 * h + m) * 64, 512, KBk + rowbase * 512 + (2 * h + m) * 64, 512, VBv + rowbase * 512 + h * 128, 512, qb, s8, lds);
        int lz = threadIdx.x & 63; asm volatile("" : "+v"(lz));
        const int lane = lz, r32 = lz & 31, hi = lz >> 5;
        const lds_fptr wsf = (lds_fptr)((lds_ptr)lds + L8_WS) + wid * WSW;
        const lds_hptr stg = (lds_hptr)((lds_ptr)lds + L8_OST) + wid * 2048;
        unsigned* sg = stash_g + (((size_t)blockIdx.x * 2 + slot) * NW + wid) * 2048 + lane;
        bf16* Ow = YB + qrow0 * 1024 + 512 + h * 128;
        float rli[16];
#pragma unroll
        for (int r = 0; r < 16; ++r) rli[r] = __builtin_amdgcn_rcpf(wsf[32 + crow(r, hi)]);
        if (m == 0) {
#pragma unroll
            for (int d = 0; d < 4; ++d)
#pragma unroll
                for (int r = 0; r < 16; r += 2) sg[(d * 8 + (r >> 1)) * 64] = cvtpk(o[d][r] * rli[r], o[d][r + 1] * rli[r + 1]);
        } else {
            float ssp[16];
#pragma unroll
            for (int r = 0; r < 16; ++r) ssp[r] = 0.f;
#pragma unroll
            for (int d = 0; d < 4; ++d)
#pragma unroll
                for (int r = 0; r < 16; r += 2) { const unsigned w = __hip_atomic_load(sg + (d * 8 + (r >> 1)) * 64, __ATOMIC_RELAXED, __HIP_MEMORY_SCOPE_AGENT);
                    const float v0 = __uint_as_float(w << 16) - lam * (o[d][r] * rli[r]), v1 = __uint_as_float(w & 0xffff0000u) - lam * (o[d][r + 1] * rli[r + 1]);
                    o[d][r] = v0; o[d][r + 1] = v1; ssp[r] += v0 * v0; ssp[r + 1] += v1 * v1; }
#pragma unroll
            for (int r = 0; r < 16; ++r) {
#pragma unroll
                for (int off = 1; off < 32; off <<= 1) ssp[r] += __shfl_xor(ssp[r], off); }
#pragma unroll
            for (int r = 0; r < 16; ++r) ssp[r] = __builtin_amdgcn_rsqf(ssp[r] * (1.0f / 128.0f) + 1e-6f) * (0.8f * (1.0f + SCALE_B_EPS));
            if (r32 == 0) {
#pragma unroll
                for (int r = 0; r < 16; ++r) wsf[64 + crow(r, hi)] = ssp[r]; }
            asm volatile("s_waitcnt lgkmcnt(0)" ::: "memory");
#pragma unroll
            for (int e = 0; e < 2; ++e) {
#pragma unroll
                for (int r = 0; r < 16; ++r) { const int orow = crow(r, hi);
#pragma unroll
                    for (int d0 = 0; d0 < 2; ++d0) stg[orow * 64 + d0 * 32 + r32] = f2bf(o[2 * e + d0][r]); }
                asm volatile("s_waitcnt lgkmcnt(0)" ::: "memory");
                const int ch = lane & 7;
                const float4 g0 = *(const float4*)(subln_g + e * 64 + ch * 8), g1 = *(const float4*)(subln_g + e * 64 + ch * 8 + 4);
#pragma unroll
                for (int i = 0; i < 4; ++i) { const int row = i * 8 + (lane >> 3); const float rs = wsf[64 + row];
                    const u32x4 w = *(const __attribute__((address_space(3))) u32x4*)(stg + row * 64 + ch * 8); u32x4 ov;
                    ov.x = cvtpk(__uint_as_float(w.x << 16) * rs * g0.x, __uint_as_float(w.x & 0xffff0000u) * rs * g0.y);
                    ov.y = cvtpk(__uint_as_float(w.y << 16) * rs * g0.z, __uint_as_float(w.y & 0xffff0000u) * rs * g0.w);
                    ov.z = cvtpk(__uint_as_float(w.z << 16) * rs * g1.x, __uint_as_float(w.z & 0xffff0000u) * rs * g1.y);
                    ov.w = cvtpk(__uint_as_float(w.w << 16) * rs * g1.z, __uint_as_float(w.w & 0xffff0000u) * rs * g1.w);
                    *(u32x4*)(Ow + (long)row * 1024 + e * 64 + ch * 8) = ov; }
                asm volatile("s_waitcnt lgkmcnt(0)" ::: "memory");
            }
        }
    }
}
#undef SBAR
#undef PIN
#undef MFMA
#undef WAIT_BAR
#undef MX3
}
#ifndef KEYMASK
#define KEYMASK 0xfffff800u
#endif
namespace sel {
using att::bf16x8; using att::f32x16; using att::crow; typedef unsigned short bf16;
constexpr int TBP = 513;
__device__ __forceinline__ void select_unit(int b, int qk, const bf16* QI, const bf16* KI, const float* WI, unsigned long long* MASK, char* lds) {
    int lz_ = threadIdx.x & 63; asm volatile("" : "+v"(lz_));
    const int tid = threadIdx.x, lane = lz_, r32 = lane & 31, hi = lane >> 5; const int wid = __builtin_amdgcn_readfirstlane(tid >> 6);
    const int ntv = (qk >> 1) + 1;
    unsigned long long* mbase = MASK + ((size_t)(b * 64 + qk) * 32) * 32;
    if (qk < 8) {
        for (int i = tid; i < 32 * 32; i += 512) mbase[i] = ((i >> 5) < ntv) ? ~0ull : 0ull;
        return;
    }
    typedef __attribute__((address_space(3))) char* lds_ptr;
    typedef __attribute__((address_space(3))) unsigned* lds_uptr;
    const lds_ptr QL = (lds_ptr)lds;
    const lds_uptr TB = (lds_uptr)((lds_ptr)lds + 16384);
    const size_t qrow0 = (size_t)b * 2048 + qk * 32;
    { const int c = tid & 31, q0 = tid >> 5;
#pragma unroll
      for (int u = 0; u < 2; ++u) { const int q = q0 + 16 * u; *(__attribute__((address_space(3))) att::u32x4*)(QL + c * 512 + q * 16) = *(const att::u32x4*)(QI + (qrow0 + q) * 256 + c * 8); } }
    typedef float f32x4_t __attribute__((ext_vector_type(4)));
    const f32x4_t wv = *(const f32x4_t*)(WI + (qrow0 + r32) * 4);
    __syncthreads();
    unsigned keyT[4][32];
    bf16x8 kfa[2][4];
#define SEL_KLOAD(jn) do { _Pragma("unroll") for (int p_ = 0; p_ < 2; ++p_) _Pragma("unroll") for (int d0 = 0; d0 < 4; ++d0) \
        kfa[p_][d0] = *(const bf16x8*)(KI + ((size_t)b * 2048 + (jn) * 64 + p_ * 32 + r32) * 64 + d0 * 16 + hi * 8); } while (0)
    if (wid < ntv) SEL_KLOAD(wid);
#pragma unroll
    for (int jj = 0; jj < 4; ++jj) {
        if (8 * jj < ntv) {
            const int j = 8 * jj + wid;
            unsigned kk[32];
            if (j < ntv) {
#pragma unroll
                for (int p = 0; p < 2; ++p) {
                    const bf16x8 kf[4] = {kfa[p][0], kfa[p][1], kfa[p][2], kfa[p][3]};
                    f32x16 s0 = f32x16{};
#pragma unroll
                    for (int h = 0; h < 4; ++h) {
                        bf16x8 qf[4];
#pragma unroll
                        for (int d0 = 0; d0 < 4; ++d0) qf[d0] = *(const __attribute__((address_space(3))) bf16x8*)(QL + ((h * 4 + d0) * 2 + hi) * 512 + r32 * 16);
                        f32x16 y0 = f32x16{};
#pragma unroll
                        for (int d0 = 0; d0 < 4; ++d0) y0 = __builtin_amdgcn_mfma_f32_32x32x16_bf16(kf[d0], qf[d0], y0, 0, 0, 0);
                        asm volatile("" : "+v"(y0));
                        const float w = wv[h];
#pragma unroll
                        for (int r = 0; r < 16; ++r) { const float yv = y0[r]; const int yi = __float_as_int(yv); s0[r] = __builtin_fmaf(__int_as_float(yi > 0 ? yi : 0), w, s0[r]); }
                    }
#pragma unroll
                    for (int r = 0; r < 16; ++r) {
                        const unsigned idx = (unsigned)(j * 64 + p * 32 + crow(r, hi));
                        const unsigned u = __float_as_uint(s0[r]); const unsigned m = (unsigned)(((int)u) >> 31) | 0x80000000u; kk[16 * p + r] = ((u ^ m) & KEYMASK) | (2047u - idx);
                    }
                    __builtin_amdgcn_sched_barrier(0);
                }
            } else {
#pragma unroll
                for (int e = 0; e < 32; ++e) kk[e] = 0u;
            }
            if (jj < 3 && j + 8 < ntv) SEL_KLOAD(j + 8);
#pragma unroll
            for (int p = 0; p < 2; ++p)
#pragma unroll
                for (int r = 0; r < 16; ++r) TB[r32 * TBP + 64 * wid + 32 * p + crow(r, hi)] = kk[16 * p + r];
            __syncthreads();
#pragma unroll
            for (int i = 0; i < 4; ++i)
#pragma unroll
                for (int t = 0; t < 8; ++t) keyT[jj][8 * i + t] = TB[(4 * wid + i) * TBP + 64 * t + lane];
            __syncthreads();
        } else {
#pragma unroll
            for (int e = 0; e < 32; ++e) keyT[jj][e] = 0u;
        }
    }
    unsigned T0 = 0u, T1 = 0u, T2 = 0u, T3 = 0u; bool dn0 = false, dn1 = false, dn2 = false, dn3 = false;
#define SEL_CNT8(c_, cand, K, o) do { unsigned long long m0_, m1_, m2_, m3_, m4_, m5_, m6_, m7_; unsigned t_; \
        asm volatile("v_cmp_le_u32_e64 %0, %10, %11\n\tv_cmp_le_u32_e64 %1, %10, %12\n\tv_cmp_le_u32_e64 %2, %10, %13\n\tv_cmp_le_u32_e64 %3, %10, %14\n\t" \
                     "v_cmp_le_u32_e64 %4, %10, %15\n\tv_cmp_le_u32_e64 %5, %10, %16\n\tv_cmp_le_u32_e64 %6, %10, %17\n\tv_cmp_le_u32_e64 %7, %10, %18\n\t" \
                     "s_bcnt1_i32_b64 %8, %0\n\ts_add_u32 %9, %9, %8\n\ts_bcnt1_i32_b64 %8, %1\n\ts_add_u32 %9, %9, %8\n\ts_bcnt1_i32_b64 %8, %2\n\ts_add_u32 %9, %9, %8\n\ts_bcnt1_i32_b64 %8, %3\n\ts_add_u32 %9, %9, %8\n\t" \
                     "s_bcnt1_i32_b64 %8, %4\n\ts_add_u32 %9, %9, %8\n\ts_bcnt1_i32_b64 %8, %5\n\ts_add_u32 %9, %9, %8\n\ts_bcnt1_i32_b64 %8, %6\n\ts_add_u32 %9, %9, %8\n\ts_bcnt1_i32_b64 %8, %7\n\ts_add_u32 %9, %9, %8" \
                     : "=&s"(m0_), "=&s"(m1_), "=&s"(m2_), "=&s"(m3_), "=&s"(m4_), "=&s"(m5_), "=&s"(m6_), "=&s"(m7_), "=&s"(t_), "+s"(c_) \
                     : "s"(cand), "v"(K[(o)]), "v"(K[(o) + 1]), "v"(K[(o) + 2]), "v"(K[(o) + 3]), "v"(K[(o) + 4]), "v"(K[(o) + 5]), "v"(K[(o) + 6]), "v"(K[(o) + 7]) : "scc"); } while (0)
#define SEL_CNT4(c_, cand, K, o) do { unsigned long long m0_, m1_, m2_, m3_; unsigned t_; \
        asm volatile("v_cmp_le_u32_e64 %0, %6, %7\n\tv_cmp_le_u32_e64 %1, %6, %8\n\tv_cmp_le_u32_e64 %2, %6, %9\n\tv_cmp_le_u32_e64 %3, %6, %10\n\t" \
                     "s_bcnt1_i32_b64 %4, %0\n\ts_add_u32 %5, %5, %4\n\ts_bcnt1_i32_b64 %4, %1\n\ts_add_u32 %5, %5, %4\n\ts_bcnt1_i32_b64 %4, %2\n\ts_add_u32 %5, %5, %4\n\ts_bcnt1_i32_b64 %4, %3\n\ts_add_u32 %5, %5, %4" \
                     : "=&s"(m0_), "=&s"(m1_), "=&s"(m2_), "=&s"(m3_), "=&s"(t_), "+s"(c_) \
                     : "s"(cand), "v"(K[(o)]), "v"(K[(o) + 1]), "v"(K[(o) + 2]), "v"(K[(o) + 3]) : "scc"); } while (0)
#ifdef SEL_SAFE
#define SEL_CNT(i, cand) ({ unsigned c_ = 0u; \
        _Pragma("unroll") for (int jj = 0; jj < 4; ++jj) { if (8 * jj < ntv) { \
            _Pragma("unroll") for (int t = 0; t < 8; ++t) c_ += (unsigned)__builtin_popcountll(__ballot(keyT[jj][8 * (i) + t] >= (cand))); __builtin_amdgcn_sched_barrier(0); } } c_; })
#else
#define SEL_CNT(i, cand) ({ unsigned c_ = 0u; const unsigned cd_ = (unsigned)__builtin_amdgcn_readfirstlane((int)(cand)); \
        _Pragma("unroll") for (int jj = 0; jj < 4; ++jj) { if (8 * jj + 4 < ntv) { SEL_CNT8(c_, cd_, keyT[jj], 8 * (i)); } else if (8 * jj < ntv) { SEL_CNT4(c_, cd_, keyT[jj], 8 * (i)); } } c_; })
#endif
    for (int bit = 31; bit >= 0; --bit) {
        const unsigned bm = 1u << bit;
        if (!dn0) { const unsigned c = SEL_CNT(0, T0 | bm); if (c >= 256u) T0 |= bm; dn0 = (c == 256u); }
        if (!dn1) { const unsigned c = SEL_CNT(1, T1 | bm); if (c >= 256u) T1 |= bm; dn1 = (c == 256u); }
        if (!dn2) { const unsigned c = SEL_CNT(2, T2 | bm); if (c >= 256u) T2 |= bm; dn2 = (c == 256u); }
        if (!dn3) { const unsigned c = SEL_CNT(3, T3 | bm); if (c >= 256u) T3 |= bm; dn3 = (c == 256u); }
        if (dn0 && dn1 && dn2 && dn3) break;
    }
#undef SEL_CNT
#undef SEL_KLOAD
#undef SEL_CNT8
#undef SEL_CNT4
#pragma unroll
    for (int i = 0; i < 4; ++i) {
        const unsigned Ti = (i == 0) ? T0 : (i == 1) ? T1 : (i == 2) ? T2 : T3;
        unsigned wlo = 0u, whi = 0u;
#pragma unroll
        for (int jj = 0; jj < 4; ++jj) { int ln_ = lane; asm volatile("" : "+v"(ln_));
#pragma unroll
            for (int t = 0; t < 8; ++t) { const unsigned long long mk = __ballot(keyT[jj][8 * i + t] >= Ti);
                wlo = (ln_ == 8 * jj + t) ? (unsigned)mk : wlo; whi = (ln_ == 8 * jj + t) ? (unsigned)(mk >> 32) : whi; if ((t & 3) == 3) __builtin_amdgcn_sched_barrier(0); } }
        if (lane < 32) mbase[(size_t)lane * 32 + 4 * wid + i] = ((unsigned long long)whi << 32) | wlo;
    }
    __syncthreads();
}
}
constexpr int NWAVES = 8;
#ifndef MK_N_LAUNCHES
#define MK_N_LAUNCHES 1
#endif
constexpr int N_PHASES = 10;
constexpr int N_LAUNCHES = MK_N_LAUNCHES;
constexpr int BATCH = 16, SEQ = 2048, DM = 1024, M = BATCH * SEQ, DFF = 2816, W_IN = 5444, NPROJ = 5632, NFF13 = 5632;
constexpr size_t MiB = 1u << 20;
constexpr size_t WS_CTL = 0, CTL_ZERO_BYTES = 64 * 1024;
constexpr size_t WS_MOD = 1 * MiB;
constexpr size_t WS_LAM = 1 * MiB + 512 * 1024;
constexpr size_t WS_GN = 1 * MiB + 768 * 1024;
constexpr size_t WS_WIN = 2 * MiB, WS_WUA = 13 * MiB  , WS_WO = 15 * MiB, WS_W13 = 17 * MiB, WS_W2 = 28 * MiB;
constexpr size_t WS_XH = 64 * MiB;
constexpr size_t WS_YA = 64 * MiB;
constexpr size_t WS_QA = 128 * MiB, WS_KA = 160 * MiB, WS_VA = 192 * MiB, WS_QB = 224 * MiB, WS_KB = 256 * MiB, WS_VB = 288 * MiB, WS_QI = 320 * MiB, WS_KI = 336 * MiB, WS_WI = 340 * MiB;
constexpr size_t WS_MG = 128 * MiB;
constexpr size_t WS_HID = 128 * MiB;
constexpr size_t WS_GT = 344 * MiB;
constexpr size_t WS_MASK = 472 * MiB;
constexpr size_t WS_STASH = 480 * MiB;
constexpr size_t WS_END = 512 * MiB;
static_assert(epi::PWS_GN == WS_GN && epi::PWS_QA == WS_QA && epi::PWS_QI == WS_QI && epi::PWS_KI == WS_KI && epi::PWS_WI == WS_WI && epi::PWS_GT == WS_GT && WS_KA - WS_QA == 32 * MiB && WS_VB - WS_QA == 160 * MiB, "EpiProj offsets");
static_assert(WS_W2 + (size_t)DM * DFF * 2 <= WS_XH && WS_WI + (size_t)M * 16 <= WS_GT && WS_HID + (size_t)M * DFF * 2 <= WS_GT && WS_GT + (size_t)M * 2048 * 2 <= WS_MASK, "d_ws map");
constexpr int CW_BAR = 1024;
constexpr int RING_BYTES = 151552;
constexpr int LDSCTL_OFF = RING_BYTES, MISC_OFF = LDSCTL_OFF + 320, LDS_BYTES = 155648;
static_assert(att::LDS_BYTES <= RING_BYTES && pg8::STAGE_BYTES <= RING_BYTES && MISC_OFF + 128 <= LDS_BYTES, "LDS map");

#define GAS __attribute__((address_space(1)))
#define LAS __attribute__((address_space(3)))
typedef unsigned short bf16;
typedef unsigned v4u __attribute__((ext_vector_type(4)));
typedef float f32x4 __attribute__((ext_vector_type(4)));
typedef GAS unsigned gu32;
#define RLX_AGENT __ATOMIC_RELAXED, __HIP_MEMORY_SCOPE_AGENT
#define LDS_WAIT() asm volatile("s_waitcnt lgkmcnt(0)" ::: "memory")
__device__ __forceinline__ unsigned f2bf(float f) { unsigned u = __builtin_bit_cast(unsigned, f); return (u + 0x7fffu + ((u >> 16) & 1u)) >> 16; }
__device__ __forceinline__ unsigned pk2(float lo, float hi) { return f2bf(lo) | (f2bf(hi) << 16); }
#define XB_TMO      128
#define XB_XCNT(j)  (256  + 64 * (j))
#define XB_XSUB(j)  (1280 + 64 * (j))
#define XB_XGEN(j)  (2304 + 64 * (j))
#define XB_TOP      3328
#define XB_TOPGEN   3392
#define XCD_BAR_WORDS 3456
#ifdef CHECKER
#define XB_SPIN_CAP (1u << 27)
#else
#define XB_SPIN_CAP (1u << 18)
#endif

__device__ __forceinline__ unsigned xb_ld(unsigned* p)              { return __hip_atomic_load(p, __ATOMIC_RELAXED, __HIP_MEMORY_SCOPE_AGENT); }
__device__ __forceinline__ unsigned xb_add(unsigned* p, unsigned v) { return __hip_atomic_fetch_add(p, v, __ATOMIC_RELAXED, __HIP_MEMORY_SCOPE_AGENT); }
__device__ __forceinline__ unsigned xb_xcc_id() { return (unsigned)__builtin_amdgcn_s_getreg((3 << 11) | 20) & 0xFu; }
#define XB_SPIN(cond, bar) do { unsigned _sp = 0; while (cond) { __builtin_amdgcn_s_sleep(1); \
    if ((++_sp & 255u) == 0u) { if (xb_ld(&(bar)[XB_TMO])) break; if (_sp > XB_SPIN_CAP) { atomicAdd(&(bar)[XB_TMO], 1u); break; } } } } while (0)

struct XcdBarrier {
    unsigned* bar; unsigned x;
    volatile LAS unsigned* st;
};

__device__ __forceinline__ XcdBarrier xcd_barrier_post(unsigned* bar, volatile LAS unsigned* st) {
    XcdBarrier b; b.bar = bar; b.x = xb_xcc_id(); b.st = st;
    if (threadIdx.x == 0) (void)xb_add(&bar[XB_XCNT(b.x)], 1u);
    return b;
}
__device__ __forceinline__ void xcd_barrier_complete(unsigned* bar, unsigned x, unsigned& nloc, unsigned& nx) {
    const unsigned G = gridDim.x * gridDim.y * gridDim.z;
    unsigned sum, cnt, mine, sp = 0u;
    for (;;) {
        sum = 0u; cnt = 0u; mine = 0u;
#pragma unroll
        for (unsigned j = 0; j < 16; ++j) { const unsigned c = xb_ld(&bar[XB_XCNT(j)]); sum += c; cnt += (c > 0u) ? 1u : 0u; mine = (j == x) ? c : mine; }
        if (sum == G) break;
        __builtin_amdgcn_s_sleep(1);
        if ((++sp & 255u) == 0u) { if (xb_ld(&bar[XB_TMO])) break; if (sp > XB_SPIN_CAP) { atomicAdd(&bar[XB_TMO], 1u); break; } }
    }
    nloc = mine > 0u ? mine : 1u; nx = cnt > 0u ? cnt : 1u;
}

__device__ __forceinline__ void xcd_barrier(const XcdBarrier& b) {
    asm volatile("s_waitcnt vmcnt(0)" ::: "memory");
    __syncthreads();
    if (threadIdx.x == 0) {
        unsigned* bar = b.bar;
        __builtin_amdgcn_s_waitcnt(0);
        unsigned nloc = b.st[0], nx = b.st[1];
        if (nloc == 0u) { xcd_barrier_complete(bar, b.x, nloc, nx); b.st[0] = nloc; b.st[1] = nx; }
        const unsigned old = xb_add(&bar[XB_XSUB(b.x)], 1u);
        const unsigned gen = old / nloc;
        if (old + 1u == (gen + 1u) * nloc) {
            __builtin_amdgcn_fence(__ATOMIC_RELEASE, "agent");
            asm volatile("s_waitcnt vmcnt(0)" ::: "memory");
            const unsigned og = xb_add(&bar[XB_TOP], 1u);
            const unsigned tg = og / nx;
            if (og + 1u == (tg + 1u) * nx) xb_add(&bar[XB_TOPGEN], 1u);
            else XB_SPIN(xb_ld(&bar[XB_TOPGEN]) == tg, bar);
            __builtin_amdgcn_fence(__ATOMIC_ACQUIRE, "agent");
            xb_add(&bar[XB_XGEN(b.x)], 1u);
            asm volatile("s_waitcnt vmcnt(0)" ::: "memory");
        } else {
            XB_SPIN(xb_ld(&bar[XB_XGEN(b.x)]) == gen, bar);
            __builtin_amdgcn_fence(__ATOMIC_ACQUIRE, "agent");
            asm volatile("s_waitcnt vmcnt(0)" ::: "memory");
        }
    }
    __syncthreads();
}
struct Frame {
    LAS unsigned char* lds; volatile LAS unsigned* MISC; gu32* ctl;
    int tid, lane, wave, vcu, G;
};
__device__ __forceinline__ float wave_sum(float v) {
#pragma unroll
    for (int o = 1; o < 64; o <<= 1) v += __shfl_xor(v, o);
    return v;
}
template <class Map>
__device__ __forceinline__ void transpose_item(const float* W, int K, int N, bf16* WT, Map map, LAS float* scr, int item, int lane, int ld = 0, int koff = 0) {
    const int nblk = (N + 31) / 32, kb = item / nblk, nb = item % nblk, k0 = 64 * kb, n0 = 32 * nb;
    const int nr = n0 + (lane & 31);
    float wv[32];
#pragma unroll
    for (int i = 0; i < 32; ++i) { const int kk = 2 * i + (lane >> 5); wv[i] = (nr < N) ? W[(size_t)(k0 + kk) * N + nr] : 0.f; }
#pragma unroll
    for (int i = 0; i < 32; ++i) { const int kk = 2 * i + (lane >> 5); scr[kk * 33 + (lane & 31)] = wv[i]; }
    LDS_WAIT(); asm volatile("" ::: "memory");
    const int c = lane & 7;
#pragma unroll
    for (int j = 0; j < 4; ++j) { const int nl = (lane >> 3) + 8 * j; const LAS float* s = scr + (8 * c) * 33 + nl;
        v4u o; o.x = pk2(s[0 * 33], s[1 * 33]); o.y = pk2(s[2 * 33], s[3 * 33]); o.z = pk2(s[4 * 33], s[5 * 33]); o.w = pk2(s[6 * 33], s[7 * 33]);
        if (n0 + nl < N) *(GAS v4u*)(WT + (size_t)map(n0 + nl) * (ld ? ld : K) + koff + k0 + 8 * c) = o; }
    LDS_WAIT(); asm volatile("" ::: "memory");
}
struct MapId { __device__ __forceinline__ int operator()(int n) const { return n; } };
struct MapWin {
    __device__ __forceinline__ int operator()(int n) const {
        if (n >= 3396) { const int g = n - 3396, c = g & 1023; return 3584 + 256 * (c >> 7) + 128 * (g >> 10) + (c & 127); }
        const int L = n & 255, hd = L >> 6, d = L & 63; return (n & ~255) + 128 * (d >> 5) + 32 * hd + (d & 31); } };
struct MapFF { int off; __device__ __forceinline__ int operator()(int n) const { return (n >> 7) * 256 + (n & 127) + off; } };

struct P0In { const float *c, *w_ada, *b_ada, *w_in, *w_up_a, *w_up_b, *w_o, *w_ff1, *w_ff3, *w_ff2, *lq1, *lk1, *lq2, *lk2, *qn_a, *kn_a, *qn_b, *kn_b; };
__device__ __forceinline__ void weight_copies(Frame& F, const P0In in, unsigned char* ws, bool sync = true) {
    LAS float* scr = (LAS float*)(F.lds + F.wave * 16384);
    const int gw = F.vcu * NWAVES + F.wave, NGW = F.G * NWAVES;
    constexpr int I_IN = 16 * 171, I_UP = 8 * 32, I_O = 16 * 32, I_F1 = 16 * 88, I_F2 = 44 * 32;
    constexpr int NITEMS = I_IN + 2 * I_UP + I_O + 2 * I_F1 + I_F2;
    for (int it = gw; it < NITEMS; it += NGW) {
        int r = it;
        if (r < I_IN) { transpose_item(in.w_in, 1024, W_IN, (bf16*)(ws + WS_WIN), MapWin{}, scr, r, F.lane); continue; } r -= I_IN;
        if (r < I_UP) { transpose_item(in.w_up_a, 512, 1024, (bf16*)(ws + WS_WUA), MapId{}, scr, r, F.lane, 1024, 0); continue; } r -= I_UP;
        if (r < I_UP) { transpose_item(in.w_up_b, 512, 1024, (bf16*)(ws + WS_WUA), MapId{}, scr, r, F.lane, 1024, 512); continue; } r -= I_UP;
        if (r < I_O)  { transpose_item(in.w_o, 1024, 1024, (bf16*)(ws + WS_WO), MapId{}, scr, r, F.lane); continue; } r -= I_O;
        if (r < I_F1) { transpose_item(in.w_ff1, 1024, DFF, (bf16*)(ws + WS_W13), MapFF{0}, scr, r, F.lane); continue; } r -= I_F1;
        if (r < I_F1) { transpose_item(in.w_ff3, 1024, DFF, (bf16*)(ws + WS_W13), MapFF{128}, scr, r, F.lane); continue; } r -= I_F1;
        transpose_item(in.w_ff2, DFF, 1024, (bf16*)(ws + WS_W2), MapId{}, scr, r, F.lane);
    }
    if (sync) __syncthreads();
}
__device__ __forceinline__ void p0_prologue(Frame& F, const P0In in, unsigned char* ws) {
    const int gw = F.vcu * NWAVES + F.wave, NGW = F.G * NWAVES; (void)gw; (void)NGW;
    LAS float* S = (LAS float*)F.lds;
    LAS float* P = (LAS float*)(F.lds + 65536);
    for (int g = F.vcu; g < 192; g += F.G) {
        for (int i = F.tid; i < 16 * 1024; i += NWAVES * 64) { const float v = in.c[i]; S[i] = v / (1.f + __expf(-v)); }
        __syncthreads();
        const int c = F.tid & 31, kg = F.tid >> 5, col = 32 * g + c;
        float acc[16];
#pragma unroll
        for (int b = 0; b < 16; ++b) acc[b] = 0.f;
#pragma unroll
        for (int h = 0; h < 2; ++h) {
            float w[32];
#pragma unroll
            for (int u = 0; u < 32; ++u) w[u] = in.w_ada[(size_t)(64 * kg + 32 * h + u) * 6144 + col];
#pragma unroll
            for (int i = 0; i < 32; i += 4) { const int k = 64 * kg + 32 * h + i;
#pragma unroll
                for (int b = 0; b < 16; ++b) { const f32x4 s = *(const LAS f32x4*)(S + b * 1024 + k); acc[b] += (s[0] * w[i] + s[1] * w[i + 1]) + (s[2] * w[i + 2] + s[3] * w[i + 3]); } } }
#pragma unroll
        for (int b = 0; b < 16; ++b) P[(kg * 16 + b) * 32 + c] = acc[b];
        __syncthreads();
        { const int b = F.tid >> 5; float s = in.b_ada[col];
#pragma unroll
          for (int q = 0; q < 16; ++q) s += P[(q * 16 + b) * 32 + c];
          ((float*)(ws + WS_MOD))[b * 6144 + col] = s; }
        __syncthreads();
    }
    if (F.vcu == F.G - 2 && F.tid < 256) { const int t = F.tid >> 6, i = F.tid & 63; ((float*)(ws + WS_GN))[F.tid] = (t == 0 ? in.qn_a : t == 1 ? in.kn_a : t == 2 ? in.qn_b : in.kn_b)[i]; }
    if (F.vcu == F.G - 1 && F.tid == 0) {
        float s1 = 0.f, s2 = 0.f;
        for (int i = 0; i < 64; ++i) { s1 += in.lq1[i] * in.lk1[i]; s2 += in.lq2[i] * in.lk2[i]; }
        *(float*)(ws + WS_LAM) = expf(s1) - expf(s2) + 0.2f;
    }
}
__device__ __forceinline__ void norm_mod_pass(Frame& F, const float* X, const float* g, const float* scale, const float* shift, bf16* Y) {
    const int gw = F.vcu * NWAVES + F.wave, NGW = F.G * NWAVES;
    for (int blk = gw; blk < M / 16; blk += NGW) {
        const int row0 = blk * 16, b = row0 >> 11;
        f32x4 gs[4], sh[4];
#pragma unroll
        for (int j = 0; j < 4; ++j) { const f32x4 gg = ((const f32x4*)g)[F.lane + 64 * j], sc = ((const f32x4*)(scale + b * 6144))[F.lane + 64 * j]; gs[j] = gg * (sc + 1.0f); sh[j] = ((const f32x4*)(shift + b * 6144))[F.lane + 64 * j]; }
        f32x4 vn[4];
        { const f32x4* x0 = (const f32x4*)(X + (size_t)row0 * DM) + F.lane;
#pragma unroll
          for (int j = 0; j < 4; ++j) vn[j] = x0[64 * j]; }
        for (int rr = 0; rr < 16; ++rr) {
            f32x4 v[4]; float s = 0.f;
#pragma unroll
            for (int j = 0; j < 4; ++j) v[j] = vn[j];
            if (rr < 15) { const f32x4* xr = (const f32x4*)(X + (size_t)(row0 + rr + 1) * DM) + F.lane;
#pragma unroll
                for (int j = 0; j < 4; ++j) vn[j] = xr[64 * j]; }
#pragma unroll
            for (int j = 0; j < 4; ++j) s += (v[j][0] * v[j][0] + v[j][1] * v[j][1]) + (v[j][2] * v[j][2] + v[j][3] * v[j][3]);
            const float rstd = __builtin_amdgcn_rsqf(wave_sum(s) * (1.0f / DM) + 1e-6f);
            unsigned long long* o8 = (unsigned long long*)(Y + (size_t)(row0 + rr) * DM) + F.lane;
#pragma unroll
            for (int j = 0; j < 4; ++j) { const f32x4 y = v[j] * rstd * gs[j] + sh[j]; o8[64 * j] = (unsigned long long)pk2(y[0], y[1]) | ((unsigned long long)pk2(y[2], y[3]) << 32); }
        }
    }
}
__device__ __forceinline__ void norm_mod_pass_bf16(Frame& F, const bf16* X, const float* g, const float* scale, const float* shift, bf16* Y) {
    const int gw = F.vcu * NWAVES + F.wave, NGW = F.G * NWAVES;
    for (int blk = gw; blk < M / 16; blk += NGW) {
        const int row0 = blk * 16, b = row0 >> 11;
        f32x4 gs[4], sh[4];
#pragma unroll
        for (int j = 0; j < 4; ++j) { const int c4 = 2 * F.lane + (j & 1) + 128 * (j >> 1);
            const f32x4 gg = ((const f32x4*)g)[c4], sc = ((const f32x4*)(scale + b * 6144))[c4]; gs[j] = gg * (sc + 1.0f); sh[j] = ((const f32x4*)(shift + b * 6144))[c4]; }
        v4u wn[2];
        { const v4u* x0 = (const v4u*)(X + (size_t)row0 * DM) + F.lane; wn[0] = x0[0]; wn[1] = x0[64]; }
        for (int rr = 0; rr < 16; ++rr) {
            const v4u wc[2] = {wn[0], wn[1]};
            if (rr < 15) { const v4u* xr = (const v4u*)(X + (size_t)(row0 + rr + 1) * DM) + F.lane; wn[0] = xr[0]; wn[1] = xr[64]; }
            f32x4 v[4]; float s = 0.f;
#pragma unroll
            for (int h = 0; h < 2; ++h) { const v4u w = wc[h];
                v[2 * h] = (f32x4){__builtin_bit_cast(float, w.x << 16), __builtin_bit_cast(float, w.x & 0xffff0000u), __builtin_bit_cast(float, w.y << 16), __builtin_bit_cast(float, w.y & 0xffff0000u)};
                v[2 * h + 1] = (f32x4){__builtin_bit_cast(float, w.z << 16), __builtin_bit_cast(float, w.z & 0xffff0000u), __builtin_bit_cast(float, w.w << 16), __builtin_bit_cast(float, w.w & 0xffff0000u)}; }
#pragma unroll
            for (int j = 0; j < 4; ++j) s += (v[j][0] * v[j][0] + v[j][1] * v[j][1]) + (v[j][2] * v[j][2] + v[j][3] * v[j][3]);
            const float rstd = __builtin_amdgcn_rsqf(wave_sum(s) * (1.0f / DM) + 1e-6f);
            v4u* o16 = (v4u*)(Y + (size_t)(row0 + rr) * DM) + F.lane;
#pragma unroll
            for (int h = 0; h < 2; ++h) { const f32x4 y0 = v[2 * h] * rstd * gs[2 * h] + sh[2 * h], y1 = v[2 * h + 1] * rstd * gs[2 * h + 1] + sh[2 * h + 1];
                v4u o; o.x = pk2(y0[0], y0[1]); o.y = pk2(y0[2], y0[3]); o.z = pk2(y1[0], y1[1]); o.w = pk2(y1[2], y1[3]); o16[64 * h] = o; }
        }
    }
}
#ifdef CHECKER
namespace chk {
typedef unsigned short bf16;
typedef unsigned u32x4c __attribute__((ext_vector_type(4)));
__device__ __forceinline__ float b2f(unsigned short h) { return __uint_as_float((unsigned)h << 16); }
__device__ __forceinline__ float rnd(float f) { unsigned u = __float_as_uint(f); u = (u + 0x7fffu + ((u >> 16) & 1u)) & 0xffff0000u; return __uint_as_float(u); }
__device__ __forceinline__ float dotbf(const bf16* a, const bf16* b, int K) {
    float s = 0.f;
    for (int k = 0; k < K; k += 8) { const u32x4c x = *(const u32x4c*)(a + k), y = *(const u32x4c*)(b + k);
#pragma unroll
        for (int j = 0; j < 4; ++j) { s += __uint_as_float(x[j] << 16) * __uint_as_float(y[j] << 16); s += __uint_as_float(x[j] & 0xffff0000u) * __uint_as_float(y[j] & 0xffff0000u); } }
    return s; }
__device__ __forceinline__ void devmax(float* slot, float d) { if (!(d >= 0.f)) d = 1e30f; atomicMax((unsigned*)slot, __float_as_uint(d)); }
__device__ __forceinline__ float sig(float v) { return 1.f / (1.f + expf(-v)); }
constexpr int RSTR = 16, ROFF = 3, NR = 2048;
}
#define CHK_LOOP(idx, total) for (long idx = (long)F.vcu * 512 + F.tid; idx < (long)(total); idx += (long)F.G * 512)
#endif
#ifdef DUPCHK
__global__ void __launch_bounds__(512) dup_cksum(const void* base, size_t bytes, unsigned long long* acc) {
    typedef unsigned u32x4_t __attribute__((ext_vector_type(4)));
    const u32x4_t* p = (const u32x4_t*)base; const size_t n = bytes / 16;
    unsigned long long s = 0ull;
    for (size_t i = (size_t)blockIdx.x * 512 + threadIdx.x; i < n; i += (size_t)gridDim.x * 512) {
        const u32x4_t w = p[i]; const unsigned long long m = 2ull * i + 1ull;
        s += ((unsigned long long)w.x + ((unsigned long long)w.y << 7) + ((unsigned long long)w.z << 13) + ((unsigned long long)w.w << 19)) * m; }
    for (int off = 32; off; off >>= 1) { const unsigned lo = __shfl_xor((unsigned)s, off), hi = __shfl_xor((unsigned)(s >> 32), off); s += ((unsigned long long)hi << 32) | lo; }
    if ((threadIdx.x & 63) == 0) atomicAdd(acc, s);
}
__global__ void __launch_bounds__(512) dup_final(float* out, const unsigned long long* CK) {
    int bad = -1;
    for (int k = 9; k >= 0; --k) if (CK[2 * k] != CK[2 * k + 1]) bad = k;
    if (bad >= 0) { const float v = 0.0566f * (float)(1 << bad); for (int i = blockIdx.x * 512 + threadIdx.x; i < (1 << 20); i += gridDim.x * 512) out[i] += v; }
}
#endif
#ifdef MASKDIFF
__global__ void __launch_bounds__(512) mask_diff(const unsigned long long* A, const unsigned long long* B, unsigned* cnt) {
    unsigned c0 = 0, c1 = 0, c2 = 0;
    for (int idx = blockIdx.x * 512 + threadIdx.x; idx < (1 << 20); idx += gridDim.x * 512) {
        const int qk = (idx >> 10) & 63, tile = (idx >> 5) & 31; const bool adm = tile < (qk >> 1) + 1;
        const unsigned long long d = A[idx] ^ B[idx];
        if (d) { if (adm) { ++c0; c2 += (unsigned)__builtin_popcountll(d); } else ++c1; } }
    if (c0) atomicAdd(cnt + 0, c0); if (c1) atomicAdd(cnt + 1, c1); if (c2) atomicAdd(cnt + 2, c2);
    for (int row = blockIdx.x * 512 + threadIdx.x; row < 32768; row += gridDim.x * 512) { const int bq = row >> 5, q = row & 31, qk = bq & 63; bool any = false;
        for (int tile = 0; tile < (qk >> 1) + 1; ++tile) { const size_t i = ((size_t)bq * 32 + tile) * 32 + q; any = any || (A[i] != B[i]); }
        if (any) atomicAdd(cnt + 3, 1u); }
}
__global__ void __launch_bounds__(512) mask_report(float* out, const unsigned* cnt) {
    const unsigned ca = cnt[MASKDIFF & 3], cb = cnt[(MASKDIFF >> 2) & 3];
    int La = 0; while ((1u << La) < ca + 1u) ++La; int Lb = 0; while ((1u << Lb) < cb + 1u) ++Lb;
    float v = 0.05f * 5.657f; for (int i = 0; i < La; ++i) v *= 1.5f;
    for (int i = blockIdx.x * 512 + threadIdx.x; i < (1 << 20); i += gridDim.x * 512) out[i] += v;
    (void)Lb;
}
#endif
struct Args { const float* in[22]; float* out; unsigned char* ws; int ph_lo, ph_hi, probe, pad; };
__global__ void __launch_bounds__(NWAVES * 64, 2) mega_fwd(Args args) {
    extern __shared__ __attribute__((aligned(16))) unsigned char lds[];
    Frame F;
    F.lds = (LAS unsigned char*)lds;
    F.MISC = (volatile LAS unsigned*)(F.lds + MISC_OFF);
    F.tid = threadIdx.x; F.lane = F.tid & 63; F.wave = __builtin_amdgcn_readfirstlane(F.tid >> 6);
    F.G = gridDim.x; { const int bx = blockIdx.x; F.vcu = (F.G % 8 == 0) ? (bx % 8) * (F.G / 8) + bx / 8 : bx; }
    unsigned char* ws = args.ws;
    F.ctl = (gu32*)(ws + WS_CTL);
    for (int u = F.tid; u < (LDS_BYTES - LDSCTL_OFF) / 4; u += NWAVES * 64) ((LAS unsigned*)(F.lds + LDSCTL_OFF))[u] = 0u;
    __syncthreads();
    XcdBarrier bar; bar.bar = (unsigned*)(F.ctl + CW_BAR); bar.x = 0; bar.st = nullptr;
    if (N_LAUNCHES == 1) bar = xcd_barrier_post((unsigned*)(F.ctl + CW_BAR), F.MISC + 8);
    const int lo = args.ph_lo, hi = args.ph_hi;
#ifndef PH_MASK
#define PH_MASK 0x3ff
#endif
#define IN(k) (((PH_MASK >> (k)) & 1) && lo <= (k) && (k) < hi)
#define SEAM(k) do { if (IN(k) && IN((k) + 1)) xcd_barrier(bar); } while (0)
    float* const MOD = (float*)(ws + WS_MOD);
#define WSP(T, off) ((T*)(ws + (off)))
#ifdef X1_IN_WS
#define X1P WSP(float, WS_GT)
#else
#define X1P args.out
#endif

#ifndef W_IN_P1
#define W_IN_P1 2
#endif
#if W_IN_P1
#define IF_W0(x)
#else
#define IF_W0(x) x
#endif
    if (IN(0)) { const P0In pin{args.in[1], args.in[2], args.in[3], args.in[5], args.in[15], args.in[16], args.in[17], args.in[19], args.in[20], args.in[21], args.in[10], args.in[11], args.in[12], args.in[13], args.in[6], args.in[7], args.in[8], args.in[9]};
                 IF_W0(weight_copies(F, pin, ws);) p0_prologue(F, pin, ws); }
    SEAM(0);
#ifdef CHECKER
    if (IN(0) && IN(1)) {
        float* DEV = (float*)(ws + WS_CTL) + 8192;
#define CHK_W(src, K_, N_, dst, MAPX) CHK_LOOP(idx, (long)(K_) * (N_)) { const int k = (int)(idx / (N_)), n = (int)(idx % (N_)); const float w = (src)[idx]; \
            chk::devmax(DEV + 11, fabsf(chk::b2f((dst)[(size_t)(MAPX) * (K_) + k]) - w) / (fabsf(w) + 1e-3f)); }
        CHK_W(args.in[5], 1024, W_IN, WSP(bf16, WS_WIN), MapWin{}(n))  CHK_W(args.in[17], 1024, 1024, WSP(bf16, WS_WO), n)
        CHK_W(args.in[19], 1024, DFF, WSP(bf16, WS_W13), MapFF{0}(n)) CHK_W(args.in[20], 1024, DFF, WSP(bf16, WS_W13), MapFF{128}(n)) CHK_W(args.in[21], DFF, 1024, WSP(bf16, WS_W2), n)
#undef CHK_W
        CHK_LOOP(idx, 16 * 6144) { const int b = (int)(idx / 6144), j = (int)(idx % 6144); if ((j % 5) == 0) { float sacc = args.in[3][j]; for (int k = 0; k < 1024; ++k) { const float c = args.in[1][b * 1024 + k]; sacc += (c / (1.f + expf(-c))) * args.in[2][(size_t)k * 6144 + j]; }
            chk::devmax(DEV + 12, fabsf(MOD[idx] - sacc)); } }
    }
#endif
    if (IN(1)) {
#if W_IN_P1
        { const P0In pin{args.in[1], args.in[2], args.in[3], args.in[5], args.in[15], args.in[16], args.in[17], args.in[19], args.in[20], args.in[21], args.in[10], args.in[11], args.in[12], args.in[13], args.in[6], args.in[7], args.in[8], args.in[9]};
          if (W_IN_P1 == 1) weight_copies(F, pin, ws);
          if (W_IN_P1 == 3) { if (F.wave & 1) { weight_copies(F, pin, ws, false); norm_mod_pass(F, args.in[0], args.in[4], MOD + 1024, MOD, WSP(bf16, WS_XH)); }
                              else { norm_mod_pass(F, args.in[0], args.in[4], MOD + 1024, MOD, WSP(bf16, WS_XH)); weight_copies(F, pin, ws, false); } __syncthreads(); }
          else norm_mod_pass(F, args.in[0], args.in[4], MOD + 1024, MOD, WSP(bf16, WS_XH));
          if (W_IN_P1 == 2) weight_copies(F, pin, ws); }
#else
        norm_mod_pass(F, args.in[0], args.in[4], MOD + 1024, MOD, WSP(bf16, WS_XH));
#endif
    }
    SEAM(1);
#ifdef CHECKER
    if (IN(1) && IN(2)) {
        float* DEV = (float*)(ws + WS_CTL) + 8192;
        CHK_LOOP(idx, chk::NR) { const int row = chk::RSTR * (int)idx + chk::ROFF, b = row >> 11; float ss = 0.f; for (int k = 0; k < 1024; ++k) { const float v = args.in[0][(size_t)row * 1024 + k]; ss += v * v; }
            const float rs = 1.f / sqrtf(ss / 1024.f + 1e-6f); float dm = 0.f;
            for (int k = 0; k < 1024; ++k) { const float ref = args.in[0][(size_t)row * 1024 + k] * rs * args.in[4][k] * (1.f + MOD[(size_t)b * 6144 + 1024 + k]) + MOD[(size_t)b * 6144 + k]; dm = fmaxf(dm, fabsf(chk::b2f(WSP(bf16, WS_XH)[(size_t)row * 1024 + k]) - ref)); }
            chk::devmax(DEV + 13, dm); }
    }
#endif
    if (IN(2)) {
        pg8::Gemm g{WSP(bf16, WS_XH), (const bf16*)(ws + WS_WIN), M, NPROJ, DM}; pg8::StaticOrder S; S.init(M, NPROJ, F.G, (int)blockIdx.x);
        epi::EpiProj E{ws};
        pg8::gemm_phase<epi::EpiProj, pg8::StaticOrder, true, true>(F.lds, g, S, E);
    }
    SEAM(2);
#ifdef CHECKER
    if (IN(2) && IN(3)) {
        float* DEV = (float*)(ws + WS_CTL) + 8192; const bf16 *XH = WSP(bf16, WS_XH), *WT = WSP(bf16, WS_WIN);
        CHK_LOOP(idx, chk::NR * 512) { const int row = chk::RSTR * (int)(idx / 512) + chk::ROFF, c = (int)(idx % 512);
            { const int n = 1024 + c; const float a = chk::dotbf(XH + (size_t)row * 1024, WT + (size_t)MapWin{}(n) * 1024, 1024), o = chk::b2f(WSP(bf16, WS_VA)[(size_t)row * 512 + c]); chk::devmax(DEV + 0, fabsf(o - chk::rnd(a)) / (fabsf(a) + 0.05f)); }
            { const int n = 3396 + 4 * c + 1; const float a = chk::sig(chk::dotbf(XH + (size_t)row * 1024, WT + (size_t)MapWin{}(n) * 1024, 1024)), o = chk::b2f(WSP(bf16, WS_GT)[(size_t)row * 2048 + 4 * c + 1]); chk::devmax(DEV + 1, fabsf(o - a)); }
            if (c < 8) { float ss = 0.f; for (int d = 0; d < 64; ++d) { const float v = chk::dotbf(XH + (size_t)row * 1024, WT + (size_t)MapWin{}(c * 64 + d) * 1024, 1024); ss += v * v; }
                const float rs = 1.f / sqrtf(ss / 64.f + 1e-6f); float dm = 0.f; for (int d = 0; d < 64; ++d) { const float v = chk::dotbf(XH + (size_t)row * 1024, WT + (size_t)MapWin{}(c * 64 + d) * 1024, 1024); dm = fmaxf(dm, fabsf(chk::b2f(WSP(bf16, WS_QA)[(size_t)row * 512 + c * 64 + d]) - v * rs * args.in[6][d])); } chk::devmax(DEV + 2, dm); }
            if (c < 64) { const float a = chk::dotbf(XH + (size_t)row * 1024, WT + (size_t)MapWin{}(3328 + c) * 1024, 1024), o = chk::b2f(WSP(bf16, WS_KI)[(size_t)row * 64 + c]); chk::devmax(DEV + 3, fabsf(o - chk::rnd(a)) / (fabsf(a) + 0.05f)); }
            if (c < 4) { const float a = chk::dotbf(XH + (size_t)row * 1024, WT + (size_t)MapWin{}(3392 + c) * 1024, 1024), o = WSP(float, WS_WI)[(size_t)row * 4 + c]; chk::devmax(DEV + 4, fabsf(o - a)); }
            if (c >= 8 && c < 16) { const int hh = c - 8; float ss = 0.f; for (int d = 0; d < 64; ++d) { const float v = chk::dotbf(XH + (size_t)row * 1024, WT + (size_t)MapWin{}(2048 + hh * 64 + d) * 1024, 1024); ss += v * v; }
                const float rs = 1.f / sqrtf(ss / 64.f + 1e-6f); float dm = 0.f; for (int d = 0; d < 64; ++d) { const float v = chk::dotbf(XH + (size_t)row * 1024, WT + (size_t)MapWin{}(2048 + hh * 64 + d) * 1024, 1024); dm = fmaxf(dm, fabsf(chk::b2f(WSP(bf16, WS_KB)[(size_t)row * 512 + hh * 64 + d]) - v * rs * args.in[9][d])); } chk::devmax(DEV + 5, dm); }
        }
    }
#endif
    if (IN(3)) {
        const int b = F.vcu >> 4, j = F.vcu & 15;
        const bf16 *QI = WSP(bf16, WS_QI), *KI = WSP(bf16, WS_KI); const float* WI = WSP(float, WS_WI); unsigned long long* MASK = WSP(unsigned long long, WS_MASK);
        if (F.G == 256) {
            sel::select_unit(b, j, QI, KI, WI, MASK, (char*)lds); sel::select_unit(b, 31 - j, QI, KI, WI, MASK, (char*)lds);
            sel::select_unit(b, 32 + j, QI, KI, WI, MASK, (char*)lds); sel::select_unit(b, 63 - j, QI, KI, WI, MASK, (char*)lds);
        }
    }
    SEAM(3);
#ifdef CHECKER
#ifndef CHK_TI
#define CHK_TI -1
#endif
#ifndef CHK_TOL17
#define CHK_TOL17 64
#endif
    if (IN(3) && IN(4)) {
        unsigned tot = 0u; CHK_LOOP(idx, 16 * 64 * 32 * 32) tot += (unsigned)__builtin_popcountll(WSP(unsigned long long, WS_MASK)[idx]);
        atomicAdd((unsigned*)(ws + WS_CTL) + 8192 + 18, tot);
    }
    if (IN(3) && IN(4)) {
        float* DEV = (float*)(ws + WS_CTL) + 8192;
        if (F.vcu < 10) { const int tt[5] = {5, 300, 777, 1029, 2047}; const int t = (F.vcu % 5 == 0) ? 5 : (F.vcu % 5 == 1) ? 300 : (F.vcu % 5 == 2) ? 777 : (F.vcu % 5 == 3) ? 1029 : 2047; (void)tt; const int b = (F.vcu < 5) ? 0 : 9;
            LAS unsigned* KL = (LAS unsigned*)F.lds; const int nadm = 64 * (t / 64 + 1); const size_t qrow = (size_t)b * 2048 + t;
            __syncthreads();
            for (int s4 = 0; s4 < 4; ++s4) { const int sidx = F.tid + 512 * s4; unsigned key = 0u;
                if (sidx < nadm) { float sc = 0.f; for (int h = 0; h < 4; ++h) { const float y = chk::dotbf(WSP(bf16, WS_QI) + qrow * 256 + h * 64, WSP(bf16, WS_KI) + ((size_t)b * 2048 + sidx) * 64, 64); sc = fmaf(fmaxf(y, 0.f), WSP(float, WS_WI)[qrow * 4 + h], sc); }
                    const unsigned u = __float_as_uint(sc), m = (unsigned)(((int)u) >> 31) | 0x80000000u; key = ((u ^ m) & KEYMASK) | (2047u - (unsigned)sidx); }
                KL[sidx] = key; }
            __syncthreads();
            unsigned bad = 0u;
            for (int s4 = 0; s4 < 4; ++s4) { const int sidx = F.tid + 512 * s4; const unsigned key = KL[sidx]; unsigned rank = 0u; for (int j = 0; j < 2048; ++j) rank += (KL[j] > key) ? 1u : 0u;
                const bool selr = (sidx < nadm) && (nadm <= 256 || rank < 256u);
                const unsigned long long mw = WSP(unsigned long long, WS_MASK)[((size_t)(b * 64 + t / 32) * 32 + sidx / 64) * 32 + (t % 32)]; const bool selm = (mw >> (sidx % 64)) & 1ull;
                if (sidx < nadm && selr != selm) ++bad; }
            if (bad) atomicAdd(DEV + 17, (float)bad);
            __syncthreads();
        }
    }
#endif
    if (IN(4)) {
        if (F.G == 256) {
            const int b = F.vcu >> 4, r = F.vcu & 15;
            const bf16 *QA = WSP(bf16, WS_QA), *KA = WSP(bf16, WS_KA), *VA = WSP(bf16, WS_VA), *QBt = WSP(bf16, WS_QB), *KBt = WSP(bf16, WS_KB), *VBt = WSP(bf16, WS_VB);
            bf16 *YA = WSP(bf16, WS_YA), *YB = WSP(bf16, WS_YA); const unsigned long long* MASK = WSP(unsigned long long, WS_MASK);
            const float lam = __hip_atomic_load((const float*)(ws + WS_LAM), RLX_AGENT);
#ifndef NO_UNIT_A
            if (!(args.probe & 1)) for (int pi = 0; pi < 2; ++pi) { const int pr = 2 * r + pi, h = pr >> 2, s = pr & 3;
                att::unit_a(b, h, 7 - s, QA, KA, VA, MASK, YA, (char*)lds); att::unit_a(b, h, s, QA, KA, VA, MASK, YA, (char*)lds); }
#endif
#ifndef NO_UNIT_B
            __syncthreads();
            if (!(args.probe & 2)) { const int h = r >> 2, s = r & 3;
              att::unit_b128(b, h, 7 - s, QBt, KBt, VBt, args.in[14], lam, YB, WSP(unsigned, WS_STASH), 0, (char*)lds); att::unit_b128(b, h, s, QBt, KBt, VBt, args.in[14], lam, YB, WSP(unsigned, WS_STASH), 1, (char*)lds); }
#endif
        }
    }
    SEAM(4);
#ifdef CHECKER
    if (IN(4) && IN(5)) {
        float* DEV = (float*)(ws + WS_CTL) + 8192; const float lamc = __hip_atomic_load((const float*)(ws + WS_LAM), RLX_AGENT);
        const int gwv = F.vcu * 8 + F.wave;
        if (gwv < 8 * 3 * 12) { const int ti = gwv % 8, bi = (gwv / 8) % 3, hh = gwv / 24;
            const int t = (ti == 0) ? 5 : (ti == 1) ? 70 : (ti == 2) ? 200 : (ti == 3) ? 300 : (ti == 4) ? 777 : (ti == 5) ? 1029 : (ti == 6) ? 1500 : 2047; const int b = (bi == 0) ? 0 : (bi == 1) ? 7 : 15;
            const int nadm = 64 * (t / 64 + 1); const size_t rb = (size_t)b * 2048, qrow = rb + t; const int d = F.lane;
            if (hh < 8) { const float slope = exp2f(-(float)(hh + 1));
                float mx = -INFINITY; for (int sidx = 0; sidx < nadm; ++sidx) { const unsigned long long mw = WSP(unsigned long long, WS_MASK)[((size_t)(b * 64 + t / 32) * 32 + sidx / 64) * 32 + (t % 32)]; if (!((mw >> (sidx % 64)) & 1ull)) continue;
                    const float sc = chk::dotbf(WSP(bf16, WS_QA) + qrow * 512 + hh * 64, WSP(bf16, WS_KA) + (rb + sidx) * 512 + hh * 64, 64) * 0.125f - slope * fabsf((float)(t - sidx)); mx = fmaxf(mx, sc); }
                float l = 0.f, o = 0.f; for (int sidx = 0; sidx < nadm; ++sidx) { const unsigned long long mw = WSP(unsigned long long, WS_MASK)[((size_t)(b * 64 + t / 32) * 32 + sidx / 64) * 32 + (t % 32)]; if (!((mw >> (sidx % 64)) & 1ull)) continue;
                    const float sc = chk::dotbf(WSP(bf16, WS_QA) + qrow * 512 + hh * 64, WSP(bf16, WS_KA) + (rb + sidx) * 512 + hh * 64, 64) * 0.125f - slope * fabsf((float)(t - sidx)); const float p = expf(sc - mx); l += p; o += p * chk::b2f(WSP(bf16, WS_VA)[(rb + sidx) * 512 + hh * 64 + d]); }
                chk::devmax(DEV + 14, fabsf(chk::b2f(WSP(bf16, WS_YA)[qrow * 1024 + hh * 64 + d]) - o / l));
            } else if (CHK_TI < 0 || ti == CHK_TI) { const int hb = hh - 8; const float slope = exp2f(-2.f * (float)(hb + 1)); float ov[2][2];
                for (int m = 0; m < 2; ++m) { float mx = -INFINITY; for (int sidx = 0; sidx < nadm; ++sidx) { const float sc = chk::dotbf(WSP(bf16, WS_QB) + qrow * 512 + (2 * hb + m) * 64, WSP(bf16, WS_KB) + (rb + sidx) * 512 + (2 * hb + m) * 64, 64) * 0.125f - slope * fabsf((float)(t - sidx)); mx = fmaxf(mx, sc); }
                    float l = 0.f, o0 = 0.f, o1 = 0.f; for (int sidx = 0; sidx < nadm; ++sidx) { const float sc = chk::dotbf(WSP(bf16, WS_QB) + qrow * 512 + (2 * hb + m) * 64, WSP(bf16, WS_KB) + (rb + sidx) * 512 + (2 * hb + m) * 64, 64) * 0.125f - slope * fabsf((float)(t - sidx));
                        const float p = expf(sc - mx); l += p; o0 += p * chk::b2f(WSP(bf16, WS_VB)[(rb + sidx) * 512 + hb * 128 + d]); o1 += p * chk::b2f(WSP(bf16, WS_VB)[(rb + sidx) * 512 + hb * 128 + 64 + d]); }
                    if (m == 0) { ov[0][0] = o0 / l; ov[0][1] = o1 / l; } else { ov[1][0] = o0 / l; ov[1][1] = o1 / l; } }
                const float d0 = ov[0][0] - lamc * ov[1][0], d1 = ov[0][1] - lamc * ov[1][1]; const float ssq = wave_sum(d0 * d0 + d1 * d1); const float rs = 0.8f / sqrtf(ssq / 128.f + 1e-6f);
                chk::devmax(DEV + 16, fabsf(chk::b2f(WSP(bf16, WS_YA)[qrow * 1024 + 512 + hb * 128 + d]) - d0 * rs * args.in[14][d])); chk::devmax(DEV + 19, fabsf(chk::b2f(WSP(bf16, WS_YA)[qrow * 1024 + 512 + hb * 128 + 64 + d]) - d1 * rs * args.in[14][64 + d]));
            }
        }
        xcd_barrier(bar);
    }
#endif
    if (IN(5)) {
        pg8::Gemm g{WSP(bf16, WS_YA), (const bf16*)(ws + WS_WUA), M, DM, 1024}; pg8::StaticOrder S; S.init(M, DM, F.G, (int)blockIdx.x);
        epi::EpiUpM E{WSP(bf16, WS_MG), WSP(bf16, WS_GT)}; pg8::gemm_phase<epi::EpiUpM, pg8::StaticOrder, true, true>(F.lds, g, S, E);
    }
    SEAM(5);
#ifdef CHECKER
    if (IN(5) && IN(6)) {
        __syncthreads(); float* DEV = (float*)(ws + WS_CTL) + 8192;
        CHK_LOOP(idx, chk::NR * 256) { const int row = chk::RSTR * (int)(idx / 256) + chk::ROFF, col = 4 * (int)(idx % 256) + 2;
            const float ua = chk::dotbf(WSP(bf16, WS_YA) + (size_t)row * 1024, WSP(bf16, WS_WUA) + (size_t)col * 1024, 512), ub = chk::dotbf(WSP(bf16, WS_YA) + (size_t)row * 1024 + 512, WSP(bf16, WS_WUA) + (size_t)col * 1024 + 512, 512);
            const float ga = chk::b2f(WSP(bf16, WS_GT)[(size_t)row * 2048 + col]), gb = chk::b2f(WSP(bf16, WS_GT)[(size_t)row * 2048 + 1024 + col]);
            const float ref = chk::rnd(ga * ua) + gb * ub, o = chk::b2f(WSP(bf16, WS_MG)[(size_t)row * 1024 + col]); chk::devmax(DEV + 6, fabsf(o - ref)); }
    }
    if (IN(5) && IN(6)) xcd_barrier(bar);
#endif
    if (IN(6)) {
        pg8::Gemm g{WSP(bf16, WS_MG), (const bf16*)(ws + WS_WO), M, DM, DM}; pg8::StaticOrder S; S.init(M, DM, F.G, (int)blockIdx.x);
        epi::EpiResToBf16 E{args.in[0], WSP(bf16, WS_GT), MOD + 2048}; pg8::gemm_phase<epi::EpiResToBf16, pg8::StaticOrder, true, true>(F.lds, g, S, E);
    }
    SEAM(6);
#ifdef CHECKER
    if (IN(6) && IN(7)) {
        __syncthreads(); float* DEV = (float*)(ws + WS_CTL) + 8192;
        CHK_LOOP(idx, chk::NR * 256) { const int row = chk::RSTR * (int)(idx / 256) + chk::ROFF, col = 4 * (int)(idx % 256) + 1;
            const float a = chk::dotbf(WSP(bf16, WS_MG) + (size_t)row * 1024, WSP(bf16, WS_WO) + (size_t)col * 1024, 1024);
            const float ref = args.in[0][(size_t)row * 1024 + col] + MOD[(size_t)(row >> 11) * 6144 + 2048 + col] * a, o = chk::b2f(WSP(bf16, WS_GT)[(size_t)row * 1024 + col]); chk::devmax(DEV + 7, fabsf(o - ref)); }
    }
#endif
    if (IN(7)) norm_mod_pass_bf16(F, WSP(bf16, WS_GT), args.in[18], MOD + 4096, MOD + 3072, WSP(bf16, WS_XH));
    SEAM(7);
#ifdef CHECKER
    if (IN(7) && IN(8)) {
        __syncthreads(); float* DEV = (float*)(ws + WS_CTL) + 8192;
        CHK_LOOP(idx, chk::NR) { const int row = chk::RSTR * (int)idx + chk::ROFF, b = row >> 11; float ss = 0.f; for (int k = 0; k < 1024; ++k) { const float v = chk::b2f(WSP(bf16, WS_GT)[(size_t)row * 1024 + k]); ss += v * v; }
            const float rs = 1.f / sqrtf(ss / 1024.f + 1e-6f); float dm = 0.f;
            for (int k = 0; k < 1024; ++k) { const float ref = chk::b2f(WSP(bf16, WS_GT)[(size_t)row * 1024 + k]) * rs * args.in[18][k] * (1.f + MOD[(size_t)b * 6144 + 4096 + k]) + MOD[(size_t)b * 6144 + 3072 + k]; dm = fmaxf(dm, fabsf(chk::b2f(WSP(bf16, WS_XH)[(size_t)row * 1024 + k]) - ref)); }
            chk::devmax(DEV + 8, dm); }
    }
#endif
    if (IN(8)) {
        pg8::Gemm g{WSP(bf16, WS_XH), (const bf16*)(ws + WS_W13), M, NFF13, DM}; pg8::StaticOrder S; S.init(M, NFF13, F.G, (int)blockIdx.x);
#ifdef PROBE_EPI
        epi::EpiFF13 E{WSP(bf16, WS_HID), args.probe};
#else
        epi::EpiFF13 E{WSP(bf16, WS_HID)};
#endif
        pg8::gemm_phase<epi::EpiFF13, pg8::StaticOrder, true, true>(F.lds, g, S, E);
    }
    SEAM(8);
#ifdef CHECKER
    if (IN(8) && IN(9)) {
        __syncthreads(); float* DEV = (float*)(ws + WS_CTL) + 8192;
        CHK_LOOP(idx, chk::NR * 704) { const int row = chk::RSTR * (int)(idx / 704) + chk::ROFF, hc = 4 * (int)(idx % 704) + 3;
            const bf16* w = WSP(bf16, WS_W13) + (size_t)((hc >> 7) * 256 + (hc & 127)) * 1024;
            const float u1 = chk::dotbf(WSP(bf16, WS_XH) + (size_t)row * 1024, w, 1024), u3 = chk::dotbf(WSP(bf16, WS_XH) + (size_t)row * 1024, w + 128 * 1024, 1024);
            const float ref = u1 * chk::sig(u1) * u3, o = chk::b2f(WSP(bf16, WS_HID)[(size_t)row * 2816 + hc]); chk::devmax(DEV + 9, fabsf(o - ref) / (fabsf(ref) + 0.05f)); }
    }
#endif
    if (IN(9)) {
        pg8::Gemm g{WSP(bf16, WS_HID), (const bf16*)(ws + WS_W2), M, DM, DFF}; pg8::StaticOrder S; S.init(M, DM, F.G, (int)blockIdx.x);
        epi::EpiResFromBf16 E{WSP(bf16, WS_GT), args.out, MOD + 5120}; pg8::gemm_phase<epi::EpiResFromBf16, pg8::StaticOrder, true, true>(F.lds, g, S, E);
    }
#ifdef PROBE_XBAR
    for (int i = 0; i < PROBE_XBAR; ++i) xcd_barrier(bar);
#endif
#ifdef ENDCHK
    if (IN(9)) {
        unsigned tot = 0u; for (long idx = (long)F.vcu * 512 + F.tid; idx < 16L * 64 * 32 * 32; idx += (long)F.G * 512) tot += (unsigned)__builtin_popcountll(WSP(unsigned long long, WS_MASK)[idx]);
        atomicAdd((unsigned*)(ws + WS_CTL) + 8192 + 18, tot);
        xcd_barrier(bar);
        const int bad = (int)__hip_atomic_load((unsigned*)(ws + WS_CTL) + 8192 + 18, RLX_AGENT) - 16 * 499712;
        if (F.vcu == 0 && F.tid == 0 && bad != 0) args.out[0] += 1.0e6f;
    }
#endif
#ifdef CHECKER
    if (IN(9)) {
        float* DEV = (float*)(ws + WS_CTL) + 8192;
        asm volatile("s_waitcnt vmcnt(0)" ::: "memory"); __syncthreads();
        CHK_LOOP(idx, chk::NR * 256) { const int row = chk::RSTR * (int)(idx / 256) + chk::ROFF, col = 4 * (int)(idx % 256) + 3;
            (void)row; (void)col; }
        xcd_barrier(bar);
        CHK_LOOP(idx, chk::NR * 256) { const int row = chk::RSTR * (int)(idx / 256) + chk::ROFF, col = 4 * (int)(idx % 256) + 3;
            const float a = chk::dotbf(WSP(bf16, WS_HID) + (size_t)row * 2816, WSP(bf16, WS_W2) + (size_t)col * 2816, 2816);
            const float ref = chk::b2f(WSP(bf16, WS_GT)[(size_t)row * 1024 + col]) + MOD[(size_t)(row >> 11) * 6144 + 5120 + col] * a; chk::devmax(DEV + 10, fabsf(args.out[(size_t)row * 1024 + col] - ref)); }
        xcd_barrier(bar);
        float da = __hip_atomic_load(DEV + CHK_A, RLX_AGENT), db = __hip_atomic_load(DEV + CHK_B, RLX_AGENT);
        if (CHK_A == 17) da = (da > (float)CHK_TOL17) ? da : 0.f;
        if (CHK_A == 18) da = fabsf((float)((int)__hip_atomic_load((unsigned*)DEV + 18, RLX_AGENT) - 16 * 499712));
        if (F.vcu == 0 && F.tid == 0) args.out[0] += 1000.f * da;
        const float pb = 16.f * sqrtf(db);
        for (int i = F.vcu * 512 + F.tid; i < (1 << 18); i += F.G * 512) if (i > 0) args.out[i] += pb;
    }
#endif
#undef IN
#undef SEAM
#undef WSP
}

extern "C" void kernel_launch(void* const* d_in, const int* in_sizes, int n_in, void* d_out, int out_size, void* d_ws, size_t ws_size, hipStream_t stream) {
    static int grid = 0;
    if (grid == 0) {
        if (n_in != 22 || in_sizes[0] != M * DM || out_size != M * DM || ws_size < WS_END) { fprintf(stderr, "kernel_launch: unexpected shapes (n_in %d, in0 %d, out %d, ws %zu); nothing launched\n", n_in, n_in > 0 ? in_sizes[0] : -1, out_size, ws_size); grid = -1; return; }
        int dev = 0, cus = 0, per_cu = 0;
        if (hipGetDevice(&dev) != hipSuccess || hipDeviceGetAttribute(&cus, hipDeviceAttributeMultiprocessorCount, dev) != hipSuccess) { fprintf(stderr, "kernel_launch: device query failed\n"); grid = -1; return; }
        if (hipFuncSetAttribute((const void*)mega_fwd, hipFuncAttributeMaxDynamicSharedMemorySize, LDS_BYTES) != hipSuccess) { fprintf(stderr, "kernel_launch: hipFuncSetAttribute failed\n"); grid = -1; return; }
        if (hipOccupancyMaxActiveBlocksPerMultiprocessor(&per_cu, (const void*)mega_fwd, NWAVES * 64, LDS_BYTES) != hipSuccess || per_cu < 1) fprintf(stderr, "kernel_launch: note: occupancy query reports %d workgroups per CU\n", per_cu);
        (void)hipGetLastError();
        grid = cus;
        if (grid != 256) fprintf(stderr, "kernel_launch: %d CUs; the attention/selection schedules need 256\n", grid);
    }
    if (grid < 0) return;
    if (hipMemsetAsync((char*)d_ws + WS_CTL, 0, CTL_ZERO_BYTES, stream) != hipSuccess) { fprintf(stderr, "kernel_launch: hipMemsetAsync failed\n"); return; }
    Args a{};
    for (int i = 0; i < 22; ++i) a.in[i] = (const float*)d_in[i];
    a.out = (float*)d_out; a.ws = (unsigned char*)d_ws;
#ifdef PROBE_RERUN_MASK
    constexpr int n_l = N_LAUNCHES + __builtin_popcount(PROBE_RERUN_MASK);
#else
    constexpr int n_l = N_LAUNCHES;
#endif
#ifdef MASKDIFF
    { unsigned char* ws = (unsigned char*)d_ws; unsigned* CNT = (unsigned*)(ws + WS_CTL + 32768);
#ifdef MASKDIFF_SPLIT
      a.ph_lo = 0; a.ph_hi = 3; hipLaunchKernelGGL(mega_fwd, dim3(grid), dim3(NWAVES * 64), LDS_BYTES, stream, a);
      a.ph_lo = 3; a.ph_hi = 4; hipLaunchKernelGGL(mega_fwd, dim3(grid), dim3(NWAVES * 64), LDS_BYTES, stream, a);
#else
      a.ph_lo = 0; a.ph_hi = 4; hipLaunchKernelGGL(mega_fwd, dim3(grid), dim3(NWAVES * 64), LDS_BYTES, stream, a);
#endif
      (void)hipMemcpyAsync(ws + WS_STASH, ws + WS_MASK, 8u << 20, hipMemcpyDeviceToDevice, stream);
      a.ph_lo = 3; a.ph_hi = 4; hipLaunchKernelGGL(mega_fwd, dim3(grid), dim3(NWAVES * 64), LDS_BYTES, stream, a);
      hipLaunchKernelGGL(mask_diff, dim3(256), dim3(512), 0, stream, (const unsigned long long*)(ws + WS_MASK), (const unsigned long long*)(ws + WS_STASH), CNT);
      (void)hipMemsetAsync((char*)d_ws + WS_CTL, 0, 32768, stream);
      a.ph_lo = 4; a.ph_hi = 10; hipLaunchKernelGGL(mega_fwd, dim3(grid), dim3(NWAVES * 64), LDS_BYTES, stream, a);
      hipLaunchKernelGGL(mask_report, dim3(256), dim3(512), 0, stream, (float*)d_out, (const unsigned*)CNT);
      return; }
#endif
#ifdef DUPCHK
    { unsigned char* ws = (unsigned char*)d_ws; unsigned long long* CK = (unsigned long long*)(ws + WS_CTL + 32768);
      const void* rp[10] = {ws + WS_MOD, ws + WS_XH, ws + WS_QA, ws + WS_MASK, ws + WS_XH, ws + WS_MG, ws + WS_GT, ws + WS_XH, ws + WS_HID, d_out};
      const size_t rb[10] = {33ull << 20, 64ull << 20, 344ull << 20, 8ull << 20, 64ull << 20, 64ull << 20, 64ull << 20, 64ull << 20, 176ull << 20, 128ull << 20};
      int lo = 0;
      for (int k = 0; k < 10; ++k) { const bool cut = (DUPCHK >> k) & 1; if (!cut && k != 9) continue;
          if (lo > 0) (void)hipMemsetAsync((char*)d_ws + WS_CTL, 0, 32768, stream);
          a.ph_lo = lo; a.ph_hi = k + 1; hipLaunchKernelGGL(mega_fwd, dim3(grid), dim3(NWAVES * 64), LDS_BYTES, stream, a);
          if (cut) { hipLaunchKernelGGL(dup_cksum, dim3(256), dim3(512), 0, stream, rp[k], rb[k], CK + 2 * k);
                     a.ph_lo = k; a.ph_hi = k + 1; hipLaunchKernelGGL(mega_fwd, dim3(grid), dim3(NWAVES * 64), LDS_BYTES, stream, a);
                     hipLaunchKernelGGL(dup_cksum, dim3(256), dim3(512), 0, stream, rp[k], rb[k], CK + 2 * k + 1); }
          lo = k + 1; }
      hipLaunchKernelGGL(dup_final, dim3(256), dim3(512), 0, stream, (float*)d_out, (const unsigned long long*)CK);
      return; }
#endif
    int probe_next = 0;
    for (int li = 0; li < n_l; ++li) {
        a.ph_lo = (N_LAUNCHES == 1) ? 0 : li; a.ph_hi = (N_LAUNCHES == 1) ? N_PHASES : li + 1;
#ifdef PROBE_RERUN_MASK
        if (li >= N_LAUNCHES) { while (!((PROBE_RERUN_MASK >> probe_next) & 1)) ++probe_next; a.ph_lo = probe_next; a.ph_hi = probe_next + 1; ++probe_next;
#ifdef PROBE_MODE
            a.probe = PROBE_MODE;
#endif
        }
#endif
        hipLaunchKernelGGL(mega_fwd, dim3(grid), dim3(NWAVES * 64), LDS_BYTES, stream, a);
        const hipError_t le = hipPeekAtLastError();
        if (le != hipSuccess) { fprintf(stderr, "kernel_launch: launch %d failed: %s\n", li, hipGetErrorName(le)); break; }
    }
}
```

```cpp
#include <hip/hip_runtime.h>
#include <cstdio>
#include <cstdint>
namespace pg8 {
#define PG8_LAS __attribute__((address_space(3)))
typedef unsigned short bf16_t;
typedef short bf16x8 __attribute__((ext_vector_type(8)));
typedef float f32x4 __attribute__((ext_vector_type(4)));
typedef unsigned u32x4 __attribute__((ext_vector_type(4)));
constexpr int BM = 256, BK = 64, HALF = 128, HTB = HALF * BK * 2  , STAGE_BYTES = 8 * HTB, NXCD = 8, WGM = 8;

__host__ __device__ __forceinline__ int lds_byte(int r, int c) { const int st = (r >> 4) * 2 + (c >> 5), rr = r & 15, cc = c & 31, ob = rr * 64 + cc * 2; return st * 1024 + (ob ^ (((ob >> 9) & 1) << 5)); }
__host__ __device__ __forceinline__ void stage_rc(int b, int& R, int& C) { const int st = b / 1024, sb = b % 1024, swz = sb ^ (((sb >> 9) & 1) << 5); R = (st >> 1) * 16 + swz / 64; C = (st & 1) * 32 + (swz % 64) / 2; }
__host__ __device__ __forceinline__ int perm32(int rho) { const int n = rho >> 4, i = rho & 15; return 8 * (i >> 2) + 4 * n + (i & 3); }

struct Unit { int pm, pn; };
struct Gemm { const bf16_t* A; const bf16_t* Bt; int M, N, K; };

struct StaticOrder {
    int nM, nN, nwg, G, c;
    __host__ __device__ void init(int M, int N, int G_, int c_) { nM = M / BM; nN = N / BM; nwg = nM * nN; G = G_; c = c_; }
    __host__ __device__ bool next(int i, Unit& u) const {
        const long L = (long)i * G + c; if (L >= nwg) return false;
        int wgid = (int)L; { const int q = nwg / NXCD, r = nwg % NXCD, xcd = wgid % NXCD, off = wgid / NXCD; wgid = (xcd < r ? xcd * (q + 1) : r * (q + 1) + (xcd - r) * q) + off; }
        const int nig = WGM * nN, gid = wgid / nig, fm = gid * WGM, gsz = (nM - fm) < WGM ? (nM - fm) : WGM;
        u.pm = fm + ((wgid % nig) % gsz); u.pn = (wgid % nig) / gsz; return true;
    }
    __device__ __forceinline__ void a_ready(const Unit&) const {}
    __device__ __forceinline__ void done(const Unit&) const {}
};
__device__ __forceinline__ unsigned cvt_pk_bf16(float lo, float hi) { unsigned r; asm volatile("v_cvt_pk_bf16_f32 %0, %1, %2" : "=v"(r) : "v"(lo), "v"(hi)); return r; }
typedef float f32x2 __attribute__((ext_vector_type(2)));
template <class E, class = void> struct mid_t { static constexpr int v = 0; };
template <class E> struct mid_t<E, decltype((void)E::MID_T)> { static constexpr int v = E::MID_T; };
template <class Epi, class Sched, bool ALIGN_EPI = false, bool SP2 = false>
__device__ __forceinline__ void gemm_phase(PG8_LAS unsigned char* lds, const Gemm g, const Sched& S, const Epi& E) {
    const int tid = threadIdx.x, wid = __builtin_amdgcn_readfirstlane(tid >> 6), lane = tid & 63, wr = wid >> 2, wc = wid & 3, fr = lane & 15, fq = lane >> 4;
    const int K = g.K, nt = K / BK;
    unsigned voffA[2], voffB[2];
#pragma unroll
    for (int i = 0; i < 2; ++i) { int R, C; stage_rc(tid * 16 + i * 8192, R, C); const int Rb = Epi::PERM ? ((R & ~31) + perm32(R & 31)) : R;
        voffA[i] = (unsigned)(R * K + C) * 2u; voffB[i] = (unsigned)(Rb * K + C) * 2u; }
    const size_t kstep = (size_t)(BK * 2);
    const size_t hstep = (size_t)HALF * K * 2;
    const size_t tstep = 2 * hstep;
    const unsigned ldsw = (unsigned)wid * 1024u;
    const int aoff = lds_byte(wr * 64 + fr, fq * 8), boff = lds_byte(wc * 32 + fr, fq * 8);
#define PG8_SA(b, h) (((b) * 2 + (h)) * HTB)
#define PG8_SB(b, h) ((4 + (b) * 2 + (h)) * HTB)
#define PG8_STAGE(bufoff, gbase, voff) do { _Pragma("unroll") for (int _i = 0; _i < 2; ++_i) \
        __builtin_amdgcn_global_load_lds((const unsigned*)((const char*)(gbase) + (voff)[_i]), (PG8_LAS unsigned*)(lds + (bufoff) + ldsw + _i * 8192), 16, 0, 0); } while (0)
#define PG8_LDA(dst, b, h) do { _Pragma("unroll") for (int m = 0; m < 4; ++m) _Pragma("unroll") for (int k = 0; k < 2; ++k) dst[m][k] = *(const PG8_LAS bf16x8*)(lds + PG8_SA(b, h) + aoff + m * 2048 + k * 1024); } while (0)
#define PG8_LDB(dst, b, h) do { _Pragma("unroll") for (int n = 0; n < 2; ++n) _Pragma("unroll") for (int k = 0; k < 2; ++k) dst[n][k] = *(const PG8_LAS bf16x8*)(lds + PG8_SB(b, h) + boff + n * 2048 + k * 1024); } while (0)
#define PG8_MMA(ai, bj, At, Bt) do { __builtin_amdgcn_s_setprio(1); _Pragma("unroll") for (int m = 0; m < 4; ++m) _Pragma("unroll") for (int n = 0; n < 2; ++n) _Pragma("unroll") for (int k = 0; k < 2; ++k) \
        acc[ai][bj][m][n] = __builtin_amdgcn_mfma_f32_16x16x32_bf16(Bt[n][k], At[m][k], acc[ai][bj][m][n], 0, 0, 0); __builtin_amdgcn_s_setprio(0); } while (0)
#define PG8_WAIT_V(n) asm volatile("s_waitcnt vmcnt(" #n ")" ::: "memory")
#define PG8_WAIT_L(n) asm volatile("s_waitcnt lgkmcnt(" #n ")" ::: "memory")
#define PG8_BAR __builtin_amdgcn_s_barrier()
#define PG8_SCHED __builtin_amdgcn_sched_barrier(0)
    Unit cur, nxt; int ui = 0;
    if (!S.next(0, cur)) return;
    f32x4 acc[2][2][4][2];
#pragma unroll
    for (int a = 0; a < 2; ++a)
#pragma unroll
        for (int b = 0; b < 2; ++b)
#pragma unroll
            for (int m = 0; m < 4; ++m)
#pragma unroll
                for (int n = 0; n < 2; ++n) acc[a][b][m][n] = (f32x4){0.f, 0.f, 0.f, 0.f};
    bf16x8 At[4][2], B0[2][2], B1[2][2];
    const char* cA = (const char*)g.A + (size_t)cur.pm * tstep; const char* cB = (const char*)g.Bt + (size_t)cur.pn * tstep;
    S.a_ready(cur);
    if constexpr (SP2) {
        PG8_STAGE(PG8_SB(0, 0), cB, voffB); PG8_STAGE(PG8_SB(0, 1), cB + hstep, voffB); PG8_STAGE(PG8_SA(0, 0), cA, voffA); PG8_STAGE(PG8_SA(0, 1), cA + hstep, voffA);
        if (wr == 1) PG8_BAR;
        PG8_WAIT_V(2); PG8_BAR;
        PG8_STAGE(PG8_SB(1, 0), cB + kstep, voffB); PG8_STAGE(PG8_SA(1, 0), cA + kstep, voffA); PG8_STAGE(PG8_SB(1, 1), cB + hstep + kstep, voffB);
        PG8_WAIT_V(6); PG8_BAR;
    } else {
        PG8_STAGE(PG8_SB(0, 0), cB, voffB); PG8_STAGE(PG8_SA(0, 0), cA, voffA); PG8_STAGE(PG8_SB(0, 1), cB + hstep, voffB); PG8_STAGE(PG8_SA(0, 1), cA + hstep, voffA);
        if (wr == 1) PG8_BAR;
        PG8_WAIT_V(4); PG8_BAR;
        PG8_STAGE(PG8_SB(1, 0), cB + kstep, voffB); PG8_STAGE(PG8_SA(1, 0), cA + kstep, voffA); PG8_STAGE(PG8_SB(1, 1), cB + hstep + kstep, voffB);
        PG8_WAIT_V(6); PG8_BAR;
    }
    for (;;) {
        const bool has_next = S.next(ui + 1, nxt);
        const char* nA = has_next ? (const char*)g.A + (size_t)nxt.pm * tstep : cA; const char* nB = has_next ? (const char*)g.Bt + (size_t)nxt.pn * tstep : cB;
        for (int t = 0; t < nt; t += 2) {
            if constexpr (mid_t<Epi>::v > 0) { if (t == mid_t<Epi>::v) E.mid(acc, cur, wr, wc, fr, fq); }
            const bool last = (t == nt - 2);
            const char* a1 = cA + (size_t)(t + 1) * kstep;
            const char* a2 = last ? nA : cA + (size_t)(t + 2) * kstep; const char* b2 = last ? nB : cB + (size_t)(t + 2) * kstep;
            const char* a3 = a2 + kstep; const char* b3 = b2 + kstep;
            if (last && has_next) S.a_ready(nxt);
            if constexpr (SP2) {
            PG8_LDB(B0, 0, 0); PG8_LDB(B1, 0, 1); PG8_SCHED; PG8_LDA(At, 0, 0); PG8_STAGE(PG8_SA(1, 1), a1 + hstep, voffA);
            PG8_WAIT_V(8); PG8_WAIT_L(0); PG8_BAR; PG8_MMA(0, 0, At, B0); PG8_MMA(0, 1, At, B1); PG8_BAR; PG8_SCHED;
            PG8_LDA(At, 0, 1); PG8_STAGE(PG8_SB(0, 0), b2, voffB); PG8_STAGE(PG8_SB(0, 1), b2 + hstep, voffB); PG8_STAGE(PG8_SA(0, 0), a2, voffA);
            PG8_WAIT_V(8); PG8_WAIT_L(0); PG8_BAR; PG8_MMA(1, 0, At, B0); PG8_MMA(1, 1, At, B1); PG8_BAR; PG8_SCHED;
            PG8_LDB(B0, 1, 0); PG8_LDB(B1, 1, 1); PG8_SCHED; PG8_LDA(At, 1, 0); PG8_STAGE(PG8_SA(0, 1), a2 + hstep, voffA);
            PG8_WAIT_V(8); PG8_WAIT_L(0); PG8_BAR; PG8_MMA(0, 0, At, B0); PG8_MMA(0, 1, At, B1); PG8_BAR; PG8_SCHED;
            PG8_LDA(At, 1, 1); PG8_STAGE(PG8_SB(1, 0), b3, voffB); PG8_STAGE(PG8_SB(1, 1), b3 + hstep, voffB); PG8_STAGE(PG8_SA(1, 0), a3, voffA);
            PG8_WAIT_V(8); PG8_WAIT_L(0); PG8_BAR; PG8_MMA(1, 0, At, B0); PG8_MMA(1, 1, At, B1); PG8_BAR; PG8_SCHED;
            } else {
            PG8_LDB(B0, 0, 0); PG8_SCHED; PG8_LDA(At, 0, 0); PG8_STAGE(PG8_SA(1, 1), a1 + hstep, voffA);
            PG8_WAIT_L(8); PG8_BAR; PG8_WAIT_L(0); PG8_MMA(0, 0, At, B0); PG8_BAR; PG8_SCHED;
            PG8_LDB(B1, 0, 1); PG8_STAGE(PG8_SB(0, 0), b2, voffB);
            PG8_BAR; PG8_WAIT_L(0); PG8_MMA(0, 1, At, B1); PG8_BAR;
            PG8_LDA(At, 0, 1); PG8_STAGE(PG8_SA(0, 0), a2, voffA);
            PG8_BAR; PG8_WAIT_L(0); PG8_MMA(1, 0, At, B0); PG8_BAR; PG8_SCHED;
            PG8_STAGE(PG8_SB(0, 1), b2 + hstep, voffB);
            PG8_WAIT_V(6); PG8_BAR; PG8_MMA(1, 1, At, B1); PG8_BAR;
            PG8_LDB(B0, 1, 0); PG8_SCHED; PG8_LDA(At, 1, 0); PG8_STAGE(PG8_SA(0, 1), a2 + hstep, voffA);
            PG8_WAIT_L(8); PG8_BAR; PG8_WAIT_L(0); PG8_MMA(0, 0, At, B0); PG8_BAR; PG8_SCHED;
            PG8_LDB(B1, 1, 1); PG8_STAGE(PG8_SB(1, 0), b3, voffB);
            PG8_BAR; PG8_WAIT_L(0); PG8_MMA(0, 1, At, B1); PG8_BAR;
            PG8_LDA(At, 1, 1); PG8_STAGE(PG8_SA(1, 0), a3, voffA);
            PG8_BAR; PG8_WAIT_L(0); PG8_MMA(1, 0, At, B0); PG8_BAR; PG8_SCHED;
            PG8_STAGE(PG8_SB(1, 1), b3 + hstep, voffB);
            PG8_WAIT_V(6); PG8_BAR; PG8_MMA(1, 1, At, B1); PG8_BAR;
            }
        }
        if constexpr (ALIGN_EPI) { if (wr == 0) PG8_BAR; }
        if constexpr (!Epi::AFTER_DRAIN) { E(acc, cur, wr, wc, fr, fq); S.done(cur); }
        if (!has_next) break;
#pragma unroll
        for (int a = 0; a < 2; ++a)
#pragma unroll
            for (int b = 0; b < 2; ++b)
#pragma unroll
                for (int m = 0; m < 4; ++m)
#pragma unroll
                    for (int n = 0; n < 2; ++n) acc[a][b][m][n] = (f32x4){0.f, 0.f, 0.f, 0.f};
        cur = nxt; cA = nA; cB = nB; ++ui;
        if constexpr (ALIGN_EPI) { if (wr == 1) PG8_BAR; }
    }
    PG8_WAIT_V(0);
    if constexpr (!ALIGN_EPI) { if (wr == 0) PG8_BAR; }
    PG8_BAR;
    if constexpr (Epi::AFTER_DRAIN) { E.fused(acc, cur, wr, wc, fr, fq, lds, wid, lane); S.done(cur); }
#undef PG8_SA
#undef PG8_SB
#undef PG8_STAGE
#undef PG8_LDA
#undef PG8_LDB
#undef PG8_MMA
#undef PG8_WAIT_V
#undef PG8_WAIT_L
#undef PG8_BAR
#undef PG8_SCHED
}
}
#ifndef SCALE_F_EPS
#define SCALE_F_EPS 0.0f
#endif
namespace epi {
constexpr size_t PWS_GN = (1u << 20) + 768 * 1024, PWS_QA = 128u << 20, PWS_QI = 320u << 20, PWS_KI = 336u << 20, PWS_WI = 340u << 20, PWS_GT = 344u << 20;
using pg8::f32x4; using pg8::u32x4; using pg8::bf16_t; using pg8::Unit; using pg8::BM; using pg8::HALF;
__device__ __forceinline__ unsigned pk2(float lo, float hi) { return pg8::cvt_pk_bf16(lo, hi); }
__device__ __forceinline__ float bflo(unsigned u) { return __uint_as_float(u << 16); }
__device__ __forceinline__ float bfhi(unsigned u) { return __uint_as_float(u & 0xffff0000u); }
__device__ __forceinline__ float sigm(float v) { return __builtin_amdgcn_rcpf(1.f + __expf(-v)); }
__device__ __forceinline__ u32x4 pack8(const f32x4& a, const f32x4& b) { u32x4 w; w.x = pk2(a[0], a[1]); w.y = pk2(a[2], a[3]); w.z = pk2(b[0], b[1]); w.w = pk2(b[2], b[3]); return w; }
__device__ __forceinline__ float dot4(const f32x4& a) { return (a[0] * a[0] + a[1] * a[1]) + (a[2] * a[2] + a[3] * a[3]); }

struct EpiProj {
    static constexpr bool PERM = true, AFTER_DRAIN = false;
    unsigned char* ws;
    template <int MODE  >
    __device__ __forceinline__ void emit(const f32x4 (&acc)[2][2][4][2], bf16_t* dst, int pitch, int cb, const float* g, int row0, int wc, int fq) const {
        f32x4 gv[2][2];
#pragma unroll
        for (int bj = 0; bj < 2; ++bj)
#pragma unroll
            for (int n = 0; n < 2; ++n) gv[bj][n] = (MODE == 1) ? *(const f32x4*)(g + 32 * bj + 8 * fq + 4 * n) : (f32x4){1.f, 1.f, 1.f, 1.f};
#pragma unroll
        for (int ai = 0; ai < 2; ++ai)
#pragma unroll
            for (int m = 0; m < 4; ++m) {
                f32x4 v[2][2];
#pragma unroll
                for (int bj = 0; bj < 2; ++bj)
#pragma unroll
                    for (int n = 0; n < 2; ++n) v[bj][n] = acc[ai][bj][m][n];
                if (MODE == 1) {
                    float ss = (dot4(v[0][0]) + dot4(v[0][1])) + (dot4(v[1][0]) + dot4(v[1][1]));
                    ss += __shfl_xor(ss, 16); ss += __shfl_xor(ss, 32);
                    const float rs = __builtin_amdgcn_rsqf(ss * (1.0f / 64.0f) + 1e-6f);
#pragma unroll
                    for (int bj = 0; bj < 2; ++bj)
#pragma unroll
                        for (int n = 0; n < 2; ++n) v[bj][n] = v[bj][n] * rs * gv[bj][n];
                } else if (MODE == 2) {
#pragma unroll
                    for (int bj = 0; bj < 2; ++bj)
#pragma unroll
                        for (int n = 0; n < 2; ++n)
#pragma unroll
                            for (int i = 0; i < 4; ++i) v[bj][n][i] = sigm(v[bj][n][i]);
                }
                bf16_t* rowp = dst + (size_t)(row0 + ai * HALF + m * 16) * pitch + cb + 64 * wc + 8 * fq;
#pragma unroll
                for (int bj = 0; bj < 2; ++bj) *(u32x4*)(rowp + 32 * bj) = pack8(v[bj][0], v[bj][1]);
            }
    }
    __device__ __forceinline__ void operator()(const f32x4 (&acc)[2][2][4][2], const Unit& u, int wr, int wc, int fr, int fq) const {
        const int pn = u.pn, row0 = u.pm * BM + wr * 64 + fr, cb = (pn & 1) * 256;
        bf16_t* const QA = (bf16_t*)(ws + PWS_QA); const float* const gn = (const float*)(ws + PWS_GN);
        bf16_t* const KI = (bf16_t*)(ws + PWS_KI); float* const WI = (float*)(ws + PWS_WI); bf16_t* const GT = (bf16_t*)(ws + PWS_GT);
        if (pn < 12) {
            const int tsr = pn >> 1; bf16_t* dst = QA + (size_t)tsr * (size_t)(32u << 19);
            if (tsr == 2 || tsr == 5) emit<0>(acc, dst, 512, cb, nullptr, row0, wc, fq);
            else emit<1>(acc, dst, 512, cb, gn + 64 * (tsr - (tsr > 2 ? 1 : 0)), row0, wc, fq);
        }
        else if (pn == 12) emit<0>(acc, (bf16_t*)(ws + PWS_QI), 256, 0, nullptr, row0, wc, fq);
        else if (pn == 13) {
            if (wc == 0) emit<0>(acc, KI, 64, 0, nullptr, row0, 0, fq);
            else if (wc == 1) { if (fq == 0) {
#pragma unroll
                for (int ai = 0; ai < 2; ++ai)
#pragma unroll
                    for (int m = 0; m < 4; ++m) *(f32x4*)(WI + (size_t)(row0 + ai * HALF + m * 16) * 4) = acc[ai][0][m][0]; } }
        } else {
#pragma unroll
            for (int ai = 0; ai < 2; ++ai)
#pragma unroll
                for (int m = 0; m < 4; ++m) { f32x4 r[2], gb[2];
#pragma unroll
                    for (int n = 0; n < 2; ++n)
#pragma unroll
                        for (int i = 0; i < 4; ++i) { const float ea = __expf(-acc[ai][0][m][n][i]), eb = __builtin_fminf(__expf(-acc[ai][1][m][n][i]), 1.152921504606847e18f);
                            gb[n][i] = __builtin_amdgcn_rcpf(1.f + eb); r[n][i] = (1.f + eb) * __builtin_amdgcn_rcpf(1.f + ea); }
                    bf16_t* rowp = GT + (size_t)(row0 + ai * HALF + m * 16) * 2048 + (pn - 14) * 128 + 32 * wc + 8 * fq;
                    *(u32x4*)rowp = pack8(r[0], r[1]); *(u32x4*)(rowp + 1024) = pack8(gb[0], gb[1]); }
        }
    }
};
struct EpiUpM {
    static constexpr bool PERM = true, AFTER_DRAIN = false; static constexpr int MID_T = 8;
    bf16_t* MG; const bf16_t* GT;
    static __device__ __forceinline__ float gcl(float g) { return __builtin_fmaxf(g, 8.673617379884035e-19f); }
    __device__ __forceinline__ void mid(f32x4 (&acc)[2][2][4][2], const Unit& u, int wr, int wc, int fr, int fq) const {
        int zo = 0; asm volatile("" : "+v"(zo));
        const int row0 = u.pm * BM + wr * 64 + fr + zo, col0 = u.pn * BM + wc * 32 + 8 * fq;
        u32x4 ra[2][4][2];
#pragma unroll
        for (int ai = 0; ai < 2; ++ai)
#pragma unroll
            for (int m = 0; m < 4; ++m)
#pragma unroll
                for (int bj = 0; bj < 2; ++bj) { const size_t row = (size_t)(row0 + ai * HALF + m * 16); const int c = col0 + bj * HALF; ra[ai][m][bj] = *(const u32x4*)(GT + row * 2048 + c); }
        asm volatile("" ::: "memory");
#pragma unroll
        for (int ai = 0; ai < 2; ++ai)
#pragma unroll
            for (int m = 0; m < 4; ++m)
#pragma unroll
                for (int bj = 0; bj < 2; ++bj) { const u32x4 a = ra[ai][m][bj];
                    acc[ai][bj][m][0] = acc[ai][bj][m][0] * (f32x4){bflo(a.x), bfhi(a.x), bflo(a.y), bfhi(a.y)}; acc[ai][bj][m][1] = acc[ai][bj][m][1] * (f32x4){bflo(a.z), bfhi(a.z), bflo(a.w), bfhi(a.w)}; }
        asm volatile("" ::: "memory");
    }
    __device__ __forceinline__ void operator()(const f32x4 (&acc)[2][2][4][2], const Unit& u, int wr, int wc, int fr, int fq) const {
        const int row0 = u.pm * BM + wr * 64 + fr, col0 = u.pn * BM + wc * 32 + 8 * fq;
#pragma unroll
        for (int ai = 0; ai < 2; ++ai) {
            u32x4 gw[4][2];
#pragma unroll
            for (int m = 0; m < 4; ++m)
#pragma unroll
                for (int bj = 0; bj < 2; ++bj) { const size_t row = (size_t)(row0 + ai * HALF + m * 16); const int c = col0 + bj * HALF; gw[m][bj] = *(const u32x4*)(GT + row * 2048 + 1024 + c); }
            asm volatile("" ::: "memory");
#pragma unroll
            for (int m = 0; m < 4; ++m)
#pragma unroll
                for (int bj = 0; bj < 2; ++bj) { const size_t row = (size_t)(row0 + ai * HALF + m * 16); const int c = col0 + bj * HALF; const u32x4 g = gw[m][bj];
                    const f32x4 v0 = acc[ai][bj][m][0] * (f32x4){gcl(bflo(g.x)), gcl(bfhi(g.x)), gcl(bflo(g.y)), gcl(bfhi(g.y))}, v1 = acc[ai][bj][m][1] * (f32x4){gcl(bflo(g.z)), gcl(bfhi(g.z)), gcl(bflo(g.w)), gcl(bfhi(g.w))};
                    *(u32x4*)(MG + row * 1024 + c) = pack8(v0, v1); }
        }
    }
};
struct EpiFF13 {
    static constexpr bool PERM = true, AFTER_DRAIN = false;
    bf16_t* H;
#ifdef PROBE_EPI
    int skip;
#endif
    __device__ __forceinline__ void operator()(const f32x4 (&acc)[2][2][4][2], const Unit& u, int wr, int wc, int fr, int fq) const {
        const int row0 = u.pm * BM + wr * 64 + fr, col0 = u.pn * HALF + wc * 32 + 8 * fq;
#ifdef PROBE_EPI
        if (skip) { if (acc[0][0][0][0][0] == 1.2345e30f) H[0] = 0; return; }
#endif
#pragma unroll
        for (int ai = 0; ai < 2; ++ai)
#pragma unroll
            for (int m = 0; m < 4; ++m) { f32x4 h[2];
#pragma unroll
                for (int n = 0; n < 2; ++n)
#pragma unroll
                    for (int i = 0; i < 4; ++i) { const float a = acc[ai][0][m][n][i]; h[n][i] = a * sigm(a) * acc[ai][1][m][n][i]; }
                *(u32x4*)(H + (size_t)(row0 + ai * HALF + m * 16) * 2816 + col0) = pack8(h[0], h[1]); }
    }
};
struct EpiResToBf16 {
    static constexpr bool PERM = true, AFTER_DRAIN = false;
    const float* X; bf16_t* O; const float* gate;
    __device__ __forceinline__ void operator()(const f32x4 (&acc)[2][2][4][2], const Unit& u, int wr, int wc, int fr, int fq) const {
        const int row0 = u.pm * BM + wr * 64 + fr, col0 = u.pn * BM + wc * 32 + 8 * fq; const float* gp = gate + (size_t)(u.pm >> 3) * 6144 + col0;
        f32x4 gv[2][2];
#pragma unroll
        for (int bj = 0; bj < 2; ++bj)
#pragma unroll
            for (int n = 0; n < 2; ++n) gv[bj][n] = *(const f32x4*)(gp + bj * HALF + n * 4);
#pragma unroll
        for (int ai = 0; ai < 2; ++ai) {
            f32x4 xv[4][2][2];
#pragma unroll
            for (int m = 0; m < 4; ++m)
#pragma unroll
                for (int bj = 0; bj < 2; ++bj) { const size_t off = (size_t)(row0 + ai * HALF + m * 16) * 1024 + col0 + bj * HALF; xv[m][bj][0] = *(const f32x4*)(X + off); xv[m][bj][1] = *(const f32x4*)(X + off + 4); }
            asm volatile("" ::: "memory");
#pragma unroll
            for (int m = 0; m < 4; ++m)
#pragma unroll
                for (int bj = 0; bj < 2; ++bj) { const size_t off = (size_t)(row0 + ai * HALF + m * 16) * 1024 + col0 + bj * HALF;
                    *(u32x4*)(O + off) = pack8(xv[m][bj][0] + gv[bj][0] * acc[ai][bj][m][0], xv[m][bj][1] + gv[bj][1] * acc[ai][bj][m][1]); }
        }
    }
};
struct EpiResFromBf16 {
    static constexpr bool PERM = true, AFTER_DRAIN = false;
    const bf16_t* X; float* O; const float* gate;
    __device__ __forceinline__ void operator()(const f32x4 (&acc)[2][2][4][2], const Unit& u, int wr, int wc, int fr, int fq) const {
        const int row0 = u.pm * BM + wr * 64 + fr, col0 = u.pn * BM + wc * 32 + 8 * fq; const float* gp = gate + (size_t)(u.pm >> 3) * 6144 + col0;
        f32x4 gv[2][2];
#pragma unroll
        for (int bj = 0; bj < 2; ++bj)
#pragma unroll
            for (int n = 0; n < 2; ++n) gv[bj][n] = *(const f32x4*)(gp + bj * HALF + n * 4);
#pragma unroll
        for (int ai = 0; ai < 2; ++ai) {
            u32x4 xw[4][2];
#pragma unroll
            for (int m = 0; m < 4; ++m)
#pragma unroll
                for (int bj = 0; bj < 2; ++bj) xw[m][bj] = *(const u32x4*)(X + (size_t)(row0 + ai * HALF + m * 16) * 1024 + col0 + bj * HALF);
            asm volatile("" ::: "memory");
#pragma unroll
            for (int m = 0; m < 4; ++m)
#pragma unroll
                for (int bj = 0; bj < 2; ++bj) { const size_t off = (size_t)(row0 + ai * HALF + m * 16) * 1024 + col0 + bj * HALF; const u32x4 w = xw[m][bj];
                    *(f32x4*)(O + off) = (f32x4){bflo(w.x), bfhi(w.x), bflo(w.y), bfhi(w.y)} + gv[bj][0] * acc[ai][bj][m][0] * (1.0f + SCALE_F_EPS);
                    *(f32x4*)(O + off + 4) = (f32x4){bflo(w.z), bfhi(w.z), bflo(w.w), bfhi(w.w)} + gv[bj][1] * acc[ai][bj][m][1] * (1.0f + SCALE_F_EPS); }
        }
    }
};
}
#ifndef SCALE_B_EPS
#define SCALE_B_EPS 0.0f
#endif
#ifndef SCALE_A_EPS
#define SCALE_A_EPS 0.0f
#endif
namespace att {
using bf16x8 = __attribute__((ext_vector_type(8))) short;
using s16x4 = __attribute__((ext_vector_type(4))) short;
using f32x16 = __attribute__((ext_vector_type(16))) float;
using u32x4 = __attribute__((ext_vector_type(4))) unsigned;
using u32x2 = __attribute__((ext_vector_type(2))) unsigned;
typedef unsigned short bf16;
constexpr int SEQ = 2048, NW = 8, QBLK = 32, QB = QBLK * NW, KVBLK = 64;
constexpr float C2 = 0.125f * 1.4426950408889634f;
constexpr int SLOTB = 8192, LDS_K = 0, LDS_V = 3 * SLOTB, LDS_WS = 6 * SLOTB, WSW = 128, LDS_OST = LDS_WS + NW * WSW * 4, LDS_X = LDS_OST + NW * 4096, XW = 8192, LDS_BYTES = LDS_X + NW * XW;
#define SBAR() __builtin_amdgcn_sched_barrier(0)
#define PIN(x) asm volatile("" : "+v"(x))
#define MFMA(a, b, c) __builtin_amdgcn_mfma_f32_32x32x16_bf16(a, b, c, 0, 0, 0)
#define WAIT_BAR(N) asm volatile("s_waitcnt vmcnt(" #N ") lgkmcnt(0)\n\ts_barrier" ::: "memory")
#ifndef ATT_THR
#define ATT_THR 60.0f
#endif
typedef __attribute__((address_space(3))) const char* lds_cptr;
typedef __attribute__((address_space(3))) char* lds_ptr;
typedef __attribute__((address_space(3))) float* lds_fptr;
typedef __attribute__((address_space(3))) const unsigned* lds_cuptr;
typedef short v4i16_t __attribute__((ext_vector_type(4)));
__device__ __forceinline__ int crow(int r, int hi) { return (r & 3) + 8 * (r >> 2) + 4 * hi; }
__device__ __forceinline__ unsigned cvtpk(float lo, float hi) { unsigned r; asm("v_cvt_pk_bf16_f32 %0, %1, %2" : "=v"(r) : "v"(lo), "v"(hi)); return r; }
__device__ __forceinline__ void glds16(const void* g, unsigned lds_base) {
    unsigned sv; asm volatile("s_mov_b32 %0, m0\n\ts_mov_b32 m0, %2\n\ts_nop 0\n\tglobal_load_lds_dwordx4 %1, off\n\ts_mov_b32 m0, %0" : "=&s"(sv) : "v"(g), "s"(lds_base) : "memory"); }
__device__ __forceinline__ void kload2(bf16x8* kf, lds_cptr kp, int d0) { kf[2 * d0] = *(const __attribute__((address_space(3))) bf16x8*)(kp + d0 * 2048); kf[2 * d0 + 1] = *(const __attribute__((address_space(3))) bf16x8*)(kp + d0 * 2048 + 512); }
__device__ __forceinline__ s16x4 vtr(lds_cptr p) { return __builtin_bit_cast(s16x4, __builtin_amdgcn_ds_read_tr16_b64_v4i16((__attribute__((address_space(3))) v4i16_t*)p)); }
#define MX3(a, b, c) __builtin_fmaxf(__builtin_fmaxf((a), (b)), (c))
__device__ __forceinline__ float rowmax2(const f32x16& p0, const f32x16& p1, float p1off) {
    float a = MX3(p0[0], p0[1], p0[2]), b = MX3(p1[0], p1[1], p1[2]);
#pragma unroll
    for (int r = 3; r < 15; r += 2) { a = MX3(a, p0[r], p0[r + 1]); b = MX3(b, p1[r], p1[r + 1]); }
    a = __builtin_fmaxf(a, p0[15]); b = __builtin_fmaxf(b, p1[15]);
    float m = __builtin_fmaxf(a, b + p1off); auto rr = __builtin_amdgcn_permlane32_swap(__float_as_uint(m), __float_as_uint(m), false, false);
    return __builtin_fmaxf(__uint_as_float(rr[0]), __uint_as_float(rr[1])); }
__device__ __forceinline__ float msel(float x, unsigned mw, int pos) { const unsigned m = (unsigned)(((int)(mw << (31 - pos))) >> 31);
    return __uint_as_float((__float_as_uint(x) & m) | (0xff800000u & ~m)); }
__device__ __forceinline__ unsigned short f2bf(float f) { unsigned u = __float_as_uint(f); return (unsigned short)((u + 0x7fffu + ((u >> 16) & 1u)) >> 16); }

#ifndef EXP_NOBAND
#define EXP_NOBAND 0
#endif
#ifndef EXP_NOMASK
#define EXP_NOMASK 0
#endif
#ifdef EXP_NOAPPLY
#define EXP_APPLY(C0, C1, t, BAND) do {} while (0)
#else
#define EXP_APPLY(C0, C1, t, BAND) APPLY(C0, C1, t, BAND)
#endif
#ifdef EXP_NOADV
#define EXP_ADV do {} while (0)
#elif defined(EXP_ADVPIN)
#define EXP_ADV do { _Pragma("unroll") for (int r = 0; r < 16; ++r) ali[r] += tstep; PIN(ali); } while (0)
#else
#define EXP_ADV do { _Pragma("unroll") for (int r = 0; r < 16; ++r) ali[r] += tstep; } while (0)
#endif
template <bool MASKED>
__device__ __forceinline__ void attn_core(f32x16 (&o)[2], const bf16* Qw, int qp, const bf16* Kh, int kp, const bf16* Vh, int vp, int qb, float s8, const unsigned long long* gmask, char* lds) {
    int lz_ = threadIdx.x & 63; asm volatile("" : "+v"(lz_));
    const int tid = threadIdx.x, lane = lz_, r32 = lane & 31, hi = lane >> 5; const int wid = __builtin_amdgcn_readfirstlane(tid >> 6);
    const int NT = 4 * qb + 4;
    const unsigned lds0 = (unsigned)(uintptr_t)lds; const lds_fptr wsf = (lds_fptr)((lds_ptr)lds + LDS_WS) + wid * WSW;
    const bf16* ksrc = Kh + (long)lane * kp + wid * 8;
    const bf16* vsrc = Vh + (long)(16 * (wid & 3) + (lane >> 2)) * vp + (wid >> 2) * 32 + (lane & 3) * 8;
    const unsigned kdst = lds0 + LDS_K + wid * 1024, vdst = lds0 + LDS_V + wid * 1024;
#define DMA_K(t, slot) glds16(ksrc + (long)(t) * KVBLK * kp, (unsigned)__builtin_amdgcn_readfirstlane(kdst + (slot)))
#define DMA_V(t, slot) glds16(vsrc + (long)(t) * KVBLK * vp, (unsigned)__builtin_amdgcn_readfirstlane(vdst + (slot)))
    const lds_cptr vp0 = (lds_cptr)lds + LDS_V + ((lane >> 4) & 1) * 32 + (lane & 3) * 8 + (4 * hi + ((lane & 15) >> 2)) * 64;
    const lds_cptr kp0 = (lds_cptr)lds + LDS_K + hi * 1024 + r32 * 16;
    const lds_cptr mrow = (lds_cptr)lds + LDS_X + wid * XW + r32 * 8;
    if (MASKED) { for (int i = 0; i <= qb; ++i) glds16((const char*)gmask + i * 1024 + lane * 16, (unsigned)__builtin_amdgcn_readfirstlane(lds0 + LDS_X + wid * XW + i * 1024)); }
    DMA_K(0, 0); DMA_V(0, 0); DMA_K(1, SLOTB);
    bf16x8 qr[4];
#pragma unroll
    for (int d0 = 0; d0 < 4; ++d0) qr[d0] = *reinterpret_cast<const bf16x8*>(&Qw[(long)r32 * qp + d0 * 16 + hi * 8]);
    float mhat = 0.f, l_reg = 0.f; o[0] = f32x16{}; o[1] = f32x16{};
    const int qrel = wid * QBLK + r32, wch = wid >> 1; bool resc = false;
    const float p1off = 32.f * s8, tstep = 64.f * s8, nm1off = p1off * C2;
    f32x16 ali;
    { const float tq = (float)(QB * qb + qrel);
#pragma unroll
      for (int r = 0; r < 16; ++r) ali[r] = -s8 * (tq - (float)crow(r, hi)); }
    PIN(ali);
    f32x16 pA0, pA1, pB0, pB1; bf16x8 kf[8]; s16x4 vlo[8], vhi[8]; u32x4 pw0, pw1, pw2, pw3;
    int sl_prev = 0, sl_cur = 0, sl_next = SLOTB;
#define ROT() do { sl_prev = sl_cur; sl_cur = sl_next; sl_next = (sl_next == 2 * SLOTB) ? 0 : sl_next + SLOTB; } while (0)
#define EX(v, nm) __builtin_amdgcn_exp2f(__builtin_fmaf((v), C2, (nm)))
#define RESC() do { if (resc) { _Pragma("unroll") for (int d_ = 0; d_ < 2; ++d_) _Pragma("unroll") for (int r = 0; r < 16; ++r) o[d_][r] *= wsf[crow(r, hi)]; } } while (0)
#define APPLY(C0, C1, t, BAND) do { \
    const int jb_ = (t) - (NT - 4); \
    if (MASKED && !EXP_NOMASK) { const u32x2 mq_ = *(const __attribute__((address_space(3))) u32x2*)(mrow + (t) * 256); unsigned m0_ = mq_[0] >> (4 * hi), m1_ = mq_[1] >> (4 * hi); \
        if (BAND) { m0_ = (jb_ > wch) ? 0u : m0_; m1_ = (jb_ > wch) ? 0u : m1_; } SBAR(); \
        _Pragma("unroll") for (int e = 0; e < 16; e += 4) { C0[e] = msel(C0[e], m0_, 2 * e); C0[e + 1] = msel(C0[e + 1], m0_, 2 * e + 1); C0[e + 2] = msel(C0[e + 2], m0_, 2 * e + 2); C0[e + 3] = msel(C0[e + 3], m0_, 2 * e + 3); SBAR(); } \
        _Pragma("unroll") for (int e = 0; e < 16; e += 4) { C1[e] = msel(C1[e], m1_, 2 * e); C1[e + 1] = msel(C1[e + 1], m1_, 2 * e + 1); C1[e + 2] = msel(C1[e + 2], m1_, 2 * e + 2); C1[e + 3] = msel(C1[e + 3], m1_, 2 * e + 3); SBAR(); } } \
    if (BAND && !EXP_NOBAND) { const float binv_ = (!MASKED && jb_ > wch) ? -INFINITY : 0.f, m2_ = (jb_ == wch) ? -2.f * s8 : 0.f, fb_ = (float)(4 * hi - (qrel - 64 * wch)); float fbo_ = fb_; asm volatile("" : "+v"(fbo_)); SBAR(); \
        _Pragma("unroll") for (int e = 0; e < 16; ++e) { const float d0_ = fbo_ + (float)((e & 3) + 8 * (e >> 2)); \
            C0[e] = __builtin_fmaf(__builtin_fmaxf(d0_, 0.f), m2_, C0[e] + binv_); C1[e] = __builtin_fmaf(__builtin_fmaxf(d0_ + 32.f, 0.f), m2_, C1[e] + binv_); if ((e & 1) == 1) SBAR(); } } } while (0)
    DMA_K(2, 2 * SLOTB);
    WAIT_BAR(3);
    _Pragma("unroll") for (int d0 = 0; d0 < 4; ++d0) kload2(kf, kp0, d0);
    pA0 = MFMA(kf[0], qr[0], ali); pA1 = MFMA(kf[1], qr[0], ali); pA0 = MFMA(kf[2], qr[1], pA0); pA1 = MFMA(kf[3], qr[1], pA1);
    pA0 = MFMA(kf[4], qr[2], pA0); pA1 = MFMA(kf[5], qr[2], pA1); pA0 = MFMA(kf[6], qr[3], pA0); pA1 = MFMA(kf[7], qr[3], pA1);
    APPLY(pA0, pA1, 0, true);
    { const float rm = rowmax2(pA0, pA1, p1off); mhat = __builtin_fmaxf(rm * C2, -30000.f); const float nmh = -mhat, nmh1 = nmh + nm1off;
#pragma unroll
      for (int r = 0; r < 16; ++r) { pA0[r] = EX(pA0[r], nmh); pA1[r] = EX(pA1[r], nmh1); } }
#pragma unroll
    for (int r = 0; r < 16; ++r) ali[r] += tstep;
    WAIT_BAR(0);
    DMA_K(3, 0); DMA_V(1, SLOTB); ROT();
    _Pragma("unroll") for (int d0 = 0; d0 < 4; ++d0) kload2(kf, kp0 + sl_cur, d0);
    WAIT_BAR(2);
#define PKW(P, i) cvtpk(P[i], P[i + 1])
#define PAF(k) __builtin_bit_cast(bf16x8, pw##k)
#define VFR(i) (bf16x8){vlo[i][0], vlo[i][1], vlo[i][2], vlo[i][3], vhi[i][0], vhi[i][1], vhi[i][2], vhi[i][3]}
#define VRD(i) do { vlo[i] = vtr(vp_ + (((i) >> 2) * 4096 + ((i) & 3) * 1024)); vhi[i] = vtr(vp_ + (((i) >> 2) * 4096 + ((i) & 3) * 1024 + 512)); } while (0)
#define KRD(G, d0) do { if (G) { kload2(kf, kp0 + sl_next, d0); SBAR(); } } while (0)
#define GAPA(MF, a0, a1, a2, a3, W0, W1, PW) do { MF; sacc += a0; sacc += a1; sacc += a2; sacc += a3; W0; W1; PIN(PW); PIN(sacc); SBAR(); } while (0)
#define GAPB(MF, X, i, nm) do { MF; X[i] = EX(X[i], nm); X[i + 1] = EX(X[i + 1], nm); X[i + 2] = EX(X[i + 2], nm); X[i + 3] = EX(X[i + 3], nm); PIN(X); SBAR(); } while (0)
#define STEP(C0, C1, P0, P1, t, BAND, GK, GV, GL) do { SBAR(); \
    const lds_cptr vp_ = vp0 + sl_prev; \
    VRD(0); SBAR(); float sacc = P0[0] + P0[1]; \
                    GAPA(C0 = MFMA(kf[0], qr[0], ali), P0[2], P0[3], P0[4], P0[5],     pw0[0] = PKW(P0, 0),  pw0[1] = PKW(P0, 2),  pw0); \
    VRD(4); SBAR(); GAPA(C1 = MFMA(kf[1], qr[0], ali), P0[6], P0[7], P0[8], P0[9],     pw0[2] = PKW(P0, 4),  pw0[3] = PKW(P0, 6),  pw0); \
    VRD(1); SBAR(); GAPA(C0 = MFMA(kf[2], qr[1], C0),  P0[10], P0[11], P0[12], P0[13], pw1[0] = PKW(P0, 8),  pw1[1] = PKW(P0, 10), pw1); \
    VRD(5); SBAR(); GAPA(C1 = MFMA(kf[3], qr[1], C1),  P0[14], P0[15], P1[0], P1[1],   pw1[2] = PKW(P0, 12), pw1[3] = PKW(P0, 14), pw1); \
    VRD(2); SBAR(); GAPA(C0 = MFMA(kf[4], qr[2], C0),  P1[2], P1[3], P1[4], P1[5],     pw2[0] = PKW(P1, 0),  pw2[1] = PKW(P1, 2),  pw2); \
    VRD(6); SBAR(); GAPA(C1 = MFMA(kf[5], qr[2], C1),  P1[6], P1[7], P1[8], P1[9],     pw2[2] = PKW(P1, 4),  pw2[3] = PKW(P1, 6),  pw2); \
    VRD(3); SBAR(); GAPA(C0 = MFMA(kf[6], qr[3], C0),  P1[10], P1[11], P1[12], P1[13], pw3[0] = PKW(P1, 8),  pw3[1] = PKW(P1, 10), pw3); \
    VRD(7); SBAR(); GAPA(C1 = MFMA(kf[7], qr[3], C1),  P1[14], P1[15], 0.f, 0.f,       pw3[2] = PKW(P1, 12), pw3[3] = PKW(P1, 14), pw3); \
    l_reg += sacc; \
    if (GK) DMA_K((t) + 3, sl_cur); if (GV) DMA_V((t) + 1, sl_next); \
    EXP_APPLY(C0, C1, t, BAND); \
    EXP_ADV; \
    { const float rm = __builtin_fmaf(rowmax2(C0, C1, p1off), C2, -mhat); resc = false; \
      if (__builtin_expect(__any(rm > ATT_THR), 0)) { const float dl = __builtin_fmaxf(rm, 0.f); mhat += dl; \
          const float f = __builtin_amdgcn_exp2f(-dl); l_reg *= f; if (hi == 0) wsf[r32] = f; resc = true; } } \
    const float nmh = -mhat, nmh1 = nmh + nm1off; SBAR(); \
    GAPB(o[0] = MFMA(PAF(0), VFR(0), o[0]), C0, 0, nmh);              GAPB(o[1] = MFMA(PAF(0), VFR(4), o[1]), C0, 4, nmh); \
    KRD(GL, 0); GAPB(o[0] = MFMA(PAF(1), VFR(1), o[0]), C0, 8, nmh);  KRD(GL, 1); GAPB(o[1] = MFMA(PAF(1), VFR(5), o[1]), C0, 12, nmh); \
    KRD(GL, 2); GAPB(o[0] = MFMA(PAF(2), VFR(2), o[0]), C1, 0, nmh1); KRD(GL, 3); GAPB(o[1] = MFMA(PAF(2), VFR(6), o[1]), C1, 4, nmh1); \
    GAPB(o[0] = MFMA(PAF(3), VFR(3), o[0]), C1, 8, nmh1);             GAPB(o[1] = MFMA(PAF(3), VFR(7), o[1]), C1, 12, nmh1); \
    } while (0)
    int t = 1;
    for (; t + 5 < NT; t += 2) {
        STEP(pB0, pB1, pA0, pA1, t, false, true, true, true);     WAIT_BAR(2); RESC(); ROT();
        STEP(pA0, pA1, pB0, pB1, t + 1, false, true, true, true); WAIT_BAR(2); RESC(); ROT();
    }
#define ENDW(tt) do { if ((tt) + 3 < NT) { WAIT_BAR(2); } else if ((tt) + 2 < NT) { WAIT_BAR(1); } else { WAIT_BAR(0); } } while (0)
    for (; t + 1 < NT; t += 2) {
        STEP(pB0, pB1, pA0, pA1, t, true, (t + 3 < NT), (t + 1 < NT), (t + 1 < NT));         ENDW(t);     RESC(); ROT();
        STEP(pA0, pA1, pB0, pB1, t + 1, true, (t + 4 < NT), (t + 2 < NT), (t + 2 < NT));     ENDW(t + 1); RESC(); ROT();
    }
    STEP(pB0, pB1, pA0, pA1, NT - 1, true, false, false, false); RESC();
    { float sacc = pB0[0] + pB0[1];
#pragma unroll
      for (int r = 2; r < 16; ++r) sacc += pB0[r];
#pragma unroll
      for (int r = 0; r < 16; ++r) sacc += pB1[r];
      l_reg += sacc;
      pw0 = (u32x4){PKW(pB0, 0), PKW(pB0, 2), PKW(pB0, 4), PKW(pB0, 6)}; pw1 = (u32x4){PKW(pB0, 8), PKW(pB0, 10), PKW(pB0, 12), PKW(pB0, 14)};
      pw2 = (u32x4){PKW(pB1, 0), PKW(pB1, 2), PKW(pB1, 4), PKW(pB1, 6)}; pw3 = (u32x4){PKW(pB1, 8), PKW(pB1, 10), PKW(pB1, 12), PKW(pB1, 14)};
      const lds_cptr vp_ = vp0 + sl_cur; _Pragma("unroll") for (int i = 0; i < 8; ++i) VRD(i);
      o[0] = MFMA(PAF(0), VFR(0), o[0]); o[1] = MFMA(PAF(0), VFR(4), o[1]); o[0] = MFMA(PAF(1), VFR(1), o[0]); o[1] = MFMA(PAF(1), VFR(5), o[1]);
      o[0] = MFMA(PAF(2), VFR(2), o[0]); o[1] = MFMA(PAF(2), VFR(6), o[1]); o[0] = MFMA(PAF(3), VFR(3), o[0]); o[1] = MFMA(PAF(3), VFR(7), o[1]); }
    { auto rr = __builtin_amdgcn_permlane32_swap(__float_as_uint(l_reg), __float_as_uint(l_reg), false, false); l_reg = __uint_as_float(rr[0]) + __uint_as_float(rr[1]); }
    if (hi == 0) wsf[32 + r32] = l_reg;
    asm volatile("s_waitcnt lgkmcnt(0)\n\ts_barrier" ::: "memory");
#undef DMA_K
#undef DMA_V
#undef ROT
#undef EX
#undef RESC
#undef APPLY
#undef PKW
#undef PAF
#undef VFR
#undef VRD
#undef KRD
#undef ENDW
#undef GAPA
#undef GAPB
#undef STEP
}
constexpr int L8_K = 0, L8_V = 3 * SLOTB, L8_VSLOT = 2 * SLOTB, L8_WS = L8_V + 3 * L8_VSLOT, L8_OST = L8_WS + NW * WSW * 4, L8_Q = L8_OST + NW * 4096, L8_BYTES = L8_Q + NW * 4096;
static_assert(L8_BYTES <= LDS_BYTES, "core128 LDS");
__device__ __forceinline__ float rowmax_h(const f32x16& p0, const f32x16& p1, float hoff) {
    float a = MX3(p0[0], p0[1], p0[2]), b = MX3(p1[0], p1[1], p1[2]);
#pragma unroll
    for (int r = 3; r < 15; r += 2) { a = MX3(a, p0[r], p0[r + 1]); b = MX3(b, p1[r], p1[r + 1]); }
    a = __builtin_fmaxf(a, p0[15]); b = __builtin_fmaxf(b, p1[15]);
    float m = __builtin_fmaxf(a, b) + hoff; auto rr = __builtin_amdgcn_permlane32_swap(__float_as_uint(m), __float_as_uint(m), false, false);
    return __builtin_fmaxf(__uint_as_float(rr[0]), __uint_as_float(rr[1])); }
__device__ __forceinline__ void attn_core128(f32x16 (&o)[4], const bf16* Qw, int qp, const bf16* Kh, int kp, const bf16* Vh, int vp, int qb, float s8, char* lds) {
    int lz_ = threadIdx.x & 63; asm volatile("" : "+v"(lz_));
    const int tid = threadIdx.x, lane = lz_, r32 = lane & 31, hi = lane >> 5; const int wid = __builtin_amdgcn_readfirstlane(tid >> 6);
    const int NT = 4 * qb + 4;
    const unsigned lds0 = (unsigned)(uintptr_t)lds; const lds_fptr wsf = (lds_fptr)((lds_ptr)lds + L8_WS) + wid * WSW;
    const bf16* ksrc = Kh + (long)lane * kp + wid * 8;
    const bf16* vsrc = Vh + (long)(16 * (wid & 3) + (lane >> 2)) * vp + (wid >> 2) * 32 + (lane & 3) * 8;
    const unsigned kdst = lds0 + L8_K + wid * 1024, vdst = lds0 + L8_V + wid * 1024;
#define DMA_K(t, slot) glds16(ksrc + (long)(t) * KVBLK * kp, (unsigned)__builtin_amdgcn_readfirstlane(kdst + (slot)))
#define DMA_V(t, slot) do { glds16(vsrc + (long)(t) * KVBLK * vp, (unsigned)__builtin_amdgcn_readfirstlane(vdst + 2 * (slot))); \
                            glds16(vsrc + (long)(t) * KVBLK * vp + 64, (unsigned)__builtin_amdgcn_readfirstlane(vdst + 2 * (slot) + 8192)); } while (0)
    const lds_cptr vp0 = (lds_cptr)lds + L8_V + ((lane >> 4) & 1) * 32 + (lane & 3) * 8 + (4 * hi + ((lane & 15) >> 2)) * 64;
    const lds_cptr kp0 = (lds_cptr)lds + L8_K + hi * 1024 + r32 * 16;
    const lds_cptr qlp = (lds_cptr)lds + L8_Q + wid * 4096 + hi * 512 + r32 * 16;
#pragma unroll
    for (int d0 = 0; d0 < 4; ++d0) glds16(Qw + (long)r32 * qp + d0 * 16 + hi * 8, (unsigned)__builtin_amdgcn_readfirstlane(lds0 + L8_Q + wid * 4096 + d0 * 1024));
    DMA_K(0, 0); DMA_V(0, 0); DMA_K(1, SLOTB);
#ifdef DBG_QGLOBAL
#define QF(d0) (*reinterpret_cast<const bf16x8*>(&Qw[(long)r32 * qp + (d0) * 16 + hi * 8]))
#else
#define QF(d0) (*(const __attribute__((address_space(3))) bf16x8*)(qlp + (d0) * 1024))
#endif
    float mhat = 0.f, l_reg = 0.f; o[0] = f32x16{}; o[1] = f32x16{}; o[2] = f32x16{}; o[3] = f32x16{};
    const int qrel = wid * QBLK + r32, wch = wid >> 1; bool resc = false;
    float bt = -s8 * (float)(QB * qb + qrel); const float tstep = 64.f * s8, hoff = s8 * (float)(4 * hi);
    f32x16 pA0, pA1, pB0, pB1; bf16x8 kf[8]; s16x4 vlo[8], vhi[8]; u32x4 pw0, pw1, pw2, pw3;
    int sl_prev = 0, sl_cur = 0, sl_next = SLOTB;
#define ROT() do { sl_prev = sl_cur; sl_cur = sl_next; sl_next = (sl_next == 2 * SLOTB) ? 0 : sl_next + SLOTB; } while (0)
#define EX(v, nm) __builtin_amdgcn_exp2f(__builtin_fmaf((v), C2, (nm)))
#define RESC() do { if (resc) { _Pragma("unroll") for (int d_ = 0; d_ < 4; ++d_) _Pragma("unroll") for (int r = 0; r < 16; ++r) o[d_][r] *= wsf[crow(r, hi)]; } } while (0)
#define BIAS(C0, C1) do { _Pragma("unroll") for (int e = 0; e < 16; ++e) { C0[e] = __builtin_fmaf(s8, (float)((e & 3) + 8 * (e >> 2)), C0[e]); C1[e] = __builtin_fmaf(s8, (float)(32 + (e & 3) + 8 * (e >> 2)), C1[e]); } } while (0)
#define APPLY(C0, C1, t, BAND) do { \
    if (BAND) { const int jb_ = (t) - (NT - 4); const float binv_ = (jb_ > wch) ? -INFINITY : 0.f, m2_ = (jb_ == wch) ? -2.f * s8 : 0.f, fb_ = (float)(4 * hi - (qrel - 64 * wch)); float fbo_ = fb_; asm volatile("" : "+v"(fbo_)); SBAR(); \
        _Pragma("unroll") for (int e = 0; e < 16; ++e) { const float d0_ = fbo_ + (float)((e & 3) + 8 * (e >> 2)); \
            C0[e] = __builtin_fmaf(__builtin_fmaxf(d0_, 0.f), m2_, C0[e] + binv_); C1[e] = __builtin_fmaf(__builtin_fmaxf(d0_ + 32.f, 0.f), m2_, C1[e] + binv_); if ((e & 1) == 1) SBAR(); } } } while (0)
    DMA_K(2, 2 * SLOTB);
    WAIT_BAR(4);
    _Pragma("unroll") for (int d0 = 0; d0 < 4; ++d0) kload2(kf, kp0, d0);
    { const bf16x8 q0 = QF(0), q1 = QF(1), q2 = QF(2), q3 = QF(3); const f32x16 z = f32x16{};
      pA0 = MFMA(kf[0], q0, z); pA1 = MFMA(kf[1], q0, z); pA0 = MFMA(kf[2], q1, pA0); pA1 = MFMA(kf[3], q1, pA1);
      pA0 = MFMA(kf[4], q2, pA0); pA1 = MFMA(kf[5], q2, pA1); pA0 = MFMA(kf[6], q3, pA0); pA1 = MFMA(kf[7], q3, pA1); }
    BIAS(pA0, pA1); APPLY(pA0, pA1, 0, true);
    { const float rm = rowmax_h(pA0, pA1, hoff); mhat = __builtin_fmaxf((rm + bt) * C2, -30000.f); const float nmh = __builtin_fmaf(bt + hoff, C2, -mhat);
#pragma unroll
      for (int r = 0; r < 16; ++r) { pA0[r] = EX(pA0[r], nmh); pA1[r] = EX(pA1[r], nmh); } }
    bt += tstep;
    WAIT_BAR(0);
    DMA_K(3, 0); DMA_V(1, SLOTB); ROT();
    _Pragma("unroll") for (int d0 = 0; d0 < 4; ++d0) kload2(kf, kp0 + sl_cur, d0);
    WAIT_BAR(3);
#define PKW(P, i) cvtpk(P[i], P[i + 1])
#define PAF(k) __builtin_bit_cast(bf16x8, pw##k)
#define VFR(i) (bf16x8){vlo[i][0], vlo[i][1], vlo[i][2], vlo[i][3], vhi[i][0], vhi[i][1], vhi[i][2], vhi[i][3]}
#define VRD(i, hofs) do { vlo[i] = vtr(vp_ + ((hofs) + ((i) >> 2) * 4096 + ((i) & 3) * 1024)); vhi[i] = vtr(vp_ + ((hofs) + ((i) >> 2) * 4096 + ((i) & 3) * 1024 + 512)); } while (0)
#define KRD(G, d0) do { if (G) { kload2(kf, kp0 + sl_next, d0); SBAR(); } } while (0)
#define GAPA(MF, a0, a1, a2, a3, W0, W1, PW) do { MF; sacc += a0; sacc += a1; sacc += a2; sacc += a3; W0; W1; PIN(PW); PIN(sacc); SBAR(); } while (0)
#define GAPB1(MF, i, X, j, nm) do { MF; VRD(i, 8192); X[j] = EX(X[j], nm); X[j + 1] = EX(X[j + 1], nm); PIN(X); SBAR(); } while (0)
#define GAPB2(MF, X, j, nm) do { MF; X[j] = EX(X[j], nm); X[j + 1] = EX(X[j + 1], nm); PIN(X); SBAR(); } while (0)
#define STEP(C0, C1, P0, P1, t, BAND, GK, GV, GL) do { SBAR(); \
    const lds_cptr vp_ = vp0 + 2 * sl_prev; \
    VRD(0, 0); bf16x8 qa_ = QF(0); SBAR(); float sacc = P0[0] + P0[1]; const f32x16 z_ = f32x16{}; \
                       GAPA(C0 = MFMA(kf[0], qa_, z_), P0[2], P0[3], P0[4], P0[5],     pw0[0] = PKW(P0, 0),  pw0[1] = PKW(P0, 2),  pw0); \
    VRD(4, 0); bf16x8 qb_ = QF(1); SBAR(); GAPA(C1 = MFMA(kf[1], qa_, z_), P0[6], P0[7], P0[8], P0[9],     pw0[2] = PKW(P0, 4),  pw0[3] = PKW(P0, 6),  pw0);     \
    VRD(1, 0); SBAR(); GAPA(C0 = MFMA(kf[2], qb_, C0),  P0[10], P0[11], P0[12], P0[13], pw1[0] = PKW(P0, 8),  pw1[1] = PKW(P0, 10), pw1); \
    VRD(5, 0); qa_ = QF(2); SBAR(); GAPA(C1 = MFMA(kf[3], qb_, C1),  P0[14], P0[15], P1[0], P1[1],   pw1[2] = PKW(P0, 12), pw1[3] = PKW(P0, 14), pw1); \
    VRD(2, 0); SBAR(); GAPA(C0 = MFMA(kf[4], qa_, C0),  P1[2], P1[3], P1[4], P1[5],     pw2[0] = PKW(P1, 0),  pw2[1] = PKW(P1, 2),  pw2); \
    VRD(6, 0); qb_ = QF(3); SBAR(); GAPA(C1 = MFMA(kf[5], qa_, C1),  P1[6], P1[7], P1[8], P1[9],     pw2[2] = PKW(P1, 4),  pw2[3] = PKW(P1, 6),  pw2); \
    VRD(3, 0); SBAR(); GAPA(C0 = MFMA(kf[6], qb_, C0),  P1[10], P1[11], P1[12], P1[13], pw3[0] = PKW(P1, 8),  pw3[1] = PKW(P1, 10), pw3); \
    VRD(7, 0); SBAR(); GAPA(C1 = MFMA(kf[7], qb_, C1),  P1[14], P1[15], 0.f, 0.f,       pw3[2] = PKW(P1, 12), pw3[3] = PKW(P1, 14), pw3); \
    l_reg += sacc; \
    if (GK) DMA_K((t) + 3, sl_cur); if (GV) DMA_V((t) + 1, sl_next); \
    BIAS(C0, C1); APPLY(C0, C1, t, BAND); \
    { const float rm = __builtin_fmaf(rowmax_h(C0, C1, hoff) + bt, C2, -mhat); resc = false; \
      if (__builtin_expect(__any(rm > ATT_THR), 0)) { const float dl = __builtin_fmaxf(rm, 0.f); mhat += dl; \
          const float f = __builtin_amdgcn_exp2f(-dl); l_reg *= f; if (hi == 0) wsf[r32] = f; resc = true; } } \
    const float nmh = __builtin_fmaf(bt + hoff, C2, -mhat); bt += tstep; SBAR(); \
    GAPB1(o[0] = MFMA(PAF(0), VFR(0), o[0]), 0, C0, 0, nmh);              GAPB1(o[1] = MFMA(PAF(0), VFR(4), o[1]), 4, C0, 2, nmh); \
    GAPB1(o[0] = MFMA(PAF(1), VFR(1), o[0]), 1, C0, 4, nmh);              GAPB1(o[1] = MFMA(PAF(1), VFR(5), o[1]), 5, C0, 6, nmh); \
    GAPB1(o[0] = MFMA(PAF(2), VFR(2), o[0]), 2, C0, 8, nmh);              GAPB1(o[1] = MFMA(PAF(2), VFR(6), o[1]), 6, C0, 10, nmh); \
    GAPB1(o[0] = MFMA(PAF(3), VFR(3), o[0]), 3, C0, 12, nmh);             GAPB1(o[1] = MFMA(PAF(3), VFR(7), o[1]), 7, C0, 14, nmh); \
    GAPB2(o[2] = MFMA(PAF(0), VFR(0), o[2]), C1, 0, nmh);                 GAPB2(o[3] = MFMA(PAF(0), VFR(4), o[3]), C1, 2, nmh); \
    KRD(GL, 0); GAPB2(o[2] = MFMA(PAF(1), VFR(1), o[2]), C1, 4, nmh);     KRD(GL, 1); GAPB2(o[3] = MFMA(PAF(1), VFR(5), o[3]), C1, 6, nmh); \
    KRD(GL, 2); GAPB2(o[2] = MFMA(PAF(2), VFR(2), o[2]), C1, 8, nmh);     KRD(GL, 3); GAPB2(o[3] = MFMA(PAF(2), VFR(6), o[3]), C1, 10, nmh); \
    GAPB2(o[2] = MFMA(PAF(3), VFR(3), o[2]), C1, 12, nmh);                GAPB2(o[3] = MFMA(PAF(3), VFR(7), o[3]), C1, 14, nmh); \
    } while (0)
    int t = 1;
    for (; t + 5 < NT; t += 2) {
        STEP(pB0, pB1, pA0, pA1, t, false, true, true, true);     WAIT_BAR(3); RESC(); ROT();
        STEP(pA0, pA1, pB0, pB1, t + 1, false, true, true, true); WAIT_BAR(3); RESC(); ROT();
    }
#define ENDW(tt) do { if ((tt) + 3 < NT) { WAIT_BAR(3); } else if ((tt) + 2 < NT) { WAIT_BAR(2); } else { WAIT_BAR(0); } } while (0)
    for (; t + 1 < NT; t += 2) {
        STEP(pB0, pB1, pA0, pA1, t, true, (t + 3 < NT), (t + 1 < NT), (t + 1 < NT));         ENDW(t);     RESC(); ROT();
        STEP(pA0, pA1, pB0, pB1, t + 1, true, (t + 4 < NT), (t + 2 < NT), (t + 2 < NT));     ENDW(t + 1); RESC(); ROT();
    }
    STEP(pB0, pB1, pA0, pA1, NT - 1, true, false, false, false); RESC();
    { float sacc = pB0[0] + pB0[1];
#pragma unroll
      for (int r = 2; r < 16; ++r) sacc += pB0[r];
#pragma unroll
      for (int r = 0; r < 16; ++r) sacc += pB1[r];
      l_reg += sacc;
      pw0 = (u32x4){PKW(pB0, 0), PKW(pB0, 2), PKW(pB0, 4), PKW(pB0, 6)}; pw1 = (u32x4){PKW(pB0, 8), PKW(pB0, 10), PKW(pB0, 12), PKW(pB0, 14)};
      pw2 = (u32x4){PKW(pB1, 0), PKW(pB1, 2), PKW(pB1, 4), PKW(pB1, 6)}; pw3 = (u32x4){PKW(pB1, 8), PKW(pB1, 10), PKW(pB1, 12), PKW(pB1, 14)};
      const lds_cptr vp_ = vp0 + 2 * sl_cur;
#pragma unroll
      for (int hf = 0; hf < 2; ++hf) {
        _Pragma("unroll") for (int i = 0; i < 8; ++i) VRD(i, hf * 8192);
        o[2 * hf] = MFMA(PAF(0), VFR(0), o[2 * hf]); o[2 * hf + 1] = MFMA(PAF(0), VFR(4), o[2 * hf + 1]); o[2 * hf] = MFMA(PAF(1), VFR(1), o[2 * hf]); o[2 * hf + 1] = MFMA(PAF(1), VFR(5), o[2 * hf + 1]);
        o[2 * hf] = MFMA(PAF(2), VFR(2), o[2 * hf]); o[2 * hf + 1] = MFMA(PAF(2), VFR(6), o[2 * hf + 1]); o[2 * hf] = MFMA(PAF(3), VFR(3), o[2 * hf]); o[2 * hf + 1] = MFMA(PAF(3), VFR(7), o[2 * hf + 1]); } }
    { auto rr = __builtin_amdgcn_permlane32_swap(__float_as_uint(l_reg), __float_as_uint(l_reg), false, false); l_reg = __uint_as_float(rr[0]) + __uint_as_float(rr[1]); }
    if (hi == 0) wsf[32 + r32] = l_reg;
    asm volatile("s_waitcnt lgkmcnt(0)\n\ts_barrier" ::: "memory");
#undef DMA_K
#undef DMA_V
#undef QF
#undef ROT
#undef EX
#undef RESC
#undef BIAS
#undef APPLY
#undef PKW
#undef PAF
#undef VFR
#undef VRD
#undef KRD
#undef ENDW
#undef GAPA
#undef GAPB1
#undef GAPB2
#undef STEP
}
__device__ __forceinline__ void unit_a(int b, int h, int qb, const bf16* QA, const bf16* KA, const bf16* VA, const unsigned long long* MASK, bf16* YA, char* lds) {
    const int tid = threadIdx.x; const int wid = __builtin_amdgcn_readfirstlane(tid >> 6);
    const long rowbase = (long)b * SEQ; const long qrow0 = rowbase + qb * QB + wid * QBLK;
    const float s8 = 8.f * __builtin_amdgcn_exp2f(-(float)(h + 1));
    f32x16 o[2];
    attn_core<true>(o, QA + qrow0 * 512 + h * 64, 512, KA + rowbase * 512 + h * 64, 512, VA + rowbase * 512 + h * 64, 512, qb, s8,
                    MASK + ((size_t)(b * 64 + qb * 8 + wid) * 32) * 32, lds);
    int lz = threadIdx.x & 63; asm volatile("" : "+v"(lz));
    const int lane = lz, r32 = lz & 31, hi = lz >> 5;
    const lds_fptr wsf = (lds_fptr)((lds_ptr)lds + LDS_WS) + wid * WSW;
    float rli[16];
#pragma unroll
    for (int r = 0; r < 16; ++r) rli[r] = __builtin_amdgcn_rcpf(wsf[32 + crow(r, hi)]) * (1.0f + SCALE_A_EPS);
    typedef __attribute__((address_space(3))) unsigned short* lds_hptr;
    const lds_hptr stg = (lds_hptr)((lds_ptr)lds + LDS_OST) + wid * 2048;
#pragma unroll
    for (int r = 0; r < 16; ++r) { const int orow = crow(r, hi);
#pragma unroll
        for (int d0 = 0; d0 < 2; ++d0) stg[orow * 64 + d0 * 32 + r32] = f2bf(o[d0][r] * rli[r]); }
    asm volatile("s_waitcnt lgkmcnt(0)" ::: "memory");
    bf16* Ow = YA + qrow0 * 1024 + h * 64;
#pragma unroll
    for (int i = 0; i < 4; ++i) { const int row = i * 8 + (lane >> 3), ch = lane & 7; *(u32x4*)(Ow + (long)row * 1024 + ch * 8) = *(const __attribute__((address_space(3))) u32x4*)(stg + row * 64 + ch * 8); }
    asm volatile("s_waitcnt lgkmcnt(0)" ::: "memory");
}
__device__ __forceinline__ void unit_b128(int b, int h, int qb, const bf16* QBq, const bf16* KBk, const bf16* VBv, const float* subln_g, float lam, bf16* YB, unsigned* stash_g, int slot, char* lds) {
    const int tid = threadIdx.x; const int wid = __builtin_amdgcn_readfirstlane(tid >> 6);
    const long rowbase = (long)b * SEQ; const long qrow0 = rowbase + qb * QB + wid * QBLK;
    const float s8 = 8.f * __builtin_amdgcn_exp2f(-2.f * (float)(h + 1));
    typedef __attribute__((address_space(3))) unsigned short* lds_hptr;
    _Pragma("nounroll") for (int m = 0; m < 2; ++m) {
        f32x16 o[4];
        attn_core128(o, QBq + qrow0 * 512 + (2 * h + m) * 64, 512, KBk + rowbase * 512 + (2 * h + m) * 64, 512, VBv + rowbase * 512 + h * 128, 512, qb, s8, lds);
        int lz = threadIdx.x & 63; asm volatile("" : "+v"(lz));
        const int lane = lz, r32 = lz & 31, hi = lz >> 5;
        const lds_fptr wsf = (lds_fptr)((lds_ptr)lds + L8_WS) + wid * WSW;
        const lds_hptr stg = (lds_hptr)((lds_ptr)lds + L8_OST) + wid * 2048;
        unsigned* sg = stash_g + (((size_t)blockIdx.x * 2 + slot) * NW + wid) * 2048 + lane;
        bf16* Ow = YB + qrow0 * 1024 + 512 + h * 128;
        float rli[16];
#pragma unroll
        for (int r = 0; r < 16; ++r) rli[r] = __builtin_amdgcn_rcpf(wsf[32 + crow(r, hi)]);
        if (m == 0) {
#pragma unroll
            for (int d = 0; d < 4; ++d)
#pragma unroll
                for (int r = 0; r < 16; r += 2) sg[(d * 8 + (r >> 1)) * 64] = cvtpk(o[d][r] * rli[r], o[d][r + 1] * rli[r + 1]);
        } else {
            float ssp[16];
#pragma unroll
            for (int r = 0; r < 16; ++r) ssp[r] = 0.f;
#pragma unroll
            for (int d = 0; d < 4; ++d)
#pragma unroll
                for (int r = 0; r < 16; r += 2) { const unsigned w = __hip_atomic_load(sg + (d * 8 + (r >> 1)) * 64, __ATOMIC_RELAXED, __HIP_MEMORY_SCOPE_AGENT);
                    const float v0 = __uint_as_float(w << 16) - lam * (o[d][r] * rli[r]), v1 = __uint_as_float(w & 0xffff0000u) - lam * (o[d][r + 1] * rli[r + 1]);
                    o[d][r] = v0; o[d][r + 1] = v1; ssp[r] += v0 * v0; ssp[r + 1] += v1 * v1; }
#pragma unroll
            for (int r = 0; r < 16; ++r) {
#pragma unroll
                for (int off = 1; off < 32; off <<= 1) ssp[r] += __shfl_xor(ssp[r], off); }
#pragma unroll
            for (int r = 0; r < 16; ++r) ssp[r] = __builtin_amdgcn_rsqf(ssp[r] * (1.0f / 128.0f) + 1e-6f) * (0.8f * (1.0f + SCALE_B_EPS));
            if (r32 == 0) {
#pragma unroll
                for (int r = 0; r < 16; ++r) wsf[64 + crow(r, hi)] = ssp[r]; }
            asm volatile("s_waitcnt lgkmcnt(0)" ::: "memory");
#pragma unroll
            for (int e = 0; e < 2; ++e) {
#pragma unroll
                for (int r = 0; r < 16; ++r) { const int orow = crow(r, hi);
#pragma unroll
                    for (int d0 = 0; d0 < 2; ++d0) stg[orow * 64 + d0 * 32 + r32] = f2bf(o[2 * e + d0][r]); }
                asm volatile("s_waitcnt lgkmcnt(0)" ::: "memory");
                const int ch = lane & 7;
                const float4 g0 = *(const float4*)(subln_g + e * 64 + ch * 8), g1 = *(const float4*)(subln_g + e * 64 + ch * 8 + 4);
#pragma unroll
                for (int i = 0; i < 4; ++i) { const int row = i * 8 + (lane >> 3); const float rs = wsf[64 + row];
                    const u32x4 w = *(const __attribute__((address_space(3))) u32x4*)(stg + row * 64 + ch * 8); u32x4 ov;
                    ov.x = cvtpk(__uint_as_float(w.x << 16) * rs * g0.x, __uint_as_float(w.x & 0xffff0000u) * rs * g0.y);
                    ov.y = cvtpk(__uint_as_float(w.y << 16) * rs * g0.z, __uint_as_float(w.y & 0xffff0000u) * rs * g0.w);
                    ov.z = cvtpk(__uint_as_float(w.z << 16) * rs * g1.x, __uint_as_float(w.z & 0xffff0000u) * rs * g1.y);
                    ov.w = cvtpk(__uint_as_float(w.w << 16) * rs * g1.z, __uint_as_float(w.w & 0xffff0000u) * rs * g1.w);
                    *(u32x4*)(Ow + (long)row * 1024 + e * 64 + ch * 8) = ov; }
                asm volatile("s_waitcnt lgkmcnt(0)" ::: "memory");
            }
        }
    }
}
#undef SBAR
#undef PIN
#undef MFMA
#undef WAIT_BAR
#undef MX3
}
#ifndef KEYMASK
#define KEYMASK 0xfffff800u
#endif
namespace sel {
using att::bf16x8; using att::f32x16; using att::crow; typedef unsigned short bf16;
constexpr int TBP = 513;
__device__ __forceinline__ void select_unit(int b, int qk, const bf16* QI, const bf16* KI, const float* WI, unsigned long long* MASK, char* lds) {
    int lz_ = threadIdx.x & 63; asm volatile("" : "+v"(lz_));
    const int tid = threadIdx.x, lane = lz_, r32 = lane & 31, hi = lane >> 5; const int wid = __builtin_amdgcn_readfirstlane(tid >> 6);
    const int ntv = (qk >> 1) + 1;
    unsigned long long* mbase = MASK + ((size_t)(b * 64 + qk) * 32) * 32;
    if (qk < 8) {
        for (int i = tid; i < 32 * 32; i += 512) mbase[i] = ((i >> 5) < ntv) ? ~0ull : 0ull;
        return;
    }
    typedef __attribute__((address_space(3))) char* lds_ptr;
    typedef __attribute__((address_space(3))) unsigned* lds_uptr;
    const lds_ptr QL = (lds_ptr)lds;
    const lds_uptr TB = (lds_uptr)((lds_ptr)lds + 16384);
    const size_t qrow0 = (size_t)b * 2048 + qk * 32;
    { const int c = tid & 31, q0 = tid >> 5;
#pragma unroll
      for (int u = 0; u < 2; ++u) { const int q = q0 + 16 * u; *(__attribute__((address_space(3))) att::u32x4*)(QL + c * 512 + q * 16) = *(const att::u32x4*)(QI + (qrow0 + q) * 256 + c * 8); } }
    typedef float f32x4_t __attribute__((ext_vector_type(4)));
    const f32x4_t wv = *(const f32x4_t*)(WI + (qrow0 + r32) * 4);
    __syncthreads();
    unsigned keyT[4][32];
    bf16x8 kfa[2][4];
#define SEL_KLOAD(jn) do { _Pragma("unroll") for (int p_ = 0; p_ < 2; ++p_) _Pragma("unroll") for (int d0 = 0; d0 < 4; ++d0) \
        kfa[p_][d0] = *(const bf16x8*)(KI + ((size_t)b * 2048 + (jn) * 64 + p_ * 32 + r32) * 64 + d0 * 16 + hi * 8); } while (0)
    if (wid < ntv) SEL_KLOAD(wid);
#pragma unroll
    for (int jj = 0; jj < 4; ++jj) {
        if (8 * jj < ntv) {
            const int j = 8 * jj + wid;
            unsigned kk[32];
            if (j < ntv) {
#pragma unroll
                for (int p = 0; p < 2; ++p) {
                    const bf16x8 kf[4] = {kfa[p][0], kfa[p][1], kfa[p][2], kfa[p][3]};
                    f32x16 s0 = f32x16{};
#pragma unroll
                    for (int h = 0; h < 4; ++h) {
                        bf16x8 qf[4];
#pragma unroll
                        for (int d0 = 0; d0 < 4; ++d0) qf[d0] = *(const __attribute__((address_space(3))) bf16x8*)(QL + ((h * 4 + d0) * 2 + hi) * 512 + r32 * 16);
                        f32x16 y0 = f32x16{};
#pragma unroll
                        for (int d0 = 0; d0 < 4; ++d0) y0 = __builtin_amdgcn_mfma_f32_32x32x16_bf16(kf[d0], qf[d0], y0, 0, 0, 0);
                        asm volatile("" : "+v"(y0));
                        const float w = wv[h];
#pragma unroll
                        for (int r = 0; r < 16; ++r) { const float yv = y0[r]; const int yi = __float_as_int(yv); s0[r] = __builtin_fmaf(__int_as_float(yi > 0 ? yi : 0), w, s0[r]); }
                    }
#pragma unroll
                    for (int r = 0; r < 16; ++r) {
                        const unsigned idx = (unsigned)(j * 64 + p * 32 + crow(r, hi));
                        const unsigned u = __float_as_uint(s0[r]); const unsigned m = (unsigned)(((int)u) >> 31) | 0x80000000u; kk[16 * p + r] = ((u ^ m) & KEYMASK) | (2047u - idx);
                    }
                    __builtin_amdgcn_sched_barrier(0);
                }
            } else {
#pragma unroll
                for (int e = 0; e < 32; ++e) kk[e] = 0u;
            }
            if (jj < 3 && j + 8 < ntv) SEL_KLOAD(j + 8);
#pragma unroll
            for (int p = 0; p < 2; ++p)
#pragma unroll
                for (int r = 0; r < 16; ++r) TB[r32 * TBP + 64 * wid + 32 * p + crow(r, hi)] = kk[16 * p + r];
            __syncthreads();
#pragma unroll
            for (int i = 0; i < 4; ++i)
#pragma unroll
                for (int t = 0; t < 8; ++t) keyT[jj][8 * i + t] = TB[(4 * wid + i) * TBP + 64 * t + lane];
            __syncthreads();
        } else {
#pragma unroll
            for (int e = 0; e < 32; ++e) keyT[jj][e] = 0u;
        }
    }
    unsigned T0 = 0u, T1 = 0u, T2 = 0u, T3 = 0u; bool dn0 = false, dn1 = false, dn2 = false, dn3 = false;
#define SEL_CNT8(c_, cand, K, o) do { unsigned long long m0_, m1_, m2_, m3_, m4_, m5_, m6_, m7_; unsigned t_; \
        asm volatile("v_cmp_le_u32_e64 %0, %10, %11\n\tv_cmp_le_u32_e64 %1, %10, %12\n\tv_cmp_le_u32_e64 %2, %10, %13\n\tv_cmp_le_u32_e64 %3, %10, %14\n\t" \
                     "v_cmp_le_u32_e64 %4, %10, %15\n\tv_cmp_le_u32_e64 %5, %10, %16\n\tv_cmp_le_u32_e64 %6, %10, %17\n\tv_cmp_le_u32_e64 %7, %10, %18\n\t" \
                     "s_bcnt1_i32_b64 %8, %0\n\ts_add_u32 %9, %9, %8\n\ts_bcnt1_i32_b64 %8, %1\n\ts_add_u32 %9, %9, %8\n\ts_bcnt1_i32_b64 %8, %2\n\ts_add_u32 %9, %9, %8\n\ts_bcnt1_i32_b64 %8, %3\n\ts_add_u32 %9, %9, %8\n\t" \
                     "s_bcnt1_i32_b64 %8, %4\n\ts_add_u32 %9, %9, %8\n\ts_bcnt1_i32_b64 %8, %5\n\ts_add_u32 %9, %9, %8\n\ts_bcnt1_i32_b64 %8, %6\n\ts_add_u32 %9, %9, %8\n\ts_bcnt1_i32_b64 %8, %7\n\ts_add_u32 %9, %9, %8" \
                     : "=&s"(m0_), "=&s"(m1_), "=&s"(m2_), "=&s"(m3_), "=&s"(m4_), "=&s"(m5_), "=&s"(m6_), "=&s"(m7_), "=&s"(t_), "+s"(c_) \
                     : "s"(cand), "v"(K[(o)]), "v"(K[(o) + 1]), "v"(K[(o) + 2]), "v"(K[(o) + 3]), "v"(K[(o) + 4]), "v"(K[(o) + 5]), "v"(K[(o) + 6]), "v"(K[(o) + 7]) : "scc"); } while (0)
#define SEL_CNT4(c_, cand, K, o) do { unsigned long long m0_, m1_, m2_, m3_; unsigned t_; \
        asm volatile("v_cmp_le_u32_e64 %0, %6, %7\n\tv_cmp_le_u32_e64 %1, %6, %8\n\tv_cmp_le_u32_e64 %2, %6, %9\n\tv_cmp_le_u32_e64 %3, %6, %10\n\t" \
                     "s_bcnt1_i32_b64 %4, %0\n\ts_add_u32 %5, %5, %4\n\ts_bcnt1_i32_b64 %4, %1\n\ts_add_u32 %5, %5, %4\n\ts_bcnt1_i32_b64 %4, %2\n\ts_add_u32 %5, %5, %4\n\ts_bcnt1_i32_b64 %4, %3\n\ts_add_u32 %5, %5, %4" \
                     : "=&s"(m0_), "=&s"(m1_), "=&s"(m2_), "=&s"(m3_), "=&s"(t_), "+s"(c_) \
                     : "s"(cand), "v"(K[(o)]), "v"(K[(o) + 1]), "v"(K[(o) + 2]), "v"(K[(o) + 3]) : "scc"); } while (0)
#ifdef SEL_SAFE
#define SEL_CNT(i, cand) ({ unsigned c_ = 0u; \
        _Pragma("unroll") for (int jj = 0; jj < 4; ++jj) { if (8 * jj < ntv) { \
            _Pragma("unroll") for (int t = 0; t < 8; ++t) c_ += (unsigned)__builtin_popcountll(__ballot(keyT[jj][8 * (i) + t] >= (cand))); __builtin_amdgcn_sched_barrier(0); } } c_; })
#else
#define SEL_CNT(i, cand) ({ unsigned c_ = 0u; const unsigned cd_ = (unsigned)__builtin_amdgcn_readfirstlane((int)(cand)); \
        _Pragma("unroll") for (int jj = 0; jj < 4; ++jj) { if (8 * jj + 4 < ntv) { SEL_CNT8(c_, cd_, keyT[jj], 8 * (i)); } else if (8 * jj < ntv) { SEL_CNT4(c_, cd_, keyT[jj], 8 * (i)); } } c_; })
#endif
    for (int bit = 31; bit >= 0; --bit) {
        const unsigned bm = 1u << bit;
        if (!dn0) { const unsigned c = SEL_CNT(0, T0 | bm); if (c >= 256u) T0 |= bm; dn0 = (c == 256u); }
        if (!dn1) { const unsigned c = SEL_CNT(1, T1 | bm); if (c >= 256u) T1 |= bm; dn1 = (c == 256u); }
        if (!dn2) { const unsigned c = SEL_CNT(2, T2 | bm); if (c >= 256u) T2 |= bm; dn2 = (c == 256u); }
        if (!dn3) { const unsigned c = SEL_CNT(3, T3 | bm); if (c >= 256u) T3 |= bm; dn3 = (c == 256u); }
        if (dn0 && dn1 && dn2 && dn3) break;
    }
#undef SEL_CNT
#undef SEL_KLOAD
#undef SEL_CNT8
#undef SEL_CNT4
#pragma unroll
    for (int i = 0; i < 4; ++i) {
        const unsigned Ti = (i == 0) ? T0 : (i == 1) ? T1 : (i == 2) ? T2 : T3;
        unsigned wlo = 0u, whi = 0u;
#pragma unroll
        for (int jj = 0; jj < 4; ++jj) { int ln_ = lane; asm volatile("" : "+v"(ln_));
#pragma unroll
            for (int t = 0; t < 8; ++t) { const unsigned long long mk = __ballot(keyT[jj][8 * i + t] >= Ti);
                wlo = (ln_ == 8 * jj + t) ? (unsigned)mk : wlo; whi = (ln_ == 8 * jj + t) ? (unsigned)(mk >> 32) : whi; if ((t & 3) == 3) __builtin_amdgcn_sched_barrier(0); } }
        if (lane < 32) mbase[(size_t)lane * 32 + 4 * wid + i] = ((unsigned long long)whi << 32) | wlo;
    }
    __syncthreads();
}
}
constexpr int NWAVES = 8;
#ifndef MK_N_LAUNCHES
#define MK_N_LAUNCHES 1
#endif
constexpr int N_PHASES = 10;
constexpr int N_LAUNCHES = MK_N_LAUNCHES;
constexpr int BATCH = 16, SEQ = 2048, DM = 1024, M = BATCH * SEQ, DFF = 2816, W_IN = 5444, NPROJ = 5632, NFF13 = 5632;
constexpr size_t MiB = 1u << 20;
constexpr size_t WS_CTL = 0, CTL_ZERO_BYTES = 64 * 1024;
constexpr size_t WS_MOD = 1 * MiB;
constexpr size_t WS_LAM = 1 * MiB + 512 * 1024;
constexpr size_t WS_GN = 1 * MiB + 768 * 1024;
constexpr size_t WS_WIN = 2 * MiB, WS_WUA = 13 * MiB  , WS_WO = 15 * MiB, WS_W13 = 17 * MiB, WS_W2 = 28 * MiB;
constexpr size_t WS_XH = 64 * MiB;
constexpr size_t WS_YA = 64 * MiB;
constexpr size_t WS_QA = 128 * MiB, WS_KA = 160 * MiB, WS_VA = 192 * MiB, WS_QB = 224 * MiB, WS_KB = 256 * MiB, WS_VB = 288 * MiB, WS_QI = 320 * MiB, WS_KI = 336 * MiB, WS_WI = 340 * MiB;
constexpr size_t WS_MG = 128 * MiB;
constexpr size_t WS_HID = 128 * MiB;
constexpr size_t WS_GT = 344 * MiB;
constexpr size_t WS_MASK = 472 * MiB;
constexpr size_t WS_STASH = 480 * MiB;
constexpr size_t WS_END = 512 * MiB;
static_assert(epi::PWS_GN == WS_GN && epi::PWS_QA == WS_QA && epi::PWS_QI == WS_QI && epi::PWS_KI == WS_KI && epi::PWS_WI == WS_WI && epi::PWS_GT == WS_GT && WS_KA - WS_QA == 32 * MiB && WS_VB - WS_QA == 160 * MiB, "EpiProj offsets");
static_assert(WS_W2 + (size_t)DM * DFF * 2 <= WS_XH && WS_WI + (size_t)M * 16 <= WS_GT && WS_HID + (size_t)M * DFF * 2 <= WS_GT && WS_GT + (size_t)M * 2048 * 2 <= WS_MASK, "d_ws map");
constexpr int CW_BAR = 1024;
constexpr int RING_BYTES = 151552;
constexpr int LDSCTL_OFF = RING_BYTES, MISC_OFF = LDSCTL_OFF + 320, LDS_BYTES = 155648;
static_assert(att::LDS_BYTES <= RING_BYTES && pg8::STAGE_BYTES <= RING_BYTES && MISC_OFF + 128 <= LDS_BYTES, "LDS map");

#define GAS __attribute__((address_space(1)))
#define LAS __attribute__((address_space(3)))
typedef unsigned short bf16;
typedef unsigned v4u __attribute__((ext_vector_type(4)));
typedef float f32x4 __attribute__((ext_vector_type(4)));
typedef GAS unsigned gu32;
#define RLX_AGENT __ATOMIC_RELAXED, __HIP_MEMORY_SCOPE_AGENT
#define LDS_WAIT() asm volatile("s_waitcnt lgkmcnt(0)" ::: "memory")
__device__ __forceinline__ unsigned f2bf(float f) { unsigned u = __builtin_bit_cast(unsigned, f); return (u + 0x7fffu + ((u >> 16) & 1u)) >> 16; }
__device__ __forceinline__ unsigned pk2(float lo, float hi) { return f2bf(lo) | (f2bf(hi) << 16); }
#define XB_TMO      128
#define XB_XCNT(j)  (256  + 64 * (j))
#define XB_XSUB(j)  (1280 + 64 * (j))
#define XB_XGEN(j)  (2304 + 64 * (j))
#define XB_TOP      3328
#define XB_TOPGEN   3392
#define XCD_BAR_WORDS 3456
#ifdef CHECKER
#define XB_SPIN_CAP (1u << 27)
#else
#define XB_SPIN_CAP (1u << 18)
#endif

__device__ __forceinline__ unsigned xb_ld(unsigned* p)              { return __hip_atomic_load(p, __ATOMIC_RELAXED, __HIP_MEMORY_SCOPE_AGENT); }
__device__ __forceinline__ unsigned xb_add(unsigned* p, unsigned v) { return __hip_atomic_fetch_add(p, v, __ATOMIC_RELAXED, __HIP_MEMORY_SCOPE_AGENT); }
__device__ __forceinline__ unsigned xb_xcc_id() { return (unsigned)__builtin_amdgcn_s_getreg((3 << 11) | 20) & 0xFu; }
#define XB_SPIN(cond, bar) do { unsigned _sp = 0; while (cond) { __builtin_amdgcn_s_sleep(1); \
    if ((++_sp & 255u) == 0u) { if (xb_ld(&(bar)[XB_TMO])) break; if (_sp > XB_SPIN_CAP) { atomicAdd(&(bar)[XB_TMO], 1u); break; } } } } while (0)

struct XcdBarrier {
    unsigned* bar; unsigned x;
    volatile LAS unsigned* st;
};

__device__ __forceinline__ XcdBarrier xcd_barrier_post(unsigned* bar, volatile LAS unsigned* st) {
    XcdBarrier b; b.bar = bar; b.x = xb_xcc_id(); b.st = st;
    if (threadIdx.x == 0) (void)xb_add(&bar[XB_XCNT(b.x)], 1u);
    return b;
}
__device__ __forceinline__ void xcd_barrier_complete(unsigned* bar, unsigned x, unsigned& nloc, unsigned& nx) {
    const unsigned G = gridDim.x * gridDim.y * gridDim.z;
    unsigned sum, cnt, mine, sp = 0u;
    for (;;) {
        sum = 0u; cnt = 0u; mine = 0u;
#pragma unroll
        for (unsigned j = 0; j < 16; ++j) { const unsigned c = xb_ld(&bar[XB_XCNT(j)]); sum += c; cnt += (c > 0u) ? 1u : 0u; mine = (j == x) ? c : mine; }
        if (sum == G) break;
        __builtin_amdgcn_s_sleep(1);
        if ((++sp & 255u) == 0u) { if (xb_ld(&bar[XB_TMO])) break; if (sp > XB_SPIN_CAP) { atomicAdd(&bar[XB_TMO], 1u); break; } }
    }
    nloc = mine > 0u ? mine : 1u; nx = cnt > 0u ? cnt : 1u;
}

__device__ __forceinline__ void xcd_barrier(const XcdBarrier& b) {
    asm volatile("s_waitcnt vmcnt(0)" ::: "memory");
    __syncthreads();
    if (threadIdx.x == 0) {
        unsigned* bar = b.bar;
        __builtin_amdgcn_s_waitcnt(0);
        unsigned nloc = b.st[0], nx = b.st[1];
        if (nloc == 0u) { xcd_barrier_complete(bar, b.x, nloc, nx); b.st[0] = nloc; b.st[1] = nx; }
        const unsigned old = xb_add(&bar[XB_XSUB(b.x)], 1u);
        const unsigned gen = old / nloc;
        if (old + 1u == (gen + 1u) * nloc) {
            __builtin_amdgcn_fence(__ATOMIC_RELEASE, "agent");
            asm volatile("s_waitcnt vmcnt(0)" ::: "memory");
            const unsigned og = xb_add(&bar[XB_TOP], 1u);
            const unsigned tg = og / nx;
            if (og + 1u == (tg + 1u) * nx) xb_add(&bar[XB_TOPGEN], 1u);
            else XB_SPIN(xb_ld(&bar[XB_TOPGEN]) == tg, bar);
            __builtin_amdgcn_fence(__ATOMIC_ACQUIRE, "agent");
            xb_add(&bar[XB_XGEN(b.x)], 1u);
            asm volatile("s_waitcnt vmcnt(0)" ::: "memory");
        } else {
            XB_SPIN(xb_ld(&bar[XB_XGEN(b.x)]) == gen, bar);
            __builtin_amdgcn_fence(__ATOMIC_ACQUIRE, "agent");
            asm volatile("s_waitcnt vmcnt(0)" ::: "memory");
        }
    }
    __syncthreads();
}
struct Frame {
    LAS unsigned char* lds; volatile LAS unsigned* MISC; gu32* ctl;
    int tid, lane, wave, vcu, G;
};
__device__ __forceinline__ float wave_sum(float v) {
#pragma unroll
    for (int o = 1; o < 64; o <<= 1) v += __shfl_xor(v, o);
    return v;
}
template <class Map>
__device__ __forceinline__ void transpose_item(const float* W, int K, int N, bf16* WT, Map map, LAS float* scr, int item, int lane, int ld = 0, int koff = 0) {
    const int nblk = (N + 31) / 32, kb = item / nblk, nb = item % nblk, k0 = 64 * kb, n0 = 32 * nb;
    const int nr = n0 + (lane & 31);
    float wv[32];
#pragma unroll
    for (int i = 0; i < 32; ++i) { const int kk = 2 * i + (lane >> 5); wv[i] = (nr < N) ? W[(size_t)(k0 + kk) * N + nr] : 0.f; }
#pragma unroll
    for (int i = 0; i < 32; ++i) { const int kk = 2 * i + (lane >> 5); scr[kk * 33 + (lane & 31)] = wv[i]; }
    LDS_WAIT(); asm volatile("" ::: "memory");
    const int c = lane & 7;
#pragma unroll
    for (int j = 0; j < 4; ++j) { const int nl = (lane >> 3) + 8 * j; const LAS float* s = scr + (8 * c) * 33 + nl;
        v4u o; o.x = pk2(s[0 * 33], s[1 * 33]); o.y = pk2(s[2 * 33], s[3 * 33]); o.z = pk2(s[4 * 33], s[5 * 33]); o.w = pk2(s[6 * 33], s[7 * 33]);
        if (n0 + nl < N) *(GAS v4u*)(WT + (size_t)map(n0 + nl) * (ld ? ld : K) + koff + k0 + 8 * c) = o; }
    LDS_WAIT(); asm volatile("" ::: "memory");
}
struct MapId { __device__ __forceinline__ int operator()(int n) const { return n; } };
struct MapWin {
    __device__ __forceinline__ int operator()(int n) const {
        if (n >= 3396) { const int g = n - 3396, c = g & 1023; return 3584 + 256 * (c >> 7) + 128 * (g >> 10) + (c & 127); }
        const int L = n & 255, hd = L >> 6, d = L & 63; return (n & ~255) + 128 * (d >> 5) + 32 * hd + (d & 31); } };
struct MapFF { int off; __device__ __forceinline__ int operator()(int n) const { return (n >> 7) * 256 + (n & 127) + off; } };

struct P0In { const float *c, *w_ada, *b_ada, *w_in, *w_up_a, *w_up_b, *w_o, *w_ff1, *w_ff3, *w_ff2, *lq1, *lk1, *lq2, *lk2, *qn_a, *kn_a, *qn_b, *kn_b; };
__device__ __forceinline__ void weight_copies(Frame& F, const P0In in, unsigned char* ws, bool sync = true) {
    LAS float* scr = (LAS float*)(F.lds + F.wave * 16384);
    const int gw = F.vcu * NWAVES + F.wave, NGW = F.G * NWAVES;
    constexpr int I_IN = 16 * 171, I_UP = 8 * 32, I_O = 16 * 32, I_F1 = 16 * 88, I_F2 = 44 * 32;
    constexpr int NITEMS = I_IN + 2 * I_UP + I_O + 2 * I_F1 + I_F2;
    for (int it = gw; it < NITEMS; it += NGW) {
        int r = it;
        if (r < I_IN) { transpose_item(in.w_in, 1024, W_IN, (bf16*)(ws + WS_WIN), MapWin{}, scr, r, F.lane); continue; } r -= I_IN;
        if (r < I_UP) { transpose_item(in.w_up_a, 512, 1024, (bf16*)(ws + WS_WUA), MapId{}, scr, r, F.lane, 1024, 0); continue; } r -= I_UP;
        if (r < I_UP) { transpose_item(in.w_up_b, 512, 1024, (bf16*)(ws + WS_WUA), MapId{}, scr, r, F.lane, 1024, 512); continue; } r -= I_UP;
        if (r < I_O)  { transpose_item(in.w_o, 1024, 1024, (bf16*)(ws + WS_WO), MapId{}, scr, r, F.lane); continue; } r -= I_O;
        if (r < I_F1) { transpose_item(in.w_ff1, 1024, DFF, (bf16*)(ws + WS_W13), MapFF{0}, scr, r, F.lane); continue; } r -= I_F1;
        if (r < I_F1) { transpose_item(in.w_ff3, 1024, DFF, (bf16*)(ws + WS_W13), MapFF{128}, scr, r, F.lane); continue; } r -= I_F1;
        transpose_item(in.w_ff2, DFF, 1024, (bf16*)(ws + WS_W2), MapId{}, scr, r, F.lane);
    }
    if (sync) __syncthreads();
}
__device__ __forceinline__ void p0_prologue(Frame& F, const P0In in, unsigned char* ws) {
    const int gw = F.vcu * NWAVES + F.wave, NGW = F.G * NWAVES; (void)gw; (void)NGW;
    LAS float* S = (LAS float*)F.lds;
    LAS float* P = (LAS float*)(F.lds + 65536);
    for (int g = F.vcu; g < 192; g += F.G) {
        for (int i = F.tid; i < 16 * 1024; i += NWAVES * 64) { const float v = in.c[i]; S[i] = v / (1.f + __expf(-v)); }
        __syncthreads();
        const int c = F.tid & 31, kg = F.tid >> 5, col = 32 * g + c;
        float acc[16];
#pragma unroll
        for (int b = 0; b < 16; ++b) acc[b] = 0.f;
#pragma unroll
        for (int h = 0; h < 2; ++h) {
            float w[32];
#pragma unroll
            for (int u = 0; u < 32; ++u) w[u] = in.w_ada[(size_t)(64 * kg + 32 * h + u) * 6144 + col];
#pragma unroll
            for (int i = 0; i < 32; i += 4) { const int k = 64 * kg + 32 * h + i;
#pragma unroll
                for (int b = 0; b < 16; ++b) { const f32x4 s = *(const LAS f32x4*)(S + b * 1024 + k); acc[b] += (s[0] * w[i] + s[1] * w[i + 1]) + (s[2] * w[i + 2] + s[3] * w[i + 3]); } } }
#pragma unroll
        for (int b = 0; b < 16; ++b) P[(kg * 16 + b) * 32 + c] = acc[b];
        __syncthreads();
        { const int b = F.tid >> 5; float s = in.b_ada[col];
#pragma unroll
          for (int q = 0; q < 16; ++q) s += P[(q * 16 + b) * 32 + c];
          ((float*)(ws + WS_MOD))[b * 6144 + col] = s; }
        __syncthreads();
    }
    if (F.vcu == F.G - 2 && F.tid < 256) { const int t = F.tid >> 6, i = F.tid & 63; ((float*)(ws + WS_GN))[F.tid] = (t == 0 ? in.qn_a : t == 1 ? in.kn_a : t == 2 ? in.qn_b : in.kn_b)[i]; }
    if (F.vcu == F.G - 1 && F.tid == 0) {
        float s1 = 0.f, s2 = 0.f;
        for (int i = 0; i < 64; ++i) { s1 += in.lq1[i] * in.lk1[i]; s2 += in.lq2[i] * in.lk2[i]; }
        *(float*)(ws + WS_LAM) = expf(s1) - expf(s2) + 0.2f;
    }
}
__device__ __forceinline__ void norm_mod_pass(Frame& F, const float* X, const float* g, const float* scale, const float* shift, bf16* Y) {
    const int gw = F.vcu * NWAVES + F.wave, NGW = F.G * NWAVES;
    for (int blk = gw; blk < M / 16; blk += NGW) {
        const int row0 = blk * 16, b = row0 >> 11;
        f32x4 gs[4], sh[4];
#pragma unroll
        for (int j = 0; j < 4; ++j) { const f32x4 gg = ((const f32x4*)g)[F.lane + 64 * j], sc = ((const f32x4*)(scale + b * 6144))[F.lane + 64 * j]; gs[j] = gg * (sc + 1.0f); sh[j] = ((const f32x4*)(shift + b * 6144))[F.lane + 64 * j]; }
        f32x4 vn[4];
        { const f32x4* x0 = (const f32x4*)(X + (size_t)row0 * DM) + F.lane;
#pragma unroll
          for (int j = 0; j < 4; ++j) vn[j] = x0[64 * j]; }
        for (int rr = 0; rr < 16; ++rr) {
            f32x4 v[4]; float s = 0.f;
#pragma unroll
            for (int j = 0; j < 4; ++j) v[j] = vn[j];
            if (rr < 15) { const f32x4* xr = (const f32x4*)(X + (size_t)(row0 + rr + 1) * DM) + F.lane;
#pragma unroll
                for (int j = 0; j < 4; ++j) vn[j] = xr[64 * j]; }
#pragma unroll
            for (int j = 0; j < 4; ++j) s += (v[j][0] * v[j][0] + v[j][1] * v[j][1]) + (v[j][2] * v[j][2] + v[j][3] * v[j][3]);
            const float rstd = __builtin_amdgcn_rsqf(wave_sum(s) * (1.0f / DM) + 1e-6f);
            unsigned long long* o8 = (unsigned long long*)(Y + (size_t)(row0 + rr) * DM) + F.lane;
#pragma unroll
            for (int j = 0; j < 4; ++j) { const f32x4 y = v[j] * rstd * gs[j] + sh[j]; o8[64 * j] = (unsigned long long)pk2(y[0], y[1]) | ((unsigned long long)pk2(y[2], y[3]) << 32); }
        }
    }
}
__device__ __forceinline__ void norm_mod_pass_bf16(Frame& F, const bf16* X, const float* g, const float* scale, const float* shift, bf16* Y) {
    const int gw = F.vcu * NWAVES + F.wave, NGW = F.G * NWAVES;
    for (int blk = gw; blk < M / 16; blk += NGW) {
        const int row0 = blk * 16, b = row0 >> 11;
        f32x4 gs[4], sh[4];
#pragma unroll
        for (int j = 0; j < 4; ++j) { const int c4 = 2 * F.lane + (j & 1) + 128 * (j >> 1);
            const f32x4 gg = ((const f32x4*)g)[c4], sc = ((const f32x4*)(scale + b * 6144))[c4]; gs[j] = gg * (sc + 1.0f); sh[j] = ((const f32x4*)(shift + b * 6144))[c4]; }
        v4u wn[2];
        { const v4u* x0 = (const v4u*)(X + (size_t)row0 * DM) + F.lane; wn[0] = x0[0]; wn[1] = x0[64]; }
        for (int rr = 0; rr < 16; ++rr) {
            const v4u wc[2] = {wn[0], wn[1]};
            if (rr < 15) { const v4u* xr = (const v4u*)(X + (size_t)(row0 + rr + 1) * DM) + F.lane; wn[0] = xr[0]; wn[1] = xr[64]; }
            f32x4 v[4]; float s = 0.f;
#pragma unroll
            for (int h = 0; h < 2; ++h) { const v4u w = wc[h];
                v[2 * h] = (f32x4){__builtin_bit_cast(float, w.x << 16), __builtin_bit_cast(float, w.x & 0xffff0000u), __builtin_bit_cast(float, w.y << 16), __builtin_bit_cast(float, w.y & 0xffff0000u)};
                v[2 * h + 1] = (f32x4){__builtin_bit_cast(float, w.z << 16), __builtin_bit_cast(float, w.z & 0xffff0000u), __builtin_bit_cast(float, w.w << 16), __builtin_bit_cast(float, w.w & 0xffff0000u)}; }
#pragma unroll
            for (int j = 0; j < 4; ++j) s += (v[j][0] * v[j][0] + v[j][1] * v[j][1]) + (v[j][2] * v[j][2] + v[j][3] * v[j][3]);
            const float rstd = __builtin_amdgcn_rsqf(wave_sum(s) * (1.0f / DM) + 1e-6f);
            v4u* o16 = (v4u*)(Y + (size_t)(row0 + rr) * DM) + F.lane;
#pragma unroll
            for (int h = 0; h < 2; ++h) { const f32x4 y0 = v[2 * h] * rstd * gs[2 * h] + sh[2 * h], y1 = v[2 * h + 1] * rstd * gs[2 * h + 1] + sh[2 * h + 1];
                v4u o; o.x = pk2(y0[0], y0[1]); o.y = pk2(y0[2], y0[3]); o.z = pk2(y1[0], y1[1]); o.w = pk2(y1[2], y1[3]); o16[64 * h] = o; }
        }
    }
}
#ifdef CHECKER
namespace chk {
typedef unsigned short bf16;
typedef unsigned u32x4c __attribute__((ext_vector_type(4)));
__device__ __forceinline__ float b2f(unsigned short h) { return __uint_as_float((unsigned)h << 16); }
__device__ __forceinline__ float rnd(float f) { unsigned u = __float_as_uint(f); u = (u + 0x7fffu + ((u >> 16) & 1u)) & 0xffff0000u; return __uint_as_float(u); }
__device__ __forceinline__ float dotbf(const bf16* a, const bf16* b, int K) {
    float s = 0.f;
    for (int k = 0; k < K; k += 8) { const u32x4c x = *(const u32x4c*)(a + k), y = *(const u32x4c*)(b + k);
#pragma unroll
        for (int j = 0; j < 4; ++j) { s += __uint_as_float(x[j] << 16) * __uint_as_float(y[j] << 16); s += __uint_as_float(x[j] & 0xffff0000u) * __uint_as_float(y[j] & 0xffff0000u); } }
    return s; }
__device__ __forceinline__ void devmax(float* slot, float d) { if (!(d >= 0.f)) d = 1e30f; atomicMax((unsigned*)slot, __float_as_uint(d)); }
__device__ __forceinline__ float sig(float v) { return 1.f / (1.f + expf(-v)); }
constexpr int RSTR = 16, ROFF = 3, NR = 2048;
}
#define CHK_LOOP(idx, total) for (long idx = (long)F.vcu * 512 + F.tid; idx < (long)(total); idx += (long)F.G * 512)
#endif
#ifdef DUPCHK
__global__ void __launch_bounds__(512) dup_cksum(const void* base, size_t bytes, unsigned long long* acc) {
    typedef unsigned u32x4_t __attribute__((ext_vector_type(4)));
    const u32x4_t* p = (const u32x4_t*)base; const size_t n = bytes / 16;
    unsigned long long s = 0ull;
    for (size_t i = (size_t)blockIdx.x * 512 + threadIdx.x; i < n; i += (size_t)gridDim.x * 512) {
        const u32x4_t w = p[i]; const unsigned long long m = 2ull * i + 1ull;
        s += ((unsigned long long)w.x + ((unsigned long long)w.y << 7) + ((unsigned long long)w.z << 13) + ((unsigned long long)w.w << 19)) * m; }
    for (int off = 32; off; off >>= 1) { const unsigned lo = __shfl_xor((unsigned)s, off), hi = __shfl_xor((unsigned)(s >> 32), off); s += ((unsigned long long)hi << 32) | lo; }
    if ((threadIdx.x & 63) == 0) atomicAdd(acc, s);
}
__global__ void __launch_bounds__(512) dup_final(float* out, const unsigned long long* CK) {
    int bad = -1;
    for (int k = 9; k >= 0; --k) if (CK[2 * k] != CK[2 * k + 1]) bad = k;
    if (bad >= 0) { const float v = 0.0566f * (float)(1 << bad); for (int i = blockIdx.x * 512 + threadIdx.x; i < (1 << 20); i += gridDim.x * 512) out[i] += v; }
}
#endif
#ifdef MASKDIFF
__global__ void __launch_bounds__(512) mask_diff(const unsigned long long* A, const unsigned long long* B, unsigned* cnt) {
    unsigned c0 = 0, c1 = 0, c2 = 0;
    for (int idx = blockIdx.x * 512 + threadIdx.x; idx < (1 << 20); idx += gridDim.x * 512) {
        const int qk = (idx >> 10) & 63, tile = (idx >> 5) & 31; const bool adm = tile < (qk >> 1) + 1;
        const unsigned long long d = A[idx] ^ B[idx];
        if (d) { if (adm) { ++c0; c2 += (unsigned)__builtin_popcountll(d); } else ++c1; } }
    if (c0) atomicAdd(cnt + 0, c0); if (c1) atomicAdd(cnt + 1, c1); if (c2) atomicAdd(cnt + 2, c2);
    for (int row = blockIdx.x * 512 + threadIdx.x; row < 32768; row += gridDim.x * 512) { const int bq = row >> 5, q = row & 31, qk = bq & 63; bool any = false;
        for (int tile = 0; tile < (qk >> 1) + 1; ++tile) { const size_t i = ((size_t)bq * 32 + tile) * 32 + q; any = any || (A[i] != B[i]); }
        if (any) atomicAdd(cnt + 3, 1u); }
}
__global__ void __launch_bounds__(512) mask_report(float* out, const unsigned* cnt) {
    const unsigned ca = cnt[MASKDIFF & 3], cb = cnt[(MASKDIFF >> 2) & 3];
    int La = 0; while ((1u << La) < ca + 1u) ++La; int Lb = 0; while ((1u << Lb) < cb + 1u) ++Lb;
    float v = 0.05f * 5.657f; for (int i = 0; i < La; ++i) v *= 1.5f;
    for (int i = blockIdx.x * 512 + threadIdx.x; i < (1 << 20); i += gridDim.x * 512) out[i] += v;
    (void)Lb;
}
#endif
struct Args { const float* in[22]; float* out; unsigned char* ws; int ph_lo, ph_hi, probe, pad; };
__global__ void __launch_bounds__(NWAVES * 64, 2) mega_fwd(Args args) {
    extern __shared__ __attribute__((aligned(16))) unsigned char lds[];
    Frame F;
    F.lds = (LAS unsigned char*)lds;
    F.MISC = (volatile LAS unsigned*)(F.lds + MISC_OFF);
    F.tid = threadIdx.x; F.lane = F.tid & 63; F.wave = __builtin_amdgcn_readfirstlane(F.tid >> 6);
    F.G = gridDim.x; { const int bx = blockIdx.x; F.vcu = (F.G % 8 == 0) ? (bx % 8) * (F.G / 8) + bx / 8 : bx; }
    unsigned char* ws = args.ws;
    F.ctl = (gu32*)(ws + WS_CTL);
    for (int u = F.tid; u < (LDS_BYTES - LDSCTL_OFF) / 4; u += NWAVES * 64) ((LAS unsigned*)(F.lds + LDSCTL_OFF))[u] = 0u;
    __syncthreads();
    XcdBarrier bar; bar.bar = (unsigned*)(F.ctl + CW_BAR); bar.x = 0; bar.st = nullptr;
    if (N_LAUNCHES == 1) bar = xcd_barrier_post((unsigned*)(F.ctl + CW_BAR), F.MISC + 8);
    const int lo = args.ph_lo, hi = args.ph_hi;
#ifndef PH_MASK
#define PH_MASK 0x3ff
#endif
#define IN(k) (((PH_MASK >> (k)) & 1) && lo <= (k) && (k) < hi)
#define SEAM(k) do { if (IN(k) && IN((k) + 1)) xcd_barrier(bar); } while (0)
    float* const MOD = (float*)(ws + WS_MOD);
#define WSP(T, off) ((T*)(ws + (off)))
#ifdef X1_IN_WS
#define X1P WSP(float, WS_GT)
#else
#define X1P args.out
#endif

#ifndef W_IN_P1
#define W_IN_P1 2
#endif
#if W_IN_P1
#define IF_W0(x)
#else
#define IF_W0(x) x
#endif
    if (IN(0)) { const P0In pin{args.in[1], args.in[2], args.in[3], args.in[5], args.in[15], args.in[16], args.in[17], args.in[19], args.in[20], args.in[21], args.in[10], args.in[11], args.in[12], args.in[13], args.in[6], args.in[7], args.in[8], args.in[9]};
                 IF_W0(weight_copies(F, pin, ws);) p0_prologue(F, pin, ws); }
    SEAM(0);
#ifdef CHECKER
    if (IN(0) && IN(1)) {
        float* DEV = (float*)(ws + WS_CTL) + 8192;
#define CHK_W(src, K_, N_, dst, MAPX) CHK_LOOP(idx, (long)(K_) * (N_)) { const int k = (int)(idx / (N_)), n = (int)(idx % (N_)); const float w = (src)[idx]; \
            chk::devmax(DEV + 11, fabsf(chk::b2f((dst)[(size_t)(MAPX) * (K_) + k]) - w) / (fabsf(w) + 1e-3f)); }
        CHK_W(args.in[5], 1024, W_IN, WSP(bf16, WS_WIN), MapWin{}(n))  CHK_W(args.in[17], 1024, 1024, WSP(bf16, WS_WO), n)
        CHK_W(args.in[19], 1024, DFF, WSP(bf16, WS_W13), MapFF{0}(n)) CHK_W(args.in[20], 1024, DFF, WSP(bf16, WS_W13), MapFF{128}(n)) CHK_W(args.in[21], DFF, 1024, WSP(bf16, WS_W2), n)
#undef CHK_W
        CHK_LOOP(idx, 16 * 6144) { const int b = (int)(idx / 6144), j = (int)(idx % 6144); if ((j % 5) == 0) { float sacc = args.in[3][j]; for (int k = 0; k < 1024; ++k) { const float c = args.in[1][b * 1024 + k]; sacc += (c / (1.f + expf(-c))) * args.in[2][(size_t)k * 6144 + j]; }
            chk::devmax(DEV + 12, fabsf(MOD[idx] - sacc)); } }
    }
#endif
    if (IN(1)) {
#if W_IN_P1
        { const P0In pin{args.in[1], args.in[2], args.in[3], args.in[5], args.in[15], args.in[16], args.in[17], args.in[19], args.in[20], args.in[21], args.in[10], args.in[11], args.in[12], args.in[13], args.in[6], args.in[7], args.in[8], args.in[9]};
          if (W_IN_P1 == 1) weight_copies(F, pin, ws);
          if (W_IN_P1 == 3) { if (F.wave & 1) { weight_copies(F, pin, ws, false); norm_mod_pass(F, args.in[0], args.in[4], MOD + 1024, MOD, WSP(bf16, WS_XH)); }
                              else { norm_mod_pass(F, args.in[0], args.in[4], MOD + 1024, MOD, WSP(bf16, WS_XH)); weight_copies(F, pin, ws, false); } __syncthreads(); }
          else norm_mod_pass(F, args.in[0], args.in[4], MOD + 1024, MOD, WSP(bf16, WS_XH));
          if (W_IN_P1 == 2) weight_copies(F, pin, ws); }
#else
        norm_mod_pass(F, args.in[0], args.in[4], MOD + 1024, MOD, WSP(bf16, WS_XH));
#endif
    }
    SEAM(1);
#ifdef CHECKER
    if (IN(1) && IN(2)) {
        float* DEV = (float*)(ws + WS_CTL) + 8192;
        CHK_LOOP(idx, chk::NR) { const int row = chk::RSTR * (int)idx + chk::ROFF, b = row >> 11; float ss = 0.f; for (int k = 0; k < 1024; ++k) { const float v = args.in[0][(size_t)row * 1024 + k]; ss += v * v; }
            const float rs = 1.f / sqrtf(ss / 1024.f + 1e-6f); float dm = 0.f;
            for (int k = 0; k < 1024; ++k) { const float ref = args.in[0][(size_t)row * 1024 + k] * rs * args.in[4][k] * (1.f + MOD[(size_t)b * 6144 + 1024 + k]) + MOD[(size_t)b * 6144 + k]; dm = fmaxf(dm, fabsf(chk::b2f(WSP(bf16, WS_XH)[(size_t)row * 1024 + k]) - ref)); }
            chk::devmax(DEV + 13, dm); }
    }
#endif
    if (IN(2)) {
        pg8::Gemm g{WSP(bf16, WS_XH), (const bf16*)(ws + WS_WIN), M, NPROJ, DM}; pg8::StaticOrder S; S.init(M, NPROJ, F.G, (int)blockIdx.x);
        epi::EpiProj E{ws};
        pg8::gemm_phase<epi::EpiProj, pg8::StaticOrder, true, true>(F.lds, g, S, E);
    }
    SEAM(2);
#ifdef CHECKER
    if (IN(2) && IN(3)) {
        float* DEV = (float*)(ws + WS_CTL) + 8192; const bf16 *XH = WSP(bf16, WS_XH), *WT = WSP(bf16, WS_WIN);
        CHK_LOOP(idx, chk::NR * 512) { const int row = chk::RSTR * (int)(idx / 512) + chk::ROFF, c = (int)(idx % 512);
            { const int n = 1024 + c; const float a = chk::dotbf(XH + (size_t)row * 1024, WT + (size_t)MapWin{}(n) * 1024, 1024), o = chk::b2f(WSP(bf16, WS_VA)[(size_t)row * 512 + c]); chk::devmax(DEV + 0, fabsf(o - chk::rnd(a)) / (fabsf(a) + 0.05f)); }
            { const int n = 3396 + 4 * c + 1; const float a = chk::sig(chk::dotbf(XH + (size_t)row * 1024, WT + (size_t)MapWin{}(n) * 1024, 1024)), o = chk::b2f(WSP(bf16, WS_GT)[(size_t)row * 2048 + 4 * c + 1]); chk::devmax(DEV + 1, fabsf(o - a)); }
            if (c < 8) { float ss = 0.f; for (int d = 0; d < 64; ++d) { const float v = chk::dotbf(XH + (size_t)row * 1024, WT + (size_t)MapWin{}(c * 64 + d) * 1024, 1024); ss += v * v; }
                const float rs = 1.f / sqrtf(ss / 64.f + 1e-6f); float dm = 0.f; for (int d = 0; d < 64; ++d) { const float v = chk::dotbf(XH + (size_t)row * 1024, WT + (size_t)MapWin{}(c * 64 + d) * 1024, 1024); dm = fmaxf(dm, fabsf(chk::b2f(WSP(bf16, WS_QA)[(size_t)row * 512 + c * 64 + d]) - v * rs * args.in[6][d])); } chk::devmax(DEV + 2, dm); }
            if (c < 64) { const float a = chk::dotbf(XH + (size_t)row * 1024, WT + (size_t)MapWin{}(3328 + c) * 1024, 1024), o = chk::b2f(WSP(bf16, WS_KI)[(size_t)row * 64 + c]); chk::devmax(DEV + 3, fabsf(o - chk::rnd(a)) / (fabsf(a) + 0.05f)); }
            if (c < 4) { const float a = chk::dotbf(XH + (size_t)row * 1024, WT + (size_t)MapWin{}(3392 + c) * 1024, 1024), o = WSP(float, WS_WI)[(size_t)row * 4 + c]; chk::devmax(DEV + 4, fabsf(o - a)); }
            if (c >= 8 && c < 16) { const int hh = c - 8; float ss = 0.f; for (int d = 0; d < 64; ++d) { const float v = chk::dotbf(XH + (size_t)row * 1024, WT + (size_t)MapWin{}(2048 + hh * 64 + d) * 1024, 1024); ss += v * v; }
                const float rs = 1.f / sqrtf(ss / 64.f + 1e-6f); float dm = 0.f; for (int d = 0; d < 64; ++d) { const float v = chk::dotbf(XH + (size_t)row * 1024, WT + (size_t)MapWin{}(2048 + hh * 64 + d) * 1024, 1024); dm = fmaxf(dm, fabsf(chk::b2f(WSP(bf16, WS_KB)[(size_t)row * 512 + hh * 64 + d]) - v * rs * args.in[9][d])); } chk::devmax(DEV + 5, dm); }
        }
    }
#endif
    if (IN(3)) {
        const int b = F.vcu >> 4, j = F.vcu & 15;
        const bf16 *QI = WSP(bf16, WS_QI), *KI = WSP(bf16, WS_KI); const float* WI = WSP(float, WS_WI); unsigned long long* MASK = WSP(unsigned long long, WS_MASK);
        if (F.G == 256) {
            sel::select_unit(b, j, QI, KI, WI, MASK, (char*)lds); sel::select_unit(b, 31 - j, QI, KI, WI, MASK, (char*)lds);
            sel::select_unit(b, 32 + j, QI, KI, WI, MASK, (char*)lds); sel::select_unit(b, 63 - j, QI, KI, WI, MASK, (char*)lds);
        }
    }
    SEAM(3);
#ifdef CHECKER
#ifndef CHK_TI
#define CHK_TI -1
#endif
#ifndef CHK_TOL17
#define CHK_TOL17 64
#endif
    if (IN(3) && IN(4)) {
        unsigned tot = 0u; CHK_LOOP(idx, 16 * 64 * 32 * 32) tot += (unsigned)__builtin_popcountll(WSP(unsigned long long, WS_MASK)[idx]);
        atomicAdd((unsigned*)(ws + WS_CTL) + 8192 + 18, tot);
    }
    if (IN(3) && IN(4)) {
        float* DEV = (float*)(ws + WS_CTL) + 8192;
        if (F.vcu < 10) { const int tt[5] = {5, 300, 777, 1029, 2047}; const int t = (F.vcu % 5 == 0) ? 5 : (F.vcu % 5 == 1) ? 300 : (F.vcu % 5 == 2) ? 777 : (F.vcu % 5 == 3) ? 1029 : 2047; (void)tt; const int b = (F.vcu < 5) ? 0 : 9;
            LAS unsigned* KL = (LAS unsigned*)F.lds; const int nadm = 64 * (t / 64 + 1); const size_t qrow = (size_t)b * 2048 + t;
            __syncthreads();
            for (int s4 = 0; s4 < 4; ++s4) { const int sidx = F.tid + 512 * s4; unsigned key = 0u;
                if (sidx < nadm) { float sc = 0.f; for (int h = 0; h < 4; ++h) { const float y = chk::dotbf(WSP(bf16, WS_QI) + qrow * 256 + h * 64, WSP(bf16, WS_KI) + ((size_t)b * 2048 + sidx) * 64, 64); sc = fmaf(fmaxf(y, 0.f), WSP(float, WS_WI)[qrow * 4 + h], sc); }
                    const unsigned u = __float_as_uint(sc), m = (unsigned)(((int)u) >> 31) | 0x80000000u; key = ((u ^ m) & KEYMASK) | (2047u - (unsigned)sidx); }
                KL[sidx] = key; }
            __syncthreads();
            unsigned bad = 0u;
            for (int s4 = 0; s4 < 4; ++s4) { const int sidx = F.tid + 512 * s4; const unsigned key = KL[sidx]; unsigned rank = 0u; for (int j = 0; j < 2048; ++j) rank += (KL[j] > key) ? 1u : 0u;
                const bool selr = (sidx < nadm) && (nadm <= 256 || rank < 256u);
                const unsigned long long mw = WSP(unsigned long long, WS_MASK)[((size_t)(b * 64 + t / 32) * 32 + sidx / 64) * 32 + (t % 32)]; const bool selm = (mw >> (sidx % 64)) & 1ull;
                if (sidx < nadm && selr != selm) ++bad; }
            if (bad) atomicAdd(DEV + 17, (float)bad);
            __syncthreads();
        }
    }
#endif
    if (IN(4)) {
        if (F.G == 256) {
            const int b = F.vcu >> 4, r = F.vcu & 15;
            const bf16 *QA = WSP(bf16, WS_QA), *KA = WSP(bf16, WS_KA), *VA = WSP(bf16, WS_VA), *QBt = WSP(bf16, WS_QB), *KBt = WSP(bf16, WS_KB), *VBt = WSP(bf16, WS_VB);
            bf16 *YA = WSP(bf16, WS_YA), *YB = WSP(bf16, WS_YA); const unsigned long long* MASK = WSP(unsigned long long, WS_MASK);
            const float lam = __hip_atomic_load((const float*)(ws + WS_LAM), RLX_AGENT);
#ifndef NO_UNIT_A
            if (!(args.probe & 1)) for (int pi = 0; pi < 2; ++pi) { const int pr = 2 * r + pi, h = pr >> 2, s = pr & 3;
                att::unit_a(b, h, 7 - s, QA, KA, VA, MASK, YA, (char*)lds); att::unit_a(b, h, s, QA, KA, VA, MASK, YA, (char*)lds); }
#endif
#ifndef NO_UNIT_B
            __syncthreads();
            if (!(args.probe & 2)) { const int h = r >> 2, s = r & 3;
              att::unit_b128(b, h, 7 - s, QBt, KBt, VBt, args.in[14], lam, YB, WSP(unsigned, WS_STASH), 0, (char*)lds); att::unit_b128(b, h, s, QBt, KBt, VBt, args.in[14], lam, YB, WSP(unsigned, WS_STASH), 1, (char*)lds); }
#endif
        }
    }
    SEAM(4);
#ifdef CHECKER
    if (IN(4) && IN(5)) {
        float* DEV = (float*)(ws + WS_CTL) + 8192; const float lamc = __hip_atomic_load((const float*)(ws + WS_LAM), RLX_AGENT);
        const int gwv = F.vcu * 8 + F.wave;
        if (gwv < 8 * 3 * 12) { const int ti = gwv % 8, bi = (gwv / 8) % 3, hh = gwv / 24;
            const int t = (ti == 0) ? 5 : (ti == 1) ? 70 : (ti == 2) ? 200 : (ti == 3) ? 300 : (ti == 4) ? 777 : (ti == 5) ? 1029 : (ti == 6) ? 1500 : 2047; const int b = (bi == 0) ? 0 : (bi == 1) ? 7 : 15;
            const int nadm = 64 * (t / 64 + 1); const size_t rb = (size_t)b * 2048, qrow = rb + t; const int d = F.lane;
            if (hh < 8) { const float slope = exp2f(-(float)(hh + 1));
                float mx = -INFINITY; for (int sidx = 0; sidx < nadm; ++sidx) { const unsigned long long mw = WSP(unsigned long long, WS_MASK)[((size_t)(b * 64 + t / 32) * 32 + sidx / 64) * 32 + (t % 32)]; if (!((mw >> (sidx % 64)) & 1ull)) continue;
                    const float sc = chk::dotbf(WSP(bf16, WS_QA) + qrow * 512 + hh * 64, WSP(bf16, WS_KA) + (rb + sidx) * 512 + hh * 64, 64) * 0.125f - slope * fabsf((float)(t - sidx)); mx = fmaxf(mx, sc); }
                float l = 0.f, o = 0.f; for (int sidx = 0; sidx < nadm; ++sidx) { const unsigned long long mw = WSP(unsigned long long, WS_MASK)[((size_t)(b * 64 + t / 32) * 32 + sidx / 64) * 32 + (t % 32)]; if (!((mw >> (sidx % 64)) & 1ull)) continue;
                    const float sc = chk::dotbf(WSP(bf16, WS_QA) + qrow * 512 + hh * 64, WSP(bf16, WS_KA) + (rb + sidx) * 512 + hh * 64, 64) * 0.125f - slope * fabsf((float)(t - sidx)); const float p = expf(sc - mx); l += p; o += p * chk::b2f(WSP(bf16, WS_VA)[(rb + sidx) * 512 + hh * 64 + d]); }
                chk::devmax(DEV + 14, fabsf(chk::b2f(WSP(bf16, WS_YA)[qrow * 1024 + hh * 64 + d]) - o / l));
            } else if (CHK_TI < 0 || ti == CHK_TI) { const int hb = hh - 8; const float slope = exp2f(-2.f * (float)(hb + 1)); float ov[2][2];
                for (int m = 0; m < 2; ++m) { float mx = -INFINITY; for (int sidx = 0; sidx < nadm; ++sidx) { const float sc = chk::dotbf(WSP(bf16, WS_QB) + qrow * 512 + (2 * hb + m) * 64, WSP(bf16, WS_KB) + (rb + sidx) * 512 + (2 * hb + m) * 64, 64) * 0.125f - slope * fabsf((float)(t - sidx)); mx = fmaxf(mx, sc); }
                    float l = 0.f, o0 = 0.f, o1 = 0.f; for (int sidx = 0; sidx < nadm; ++sidx) { const float sc = chk::dotbf(WSP(bf16, WS_QB) + qrow * 512 + (2 * hb + m) * 64, WSP(bf16, WS_KB) + (rb + sidx) * 512 + (2 * hb + m) * 64, 64) * 0.125f - slope * fabsf((float)(t - sidx));
                        const float p = expf(sc - mx); l += p; o0 += p * chk::b2f(WSP(bf16, WS_VB)[(rb + sidx) * 512 + hb * 128 + d]); o1 += p * chk::b2f(WSP(bf16, WS_VB)[(rb + sidx) * 512 + hb * 128 + 64 + d]); }
                    if (m == 0) { ov[0][0] = o0 / l; ov[0][1] = o1 / l; } else { ov[1][0] = o0 / l; ov[1][1] = o1 / l; } }
                const float d0 = ov[0][0] - lamc * ov[1][0], d1 = ov[0][1] - lamc * ov[1][1]; const float ssq = wave_sum(d0 * d0 + d1 * d1); const float rs = 0.8f / sqrtf(ssq / 128.f + 1e-6f);
                chk::devmax(DEV + 16, fabsf(chk::b2f(WSP(bf16, WS_YA)[qrow * 1024 + 512 + hb * 128 + d]) - d0 * rs * args.in[14][d])); chk::devmax(DEV + 19, fabsf(chk::b2f(WSP(bf16, WS_YA)[qrow * 1024 + 512 + hb * 128 + 64 + d]) - d1 * rs * args.in[14][64 + d]));
            }
        }
        xcd_barrier(bar);
    }
#endif
    if (IN(5)) {
        pg8::Gemm g{WSP(bf16, WS_YA), (const bf16*)(ws + WS_WUA), M, DM, 1024}; pg8::StaticOrder S; S.init(M, DM, F.G, (int)blockIdx.x);
        epi::EpiUpM E{WSP(bf16, WS_MG), WSP(bf16, WS_GT)}; pg8::gemm_phase<epi::EpiUpM, pg8::StaticOrder, true, true>(F.lds, g, S, E);
    }
    SEAM(5);
#ifdef CHECKER
    if (IN(5) && IN(6)) {
        __syncthreads(); float* DEV = (float*)(ws + WS_CTL) + 8192;
        CHK_LOOP(idx, chk::NR * 256) { const int row = chk::RSTR * (int)(idx / 256) + chk::ROFF, col = 4 * (int)(idx % 256) + 2;
            const float ua = chk::dotbf(WSP(bf16, WS_YA) + (size_t)row * 1024, WSP(bf16, WS_WUA) + (size_t)col * 1024, 512), ub = chk::dotbf(WSP(bf16, WS_YA) + (size_t)row * 1024 + 512, WSP(bf16, WS_WUA) + (size_t)col * 1024 + 512, 512);
            const float ga = chk::b2f(WSP(bf16, WS_GT)[(size_t)row * 2048 + col]), gb = chk::b2f(WSP(bf16, WS_GT)[(size_t)row * 2048 + 1024 + col]);
            const float ref = chk::rnd(ga * ua) + gb * ub, o = chk::b2f(WSP(bf16, WS_MG)[(size_t)row * 1024 + col]); chk::devmax(DEV + 6, fabsf(o - ref)); }
    }
    if (IN(5) && IN(6)) xcd_barrier(bar);
#endif
    if (IN(6)) {
        pg8::Gemm g{WSP(bf16, WS_MG), (const bf16*)(ws + WS_WO), M, DM, DM}; pg8::StaticOrder S; S.init(M, DM, F.G, (int)blockIdx.x);
        epi::EpiResToBf16 E{args.in[0], WSP(bf16, WS_GT), MOD + 2048}; pg8::gemm_phase<epi::EpiResToBf16, pg8::StaticOrder, true, true>(F.lds, g, S, E);
    }
    SEAM(6);
#ifdef CHECKER
    if (IN(6) && IN(7)) {
        __syncthreads(); float* DEV = (float*)(ws + WS_CTL) + 8192;
        CHK_LOOP(idx, chk::NR * 256) { const int row = chk::RSTR * (int)(idx / 256) + chk::ROFF, col = 4 * (int)(idx % 256) + 1;
            const float a = chk::dotbf(WSP(bf16, WS_MG) + (size_t)row * 1024, WSP(bf16, WS_WO) + (size_t)col * 1024, 1024);
            const float ref = args.in[0][(size_t)row * 1024 + col] + MOD[(size_t)(row >> 11) * 6144 + 2048 + col] * a, o = chk::b2f(WSP(bf16, WS_GT)[(size_t)row * 1024 + col]); chk::devmax(DEV + 7, fabsf(o - ref)); }
    }
#endif
    if (IN(7)) norm_mod_pass_bf16(F, WSP(bf16, WS_GT), args.in[18], MOD + 4096, MOD + 3072, WSP(bf16, WS_XH));
    SEAM(7);
#ifdef CHECKER
    if (IN(7) && IN(8)) {
        __syncthreads(); float* DEV = (float*)(ws + WS_CTL) + 8192;
        CHK_LOOP(idx, chk::NR) { const int row = chk::RSTR * (int)idx + chk::ROFF, b = row >> 11; float ss = 0.f; for (int k = 0; k < 1024; ++k) { const float v = chk::b2f(WSP(bf16, WS_GT)[(size_t)row * 1024 + k]); ss += v * v; }
            const float rs = 1.f / sqrtf(ss / 1024.f + 1e-6f); float dm = 0.f;
            for (int k = 0; k < 1024; ++k) { const float ref = chk::b2f(WSP(bf16, WS_GT)[(size_t)row * 1024 + k]) * rs * args.in[18][k] * (1.f + MOD[(size_t)b * 6144 + 4096 + k]) + MOD[(size_t)b * 6144 + 3072 + k]; dm = fmaxf(dm, fabsf(chk::b2f(WSP(bf16, WS_XH)[(size_t)row * 1024 + k]) - ref)); }
            chk::devmax(DEV + 8, dm); }
    }
#endif
    if (IN(8)) {
        pg8::Gemm g{WSP(bf16, WS_XH), (const bf16*)(ws + WS_W13), M, NFF13, DM}; pg8::StaticOrder S; S.init(M, NFF13, F.G, (int)blockIdx.x);
#ifdef PROBE_EPI
        epi::EpiFF13 E{WSP(bf16, WS_HID), args.probe};
#else
        epi::EpiFF13 E{WSP(bf16, WS_HID)};
#endif
        pg8::gemm_phase<epi::EpiFF13, pg8::StaticOrder, true, true>(F.lds, g, S, E);
    }
    SEAM(8);
#ifdef CHECKER
    if (IN(8) && IN(9)) {
        __syncthreads(); float* DEV = (float*)(ws + WS_CTL) + 8192;
        CHK_LOOP(idx, chk::NR * 704) { const int row = chk::RSTR * (int)(idx / 704) + chk::ROFF, hc = 4 * (int)(idx % 704) + 3;
            const bf16* w = WSP(bf16, WS_W13) + (size_t)((hc >> 7) * 256 + (hc & 127)) * 1024;
            const float u1 = chk::dotbf(WSP(bf16, WS_XH) + (size_t)row * 1024, w, 1024), u3 = chk::dotbf(WSP(bf16, WS_XH) + (size_t)row * 1024, w + 128 * 1024, 1024);
            const float ref = u1 * chk::sig(u1) * u3, o = chk::b2f(WSP(bf16, WS_HID)[(size_t)row * 2816 + hc]); chk::devmax(DEV + 9, fabsf(o - ref) / (fabsf(ref) + 0.05f)); }
    }
#endif
    if (IN(9)) {
        pg8::Gemm g{WSP(bf16, WS_HID), (const bf16*)(ws + WS_W2), M, DM, DFF}; pg8::StaticOrder S; S.init(M, DM, F.G, (int)blockIdx.x);
        epi::EpiResFromBf16 E{WSP(bf16, WS_GT), args.out, MOD + 5120}; pg8::gemm_phase<epi::EpiResFromBf16, pg8::StaticOrder, true, true>(F.lds, g, S, E);
    }
#ifdef PROBE_XBAR
    for (int i = 0; i < PROBE_XBAR; ++i) xcd_barrier(bar);
#endif
#ifdef ENDCHK
    if (IN(9)) {
        unsigned tot = 0u; for (long idx = (long)F.vcu * 512 + F.tid; idx < 16L * 64 * 32 * 32; idx += (long)F.G * 512) tot += (unsigned)__builtin_popcountll(WSP(unsigned long long, WS_MASK)[idx]);
        atomicAdd((unsigned*)(ws + WS_CTL) + 8192 + 18, tot);
        xcd_barrier(bar);
        const int bad = (int)__hip_atomic_load((unsigned*)(ws + WS_CTL) + 8192 + 18, RLX_AGENT) - 16 * 499712;
        if (F.vcu == 0 && F.tid == 0 && bad != 0) args.out[0] += 1.0e6f;
    }
#endif
#ifdef CHECKER
    if (IN(9)) {
        float* DEV = (float*)(ws + WS_CTL) + 8192;
        asm volatile("s_waitcnt vmcnt(0)" ::: "memory"); __syncthreads();
        CHK_LOOP(idx, chk::NR * 256) { const int row = chk::RSTR * (int)(idx / 256) + chk::ROFF, col = 4 * (int)(idx % 256) + 3;
            (void)row; (void)col; }
        xcd_barrier(bar);
        CHK_LOOP(idx, chk::NR * 256) { const int row = chk::RSTR * (int)(idx / 256) + chk::ROFF, col = 4 * (int)(idx % 256) + 3;
            const float a = chk::dotbf(WSP(bf16, WS_HID) + (size_t)row * 2816, WSP(bf16, WS_W2) + (size_t)col * 2816, 2816);
            const float ref = chk::b2f(WSP(bf16, WS_GT)[(size_t)row * 1024 + col]) + MOD[(size_t)(row >> 11) * 6144 + 5120 + col] * a; chk::devmax(DEV + 10, fabsf(args.out[(size_t)row * 1024 + col] - ref)); }
        xcd_barrier(bar);
        float da = __hip_atomic_load(DEV + CHK_A, RLX_AGENT), db = __hip_atomic_load(DEV + CHK_B, RLX_AGENT);
        if (CHK_A == 17) da = (da > (float)CHK_TOL17) ? da : 0.f;
        if (CHK_A == 18) da = fabsf((float)((int)__hip_atomic_load((unsigned*)DEV + 18, RLX_AGENT) - 16 * 499712));
        if (F.vcu == 0 && F.tid == 0) args.out[0] += 1000.f * da;
        const float pb = 16.f * sqrtf(db);
        for (int i = F.vcu * 512 + F.tid; i < (1 << 18); i += F.G * 512) if (i > 0) args.out[i] += pb;
    }
#endif
#undef IN
#undef SEAM
#undef WSP
}

extern "C" void kernel_launch(void* const* d_in, const int* in_sizes, int n_in, void* d_out, int out_size, void* d_ws, size_t ws_size, hipStream_t stream) {
    static int grid = 0;
    if (grid == 0) {
        if (n_in != 22 || in_sizes[0] != M * DM || out_size != M * DM || ws_size < WS_END) { fprintf(stderr, "kernel_launch: unexpected shapes (n_in %d, in0 %d, out %d, ws %zu); nothing launched\n", n_in, n_in > 0 ? in_sizes[0] : -1, out_size, ws_size); grid = -1; return; }
        int dev = 0, cus = 0, per_cu = 0;
        if (hipGetDevice(&dev) != hipSuccess || hipDeviceGetAttribute(&cus, hipDeviceAttributeMultiprocessorCount, dev) != hipSuccess) { fprintf(stderr, "kernel_launch: device query failed\n"); grid = -1; return; }
        if (hipFuncSetAttribute((const void*)mega_fwd, hipFuncAttributeMaxDynamicSharedMemorySize, LDS_BYTES) != hipSuccess) { fprintf(stderr, "kernel_launch: hipFuncSetAttribute failed\n"); grid = -1; return; }
        if (hipOccupancyMaxActiveBlocksPerMultiprocessor(&per_cu, (const void*)mega_fwd, NWAVES * 64, LDS_BYTES) != hipSuccess || per_cu < 1) fprintf(stderr, "kernel_launch: note: occupancy query reports %d workgroups per CU\n", per_cu);
        (void)hipGetLastError();
        grid = cus;
        if (grid != 256) fprintf(stderr, "kernel_launch: %d CUs; the attention/selection schedules need 256\n", grid);
    }
    if (grid < 0) return;
    if (hipMemsetAsync((char*)d_ws + WS_CTL, 0, CTL_ZERO_BYTES, stream) != hipSuccess) { fprintf(stderr, "kernel_launch: hipMemsetAsync failed\n"); return; }
    Args a{};
    for (int i = 0; i < 22; ++i) a.in[i] = (const float*)d_in[i];
    a.out = (float*)d_out; a.ws = (unsigned char*)d_ws;
#ifdef PROBE_RERUN_MASK
    constexpr int n_l = N_LAUNCHES + __builtin_popcount(PROBE_RERUN_MASK);
#else
    constexpr int n_l = N_LAUNCHES;
#endif
#ifdef MASKDIFF
    { unsigned char* ws = (unsigned char*)d_ws; unsigned* CNT = (unsigned*)(ws + WS_CTL + 32768);
#ifdef MASKDIFF_SPLIT
      a.ph_lo = 0; a.ph_hi = 3; hipLaunchKernelGGL(mega_fwd, dim3(grid), dim3(NWAVES * 64), LDS_BYTES, stream, a);
      a.ph_lo = 3; a.ph_hi = 4; hipLaunchKernelGGL(mega_fwd, dim3(grid), dim3(NWAVES * 64), LDS_BYTES, stream, a);
#else
      a.ph_lo = 0; a.ph_hi = 4; hipLaunchKernelGGL(mega_fwd, dim3(grid), dim3(NWAVES * 64), LDS_BYTES, stream, a);
#endif
      (void)hipMemcpyAsync(ws + WS_STASH, ws + WS_MASK, 8u << 20, hipMemcpyDeviceToDevice, stream);
      a.ph_lo = 3; a.ph_hi = 4; hipLaunchKernelGGL(mega_fwd, dim3(grid), dim3(NWAVES * 64), LDS_BYTES, stream, a);
      hipLaunchKernelGGL(mask_diff, dim3(256), dim3(512), 0, stream, (const unsigned long long*)(ws + WS_MASK), (const unsigned long long*)(ws + WS_STASH), CNT);
      (void)hipMemsetAsync((char*)d_ws + WS_CTL, 0, 32768, stream);
      a.ph_lo = 4; a.ph_hi = 10; hipLaunchKernelGGL(mega_fwd, dim3(grid), dim3(NWAVES * 64), LDS_BYTES, stream, a);
      hipLaunchKernelGGL(mask_report, dim3(256), dim3(512), 0, stream, (float*)d_out, (const unsigned*)CNT);
      return; }
#endif
#ifdef DUPCHK
    { unsigned char* ws = (unsigned char*)d_ws; unsigned long long* CK = (unsigned long long*)(ws + WS_CTL + 32768);
      const void* rp[10] = {ws + WS_MOD, ws + WS_XH, ws + WS_QA, ws + WS_MASK, ws + WS_XH, ws + WS_MG, ws + WS_GT, ws + WS_XH, ws + WS_HID, d_out};
      const size_t rb[10] = {33ull << 20, 64ull << 20, 344ull << 20, 8ull << 20, 64ull << 20, 64ull << 20, 64ull << 20, 64ull << 20, 176ull << 20, 128ull << 20};
      int lo = 0;
      for (int k = 0; k < 10; ++k) { const bool cut = (DUPCHK >> k) & 1; if (!cut && k != 9) continue;
          if (lo > 0) (void)hipMemsetAsync((char*)d_ws + WS_CTL, 0, 32768, stream);
          a.ph_lo = lo; a.ph_hi = k + 1; hipLaunchKernelGGL(mega_fwd, dim3(grid), dim3(NWAVES * 64), LDS_BYTES, stream, a);
          if (cut) { hipLaunchKernelGGL(dup_cksum, dim3(256), dim3(512), 0, stream, rp[k], rb[k], CK + 2 * k);
                     a.ph_lo = k; a.ph_hi = k + 1; hipLaunchKernelGGL(mega_fwd, dim3(grid), dim3(NWAVES * 64), LDS_BYTES, stream, a);
                     hipLaunchKernelGGL(dup_cksum, dim3(256), dim3(512), 0, stream, rp[k], rb[k], CK + 2 * k + 1); }
          lo = k + 1; }
      hipLaunchKernelGGL(dup_final, dim3(256), dim3(512), 0, stream, (float*)d_out, (const unsigned long long*)CK);
      return; }
#endif
    int probe_next = 0;
    for (int li = 0; li < n_l; ++li) {
        a.ph_lo = (N_LAUNCHES == 1) ? 0 : li; a.ph_hi = (N_LAUNCHES == 1) ? N_PHASES : li + 1;
#ifdef PROBE_RERUN_MASK
        if (li >= N_LAUNCHES) { while (!((PROBE_RERUN_MASK >> probe_next) & 1)) ++probe_next; a.ph_lo = probe_next; a.ph_hi = probe_next + 1; ++probe_next;
#ifdef PROBE_MODE
            a.probe = PROBE_MODE;
#endif
        }
#endif
        hipLaunchKernelGGL(mega_fwd, dim3(grid), dim3(NWAVES * 64), LDS_BYTES, stream, a);
        const hipError_t le = hipPeekAtLastError();
        if (le != hipSuccess) { fprintf(stderr, "kernel_launch: launch %d failed: %s\n", li, hipGetErrorName(le)); break; }
    }
}
```

```cpp
#include <hip/hip_runtime.h>
#include <cstdio>
#include <cstdint>
namespace pg8 {
#define PG8_LAS __attribute__((address_space(3)))
typedef unsigned short bf16_t;
typedef short bf16x8 __attribute__((ext_vector_type(8)));
typedef float f32x4 __attribute__((ext_vector_type(4)));
typedef unsigned u32x4 __attribute__((ext_vector_type(4)));
constexpr int BM = 256, BK = 64, HALF = 128, HTB = HALF * BK * 2  , STAGE_BYTES = 8 * HTB, NXCD = 8, WGM = 8;

__host__ __device__ __forceinline__ int lds_byte(int r, int c) { const int st = (r >> 4) * 2 + (c >> 5), rr = r & 15, cc = c & 31, ob = rr * 64 + cc * 2; return st * 1024 + (ob ^ (((ob >> 9) & 1) << 5)); }
__host__ __device__ __forceinline__ void stage_rc(int b, int& R, int& C) { const int st = b / 1024, sb = b % 1024, swz = sb ^ (((sb >> 9) & 1) << 5); R = (st >> 1) * 16 + swz / 64; C = (st & 1) * 32 + (swz % 64) / 2; }
__host__ __device__ __forceinline__ int perm32(int rho) { const int n = rho >> 4, i = rho & 15; return 8 * (i >> 2) + 4 * n + (i & 3); }

struct Unit { int pm, pn; };
struct Gemm { const bf16_t* A; const bf16_t* Bt; int M, N, K; };

struct StaticOrder {
    int nM, nN, nwg, G, c;
    __host__ __device__ void init(int M, int N, int G_, int c_) { nM = M / BM; nN = N / BM; nwg = nM * nN; G = G_; c = c_; }
    __host__ __device__ bool next(int i, Unit& u) const {
        const long L = (long)i * G + c; if (L >= nwg) return false;
        int wgid = (int)L; { const int q = nwg / NXCD, r = nwg % NXCD, xcd = wgid % NXCD, off = wgid / NXCD; wgid = (xcd < r ? xcd * (q + 1) : r * (q + 1) + (xcd - r) * q) + off; }
        const int nig = WGM * nN, gid = wgid / nig, fm = gid * WGM, gsz = (nM - fm) < WGM ? (nM - fm) : WGM;
        u.pm = fm + ((wgid % nig) % gsz); u.pn = (wgid % nig) / gsz; return true;
    }
    __device__ __forceinline__ void a_ready(const Unit&) const {}
    __device__ __forceinline__ void done(const Unit&) const {}
};
__device__ __forceinline__ unsigned cvt_pk_bf16(float lo, float hi) { unsigned r; asm volatile("v_cvt_pk_bf16_f32 %0, %1, %2" : "=v"(r) : "v"(lo), "v"(hi)); return r; }
typedef float f32x2 __attribute__((ext_vector_type(2)));
template <class E, class = void> struct mid_t { static constexpr int v = 0; };
template <class E> struct mid_t<E, decltype((void)E::MID_T)> { static constexpr int v = E::MID_T; };
template <class Epi, class Sched, bool ALIGN_EPI = false, bool SP2 = false>
__device__ __forceinline__ void gemm_phase(PG8_LAS unsigned char* lds, const Gemm g, const Sched& S, const Epi& E) {
    const int tid = threadIdx.x, wid = __builtin_amdgcn_readfirstlane(tid >> 6), lane = tid & 63, wr = wid >> 2, wc = wid & 3, fr = lane & 15, fq = lane >> 4;
    const int K = g.K, nt = K / BK;
    unsigned voffA[2], voffB[2];
#pragma unroll
    for (int i = 0; i < 2; ++i) { int R, C; stage_rc(tid * 16 + i * 8192, R, C); const int Rb = Epi::PERM ? ((R & ~31) + perm32(R & 31)) : R;
        voffA[i] = (unsigned)(R * K + C) * 2u; voffB[i] = (unsigned)(Rb * K + C) * 2u; }
    const size_t kstep = (size_t)(BK * 2);
    const size_t hstep = (size_t)HALF * K * 2;
    const size_t tstep = 2 * hstep;
    const unsigned ldsw = (unsigned)wid * 1024u;
    const int aoff = lds_byte(wr * 64 + fr, fq * 8), boff = lds_byte(wc * 32 + fr, fq * 8);
#define PG8_SA(b, h) (((b) * 2 + (h)) * HTB)
#define PG8_SB(b, h) ((4 + (b) * 2 + (h)) * HTB)
#define PG8_STAGE(bufoff, gbase, voff) do { _Pragma("unroll") for (int _i = 0; _i < 2; ++_i) \
        __builtin_amdgcn_global_load_lds((const unsigned*)((const char*)(gbase) + (voff)[_i]), (PG8_LAS unsigned*)(lds + (bufoff) + ldsw + _i * 8192), 16, 0, 0); } while (0)
#define PG8_LDA(dst, b, h) do { _Pragma("unroll") for (int m = 0; m < 4; ++m) _Pragma("unroll") for (int k = 0; k < 2; ++k) dst[m][k] = *(const PG8_LAS bf16x8*)(lds + PG8_SA(b, h) + aoff + m * 2048 + k * 1024); } while (0)
#define PG8_LDB(dst, b, h) do { _Pragma("unroll") for (int n = 0; n < 2; ++n) _Pragma("unroll") for (int k = 0; k < 2; ++k) dst[n][k] = *(const PG8_LAS bf16x8*)(lds + PG8_SB(b, h) + boff + n * 2048 + k * 1024); } while (0)
#define PG8_MMA(ai, bj, At, Bt) do { __builtin_amdgcn_s_setprio(1); _Pragma("unroll") for (int m = 0; m < 4; ++m) _Pragma("unroll") for (int n = 0; n < 2; ++n) _Pragma("unroll") for (int k = 0; k < 2; ++k) \
        acc[ai][bj][m][n] = __builtin_amdgcn_mfma_f32_16x16x32_bf16(Bt[n][k], At[m][k], acc[ai][bj][m][n], 0, 0, 0); __builtin_amdgcn_s_setprio(0); } while (0)
#define PG8_WAIT_V(n) asm volatile("s_waitcnt vmcnt(" #n ")" ::: "memory")
#define PG8_WAIT_L(n) asm volatile("s_waitcnt lgkmcnt(" #n ")" ::: "memory")
#define PG8_BAR __builtin_amdgcn_s_barrier()
#define PG8_SCHED __builtin_amdgcn_sched_barrier(0)
    Unit cur, nxt; int ui = 0;
    if (!S.next(0, cur)) return;
    f32x4 acc[2][2][4][2];
#pragma unroll
    for (int a = 0; a < 2; ++a)
#pragma unroll
        for (int b = 0; b < 2; ++b)
#pragma unroll
            for (int m = 0; m < 4; ++m)
#pragma unroll
                for (int n = 0; n < 2; ++n) acc[a][b][m][n] = (f32x4){0.f, 0.f, 0.f, 0.f};
    bf16x8 At[4][2], B0[2][2], B1[2][2];
    const char* cA = (const char*)g.A + (size_t)cur.pm * tstep; const char* cB = (const char*)g.Bt + (size_t)cur.pn * tstep;
    S.a_ready(cur);
    if constexpr (SP2) {
        PG8_STAGE(PG8_SB(0, 0), cB, voffB); PG8_STAGE(PG8_SB(0, 1), cB + hstep, voffB); PG8_STAGE(PG8_SA(0, 0), cA, voffA); PG8_STAGE(PG8_SA(0, 1), cA + hstep, voffA);
        if (wr == 1) PG8_BAR;
        PG8_WAIT_V(2); PG8_BAR;
        PG8_STAGE(PG8_SB(1, 0), cB + kstep, voffB); PG8_STAGE(PG8_SA(1, 0), cA + kstep, voffA); PG8_STAGE(PG8_SB(1, 1), cB + hstep + kstep, voffB);
        PG8_WAIT_V(6); PG8_BAR;
    } else {
        PG8_STAGE(PG8_SB(0, 0), cB, voffB); PG8_STAGE(PG8_SA(0, 0), cA, voffA); PG8_STAGE(PG8_SB(0, 1), cB + hstep, voffB); PG8_STAGE(PG8_SA(0, 1), cA + hstep, voffA);
        if (wr == 1) PG8_BAR;
        PG8_WAIT_V(4); PG8_BAR;
        PG8_STAGE(PG8_SB(1, 0), cB + kstep, voffB); PG8_STAGE(PG8_SA(1, 0), cA + kstep, voffA); PG8_STAGE(PG8_SB(1, 1), cB + hstep + kstep, voffB);
        PG8_WAIT_V(6); PG8_BAR;
    }
    for (;;) {
        const bool has_next = S.next(ui + 1, nxt);
        const char* nA = has_next ? (const char*)g.A + (size_t)nxt.pm * tstep : cA; const char* nB = has_next ? (const char*)g.Bt + (size_t)nxt.pn * tstep : cB;
        for (int t = 0; t < nt; t += 2) {
            if constexpr (mid_t<Epi>::v > 0) { if (t == mid_t<Epi>::v) E.mid(acc, cur, wr, wc, fr, fq); }
            const bool last = (t == nt - 2);
            const char* a1 = cA + (size_t)(t + 1) * kstep;
            const char* a2 = last ? nA : cA + (size_t)(t + 2) * kstep; const char* b2 = last ? nB : cB + (size_t)(t + 2) * kstep;
            const char* a3 = a2 + kstep; const char* b3 = b2 + kstep;
            if (last && has_next) S.a_ready(nxt);
            if constexpr (SP2) {
            PG8_LDB(B0, 0, 0); PG8_LDB(B1, 0, 1); PG8_SCHED; PG8_LDA(At, 0, 0); PG8_STAGE(PG8_SA(1, 1), a1 + hstep, voffA);
            PG8_WAIT_V(8); PG8_WAIT_L(0); PG8_BAR; PG8_MMA(0, 0, At, B0); PG8_MMA(0, 1, At, B1); PG8_BAR; PG8_SCHED;
            PG8_LDA(At, 0, 1); PG8_STAGE(PG8_SB(0, 0), b2, voffB); PG8_STAGE(PG8_SB(0, 1), b2 + hstep, voffB); PG8_STAGE(PG8_SA(0, 0), a2, voffA);
            PG8_WAIT_V(8); PG8_WAIT_L(0); PG8_BAR; PG8_MMA(1, 0, At, B0); PG8_MMA(1, 1, At, B1); PG8_BAR; PG8_SCHED;
            PG8_LDB(B0, 1, 0); PG8_LDB(B1, 1, 1); PG8_SCHED; PG8_LDA(At, 1, 0); PG8_STAGE(PG8_SA(0, 1), a2 + hstep, voffA);
            PG8_WAIT_V(8); PG8_WAIT_L(0); PG8_BAR; PG8_MMA(0, 0, At, B0); PG8_MMA(0, 1, At, B1); PG8_BAR; PG8_SCHED;
            PG8_LDA(At, 1, 1); PG8_STAGE(PG8_SB(1, 0), b3, voffB); PG8_STAGE(PG8_SB(1, 1), b3 + hstep, voffB); PG8_STAGE(PG8_SA(1, 0), a3, voffA);
            PG8_WAIT_V(8); PG8_WAIT_L(0); PG8_BAR; PG8_MMA(1, 0, At, B0); PG8_MMA(1, 1, At, B1); PG8_BAR; PG8_SCHED;
            } else {
            PG8_LDB(B0, 0, 0); PG8_SCHED; PG8_LDA(At, 0, 0); PG8_STAGE(PG8_SA(1, 1), a1 + hstep, voffA);
            PG8_WAIT_L(8); PG8_BAR; PG8_WAIT_L(0); PG8_MMA(0, 0, At, B0); PG8_BAR; PG8_SCHED;
            PG8_LDB(B1, 0, 1); PG8_STAGE(PG8_SB(0, 0), b2, voffB);
            PG8_BAR; PG8_WAIT_L(0); PG8_MMA(0, 1, At, B1); PG8_BAR;
            PG8_LDA(At, 0, 1); PG8_STAGE(PG8_SA(0, 0), a2, voffA);
            PG8_BAR; PG8_WAIT_L(0); PG8_MMA(1, 0, At, B0); PG8_BAR; PG8_SCHED;
            PG8_STAGE(PG8_SB(0, 1), b2 + hstep, voffB);
            PG8_WAIT_V(6); PG8_BAR; PG8_MMA(1, 1, At, B1); PG8_BAR;
            PG8_LDB(B0, 1, 0); PG8_SCHED; PG8_LDA(At, 1, 0); PG8_STAGE(PG8_SA(0, 1), a2 + hstep, voffA);
            PG8_WAIT_L(8); PG8_BAR; PG8_WAIT_L(0); PG8_MMA(0, 0, At, B0); PG8_BAR; PG8_SCHED;
            PG8_LDB(B1, 1, 1); PG8_STAGE(PG8_SB(1, 0), b3, voffB);
            PG8_BAR; PG8_WAIT_L(0); PG8_MMA(0, 1, At, B1); PG8_BAR;
            PG8_LDA(At, 1, 1); PG8_STAGE(PG8_SA(1, 0), a3, voffA);
            PG8_BAR; PG8_WAIT_L(0); PG8_MMA(1, 0, At, B0); PG8_BAR; PG8_SCHED;
            PG8_STAGE(PG8_SB(1, 1), b3 + hstep, voffB);
            PG8_WAIT_V(6); PG8_BAR; PG8_MMA(1, 1, At, B1); PG8_BAR;
            }
        }
        if constexpr (ALIGN_EPI) { if (wr == 0) PG8_BAR; }
        if constexpr (!Epi::AFTER_DRAIN) { E(acc, cur, wr, wc, fr, fq); S.done(cur); }
        if (!has_next) break;
#pragma unroll
        for (int a = 0; a < 2; ++a)
#pragma unroll
            for (int b = 0; b < 2; ++b)
#pragma unroll
                for (int m = 0; m < 4; ++m)
#pragma unroll
                    for (int n = 0; n < 2; ++n) acc[a][b][m][n] = (f32x4){0.f, 0.f, 0.f, 0.f};
        cur = nxt; cA = nA; cB = nB; ++ui;
        if constexpr (ALIGN_EPI) { if (wr == 1) PG8_BAR; }
    }
    PG8_WAIT_V(0);
    if constexpr (!ALIGN_EPI) { if (wr == 0) PG8_BAR; }
    PG8_BAR;
    if constexpr (Epi::AFTER_DRAIN) { E.fused(acc, cur, wr, wc, fr, fq, lds, wid, lane); S.done(cur); }
#undef PG8_SA
#undef PG8_SB
#undef PG8_STAGE
#undef PG8_LDA
#undef PG8_LDB
#undef PG8_MMA
#undef PG8_WAIT_V
#undef PG8_WAIT_L
#undef PG8_BAR
#undef PG8_SCHED
}
}
#ifndef SCALE_F_EPS
#define SCALE_F_EPS 0.0f
#endif
namespace epi {
constexpr size_t PWS_GN = (1u << 20) + 768 * 1024, PWS_QA = 128u << 20, PWS_QI = 320u << 20, PWS_KI = 336u << 20, PWS_WI = 340u << 20, PWS_GT = 344u << 20;
using pg8::f32x4; using pg8::u32x4; using pg8::bf16_t; using pg8::Unit; using pg8::BM; using pg8::HALF;
__device__ __forceinline__ unsigned pk2(float lo, float hi) { return pg8::cvt_pk_bf16(lo, hi); }
__device__ __forceinline__ float bflo(unsigned u) { return __uint_as_float(u << 16); }
__device__ __forceinline__ float bfhi(unsigned u) { return __uint_as_float(u & 0xffff0000u); }
__device__ __forceinline__ float sigm(float v) { return __builtin_amdgcn_rcpf(1.f + __expf(-v)); }
__device__ __forceinline__ u32x4 pack8(const f32x4& a, const f32x4& b) { u32x4 w; w.x = pk2(a[0], a[1]); w.y = pk2(a[2], a[3]); w.z = pk2(b[0], b[1]); w.w = pk2(b[2], b[3]); return w; }
__device__ __forceinline__ float dot4(const f32x4& a) { return (a[0] * a[0] + a[1] * a[1]) + (a[2] * a[2] + a[3] * a[3]); }

struct EpiProj {
    static constexpr bool PERM = true, AFTER_DRAIN = false;
    unsigned char* ws;
    template <int MODE  >
    __device__ __forceinline__ void emit(const f32x4 (&acc)[2][2][4][2], bf16_t* dst, int pitch, int cb, const float* g, int row0, int wc, int fq) const {
        f32x4 gv[2][2];
#pragma unroll
        for (int bj = 0; bj < 2; ++bj)
#pragma unroll
            for (int n = 0; n < 2; ++n) gv[bj][n] = (MODE == 1) ? *(const f32x4*)(g + 32 * bj + 8 * fq + 4 * n) : (f32x4){1.f, 1.f, 1.f, 1.f};
#pragma unroll
        for (int ai = 0; ai < 2; ++ai)
#pragma unroll
            for (int m = 0; m < 4; ++m) {
                f32x4 v[2][2];
#pragma unroll
                for (int bj = 0; bj < 2; ++bj)
#pragma unroll
                    for (int n = 0; n < 2; ++n) v[bj][n] = acc[ai][bj][m][n];
                if (MODE == 1) {
                    float ss = (dot4(v[0][0]) + dot4(v[0][1])) + (dot4(v[1][0]) + dot4(v[1][1]));
                    ss += __shfl_xor(ss, 16); ss += __shfl_xor(ss, 32);
                    const float rs = __builtin_amdgcn_rsqf(ss * (1.0f / 64.0f) + 1e-6f);
#pragma unroll
                    for (int bj = 0; bj < 2; ++bj)
#pragma unroll
                        for (int n = 0; n < 2; ++n) v[bj][n] = v[bj][n] * rs * gv[bj][n];
                } else if (MODE == 2) {
#pragma unroll
                    for (int bj = 0; bj < 2; ++bj)
#pragma unroll
                        for (int n = 0; n < 2; ++n)
#pragma unroll
                            for (int i = 0; i < 4; ++i) v[bj][n][i] = sigm(v[bj][n][i]);
                }
                bf16_t* rowp = dst + (size_t)(row0 + ai * HALF + m * 16) * pitch + cb + 64 * wc + 8 * fq;
#pragma unroll
                for (int bj = 0; bj < 2; ++bj) *(u32x4*)(rowp + 32 * bj) = pack8(v[bj][0], v[bj][1]);
            }
    }
    __device__ __forceinline__ void operator()(const f32x4 (&acc)[2][2][4][2], const Unit& u, int wr, int wc, int fr, int fq) const {
        const int pn = u.pn, row0 = u.pm * BM + wr * 64 + fr, cb = (pn & 1) * 256;
        bf16_t* const QA = (bf16_t*)(ws + PWS_QA); const float* const gn = (const float*)(ws + PWS_GN);
        bf16_t* const KI = (bf16_t*)(ws + PWS_KI); float* const WI = (float*)(ws + PWS_WI); bf16_t* const GT = (bf16_t*)(ws + PWS_GT);
        if (pn < 12) {
            const int tsr = pn >> 1; bf16_t* dst = QA + (size_t)tsr * (size_t)(32u << 19);
            if (tsr == 2 || tsr == 5) emit<0>(acc, dst, 512, cb, nullptr, row0, wc, fq);
            else emit<1>(acc, dst, 512, cb, gn + 64 * (tsr - (tsr > 2 ? 1 : 0)), row0, wc, fq);
        }
        else if (pn == 12) emit<0>(acc, (bf16_t*)(ws + PWS_QI), 256, 0, nullptr, row0, wc, fq);
        else if (pn == 13) {
            if (wc == 0) emit<0>(acc, KI, 64, 0, nullptr, row0, 0, fq);
            else if (wc == 1) { if (fq == 0) {
#pragma unroll
                for (int ai = 0; ai < 2; ++ai)
#pragma unroll
                    for (int m = 0; m < 4; ++m) *(f32x4*)(WI + (size_t)(row0 + ai * HALF + m * 16) * 4) = acc[ai][0][m][0]; } }
        } else {
#pragma unroll
            for (int ai = 0; ai < 2; ++ai)
#pragma unroll
                for (int m = 0; m < 4; ++m) { f32x4 r[2], gb[2];
#pragma unroll
                    for (int n = 0; n < 2; ++n)
#pragma unroll
                        for (int i = 0; i < 4; ++i) { const float ea = __expf(-acc[ai][0][m][n][i]), eb = __builtin_fminf(__expf(-acc[ai][1][m][n][i]), 1.152921504606847e18f);
                            gb[n][i] = __builtin_amdgcn_rcpf(1.f + eb); r[n][i] = (1.f + eb) * __builtin_amdgcn_rcpf(1.f + ea); }
                    bf16_t* rowp = GT + (size_t)(row0 + ai * HALF + m * 16) * 2048 + (pn - 14) * 128 + 32 * wc + 8 * fq;
                    *(u32x4*)rowp = pack8(r[0], r[1]); *(u32x4*)(rowp + 1024) = pack8(gb[0], gb[1]); }
        }
    }
};
struct EpiUpM {
    static constexpr bool PERM = true, AFTER_DRAIN = false; static constexpr int MID_T = 8;
    bf16_t* MG; const bf16_t* GT;
    static __device__ __forceinline__ float gcl(float g) { return __builtin_fmaxf(g, 8.673617379884035e-19f); }
    __device__ __forceinline__ void mid(f32x4 (&acc)[2][2][4][2], const Unit& u, int wr, int wc, int fr, int fq) const {
        int zo = 0; asm volatile("" : "+v"(zo));
        const int row0 = u.pm * BM + wr * 64 + fr + zo, col0 = u.pn * BM + wc * 32 + 8 * fq;
        u32x4 ra[2][4][2];
#pragma unroll
        for (int ai = 0; ai < 2; ++ai)
#pragma unroll
            for (int m = 0; m < 4; ++m)
#pragma unroll
                for (int bj = 0; bj < 2; ++bj) { const size_t row = (size_t)(row0 + ai * HALF + m * 16); const int c = col0 + bj * HALF; ra[ai][m][bj] = *(const u32x4*)(GT + row * 2048 + c); }
        asm volatile("" ::: "memory");
#pragma unroll
        for (int ai = 0; ai < 2; ++ai)
#pragma unroll
            for (int m = 0; m < 4; ++m)
#pragma unroll
                for (int bj = 0; bj < 2; ++bj) { const u32x4 a = ra[ai][m][bj];
                    acc[ai][bj][m][0] = acc[ai][bj][m][0] * (f32x4){bflo(a.x), bfhi(a.x), bflo(a.y), bfhi(a.y)}; acc[ai][bj][m][1] = acc[ai][bj][m][1] * (f32x4){bflo(a.z), bfhi(a.z), bflo(a.w), bfhi(a.w)}; }
        asm volatile("" ::: "memory");
    }
    __device__ __forceinline__ void operator()(const f32x4 (&acc)[2][2][4][2], const Unit& u, int wr, int wc, int fr, int fq) const {
        const int row0 = u.pm * BM + wr * 64 + fr, col0 = u.pn * BM + wc * 32 + 8 * fq;
#pragma unroll
        for (int ai = 0; ai < 2; ++ai) {
            u32x4 gw[4][2];
#pragma unroll
            for (int m = 0; m < 4; ++m)
#pragma unroll
                for (int bj = 0; bj < 2; ++bj) { const size_t row = (size_t)(row0 + ai * HALF + m * 16); const int c = col0 + bj * HALF; gw[m][bj] = *(const u32x4*)(GT + row * 2048 + 1024 + c); }
            asm volatile("" ::: "memory");
#pragma unroll
            for (int m = 0; m < 4; ++m)
#pragma unroll
                for (int bj = 0; bj < 2; ++bj) { const size_t row = (size_t)(row0 + ai * HALF + m * 16); const int c = col0 + bj * HALF; const u32x4 g = gw[m][bj];
                    const f32x4 v0 = acc[ai][bj][m][0] * (f32x4){gcl(bflo(g.x)), gcl(bfhi(g.x)), gcl(bflo(g.y)), gcl(bfhi(g.y))}, v1 = acc[ai][bj][m][1] * (f32x4){gcl(bflo(g.z)), gcl(bfhi(g.z)), gcl(bflo(g.w)), gcl(bfhi(g.w))};
                    *(u32x4*)(MG + row * 1024 + c) = pack8(v0, v1); }
        }
    }
};
struct EpiFF13 {
    static constexpr bool PERM = true, AFTER_DRAIN = false;
    bf16_t* H;
#ifdef PROBE_EPI
    int skip;
#endif
    __device__ __forceinline__ void operator()(const f32x4 (&acc)[2][2][4][2], const Unit& u, int wr, int wc, int fr, int fq) const {
        const int row0 = u.pm * BM + wr * 64 + fr, col0 = u.pn * HALF + wc * 32 + 8 * fq;
#ifdef PROBE_EPI
        if (skip) { if (acc[0][0][0][0][0] == 1.2345e30f) H[0] = 0; return; }
#endif
#pragma unroll
        for (int ai = 0; ai < 2; ++ai)
#pragma unroll
            for (int m = 0; m < 4; ++m) { f32x4 h[2];
#pragma unroll
                for (int n = 0; n < 2; ++n)
#pragma unroll
                    for (int i = 0; i < 4; ++i) { const float a = acc[ai][0][m][n][i]; h[n][i] = a * sigm(a) * acc[ai][1][m][n][i]; }
                *(u32x4*)(H + (size_t)(row0 + ai * HALF + m * 16) * 2816 + col0) = pack8(h[0], h[1]); }
    }
};
struct EpiResToBf16 {
    static constexpr bool PERM = true, AFTER_DRAIN = false;
    const float* X; bf16_t* O; const float* gate;
    __device__ __forceinline__ void operator()(const f32x4 (&acc)[2][2][4][2], const Unit& u, int wr, int wc, int fr, int fq) const {
        const int row0 = u.pm * BM + wr * 64 + fr, col0 = u.pn * BM + wc * 32 + 8 * fq; const float* gp = gate + (size_t)(u.pm >> 3) * 6144 + col0;
        f32x4 gv[2][2];
#pragma unroll
        for (int bj = 0; bj < 2; ++bj)
#pragma unroll
            for (int n = 0; n < 2; ++n) gv[bj][n] = *(const f32x4*)(gp + bj * HALF + n * 4);
#pragma unroll
        for (int ai = 0; ai < 2; ++ai) {
            f32x4 xv[4][2][2];
#pragma unroll
            for (int m = 0; m < 4; ++m)
#pragma unroll
                for (int bj = 0; bj < 2; ++bj) { const size_t off = (size_t)(row0 + ai * HALF + m * 16) * 1024 + col0 + bj * HALF; xv[m][bj][0] = *(const f32x4*)(X + off); xv[m][bj][1] = *(const f32x4*)(X + off + 4); }
            asm volatile("" ::: "memory");
#pragma unroll
            for (int m = 0; m < 4; ++m)
#pragma unroll
                for (int bj = 0; bj < 2; ++bj) { const size_t off = (size_t)(row0 + ai * HALF + m * 16) * 1024 + col0 + bj * HALF;
                    *(u32x4*)(O + off) = pack8(xv[m][bj][0] + gv[bj][0] * acc[ai][bj][m][0], xv[m][bj][1] + gv[bj][1] * acc[ai][bj][m][1]); }
        }
    }
};
struct EpiResFromBf16 {
    static constexpr bool PERM = true, AFTER_DRAIN = false;
    const bf16_t* X; float* O; const float* gate;
    __device__ __forceinline__ void operator()(const f32x4 (&acc)[2][2][4][2], const Unit& u, int wr, int wc, int fr, int fq) const {
        const int row0 = u.pm * BM + wr * 64 + fr, col0 = u.pn * BM + wc * 32 + 8 * fq; const float* gp = gate + (size_t)(u.pm >> 3) * 6144 + col0;
        f32x4 gv[2][2];
#pragma unroll
        for (int bj = 0; bj < 2; ++bj)
#pragma unroll
            for (int n = 0; n < 2; ++n) gv[bj][n] = *(const f32x4*)(gp + bj * HALF + n * 4);
#pragma unroll
        for (int ai = 0; ai < 2; ++ai) {
            u32x4 xw[4][2];
#pragma unroll
            for (int m = 0; m < 4; ++m)
#pragma unroll
                for (int bj = 0; bj < 2; ++bj) xw[m][bj] = *(const u32x4*)(X + (size_t)(row0 + ai * HALF + m * 16) * 1024 + col0 + bj * HALF);
            asm volatile("" ::: "memory");
#pragma unroll
            for (int m = 0; m < 4; ++m)
#pragma unroll
                for (int bj = 0; bj < 2; ++bj) { const size_t off = (size_t)(row0 + ai * HALF + m * 16) * 1024 + col0 + bj * HALF; const u32x4 w = xw[m][bj];
                    *(f32x4*)(O + off) = (f32x4){bflo(w.x), bfhi(w.x), bflo(w.y), bfhi(w.y)} + gv[bj][0] * acc[ai][bj][m][0] * (1.0f + SCALE_F_EPS);
                    *(f32x4*)(O + off + 4) = (f32x4){bflo(w.z), bfhi(w.z), bflo(w.w), bfhi(w.w)} + gv[bj][1] * acc[ai][bj][m][1] * (1.0f + SCALE_F_EPS); }
        }
    }
};
}
#ifndef SCALE_B_EPS
#define SCALE_B_EPS 0.0f
#endif
#ifndef SCALE_A_EPS
#define SCALE_A_EPS 0.0f
#endif
namespace att {
using bf16x8 = __attribute__((ext_vector_type(8))) short;
using s16x4 = __attribute__((ext_vector_type(4))) short;
using f32x16 = __attribute__((ext_vector_type(16))) float;
using u32x4 = __attribute__((ext_vector_type(4))) unsigned;
using u32x2 = __attribute__((ext_vector_type(2))) unsigned;
typedef unsigned short bf16;
constexpr int SEQ = 2048, NW = 8, QBLK = 32, QB = QBLK * NW, KVBLK = 64;
constexpr float C2 = 0.125f * 1.4426950408889634f;
constexpr int SLOTB = 8192, LDS_K = 0, LDS_V = 3 * SLOTB, LDS_WS = 6 * SLOTB, WSW = 128, LDS_OST = LDS_WS + NW * WSW * 4, LDS_X = LDS_OST + NW * 4096, XW = 8192, LDS_BYTES = LDS_X + NW * XW;
#define SBAR() __builtin_amdgcn_sched_barrier(0)
#define PIN(x) asm volatile("" : "+v"(x))
#define MFMA(a, b, c) __builtin_amdgcn_mfma_f32_32x32x16_bf16(a, b, c, 0, 0, 0)
#define WAIT_BAR(N) asm volatile("s_waitcnt vmcnt(" #N ") lgkmcnt(0)\n\ts_barrier" ::: "memory")
#ifndef ATT_THR
#define ATT_THR 60.0f
#endif
typedef __attribute__((address_space(3))) const char* lds_cptr;
typedef __attribute__((address_space(3))) char* lds_ptr;
typedef __attribute__((address_space(3))) float* lds_fptr;
typedef __attribute__((address_space(3))) const unsigned* lds_cuptr;
typedef short v4i16_t __attribute__((ext_vector_type(4)));
__device__ __forceinline__ int crow(int r, int hi) { return (r & 3) + 8 * (r >> 2) + 4 * hi; }
__device__ __forceinline__ unsigned cvtpk(float lo, float hi) { unsigned r; asm("v_cvt_pk_bf16_f32 %0, %1, %2" : "=v"(r) : "v"(lo), "v"(hi)); return r; }
__device__ __forceinline__ void glds16(const void* g, unsigned lds_base) {
    unsigned sv; asm volatile("s_mov_b32 %0, m0\n\ts_mov_b32 m0, %2\n\ts_nop 0\n\tglobal_load_lds_dwordx4 %1, off\n\ts_mov_b32 m0, %0" : "=&s"(sv) : "v"(g), "s"(lds_base) : "memory"); }
__device__ __forceinline__ void kload2(bf16x8* kf, lds_cptr kp, int d0) { kf[2 * d0] = *(const __attribute__((address_space(3))) bf16x8*)(kp + d0 * 2048); kf[2 * d0 + 1] = *(const __attribute__((address_space(3))) bf16x8*)(kp + d0 * 2048 + 512); }
__device__ __forceinline__ s16x4 vtr(lds_cptr p) { return __builtin_bit_cast(s16x4, __builtin_amdgcn_ds_read_tr16_b64_v4i16((__attribute__((address_space(3))) v4i16_t*)p)); }
#define MX3(a, b, c) __builtin_fmaxf(__builtin_fmaxf((a), (b)), (c))
__device__ __forceinline__ float rowmax2(const f32x16& p0, const f32x16& p1, float p1off) {
    float a = MX3(p0[0], p0[1], p0[2]), b = MX3(p1[0], p1[1], p1[2]);
#pragma unroll
    for (int r = 3; r < 15; r += 2) { a = MX3(a, p0[r], p0[r + 1]); b = MX3(b, p1[r], p1[r + 1]); }
    a = __builtin_fmaxf(a, p0[15]); b = __builtin_fmaxf(b, p1[15]);
    float m = __builtin_fmaxf(a, b + p1off); auto rr = __builtin_amdgcn_permlane32_swap(__float_as_uint(m), __float_as_uint(m), false, false);
    return __builtin_fmaxf(__uint_as_float(rr[0]), __uint_as_float(rr[1])); }
__device__ __forceinline__ float msel(float x, unsigned mw, int pos) { const unsigned m = (unsigned)(((int)(mw << (31 - pos))) >> 31);
    return __uint_as_float((__float_as_uint(x) & m) | (0xff800000u & ~m)); }
__device__ __forceinline__ unsigned short f2bf(float f) { unsigned u = __float_as_uint(f); return (unsigned short)((u + 0x7fffu + ((u >> 16) & 1u)) >> 16); }

#ifndef EXP_NOBAND
#define EXP_NOBAND 0
#endif
#ifndef EXP_NOMASK
#define EXP_NOMASK 0
#endif
#ifdef EXP_NOAPPLY
#define EXP_APPLY(C0, C1, t, BAND) do {} while (0)
#else
#define EXP_APPLY(C0, C1, t, BAND) APPLY(C0, C1, t, BAND)
#endif
#ifdef EXP_NOADV
#define EXP_ADV do {} while (0)
#elif defined(EXP_ADVPIN)
#define EXP_ADV do { _Pragma("unroll") for (int r = 0; r < 16; ++r) ali[r] += tstep; PIN(ali); } while (0)
#else
#define EXP_ADV do { _Pragma("unroll") for (int r = 0; r < 16; ++r) ali[r] += tstep; } while (0)
#endif
template <bool MASKED>
__device__ __forceinline__ void attn_core(f32x16 (&o)[2], const bf16* Qw, int qp, const bf16* Kh, int kp, const bf16* Vh, int vp, int qb, float s8, const unsigned long long* gmask, char* lds) {
    int lz_ = threadIdx.x & 63; asm volatile("" : "+v"(lz_));
    const int tid = threadIdx.x, lane = lz_, r32 = lane & 31, hi = lane >> 5; const int wid = __builtin_amdgcn_readfirstlane(tid >> 6);
    const int NT = 4 * qb + 4;
    const unsigned lds0 = (unsigned)(uintptr_t)lds; const lds_fptr wsf = (lds_fptr)((lds_ptr)lds + LDS_WS) + wid * WSW;
    const bf16* ksrc = Kh + (long)lane * kp + wid * 8;
    const bf16* vsrc = Vh + (long)(16 * (wid & 3) + (lane >> 2)) * vp + (wid >> 2) * 32 + (lane & 3) * 8;
    const unsigned kdst = lds0 + LDS_K + wid * 1024, vdst = lds0 + LDS_V + wid * 1024;
#define DMA_K(t, slot) glds16(ksrc + (long)(t) * KVBLK * kp, (unsigned)__builtin_amdgcn_readfirstlane(kdst + (slot)))
#define DMA_V(t, slot) glds16(vsrc + (long)(t) * KVBLK * vp, (unsigned)__builtin_amdgcn_readfirstlane(vdst + (slot)))
    const lds_cptr vp0 = (lds_cptr)lds + LDS_V + ((lane >> 4) & 1) * 32 + (lane & 3) * 8 + (4 * hi + ((lane & 15) >> 2)) * 64;
    const lds_cptr kp0 = (lds_cptr)lds + LDS_K + hi * 1024 + r32 * 16;
    const lds_cptr mrow = (lds_cptr)lds + LDS_X + wid * XW + r32 * 8;
    if (MASKED) { for (int i = 0; i <= qb; ++i) glds16((const char*)gmask + i * 1024 + lane * 16, (unsigned)__builtin_amdgcn_readfirstlane(lds0 + LDS_X + wid * XW + i * 1024)); }
    DMA_K(0, 0); DMA_V(0, 0); DMA_K(1, SLOTB);
    bf16x8 qr[4];
#pragma unroll
    for (int d0 = 0; d0 < 4; ++d0) qr[d0] = *reinterpret_cast<const bf16x8*>(&Qw[(long)r32 * qp + d0 * 16 + hi * 8]);
    float mhat = 0.f, l_reg = 0.f; o[0] = f32x16{}; o[1] = f32x16{};
    const int qrel = wid * QBLK + r32, wch = wid >> 1; bool resc = false;
    const float p1off = 32.f * s8, tstep = 64.f * s8, nm1off = p1off * C2;
    f32x16 ali;
    { const float tq = (float)(QB * qb + qrel);
#pragma unroll
      for (int r = 0; r < 16; ++r) ali[r] = -s8 * (tq - (float)crow(r, hi)); }
    PIN(ali);
    f32x16 pA0, pA1, pB0, pB1; bf16x8 kf[8]; s16x4 vlo[8], vhi[8]; u32x4 pw0, pw1, pw2, pw3;
    int sl_prev = 0, sl_cur = 0, sl_next = SLOTB;
#define ROT() do { sl_prev = sl_cur; sl_cur = sl_next; sl_next = (sl_next == 2 * SLOTB) ? 0 : sl_next + SLOTB; } while (0)
#define EX(v, nm) __builtin_amdgcn_exp2f(__builtin_fmaf((v), C2, (nm)))
#define RESC() do { if (resc) { _Pragma("unroll") for (int d_ = 0; d_ < 2; ++d_) _Pragma("unroll") for (int r = 0; r < 16; ++r) o[d_][r] *= wsf[crow(r, hi)]; } } while (0)
#define APPLY(C0, C1, t, BAND) do { \
    const int jb_ = (t) - (NT - 4); \
    if (MASKED && !EXP_NOMASK) { const u32x2 mq_ = *(const __attribute__((address_space(3))) u32x2*)(mrow + (t) * 256); unsigned m0_ = mq_[0] >> (4 * hi), m1_ = mq_[1] >> (4 * hi); \
        if (BAND) { m0_ = (jb_ > wch) ? 0u : m0_; m1_ = (jb_ > wch) ? 0u : m1_; } SBAR(); \
        _Pragma("unroll") for (int e = 0; e < 16; e += 4) { C0[e] = msel(C0[e], m0_, 2 * e); C0[e + 1] = msel(C0[e + 1], m0_, 2 * e + 1); C0[e + 2] = msel(C0[e + 2], m0_, 2 * e + 2); C0[e + 3] = msel(C0[e + 3], m0_, 2 * e + 3); SBAR(); } \
        _Pragma("unroll") for (int e = 0; e < 16; e += 4) { C1[e] = msel(C1[e], m1_, 2 * e); C1[e + 1] = msel(C1[e + 1], m1_, 2 * e + 1); C1[e + 2] = msel(C1[e + 2], m1_, 2 * e + 2); C1[e + 3] = msel(C1[e + 3], m1_, 2 * e + 3); SBAR(); } } \
    if (BAND && !EXP_NOBAND) { const float binv_ = (!MASKED && jb_ > wch) ? -INFINITY : 0.f, m2_ = (jb_ == wch) ? -2.f * s8 : 0.f, fb_ = (float)(4 * hi - (qrel - 64 * wch)); float fbo_ = fb_; asm volatile("" : "+v"(fbo_)); SBAR(); \
        _Pragma("unroll") for (int e = 0; e < 16; ++e) { const float d0_ = fbo_ + (float)((e & 3) + 8 * (e >> 2)); \
            C0[e] = __builtin_fmaf(__builtin_fmaxf(d0_, 0.f), m2_, C0[e] + binv_); C1[e] = __builtin_fmaf(__builtin_fmaxf(d0_ + 32.f, 0.f), m2_, C1[e] + binv_); if ((e & 1) == 1) SBAR(); } } } while (0)
    DMA_K(2, 2 * SLOTB);
    WAIT_BAR(3);
    _Pragma("unroll") for (int d0 = 0; d0 < 4; ++d0) kload2(kf, kp0, d0);
    pA0 = MFMA(kf[0], qr[0], ali); pA1 = MFMA(kf[1], qr[0], ali); pA0 = MFMA(kf[2], qr[1], pA0); pA1 = MFMA(kf[3], qr[1], pA1);
    pA0 = MFMA(kf[4], qr[2], pA0); pA1 = MFMA(kf[5], qr[2], pA1); pA0 = MFMA(kf[6], qr[3], pA0); pA1 = MFMA(kf[7], qr[3], pA1);
    APPLY(pA0, pA1, 0, true);
    { const float rm = rowmax2(pA0, pA1, p1off); mhat = __builtin_fmaxf(rm * C2, -30000.f); const float nmh = -mhat, nmh1 = nmh + nm1off;
#pragma unroll
      for (int r = 0; r < 16; ++r) { pA0[r] = EX(pA0[r], nmh); pA1[r] = EX(pA1[r], nmh1); } }
#pragma unroll
    for (int r = 0; r < 16; ++r) ali[r] += tstep;
    WAIT_BAR(0);
    DMA_K(3, 0); DMA_V(1, SLOTB); ROT();
    _Pragma("unroll") for (int d0 = 0; d0 < 4; ++d0) kload2(kf, kp0 + sl_cur, d0);
    WAIT_BAR(2);
#define PKW(P, i) cvtpk(P[i], P[i + 1])
#define PAF(k) __builtin_bit_cast(bf16x8, pw##k)
#define VFR(i) (bf16x8){vlo[i][0], vlo[i][1], vlo[i][2], vlo[i][3], vhi[i][0], vhi[i][1], vhi[i][2], vhi[i][3]}
#define VRD(i) do { vlo[i] = vtr(vp_ + (((i) >> 2) * 4096 + ((i) & 3) * 1024)); vhi[i] = vtr(vp_ + (((i) >> 2) * 4096 + ((i) & 3) * 1024 + 512)); } while (0)
#define KRD(G, d0) do { if (G) { kload2(kf, kp0 + sl_next, d0); SBAR(); } } while (0)
#define GAPA(MF, a0, a1, a2, a3, W0, W1, PW) do { MF; sacc += a0; sacc += a1; sacc += a2; sacc += a3; W0; W1; PIN(PW); PIN(sacc); SBAR(); } while (0)
#define GAPB(MF, X, i, nm) do { MF; X[i] = EX(X[i], nm); X[i + 1] = EX(X[i + 1], nm); X[i + 2] = EX(X[i + 2], nm); X[i + 3] = EX(X[i + 3], nm); PIN(X); SBAR(); } while (0)
#define STEP(C0, C1, P0, P1, t, BAND, GK, GV, GL) do { SBAR(); \
    const lds_cptr vp_ = vp0 + sl_prev; \
    VRD(0); SBAR(); float sacc = P0[0] + P0[1]; \
                    GAPA(C0 = MFMA(kf[0], qr[0], ali), P0[2], P0[3], P0[4], P0[5],     pw0[0] = PKW(P0, 0),  pw0[1] = PKW(P0, 2),  pw0); \
    VRD(4); SBAR(); GAPA(C1 = MFMA(kf[1], qr[0], ali), P0[6], P0[7], P0[8], P0[9],     pw0[2] = PKW(P0, 4),  pw0[3] = PKW(P0, 6),  pw0); \
    VRD(1); SBAR(); GAPA(C0 = MFMA(kf[2], qr[1], C0),  P0[10], P0[11], P0[12], P0[13], pw1[0] = PKW(P0, 8),  pw1[1] = PKW(P0, 10), pw1); \
    VRD(5); SBAR(); GAPA(C1 = MFMA(kf[3], qr[1], C1),  P0[14], P0[15], P1[0], P1[1],   pw1[2] = PKW(P0, 12), pw1[3] = PKW(P0, 14), pw1); \
    VRD(2); SBAR(); GAPA(C0 = MFMA(kf[4], qr[2], C0),  P1[2], P1[3], P1[4], P1[5],     pw2[0] = PKW(P1, 0),  pw2[1] = PKW(P1, 2),  pw2); \
    VRD(6); SBAR(); GAPA(C1 = MFMA(kf[5], qr[2], C1),  P1[6], P1[7], P1[8], P1[9],     pw2[2] = PKW(P1, 4),  pw2[3] = PKW(P1, 6),  pw2); \
    VRD(3); SBAR(); GAPA(C0 = MFMA(kf[6], qr[3], C0),  P1[10], P1[11], P1[12], P1[13], pw3[0] = PKW(P1, 8),  pw3[1] = PKW(P1, 10), pw3); \
    VRD(7); SBAR(); GAPA(C1 = MFMA(kf[7], qr[3], C1),  P1[14], P1[15], 0.f, 0.f,       pw3[2] = PKW(P1, 12), pw3[3] = PKW(P1, 14), pw3); \
    l_reg += sacc; \
    if (GK) DMA_K((t) + 3, sl_cur); if (GV) DMA_V((t) + 1, sl_next); \
    EXP_APPLY(C0, C1, t, BAND); \
    EXP_ADV; \
    { const float rm = __builtin_fmaf(rowmax2(C0, C1, p1off), C2, -mhat); resc = false; \
      if (__builtin_expect(__any(rm > ATT_THR), 0)) { const float dl = __builtin_fmaxf(rm, 0.f); mhat += dl; \
          const float f = __builtin_amdgcn_exp2f(-dl); l_reg *= f; if (hi == 0) wsf[r32] = f; resc = true; } } \
    const float nmh = -mhat, nmh1 = nmh + nm1off; SBAR(); \
    GAPB(o[0] = MFMA(PAF(0), VFR(0), o[0]), C0, 0, nmh);              GAPB(o[1] = MFMA(PAF(0), VFR(4), o[1]), C0, 4, nmh); \
    KRD(GL, 0); GAPB(o[0] = MFMA(PAF(1), VFR(1), o[0]), C0, 8, nmh);  KRD(GL, 1); GAPB(o[1] = MFMA(PAF(1), VFR(5), o[1]), C0, 12, nmh); \
    KRD(GL, 2); GAPB(o[0] = MFMA(PAF(2), VFR(2), o[0]), C1, 0, nmh1); KRD(GL, 3); GAPB(o[1] = MFMA(PAF(2), VFR(6), o[1]), C1, 4, nmh1); \
    GAPB(o[0] = MFMA(PAF(3), VFR(3), o[0]), C1, 8, nmh1);             GAPB(o[1] = MFMA(PAF(3), VFR(7), o[1]), C1, 12, nmh1); \
    } while (0)
    int t = 1;
    for (; t + 5 < NT; t += 2) {
        STEP(pB0, pB1, pA0, pA1, t, false, true, true, true);     WAIT_BAR(2); RESC(); ROT();
        STEP(pA0, pA1, pB0, pB1, t + 1, false, true, true, true); WAIT_BAR(2); RESC(); ROT();
    }
#define ENDW(tt) do { if ((tt) + 3 < NT) { WAIT_BAR(2); } else if ((tt) + 2 < NT) { WAIT_BAR(1); } else { WAIT_BAR(0); } } while (0)
    for (; t + 1 < NT; t += 2) {
        STEP(pB0, pB1, pA0, pA1, t, true, (t + 3 < NT), (t + 1 < NT), (t + 1 < NT));         ENDW(t);     RESC(); ROT();
        STEP(pA0, pA1, pB0, pB1, t + 1, true, (t + 4 < NT), (t + 2 < NT), (t + 2 < NT));     ENDW(t + 1); RESC(); ROT();
    }
    STEP(pB0, pB1, pA0, pA1, NT - 1, true, false, false, false); RESC();
    { float sacc = pB0[0] + pB0[1];
#pragma unroll
      for (int r = 2; r < 16; ++r) sacc += pB0[r];
#pragma unroll
      for (int r = 0; r < 16; ++r) sacc += pB1[r];
      l_reg += sacc;
      pw0 = (u32x4){PKW(pB0, 0), PKW(pB0, 2), PKW(pB0, 4), PKW(pB0, 6)}; pw1 = (u32x4){PKW(pB0, 8), PKW(pB0, 10), PKW(pB0, 12), PKW(pB0, 14)};
      pw2 = (u32x4){PKW(pB1, 0), PKW(pB1, 2), PKW(pB1, 4), PKW(pB1, 6)}; pw3 = (u32x4){PKW(pB1, 8), PKW(pB1, 10), PKW(pB1, 12), PKW(pB1, 14)};
      const lds_cptr vp_ = vp0 + sl_cur; _Pragma("unroll") for (int i = 0; i < 8; ++i) VRD(i);
      o[0] = MFMA(PAF(0), VFR(0), o[0]); o[1] = MFMA(PAF(0), VFR(4), o[1]); o[0] = MFMA(PAF(1), VFR(1), o[0]); o[1] = MFMA(PAF(1), VFR(5), o[1]);
      o[0] = MFMA(PAF(2), VFR(2), o[0]); o[1] = MFMA(PAF(2), VFR(6), o[1]); o[0] = MFMA(PAF(3), VFR(3), o[0]); o[1] = MFMA(PAF(3), VFR(7), o[1]); }
    { auto rr = __builtin_amdgcn_permlane32_swap(__float_as_uint(l_reg), __float_as_uint(l_reg), false, false); l_reg = __uint_as_float(rr[0]) + __uint_as_float(rr[1]); }
    if (hi == 0) wsf[32 + r32] = l_reg;
    asm volatile("s_waitcnt lgkmcnt(0)\n\ts_barrier" ::: "memory");
#undef DMA_K
#undef DMA_V
#undef ROT
#undef EX
#undef RESC
#undef APPLY
#undef PKW
#undef PAF
#undef VFR
#undef VRD
#undef KRD
#undef ENDW
#undef GAPA
#undef GAPB
#undef STEP
}
constexpr int L8_K = 0, L8_V = 3 * SLOTB, L8_VSLOT = 2 * SLOTB, L8_WS = L8_V + 3 * L8_VSLOT, L8_OST = L8_WS + NW * WSW * 4, L8_Q = L8_OST + NW * 4096, L8_BYTES = L8_Q + NW * 4096;
static_assert(L8_BYTES <= LDS_BYTES, "core128 LDS");
__device__ __forceinline__ float rowmax_h(const f32x16& p0, const f32x16& p1, float hoff) {
    float a = MX3(p0[0], p0[1], p0[2]), b = MX3(p1[0], p1[1], p1[2]);
#pragma unroll
    for (int r = 3; r < 15; r += 2) { a = MX3(a, p0[r], p0[r + 1]); b = MX3(b, p1[r], p1[r + 1]); }
    a = __builtin_fmaxf(a, p0[15]); b = __builtin_fmaxf(b, p1[15]);
    float m = __builtin_fmaxf(a, b) + hoff; auto rr = __builtin_amdgcn_permlane32_swap(__float_as_uint(m), __float_as_uint(m), false, false);
    return __builtin_fmaxf(__uint_as_float(rr[0]), __uint_as_float(rr[1])); }
__device__ __forceinline__ void attn_core128(f32x16 (&o)[4], const bf16* Qw, int qp, const bf16* Kh, int kp, const bf16* Vh, int vp, int qb, float s8, char* lds) {
    int lz_ = threadIdx.x & 63; asm volatile("" : "+v"(lz_));
    const int tid = threadIdx.x, lane = lz_, r32 = lane & 31, hi = lane >> 5; const int wid = __builtin_amdgcn_readfirstlane(tid >> 6);
    const int NT = 4 * qb + 4;
    const unsigned lds0 = (unsigned)(uintptr_t)lds; const lds_fptr wsf = (lds_fptr)((lds_ptr)lds + L8_WS) + wid * WSW;
    const bf16* ksrc = Kh + (long)lane * kp + wid * 8;
    const bf16* vsrc = Vh + (long)(16 * (wid & 3) + (lane >> 2)) * vp + (wid >> 2) * 32 + (lane & 3) * 8;
    const unsigned kdst = lds0 + L8_K + wid * 1024, vdst = lds0 + L8_V + wid * 1024;
#define DMA_K(t, slot) glds16(ksrc + (long)(t) * KVBLK * kp, (unsigned)__builtin_amdgcn_readfirstlane(kdst + (slot)))
#define DMA_V(t, slot) do { glds16(vsrc + (long)(t) * KVBLK * vp, (unsigned)__builtin_amdgcn_readfirstlane(vdst + 2 * (slot))); \
                            glds16(vsrc + (long)(t) * KVBLK * vp + 64, (unsigned)__builtin_amdgcn_readfirstlane(vdst + 2 * (slot) + 8192)); } while (0)
    const lds_cptr vp0 = (lds_cptr)lds + L8_V + ((lane >> 4) & 1) * 32 + (lane & 3) * 8 + (4 * hi + ((lane & 15) >> 2)) * 64;
    const lds_cptr kp0 = (lds_cptr)lds + L8_K + hi * 1024 + r32 * 16;
    const lds_cptr qlp = (lds_cptr)lds + L8_Q + wid * 4096 + hi * 512 + r32 * 16;
#pragma unroll
    for (int d0 = 0; d0 < 4; ++d0) glds16(Qw + (long)r32 * qp + d0 * 16 + hi * 8, (unsigned)__builtin_amdgcn_readfirstlane(lds0 + L8_Q + wid * 4096 + d0 * 1024));
    DMA_K(0, 0); DMA_V(0, 0); DMA_K(1, SLOTB);
#ifdef DBG_QGLOBAL
#define QF(d0) (*reinterpret_cast<const bf16x8*>(&Qw[(long)r32 * qp + (d0) * 16 + hi * 8]))
#else
#define QF(d0) (*(const __attribute__((address_space(3))) bf16x8*)(qlp + (d0) * 1024))
#endif
    float mhat = 0.f, l_reg = 0.f; o[0] = f32x16{}; o[1] = f32x16{}; o[2] = f32x16{}; o[3] = f32x16{};
    const int qrel = wid * QBLK + r32, wch = wid >> 1; bool resc = false;
    float bt = -s8 * (float)(QB * qb + qrel); const float tstep = 64.f * s8, hoff = s8 * (float)(4 * hi);
    f32x16 pA0, pA1, pB0, pB1; bf16x8 kf[8]; s16x4 vlo[8], vhi[8]; u32x4 pw0, pw1, pw2, pw3;
    int sl_prev = 0, sl_cur = 0, sl_next = SLOTB;
#define ROT() do { sl_prev = sl_cur; sl_cur = sl_next; sl_next = (sl_next == 2 * SLOTB) ? 0 : sl_next + SLOTB; } while (0)
#define EX(v, nm) __builtin_amdgcn_exp2f(__builtin_fmaf((v), C2, (nm)))
#define RESC() do { if (resc) { _Pragma("unroll") for (int d_ = 0; d_ < 4; ++d_) _Pragma("unroll") for (int r = 0; r < 16; ++r) o[d_][r] *= wsf[crow(r, hi)]; } } while (0)
#define BIAS(C0, C1) do { _Pragma("unroll") for (int e = 0; e < 16; ++e) { C0[e] = __builtin_fmaf(s8, (float)((e & 3) + 8 * (e >> 2)), C0[e]); C1[e] = __builtin_fmaf(s8, (float)(32 + (e & 3) + 8 * (e >> 2)), C1[e]); } } while (0)
#define APPLY(C0, C1, t, BAND) do { \
    if (BAND) { const int jb_ = (t) - (NT - 4); const float binv_ = (jb_ > wch) ? -INFINITY : 0.f, m2_ = (jb_ == wch) ? -2.f * s8 : 0.f, fb_ = (float)(4 * hi - (qrel - 64 * wch)); float fbo_ = fb_; asm volatile("" : "+v"(fbo_)); SBAR(); \
        _Pragma("unroll") for (int e = 0; e < 16; ++e) { const float d0_ = fbo_ + (float)((e & 3) + 8 * (e >> 2)); \
            C0[e] = __builtin_fmaf(__builtin_fmaxf(d0_, 0.f), m2_, C0[e] + binv_); C1[e] = __builtin_fmaf(__builtin_fmaxf(d0_ + 32.f, 0.f), m2_, C1[e] + binv_); if ((e & 1) == 1) SBAR(); } } } while (0)
    DMA_K(2, 2 * SLOTB);
    WAIT_BAR(4);
    _Pragma("unroll") for (int d0 = 0; d0 < 4; ++d0) kload2(kf, kp0, d0);
    { const bf16x8 q0 = QF(0), q1 = QF(1), q2 = QF(2), q3 = QF(3); const f32x16 z = f32x16{};
      pA0 = MFMA(kf[0], q0, z); pA1 = MFMA(kf[1], q0, z); pA0 = MFMA(kf[2], q1, pA0); pA1 = MFMA(kf[3], q1, pA1);
      pA0 = MFMA(kf[4], q2, pA0); pA1 = MFMA(kf[5], q2, pA1); pA0 = MFMA(kf[6], q3, pA0); pA1 = MFMA(kf[7], q3, pA1); }
    BIAS(pA0, pA1); APPLY(pA0, pA1, 0, true);
    { const float rm = rowmax_h(pA0, pA1, hoff); mhat = __builtin_fmaxf((rm + bt) * C2, -30000.f); const float nmh = __builtin_fmaf(bt + hoff, C2, -mhat);
#pragma unroll
      for (int r = 0; r < 16; ++r) { pA0[r] = EX(pA0[r], nmh); pA1[r] = EX(pA1[r], nmh); } }
    bt += tstep;
    WAIT_BAR(0);
    DMA_K(3, 0); DMA_V(1, SLOTB); ROT();
    _Pragma("unroll") for (int d0 = 0; d0 < 4; ++d0) kload2(kf, kp0 + sl_cur, d0);
    WAIT_BAR(3);
#define PKW(P, i) cvtpk(P[i], P[i + 1])
#define PAF(k) __builtin_bit_cast(bf16x8, pw##k)
#define VFR(i) (bf16x8){vlo[i][0], vlo[i][1], vlo[i][2], vlo[i][3], vhi[i][0], vhi[i][1], vhi[i][2], vhi[i][3]}
#define VRD(i, hofs) do { vlo[i] = vtr(vp_ + ((hofs) + ((i) >> 2) * 4096 + ((i) & 3) * 1024)); vhi[i] = vtr(vp_ + ((hofs) + ((i) >> 2) * 4096 + ((i) & 3) * 1024 + 512)); } while (0)
#define KRD(G, d0) do { if (G) { kload2(kf, kp0 + sl_next, d0); SBAR(); } } while (0)
#define GAPA(MF, a0, a1, a2, a3, W0, W1, PW) do { MF; sacc += a0; sacc += a1; sacc += a2; sacc += a3; W0; W1; PIN(PW); PIN(sacc); SBAR(); } while (0)
#define GAPB1(MF, i, X, j, nm) do { MF; VRD(i, 8192); X[j] = EX(X[j], nm); X[j + 1] = EX(X[j + 1], nm); PIN(X); SBAR(); } while (0)
#define GAPB2(MF, X, j, nm) do { MF; X[j] = EX(X[j], nm); X[j + 1] = EX(X[j + 1], nm); PIN(X); SBAR(); } while (0)
#define STEP(C0, C1, P0, P1, t, BAND, GK, GV, GL) do { SBAR(); \
    const lds_cptr vp_ = vp0 + 2 * sl_prev; \
    VRD(0, 0); bf16x8 qa_ = QF(0); SBAR(); float sacc = P0[0] + P0[1]; const f32x16 z_ = f32x16{}; \
                       GAPA(C0 = MFMA(kf[0], qa_, z_), P0[2], P0[3], P0[4], P0[5],     pw0[0] = PKW(P0, 0),  pw0[1] = PKW(P0, 2),  pw0); \
    VRD(4, 0); bf16x8 qb_ = QF(1); SBAR(); GAPA(C1 = MFMA(kf[1], qa_, z_), P0[6], P0[7], P0[8], P0[9],     pw0[2] = PKW(P0, 4),  pw0[3] = PKW(P0, 6),  pw0);     \
    VRD(1, 0); SBAR(); GAPA(C0 = MFMA(kf[2], qb_, C0),  P0[10], P0[11], P0[12], P0[13], pw1[0] = PKW(P0, 8),  pw1[1] = PKW(P0, 10), pw1); \
    VRD(5, 0); qa_ = QF(2); SBAR(); GAPA(C1 = MFMA(kf[3], qb_, C1),  P0[14], P0[15], P1[0], P1[1],   pw1[2] = PKW(P0, 12), pw1[3] = PKW(P0, 14), pw1); \
    VRD(2, 0); SBAR(); GAPA(C0 = MFMA(kf[4], qa_, C0),  P1[2], P1[3], P1[4], P1[5],     pw2[0] = PKW(P1, 0),  pw2[1] = PKW(P1, 2),  pw2); \
    VRD(6, 0); qb_ = QF(3); SBAR(); GAPA(C1 = MFMA(kf[5], qa_, C1),  P1[6], P1[7], P1[8], P1[9],     pw2[2] = PKW(P1, 4),  pw2[3] = PKW(P1, 6),  pw2); \
    VRD(3, 0); SBAR(); GAPA(C0 = MFMA(kf[6], qb_, C0),  P1[10], P1[11], P1[12], P1[13], pw3[0] = PKW(P1, 8),  pw3[1] = PKW(P1, 10), pw3); \
    VRD(7, 0); SBAR(); GAPA(C1 = MFMA(kf[7], qb_, C1),  P1[14], P1[15], 0.f, 0.f,       pw3[2] = PKW(P1, 12), pw3[3] = PKW(P1, 14), pw3); \
    l_reg += sacc; \
    if (GK) DMA_K((t) + 3, sl_cur); if (GV) DMA_V((t) + 1, sl_next); \
    BIAS(C0, C1); APPLY(C0, C1, t, BAND); \
    { const float rm = __builtin_fmaf(rowmax_h(C0, C1, hoff) + bt, C2, -mhat); resc = false; \
      if (__builtin_expect(__any(rm > ATT_THR), 0)) { const float dl = __builtin_fmaxf(rm, 0.f); mhat += dl; \
          const float f = __builtin_amdgcn_exp2f(-dl); l_reg *= f; if (hi == 0) wsf[r32] = f; resc = true; } } \
    const float nmh = __builtin_fmaf(bt + hoff, C2, -mhat); bt += tstep; SBAR(); \
    GAPB1(o[0] = MFMA(PAF(0), VFR(0), o[0]), 0, C0, 0, nmh);              GAPB1(o[1] = MFMA(PAF(0), VFR(4), o[1]), 4, C0, 2, nmh); \
    GAPB1(o[0] = MFMA(PAF(1), VFR(1), o[0]), 1, C0, 4, nmh);              GAPB1(o[1] = MFMA(PAF(1), VFR(5), o[1]), 5, C0, 6, nmh); \
    GAPB1(o[0] = MFMA(PAF(2), VFR(2), o[0]), 2, C0, 8, nmh);              GAPB1(o[1] = MFMA(PAF(2), VFR(6), o[1]), 6, C0, 10, nmh); \
    GAPB1(o[0] = MFMA(PAF(3), VFR(3), o[0]), 3, C0, 12, nmh);             GAPB1(o[1] = MFMA(PAF(3), VFR(7), o[1]), 7, C0, 14, nmh); \
    GAPB2(o[2] = MFMA(PAF(0), VFR(0), o[2]), C1, 0, nmh);                 GAPB2(o[3] = MFMA(PAF(0), VFR(4), o[3]), C1, 2, nmh); \
    KRD(GL, 0); GAPB2(o[2] = MFMA(PAF(1), VFR(1), o[2]), C1, 4, nmh);     KRD(GL, 1); GAPB2(o[3] = MFMA(PAF(1), VFR(5), o[3]), C1, 6, nmh); \
    KRD(GL, 2); GAPB2(o[2] = MFMA(PAF(2), VFR(2), o[2]), C1, 8, nmh);     KRD(GL, 3); GAPB2(o[3] = MFMA(PAF(2), VFR(6), o[3]), C1, 10, nmh); \
    GAPB2(o[2] = MFMA(PAF(3), VFR(3), o[2]), C1, 12, nmh);                GAPB2(o[3] = MFMA(PAF(3), VFR(7), o[3]), C1, 14, nmh); \
    } while (0)
    int t = 1;
    for (; t + 5 < NT; t += 2) {
        STEP(pB0, pB1, pA0, pA1, t, false, true, true, true);     WAIT_BAR(3); RESC(); ROT();
        STEP(pA0, pA1, pB0, pB1, t + 1, false, true, true, true); WAIT_BAR(3); RESC(); ROT();
    }
#define ENDW(tt) do { if ((tt) + 3 < NT) { WAIT_BAR(3); } else if ((tt) + 2 < NT) { WAIT_BAR(2); } else { WAIT_BAR(0); } } while (0)
    for (; t + 1 < NT; t += 2) {
        STEP(pB0, pB1, pA0, pA1, t, true, (t + 3 < NT), (t + 1 < NT), (t + 1 < NT));         ENDW(t);     RESC(); ROT();
        STEP(pA0, pA1, pB0, pB1, t + 1, true, (t + 4 < NT), (t + 2 < NT), (t + 2 < NT));     ENDW(t + 1); RESC(); ROT();
    }
    STEP(pB0, pB1, pA0, pA1, NT - 1, true, false, false, false); RESC();
    { float sacc = pB0[0] + pB0[1];
#pragma unroll
      for (int r = 2; r < 16; ++r) sacc += pB0[r];
#pragma unroll
      for (int r = 0; r < 16; ++r) sacc += pB1[r];
      l_reg += sacc;
      pw0 = (u32x4){PKW(pB0, 0), PKW(pB0, 2), PKW(pB0, 4), PKW(pB0, 6)}; pw1 = (u32x4){PKW(pB0, 8), PKW(pB0, 10), PKW(pB0, 12), PKW(pB0, 14)};
      pw2 = (u32x4){PKW(pB1, 0), PKW(pB1, 2), PKW(pB1, 4), PKW(pB1, 6)}; pw3 = (u32x4){PKW(pB1, 8), PKW(pB1, 10), PKW(pB1, 12), PKW(pB1, 14)};
      const lds_cptr vp_ = vp0 + 2 * sl_cur;
#pragma unroll
      for (int hf = 0; hf < 2; ++hf) {
        _Pragma("unroll") for (int i = 0; i < 8; ++i) VRD(i, hf * 8192);
        o[2 * hf] = MFMA(PAF(0), VFR(0), o[2 * hf]); o[2 * hf + 1] = MFMA(PAF(0), VFR(4), o[2 * hf + 1]); o[2 * hf] = MFMA(PAF(1), VFR(1), o[2 * hf]); o[2 * hf + 1] = MFMA(PAF(1), VFR(5), o[2 * hf + 1]);
        o[2 * hf] = MFMA(PAF(2), VFR(2), o[2 * hf]); o[2 * hf + 1] = MFMA(PAF(2), VFR(6), o[2 * hf + 1]); o[2 * hf] = MFMA(PAF(3), VFR(3), o[2 * hf]); o[2 * hf + 1] = MFMA(PAF(3), VFR(7), o[2 * hf + 1]); } }
    { auto rr = __builtin_amdgcn_permlane32_swap(__float_as_uint(l_reg), __float_as_uint(l_reg), false, false); l_reg = __uint_as_float(rr[0]) + __uint_as_float(rr[1]); }
    if (hi == 0) wsf[32 + r32] = l_reg;
    asm volatile("s_waitcnt lgkmcnt(0)\n\ts_barrier" ::: "memory");
#undef DMA_K
#undef DMA_V
#undef QF
#undef ROT
#undef EX
#undef RESC
#undef BIAS
#undef APPLY
#undef PKW
#undef PAF
#undef VFR
#undef VRD
#undef KRD
#undef ENDW
#undef GAPA
#undef GAPB1
#undef GAPB2
#undef STEP
}
__device__ __forceinline__ void unit_a(int b, int h, int qb, const bf16* QA, const bf16* KA, const bf16* VA, const unsigned long long* MASK, bf16* YA, char* lds) {
    const int tid = threadIdx.x; const int wid = __builtin_amdgcn_readfirstlane(tid >> 6);
    const long rowbase = (long)b * SEQ; const long qrow0 = rowbase + qb * QB + wid * QBLK;
    const float s8 = 8.f * __builtin_amdgcn_exp2f(-(float)(h + 1));
    f32x16 o[2];
    attn_core<true>(o, QA + qrow0 * 512 + h * 64, 512, KA + rowbase * 512 + h * 64, 512, VA + rowbase * 512 + h * 64, 512, qb, s8,
                    MASK + ((size_t)(b * 64 + qb * 8 + wid) * 32) * 32, lds);
    int lz = threadIdx.x & 63; asm volatile("" : "+v"(lz));
    const int lane = lz, r32 = lz & 31, hi = lz >> 5;
    const lds_fptr wsf = (lds_fptr)((lds_ptr)lds + LDS_WS) + wid * WSW;
    float rli[16];
#pragma unroll
    for (int r = 0; r < 16; ++r) rli[r] = __builtin_amdgcn_rcpf(wsf[32 + crow(r, hi)]) * (1.0f + SCALE_A_EPS);
    typedef __attribute__((address_space(3))) unsigned short* lds_hptr;
    const lds_hptr stg = (lds_hptr)((lds_ptr)lds + LDS_OST) + wid * 2048;
#pragma unroll
    for (int r = 0; r < 16; ++r) { const int orow = crow(r, hi);
#pragma unroll
        for (int d0 = 0; d0 < 2; ++d0) stg[orow * 64 + d0 * 32 + r32] = f2bf(o[d0][r] * rli[r]); }
    asm volatile("s_waitcnt lgkmcnt(0)" ::: "memory");
    bf16* Ow = YA + qrow0 * 1024 + h * 64;
#pragma unroll
    for (int i = 0; i < 4; ++i) { const int row = i * 8 + (lane >> 3), ch = lane & 7; *(u32x4*)(Ow + (long)row * 1024 + ch * 8) = *(const __attribute__((address_space(3))) u32x4*)(stg + row * 64 + ch * 8); }
    asm volatile("s_waitcnt lgkmcnt(0)" ::: "memory");
}
__device__ __forceinline__ void unit_b128(int b, int h, int qb, const bf16* QBq, const bf16* KBk, const bf16* VBv, const float* subln_g, float lam, bf16* YB, unsigned* stash_g, int slot, char* lds) {
    const int tid = threadIdx.x; const int wid = __builtin_amdgcn_readfirstlane(tid >> 6);
    const long rowbase = (long)b * SEQ; const long qrow0 = rowbase + qb * QB + wid * QBLK;
    const float s8 = 8.f * __builtin_amdgcn_exp2f(-2.f * (float)(h + 1));
    typedef __attribute__((address_space(3))) unsigned short* lds_hptr;
    _Pragma("nounroll") for (int m = 0; m < 2; ++m) {
        f32x16 o[4];
        attn_core128(o, QBq + qrow0 * 512 + (2 * h + m) * 64, 512, KBk + rowbase * 512 + (2 * h + m) * 64, 512, VBv + rowbase * 512 + h * 128, 512, qb, s8, lds);
        int lz = threadIdx.x & 63; asm volatile("" : "+v"(lz));
        const int lane = lz, r32 = lz & 31, hi = lz >> 5;
        const lds_fptr wsf = (lds_fptr)((lds_ptr)lds + L8_WS) + wid * WSW;
        const lds_hptr stg = (lds_hptr)((lds_ptr)lds + L8_OST) + wid * 2048;
        unsigned* sg = stash_g + (((size_t)blockIdx.x * 2 + slot) * NW + wid) * 2048 + lane;
        bf16* Ow = YB + qrow0 * 1024 + 512 + h * 128;
        float rli[16];
#pragma unroll
        for (int r = 0; r < 16; ++r) rli[r] = __builtin_amdgcn_rcpf(wsf[32 + crow(r, hi)]);
        if (m == 0) {
#pragma unroll
            for (int d = 0; d < 4; ++d)
#pragma unroll
                for (int r = 0; r < 16; r += 2) sg[(d * 8 + (r >> 1)) * 64] = cvtpk(o[d][r] * rli[r], o[d][r + 1] * rli[r + 1]);
        } else {
            float ssp[16];
#pragma unroll
            for (int r = 0; r < 16; ++r) ssp[r] = 0.f;
#pragma unroll
            for (int d = 0; d < 4; ++d)
#pragma unroll
                for (int r = 0; r < 16; r += 2) { const unsigned w = __hip_atomic_load(sg + (d * 8 + (r >> 1)) * 64, __ATOMIC_RELAXED, __HIP_MEMORY_SCOPE_AGENT);
                    const float v0 = __uint_as_float(w << 16) - lam * (o[d][r] * rli[r]), v1 = __uint_as_float(w & 0xffff0000u) - lam * (o[d][r + 1] * rli[r + 1]);
                    o[d][r] = v0; o[d][r + 1] = v1; ssp[r] += v0 * v0; ssp[r + 1] += v1 * v1; }
#pragma unroll
            for (int r = 0; r < 16; ++r) {
#pragma unroll
                for (int off = 1; off < 32; off <<= 1) ssp[r] += __shfl_xor(ssp[r], off); }
#pragma unroll
            for (int r = 0; r < 16; ++r) ssp[r] = __builtin_amdgcn_rsqf(ssp[r] * (1.0f / 128.0f) + 1e-6f) * (0.8f * (1.0f + SCALE_B_EPS));
            if (r32 == 0) {
#pragma unroll
                for (int r = 0; r < 16; ++r) wsf[64 + crow(r, hi)] = ssp[r]; }
            asm volatile("s_waitcnt lgkmcnt(0)" ::: "memory");
#pragma unroll
            for (int e = 0; e < 2; ++e) {
#pragma unroll
                for (int r = 0; r < 16; ++r) { const int orow = crow(r, hi);
#pragma unroll
                    for (int d0 = 0; d0 < 2; ++d0) stg[orow * 64 + d0 * 32 + r32] = f2bf(o[2 * e + d0][r]); }
                asm volatile("s_waitcnt lgkmcnt(0)" ::: "memory");
                const int ch = lane & 7;
                const float4 g0 = *(const float4*)(subln_g + e * 64 + ch * 8), g1 = *(const float4*)(subln_g + e * 64 + ch * 8 + 4);
#pragma unroll
                for (int i = 0; i < 4; ++i) { const int row = i * 8 + (lane >> 3); const float rs = wsf[64 + row];
                    const u32x4 w = *(const __attribute__((address_space(3))) u32x4*)(stg + row * 64 + ch * 8); u32x4 ov;
                    ov.x = cvtpk(__uint_as_float(w.x << 16) * rs * g0.x, __uint_as_float(w.x & 0xffff0000u) * rs * g0.y);
                    ov.y = cvtpk(__uint_as_float(w.y << 16) * rs * g0.z, __uint_as_float(w.y & 0xffff0000u) * rs * g0.w);
                    ov.z = cvtpk(__uint_as_float(w.z << 16) * rs * g1.x, __uint_as_float(w.z & 0xffff0000u) * rs * g1.y);
                    ov.w = cvtpk(__uint_as_float(w.w << 16) * rs * g1.z, __uint_as_float(w.w & 0xffff0000u) * rs * g1.w);
                    *(u32x4*)(Ow + (long)row * 1024 + e * 64 + ch * 8) = ov; }
                asm volatile("s_waitcnt lgkmcnt(0)" ::: "memory");
            }
        }
    }
}
#undef SBAR
#undef PIN
#undef MFMA
#undef WAIT_BAR
#undef MX3
}
#ifndef KEYMASK
#define KEYMASK 0xfffff800u
#endif
namespace sel {
using att::bf16x8; using att::f32x16; using att::crow; typedef unsigned short bf16;
constexpr int TBP = 513;
__device__ __forceinline__ void select_unit(int b, int qk, const bf16* QI, const bf16* KI, const float* WI, unsigned long long* MASK, char* lds) {
    int lz_ = threadIdx.x & 63; asm volatile("" : "+v"(lz_));
    const int tid = threadIdx.x, lane = lz_, r32 = lane & 31, hi = lane >> 5; const int wid = __builtin_amdgcn_readfirstlane(tid >> 6);
    const int ntv = (qk >> 1) + 1;
    unsigned long long* mbase = MASK + ((size_t)(b * 64 + qk) * 32) * 32;
    if (qk < 8) {
        for (int i = tid; i < 32 * 32; i += 512) mbase[i] = ((i >> 5) < ntv) ? ~0ull : 0ull;
        return;
    }
    typedef __attribute__((address_space(3))) char* lds_ptr;
    typedef __attribute__((address_space(3))) unsigned* lds_uptr;
    const lds_ptr QL = (lds_ptr)lds;
    const lds_uptr TB = (lds_uptr)((lds_ptr)lds + 16384);
    const size_t qrow0 = (size_t)b * 2048 + qk * 32;
    { const int c = tid & 31, q0 = tid >> 5;
#pragma unroll
      for (int u = 0; u < 2; ++u) { const int q = q0 + 16 * u; *(__attribute__((address_space(3))) att::u32x4*)(QL + c * 512 + q * 16) = *(const att::u32x4*)(QI + (qrow0 + q) * 256 + c * 8); } }
    typedef float f32x4_t __attribute__((ext_vector_type(4)));
    const f32x4_t wv = *(const f32x4_t*)(WI + (qrow0 + r32) * 4);
    __syncthreads();
    unsigned keyT[4][32];
    bf16x8 kfa[2][4];
#define SEL_KLOAD(jn) do { _Pragma("unroll") for (int p_ = 0; p_ < 2; ++p_) _Pragma("unroll") for (int d0 = 0; d0 < 4; ++d0) \
        kfa[p_][d0] = *(const bf16x8*)(KI + ((size_t)b * 2048 + (jn) * 64 + p_ * 32 + r32) * 64 + d0 * 16 + hi * 8); } while (0)
    if (wid < ntv) SEL_KLOAD(wid);
#pragma unroll
    for (int jj = 0; jj < 4; ++jj) {
        if (8 * jj < ntv) {
            const int j = 8 * jj + wid;
            unsigned kk[32];
            if (j < ntv) {
#pragma unroll
                for (int p = 0; p < 2; ++p) {
                    const bf16x8 kf[4] = {kfa[p][0], kfa[p][1], kfa[p][2], kfa[p][3]};
                    f32x16 s0 = f32x16{};
#pragma unroll
                    for (int h = 0; h < 4; ++h) {
                        bf16x8 qf[4];
#pragma unroll
                        for (int d0 = 0; d0 < 4; ++d0) qf[d0] = *(const __attribute__((address_space(3))) bf16x8*)(QL + ((h * 4 + d0) * 2 + hi) * 512 + r32 * 16);
                        f32x16 y0 = f32x16{};
#pragma unroll
                        for (int d0 = 0; d0 < 4; ++d0) y0 = __builtin_amdgcn_mfma_f32_32x32x16_bf16(kf[d0], qf[d0], y0, 0, 0, 0);
                        asm volatile("" : "+v"(y0));
                        const float w = wv[h];
#pragma unroll
                        for (int r = 0; r < 16; ++r) { const float yv = y0[r]; const int yi = __float_as_int(yv); s0[r] = __builtin_fmaf(__int_as_float(yi > 0 ? yi : 0), w, s0[r]); }
                    }
#pragma unroll
                    for (int r = 0; r < 16; ++r) {
                        const unsigned idx = (unsigned)(j * 64 + p * 32 + crow(r, hi));
                        const unsigned u = __float_as_uint(s0[r]); const unsigned m = (unsigned)(((int)u) >> 31) | 0x80000000u; kk[16 * p + r] = ((u ^ m) & KEYMASK) | (2047u - idx);
                    }
                    __builtin_amdgcn_sched_barrier(0);
                }
            } else {
#pragma unroll
                for (int e = 0; e < 32; ++e) kk[e] = 0u;
            }
            if (jj < 3 && j + 8 < ntv) SEL_KLOAD(j + 8);
#pragma unroll
            for (int p = 0; p < 2; ++p)
#pragma unroll
                for (int r = 0; r < 16; ++r) TB[r32 * TBP + 64 * wid + 32 * p + crow(r, hi)] = kk[16 * p + r];
            __syncthreads();
#pragma unroll
            for (int i = 0; i < 4; ++i)
#pragma unroll
                for (int t = 0; t < 8; ++t) keyT[jj][8 * i + t] = TB[(4 * wid + i) * TBP + 64 * t + lane];
            __syncthreads();
        } else {
#pragma unroll
            for (int e = 0; e < 32; ++e) keyT[jj][e] = 0u;
        }
    }
    unsigned T0 = 0u, T1 = 0u, T2 = 0u, T3 = 0u; bool dn0 = false, dn1 = false, dn2 = false, dn3 = false;
#define SEL_CNT8(c_, cand, K, o) do { unsigned long long m0_, m1_, m2_, m3_, m4_, m5_, m6_, m7_; unsigned t_; \
        asm volatile("v_cmp_le_u32_e64 %0, %10, %11\n\tv_cmp_le_u32_e64 %1, %10, %12\n\tv_cmp_le_u32_e64 %2, %10, %13\n\tv_cmp_le_u32_e64 %3, %10, %14\n\t" \
                     "v_cmp_le_u32_e64 %4, %10, %15\n\tv_cmp_le_u32_e64 %5, %10, %16\n\tv_cmp_le_u32_e64 %6, %10, %17\n\tv_cmp_le_u32_e64 %7, %10, %18\n\t" \
                     "s_bcnt1_i32_b64 %8, %0\n\ts_add_u32 %9, %9, %8\n\ts_bcnt1_i32_b64 %8, %1\n\ts_add_u32 %9, %9, %8\n\ts_bcnt1_i32_b64 %8, %2\n\ts_add_u32 %9, %9, %8\n\ts_bcnt1_i32_b64 %8, %3\n\ts_add_u32 %9, %9, %8\n\t" \
                     "s_bcnt1_i32_b64 %8, %4\n\ts_add_u32 %9, %9, %8\n\ts_bcnt1_i32_b64 %8, %5\n\ts_add_u32 %9, %9, %8\n\ts_bcnt1_i32_b64 %8, %6\n\ts_add_u32 %9, %9, %8\n\ts_bcnt1_i32_b64 %8, %7\n\ts_add_u32 %9, %9, %8" \
                     : "=&s"(m0_), "=&s"(m1_), "=&s"(m2_), "=&s"(m3_), "=&s"(m4_), "=&s"(m5_), "=&s"(m6_), "=&s"(m7_), "=&s"(t_), "+s"(c_) \
                     : "s"(cand), "v"(K[(o)]), "v"(K[(o) + 1]), "v"(K[(o) + 2]), "v"(K[(o) + 3]), "v"(K[(o) + 4]), "v"(K[(o) + 5]), "v"(K[(o) + 6]), "v"(K[(o) + 7]) : "scc"); } while (0)
#define SEL_CNT4(c_, cand, K, o) do { unsigned long long m0_, m1_, m2_, m3_; unsigned t_; \
        asm volatile("v_cmp_le_u32_e64 %0, %6, %7\n\tv_cmp_le_u32_e64 %1, %6, %8\n\tv_cmp_le_u32_e64 %2, %6, %9\n\tv_cmp_le_u32_e64 %3, %6, %10\n\t" \
                     "s_bcnt1_i32_b64 %4, %0\n\ts_add_u32 %5, %5, %4\n\ts_bcnt1_i32_b64 %4, %1\n\ts_add_u32 %5, %5, %4\n\ts_bcnt1_i32_b64 %4, %2\n\ts_add_u32 %5, %5, %4\n\ts_bcnt1_i32_b64 %4, %3\n\ts_add_u32 %5, %5, %4" \
                     : "=&s"(m0_), "=&s"(m1_), "=&s"(m2_), "=&s"(m3_), "=&s"(t_), "+s"(c_) \
                     : "s"(cand), "v"(K[(o)]), "v"(K[(o) + 1]), "v"(K[(o) + 2]), "v"(K[(o) + 3]) : "scc"); } while (0)
#ifdef SEL_SAFE
#define SEL_CNT(i, cand) ({ unsigned c_ = 0u; \
        _Pragma("unroll") for (int jj = 0; jj < 4; ++jj) { if (8 * jj < ntv) { \
            _Pragma("unroll") for (int t = 0; t < 8; ++t) c_ += (unsigned)__builtin_popcountll(__ballot(keyT[jj][8 * (i) + t] >= (cand))); __builtin_amdgcn_sched_barrier(0); } } c_; })
#else
#define SEL_CNT(i, cand) ({ unsigned c_ = 0u; const unsigned cd_ = (unsigned)__builtin_amdgcn_readfirstlane((int)(cand)); \
        _Pragma("unroll") for (int jj = 0; jj < 4; ++jj) { if (8 * jj + 4 < ntv) { SEL_CNT8(c_, cd_, keyT[jj], 8 * (i)); } else if (8 * jj < ntv) { SEL_CNT4(c_, cd_, keyT[jj], 8 * (i)); } } c_; })
#endif
    for (int bit = 31; bit >= 0; --bit) {
        const unsigned bm = 1u << bit;
        if (!dn0) { const unsigned c = SEL_CNT(0, T0 | bm); if (c >= 256u) T0 |= bm; dn0 = (c == 256u); }
        if (!dn1) { const unsigned c = SEL_CNT(1, T1 | bm); if (c >= 256u) T1 |= bm; dn1 = (c == 256u); }
        if (!dn2) { const unsigned c = SEL_CNT(2, T2 | bm); if (c >= 256u) T2 |= bm; dn2 = (c == 256u); }
        if (!dn3) { const unsigned c = SEL_CNT(3, T3 | bm); if (c >= 256u) T3 |= bm; dn3 = (c == 256u); }
        if (dn0 && dn1 && dn2 && dn3) break;
    }
#undef SEL_CNT
#undef SEL_KLOAD
#undef SEL_CNT8
#undef SEL_CNT4
#pragma unroll
    for (int i = 0; i < 4; ++i) {
        const unsigned Ti = (i == 0) ? T0 : (i == 1) ? T1 : (i == 2) ? T2 : T3;
        unsigned wlo = 0u, whi = 0u;
#pragma unroll
        for (int jj = 0; jj < 4; ++jj) { int ln_ = lane; asm volatile("" : "+v"(ln_));
#pragma unroll
            for (int t = 0; t < 8; ++t) { const unsigned long long mk = __ballot(keyT[jj][8 * i + t] >= Ti);
                wlo = (ln_ == 8 * jj + t) ? (unsigned)mk : wlo; whi = (ln_ == 8 * jj + t) ? (unsigned)(mk >> 32) : whi; if ((t & 3) == 3) __builtin_amdgcn_sched_barrier(0); } }
        if (lane < 32) mbase[(size_t)lane * 32 + 4 * wid + i] = ((unsigned long long)whi << 32) | wlo;
    }
    __syncthreads();
}
}
constexpr int NWAVES = 8;
#ifndef MK_N_LAUNCHES
#define MK_N_LAUNCHES 1
#endif
constexpr int N_PHASES = 10;
constexpr int N_LAUNCHES = MK_N_LAUNCHES;
constexpr int BATCH = 16, SEQ = 2048, DM = 1024, M = BATCH * SEQ, DFF = 2816, W_IN = 5444, NPROJ = 5632, NFF13 = 5632;
constexpr size_t MiB = 1u << 20;
constexpr size_t WS_CTL = 0, CTL_ZERO_BYTES = 64 * 1024;
constexpr size_t WS_MOD = 1 * MiB;
constexpr size_t WS_LAM = 1 * MiB + 512 * 1024;
constexpr size_t WS_GN = 1 * MiB + 768 * 1024;
constexpr size_t WS_WIN = 2 * MiB, WS_WUA = 13 * MiB  , WS_WO = 15 * MiB, WS_W13 = 17 * MiB, WS_W2 = 28 * MiB;
constexpr size_t WS_XH = 64 * MiB;
constexpr size_t WS_YA = 64 * MiB;
constexpr size_t WS_QA = 128 * MiB, WS_KA = 160 * MiB, WS_VA = 192 * MiB, WS_QB = 224 * MiB, WS_KB = 256 * MiB, WS_VB = 288 * MiB, WS_QI = 320 * MiB, WS_KI = 336 * MiB, WS_WI = 340 * MiB;
constexpr size_t WS_MG = 128 * MiB;
constexpr size_t WS_HID = 128 * MiB;
constexpr size_t WS_GT = 344 * MiB;
constexpr size_t WS_MASK = 472 * MiB;
constexpr size_t WS_STASH = 480 * MiB;
constexpr size_t WS_END = 512 * MiB;
static_assert(epi::PWS_GN == WS_GN && epi::PWS_QA == WS_QA && epi::PWS_QI == WS_QI && epi::PWS_KI == WS_KI && epi::PWS_WI == WS_WI && epi::PWS_GT == WS_GT && WS_KA - WS_QA == 32 * MiB && WS_VB - WS_QA == 160 * MiB, "EpiProj offsets");
static_assert(WS_W2 + (size_t)DM * DFF * 2 <= WS_XH && WS_WI + (size_t)M * 16 <= WS_GT && WS_HID + (size_t)M * DFF * 2 <= WS_GT && WS_GT + (size_t)M * 2048 * 2 <= WS_MASK, "d_ws map");
constexpr int CW_BAR = 1024;
constexpr int RING_BYTES = 151552;
constexpr int LDSCTL_OFF = RING_BYTES, MISC_OFF = LDSCTL_OFF + 320, LDS_BYTES = 155648;
static_assert(att::LDS_BYTES <= RING_BYTES && pg8::STAGE_BYTES <= RING_BYTES && MISC_OFF + 128 <= LDS_BYTES, "LDS map");

#define GAS __attribute__((address_space(1)))
#define LAS __attribute__((address_space(3)))
typedef unsigned short bf16;
typedef unsigned v4u __attribute__((ext_vector_type(4)));
typedef float f32x4 __attribute__((ext_vector_type(4)));
typedef GAS unsigned gu32;
#define RLX_AGENT __ATOMIC_RELAXED, __HIP_MEMORY_SCOPE_AGENT
#define LDS_WAIT() asm volatile("s_waitcnt lgkmcnt(0)" ::: "memory")
__device__ __forceinline__ unsigned f2bf(float f) { unsigned u = __builtin_bit_cast(unsigned, f); return (u + 0x7fffu + ((u >> 16) & 1u)) >> 16; }
__device__ __forceinline__ unsigned pk2(float lo, float hi) { return f2bf(lo) | (f2bf(hi) << 16); }
#define XB_TMO      128
#define XB_XCNT(j)  (256  + 64 * (j))
#define XB_XSUB(j)  (1280 + 64 * (j))
#define XB_XGEN(j)  (2304 + 64 * (j))
#define XB_TOP      3328
#define XB_TOPGEN   3392
#define XCD_BAR_WORDS 3456
#ifdef CHECKER
#define XB_SPIN_CAP (1u << 27)
#else
#define XB_SPIN_CAP (1u << 18)
#endif

__device__ __forceinline__ unsigned xb_ld(unsigned* p)              { return __hip_atomic_load(p, __ATOMIC_RELAXED, __HIP_MEMORY_SCOPE_AGENT); }
__device__ __forceinline__ unsigned xb_add(unsigned* p, unsigned v) { return __hip_atomic_fetch_add(p, v, __ATOMIC_RELAXED, __HIP_MEMORY_SCOPE_AGENT); }
__device__ __forceinline__ unsigned xb_xcc_id() { return (unsigned)__builtin_amdgcn_s_getreg((3 << 11) | 20) & 0xFu; }
#define XB_SPIN(cond, bar) do { unsigned _sp = 0; while (cond) { __builtin_amdgcn_s_sleep(1); \
    if ((++_sp & 255u) == 0u) { if (xb_ld(&(bar)[XB_TMO])) break; if (_sp > XB_SPIN_CAP) { atomicAdd(&(bar)[XB_TMO], 1u); break; } } } } while (0)

struct XcdBarrier {
    unsigned* bar; unsigned x;
    volatile LAS unsigned* st;
};

__device__ __forceinline__ XcdBarrier xcd_barrier_post(unsigned* bar, volatile LAS unsigned* st) {
    XcdBarrier b; b.bar = bar; b.x = xb_xcc_id(); b.st = st;
    if (threadIdx.x == 0) (void)xb_add(&bar[XB_XCNT(b.x)], 1u);
    return b;
}
__device__ __forceinline__ void xcd_barrier_complete(unsigned* bar, unsigned x, unsigned& nloc, unsigned& nx) {
    const unsigned G = gridDim.x * gridDim.y * gridDim.z;
    unsigned sum, cnt, mine, sp = 0u;
    for (;;) {
        sum = 0u; cnt = 0u; mine = 0u;
#pragma unroll
        for (unsigned j = 0; j < 16; ++j) { const unsigned c = xb_ld(&bar[XB_XCNT(j)]); sum += c; cnt += (c > 0u) ? 1u : 0u; mine = (j == x) ? c : mine; }
        if (sum == G) break;
        __builtin_amdgcn_s_sleep(1);
        if ((++sp & 255u) == 0u) { if (xb_ld(&bar[XB_TMO])) break; if (sp > XB_SPIN_CAP) { atomicAdd(&bar[XB_TMO], 1u); break; } }
    }
    nloc = mine > 0u ? mine : 1u; nx = cnt > 0u ? cnt : 1u;
}

__device__ __forceinline__ void xcd_barrier(const XcdBarrier& b) {
    asm volatile("s_waitcnt vmcnt(0)" ::: "memory");
    __syncthreads();
    if (threadIdx.x == 0) {
        unsigned* bar = b.bar;
        __builtin_amdgcn_s_waitcnt(0);
        unsigned nloc = b.st[0], nx = b.st[1];
        if (nloc == 0u) { xcd_barrier_complete(bar, b.x, nloc, nx); b.st[0] = nloc; b.st[1] = nx; }
        const unsigned old = xb_add(&bar[XB_XSUB(b.x)], 1u);
        const unsigned gen = old / nloc;
        if (old + 1u == (gen + 1u) * nloc) {
            __builtin_amdgcn_fence(__ATOMIC_RELEASE, "agent");
            asm volatile("s_waitcnt vmcnt(0)" ::: "memory");
            const unsigned og = xb_add(&bar[XB_TOP], 1u);
            const unsigned tg = og / nx;
            if (og + 1u == (tg + 1u) * nx) xb_add(&bar[XB_TOPGEN], 1u);
            else XB_SPIN(xb_ld(&bar[XB_TOPGEN]) == tg, bar);
            __builtin_amdgcn_fence(__ATOMIC_ACQUIRE, "agent");
            xb_add(&bar[XB_XGEN(b.x)], 1u);
            asm volatile("s_waitcnt vmcnt(0)" ::: "memory");
        } else {
            XB_SPIN(xb_ld(&bar[XB_XGEN(b.x)]) == gen, bar);
            __builtin_amdgcn_fence(__ATOMIC_ACQUIRE, "agent");
            asm volatile("s_waitcnt vmcnt(0)" ::: "memory");
        }
    }
    __syncthreads();
}

#define XB_GRP(g)   (3584 + 64 * (g))
#define XB_WRDY     8192
__device__ __forceinline__ void grp_barrier(unsigned* bar, int grp, unsigned members) {
    asm volatile("s_waitcnt vmcnt(0)" ::: "memory");
    __syncthreads();
    if (threadIdx.x == 0) {
        __builtin_amdgcn_fence(__ATOMIC_RELEASE, "agent");
        asm volatile("s_waitcnt vmcnt(0)" ::: "memory");
        unsigned* c = &bar[XB_GRP(grp)];
        const unsigned old = xb_add(c, 1u); const unsigned target = (old / members + 1u) * members;
        XB_SPIN(xb_ld(c) < target, bar);
        __builtin_amdgcn_fence(__ATOMIC_ACQUIRE, "agent");
        asm volatile("s_waitcnt vmcnt(0)" ::: "memory");
    }
    __syncthreads();
}
__device__ __forceinline__ void wrdy_post(unsigned* bar) {
    asm volatile("s_waitcnt vmcnt(0)" ::: "memory");
    __syncthreads();
    if (threadIdx.x == 0) { __builtin_amdgcn_fence(__ATOMIC_RELEASE, "agent"); asm volatile("s_waitcnt vmcnt(0)" ::: "memory"); (void)xb_add(&bar[XB_WRDY], 1u); }
}
__device__ __forceinline__ void wrdy_wait(unsigned* bar, unsigned total) {
    if (threadIdx.x == 0) { XB_SPIN(xb_ld(&bar[XB_WRDY]) < total, bar); __builtin_amdgcn_fence(__ATOMIC_ACQUIRE, "agent"); asm volatile("s_waitcnt vmcnt(0)" ::: "memory"); }
    __syncthreads();
}

struct Frame {
    LAS unsigned char* lds; volatile LAS unsigned* MISC; gu32* ctl;
    int tid, lane, wave, vcu, G;
};
__device__ __forceinline__ float wave_sum(float v) {
#pragma unroll
    for (int o = 1; o < 64; o <<= 1) v += __shfl_xor(v, o);
    return v;
}
template <class Map>
__device__ __forceinline__ void transpose_item(const float* W, int K, int N, bf16* WT, Map map, LAS float* scr, int item, int lane, int ld = 0, int koff = 0) {
    const int nblk = (N + 31) / 32, kb = item / nblk, nb = item % nblk, k0 = 64 * kb, n0 = 32 * nb;
    const int nr = n0 + (lane & 31);
    float wv[32];
#pragma unroll
    for (int i = 0; i < 32; ++i) { const int kk = 2 * i + (lane >> 5); wv[i] = (nr < N) ? W[(size_t)(k0 + kk) * N + nr] : 0.f; }
#pragma unroll
    for (int i = 0; i < 32; ++i) { const int kk = 2 * i + (lane >> 5); scr[kk * 33 + (lane & 31)] = wv[i]; }
    LDS_WAIT(); asm volatile("" ::: "memory");
    const int c = lane & 7;
#pragma unroll
    for (int j = 0; j < 4; ++j) { const int nl = (lane >> 3) + 8 * j; const LAS float* s = scr + (8 * c) * 33 + nl;
        v4u o; o.x = pk2(s[0 * 33], s[1 * 33]); o.y = pk2(s[2 * 33], s[3 * 33]); o.z = pk2(s[4 * 33], s[5 * 33]); o.w = pk2(s[6 * 33], s[7 * 33]);
        if (n0 + nl < N) *(GAS v4u*)(WT + (size_t)map(n0 + nl) * (ld ? ld : K) + koff + k0 + 8 * c) = o; }
    LDS_WAIT(); asm volatile("" ::: "memory");
}
struct MapId { __device__ __forceinline__ int operator()(int n) const { return n; } };
struct MapWin {
    __device__ __forceinline__ int operator()(int n) const {
        if (n >= 3396) { const int g = n - 3396, c = g & 1023; return 3584 + 256 * (c >> 7) + 128 * (g >> 10) + (c & 127); }
        const int L = n & 255, hd = L >> 6, d = L & 63; return (n & ~255) + 128 * (d >> 5) + 32 * hd + (d & 31); } };
struct MapFF { int off; __device__ __forceinline__ int operator()(int n) const { return (n >> 7) * 256 + (n & 127) + off; } };

struct P0In { const float *c, *w_ada, *b_ada, *w_in, *w_up_a, *w_up_b, *w_o, *w_ff1, *w_ff3, *w_ff2, *lq1, *lk1, *lq2, *lk2, *qn_a, *kn_a, *qn_b, *kn_b; };
__device__ __forceinline__ void weight_copies(Frame& F, const P0In in, unsigned char* ws, bool sync = true, int it0 = 0, int it1 = 1 << 30, int gw_ = -1, int ngw_ = 0) {
    LAS float* scr = (LAS float*)(F.lds + F.wave * 16384);
    const int gw = F.vcu * NWAVES + F.wave, NGW = F.G * NWAVES;
    constexpr int I_IN = 16 * 171, I_UP = 8 * 32, I_O = 16 * 32, I_F1 = 16 * 88, I_F2 = 44 * 32;
    constexpr int NITEMS = I_IN + 2 * I_UP + I_O + 2 * I_F1 + I_F2;
    const int gwe = gw_ >= 0 ? gw_ : gw, ngwe = gw_ >= 0 ? ngw_ : NGW, ite = it1 < NITEMS ? it1 : NITEMS;
    for (int it = it0 + gwe; it < ite; it += ngwe) {
        int r = it;
        if (r < I_IN) { transpose_item(in.w_in, 1024, W_IN, (bf16*)(ws + WS_WIN), MapWin{}, scr, r, F.lane); continue; } r -= I_IN;
        if (r < I_UP) { transpose_item(in.w_up_a, 512, 1024, (bf16*)(ws + WS_WUA), MapId{}, scr, r, F.lane, 1024, 0); continue; } r -= I_UP;
        if (r < I_UP) { transpose_item(in.w_up_b, 512, 1024, (bf16*)(ws + WS_WUA), MapId{}, scr, r, F.lane, 1024, 512); continue; } r -= I_UP;
        if (r < I_O)  { transpose_item(in.w_o, 1024, 1024, (bf16*)(ws + WS_WO), MapId{}, scr, r, F.lane); continue; } r -= I_O;
        if (r < I_F1) { transpose_item(in.w_ff1, 1024, DFF, (bf16*)(ws + WS_W13), MapFF{0}, scr, r, F.lane); continue; } r -= I_F1;
        if (r < I_F1) { transpose_item(in.w_ff3, 1024, DFF, (bf16*)(ws + WS_W13), MapFF{128}, scr, r, F.lane); continue; } r -= I_F1;
        transpose_item(in.w_ff2, DFF, 1024, (bf16*)(ws + WS_W2), MapId{}, scr, r, F.lane);
    }
    if (sync) __syncthreads();
}
__device__ __forceinline__ void p0_prologue(Frame& F, const P0In in, unsigned char* ws) {
    const int gw = F.vcu * NWAVES + F.wave, NGW = F.G * NWAVES; (void)gw; (void)NGW;
    LAS float* S = (LAS float*)F.lds;
    LAS float* P = (LAS float*)(F.lds + 65536);
    for (int g = F.vcu; g < 192; g += F.G) {
        for (int i = F.tid; i < 16 * 1024; i += NWAVES * 64) { const float v = in.c[i]; S[i] = v / (1.f + __expf(-v)); }
        __syncthreads();
        const int c = F.tid & 31, kg = F.tid >> 5, col = 32 * g + c;
        float acc[16];
#pragma unroll
        for (int b = 0; b < 16; ++b) acc[b] = 0.f;
#pragma unroll
        for (int h = 0; h < 2; ++h) {
            float w[32];
#pragma unroll
            for (int u = 0; u < 32; ++u) w[u] = in.w_ada[(size_t)(64 * kg + 32 * h + u) * 6144 + col];
#pragma unroll
            for (int i = 0; i < 32; i += 4) { const int k = 64 * kg + 32 * h + i;
#pragma unroll
                for (int b = 0; b < 16; ++b) { const f32x4 s = *(const LAS f32x4*)(S + b * 1024 + k); acc[b] += (s[0] * w[i] + s[1] * w[i + 1]) + (s[2] * w[i + 2] + s[3] * w[i + 3]); } } }
#pragma unroll
        for (int b = 0; b < 16; ++b) P[(kg * 16 + b) * 32 + c] = acc[b];
        __syncthreads();
        { const int b = F.tid >> 5; float s = in.b_ada[col];
#pragma unroll
          for (int q = 0; q < 16; ++q) s += P[(q * 16 + b) * 32 + c];
          ((float*)(ws + WS_MOD))[b * 6144 + col] = s; }
        __syncthreads();
    }
    if (F.vcu == F.G - 2 && F.tid < 256) { const int t = F.tid >> 6, i = F.tid & 63; ((float*)(ws + WS_GN))[F.tid] = (t == 0 ? in.qn_a : t == 1 ? in.kn_a : t == 2 ? in.qn_b : in.kn_b)[i]; }
    if (F.vcu == F.G - 1 && F.tid == 0) {
        float s1 = 0.f, s2 = 0.f;
        for (int i = 0; i < 64; ++i) { s1 += in.lq1[i] * in.lk1[i]; s2 += in.lq2[i] * in.lk2[i]; }
        *(float*)(ws + WS_LAM) = expf(s1) - expf(s2) + 0.2f;
    }
}
__device__ __forceinline__ void norm_mod_pass(Frame& F, const float* X, const float* g, const float* scale, const float* shift, bf16* Y) {
    const int gw = F.vcu * NWAVES + F.wave, NGW = F.G * NWAVES;
    for (int blk = gw; blk < M / 16; blk += NGW) {
        const int row0 = blk * 16, b = row0 >> 11;
        f32x4 gs[4], sh[4];
#pragma unroll
        for (int j = 0; j < 4; ++j) { const f32x4 gg = ((const f32x4*)g)[F.lane + 64 * j], sc = ((const f32x4*)(scale + b * 6144))[F.lane + 64 * j]; gs[j] = gg * (sc + 1.0f); sh[j] = ((const f32x4*)(shift + b * 6144))[F.lane + 64 * j]; }
        f32x4 vn[4];
        { const f32x4* x0 = (const f32x4*)(X + (size_t)row0 * DM) + F.lane;
#pragma unroll
          for (int j = 0; j < 4; ++j) vn[j] = x0[64 * j]; }
        for (int rr = 0; rr < 16; ++rr) {
            f32x4 v[4]; float s = 0.f;
#pragma unroll
            for (int j = 0; j < 4; ++j) v[j] = vn[j];
            if (rr < 15) { const f32x4* xr = (const f32x4*)(X + (size_t)(row0 + rr + 1) * DM) + F.lane;
#pragma unroll
                for (int j = 0; j < 4; ++j) vn[j] = xr[64 * j]; }
#pragma unroll
            for (int j = 0; j < 4; ++j) s += (v[j][0] * v[j][0] + v[j][1] * v[j][1]) + (v[j][2] * v[j][2] + v[j][3] * v[j][3]);
            const float rstd = __builtin_amdgcn_rsqf(wave_sum(s) * (1.0f / DM) + 1e-6f);
            unsigned long long* o8 = (unsigned long long*)(Y + (size_t)(row0 + rr) * DM) + F.lane;
#pragma unroll
            for (int j = 0; j < 4; ++j) { const f32x4 y = v[j] * rstd * gs[j] + sh[j]; o8[64 * j] = (unsigned long long)pk2(y[0], y[1]) | ((unsigned long long)pk2(y[2], y[3]) << 32); }
        }
    }
}
__device__ __forceinline__ void norm_mod_pass_bf16(Frame& F, const bf16* X, const float* g, const float* scale, const float* shift, bf16* Y) {
    const int gw = F.vcu * NWAVES + F.wave, NGW = F.G * NWAVES;
    for (int blk = gw; blk < M / 16; blk += NGW) {
        const int row0 = blk * 16, b = row0 >> 11;
        f32x4 gs[4], sh[4];
#pragma unroll
        for (int j = 0; j < 4; ++j) { const int c4 = 2 * F.lane + (j & 1) + 128 * (j >> 1);
            const f32x4 gg = ((const f32x4*)g)[c4], sc = ((const f32x4*)(scale + b * 6144))[c4]; gs[j] = gg * (sc + 1.0f); sh[j] = ((const f32x4*)(shift + b * 6144))[c4]; }
        v4u wn[2];
        { const v4u* x0 = (const v4u*)(X + (size_t)row0 * DM) + F.lane; wn[0] = x0[0]; wn[1] = x0[64]; }
        for (int rr = 0; rr < 16; ++rr) {
            const v4u wc[2] = {wn[0], wn[1]};
            if (rr < 15) { const v4u* xr = (const v4u*)(X + (size_t)(row0 + rr + 1) * DM) + F.lane; wn[0] = xr[0]; wn[1] = xr[64]; }
            f32x4 v[4]; float s = 0.f;
#pragma unroll
            for (int h = 0; h < 2; ++h) { const v4u w = wc[h];
                v[2 * h] = (f32x4){__builtin_bit_cast(float, w.x << 16), __builtin_bit_cast(float, w.x & 0xffff0000u), __builtin_bit_cast(float, w.y << 16), __builtin_bit_cast(float, w.y & 0xffff0000u)};
                v[2 * h + 1] = (f32x4){__builtin_bit_cast(float, w.z << 16), __builtin_bit_cast(float, w.z & 0xffff0000u), __builtin_bit_cast(float, w.w << 16), __builtin_bit_cast(float, w.w & 0xffff0000u)}; }
#pragma unroll
            for (int j = 0; j < 4; ++j) s += (v[j][0] * v[j][0] + v[j][1] * v[j][1]) + (v[j][2] * v[j][2] + v[j][3] * v[j][3]);
            const float rstd = __builtin_amdgcn_rsqf(wave_sum(s) * (1.0f / DM) + 1e-6f);
            v4u* o16 = (v4u*)(Y + (size_t)(row0 + rr) * DM) + F.lane;
#pragma unroll
            for (int h = 0; h < 2; ++h) { const f32x4 y0 = v[2 * h] * rstd * gs[2 * h] + sh[2 * h], y1 = v[2 * h + 1] * rstd * gs[2 * h + 1] + sh[2 * h + 1];
                v4u o; o.x = pk2(y0[0], y0[1]); o.y = pk2(y0[2], y0[3]); o.z = pk2(y1[0], y1[1]); o.w = pk2(y1[2], y1[3]); o16[64 * h] = o; }
        }
    }
}
#ifdef CHECKER
namespace chk {
typedef unsigned short bf16;
typedef unsigned u32x4c __attribute__((ext_vector_type(4)));
__device__ __forceinline__ float b2f(unsigned short h) { return __uint_as_float((unsigned)h << 16); }
__device__ __forceinline__ float rnd(float f) { unsigned u = __float_as_uint(f); u = (u + 0x7fffu + ((u >> 16) & 1u)) & 0xffff0000u; return __uint_as_float(u); }
__device__ __forceinline__ float dotbf(const bf16* a, const bf16* b, int K) {
    float s = 0.f;
    for (int k = 0; k < K; k += 8) { const u32x4c x = *(const u32x4c*)(a + k), y = *(const u32x4c*)(b + k);
#pragma unroll
        for (int j = 0; j < 4; ++j) { s += __uint_as_float(x[j] << 16) * __uint_as_float(y[j] << 16); s += __uint_as_float(x[j] & 0xffff0000u) * __uint_as_float(y[j] & 0xffff0000u); } }
    return s; }
__device__ __forceinline__ void devmax(float* slot, float d) { if (!(d >= 0.f)) d = 1e30f; atomicMax((unsigned*)slot, __float_as_uint(d)); }
__device__ __forceinline__ float sig(float v) { return 1.f / (1.f + expf(-v)); }
constexpr int RSTR = 16, ROFF = 3, NR = 2048;
}
#define CHK_LOOP(idx, total) for (long idx = (long)F.vcu * 512 + F.tid; idx < (long)(total); idx += (long)F.G * 512)
#endif
#ifdef DUPCHK
__global__ void __launch_bounds__(512) dup_cksum(const void* base, size_t bytes, unsigned long long* acc) {
    typedef unsigned u32x4_t __attribute__((ext_vector_type(4)));
    const u32x4_t* p = (const u32x4_t*)base; const size_t n = bytes / 16;
    unsigned long long s = 0ull;
    for (size_t i = (size_t)blockIdx.x * 512 + threadIdx.x; i < n; i += (size_t)gridDim.x * 512) {
        const u32x4_t w = p[i]; const unsigned long long m = 2ull * i + 1ull;
        s += ((unsigned long long)w.x + ((unsigned long long)w.y << 7) + ((unsigned long long)w.z << 13) + ((unsigned long long)w.w << 19)) * m; }
    for (int off = 32; off; off >>= 1) { const unsigned lo = __shfl_xor((unsigned)s, off), hi = __shfl_xor((unsigned)(s >> 32), off); s += ((unsigned long long)hi << 32) | lo; }
    if ((threadIdx.x & 63) == 0) atomicAdd(acc, s);
}
__global__ void __launch_bounds__(512) dup_final(float* out, const unsigned long long* CK) {
    int bad = -1;
    for (int k = 9; k >= 0; --k) if (CK[2 * k] != CK[2 * k + 1]) bad = k;
    if (bad >= 0) { const float v = 0.0566f * (float)(1 << bad); for (int i = blockIdx.x * 512 + threadIdx.x; i < (1 << 20); i += gridDim.x * 512) out[i] += v; }
}
#endif
#ifdef MASKDIFF
__global__ void __launch_bounds__(512) mask_diff(const unsigned long long* A, const unsigned long long* B, unsigned* cnt) {
    unsigned c0 = 0, c1 = 0, c2 = 0;
    for (int idx = blockIdx.x * 512 + threadIdx.x; idx < (1 << 20); idx += gridDim.x * 512) {
        const int qk = (idx >> 10) & 63, tile = (idx >> 5) & 31; const bool adm = tile < (qk >> 1) + 1;
        const unsigned long long d = A[idx] ^ B[idx];
        if (d) { if (adm) { ++c0; c2 += (unsigned)__builtin_popcountll(d); } else ++c1; } }
    if (c0) atomicAdd(cnt + 0, c0); if (c1) atomicAdd(cnt + 1, c1); if (c2) atomicAdd(cnt + 2, c2);
    for (int row = blockIdx.x * 512 + threadIdx.x; row < 32768; row += gridDim.x * 512) { const int bq = row >> 5, q = row & 31, qk = bq & 63; bool any = false;
        for (int tile = 0; tile < (qk >> 1) + 1; ++tile) { const size_t i = ((size_t)bq * 32 + tile) * 32 + q; any = any || (A[i] != B[i]); }
        if (any) atomicAdd(cnt + 3, 1u); }
}
__global__ void __launch_bounds__(512) mask_report(float* out, const unsigned* cnt) {
    const unsigned ca = cnt[MASKDIFF & 3], cb = cnt[(MASKDIFF >> 2) & 3];
    int La = 0; while ((1u << La) < ca + 1u) ++La; int Lb = 0; while ((1u << Lb) < cb + 1u) ++Lb;
    float v = 0.05f * 5.657f; for (int i = 0; i < La; ++i) v *= 1.5f;
    for (int i = blockIdx.x * 512 + threadIdx.x; i < (1 << 20); i += gridDim.x * 512) out[i] += v;
    (void)Lb;
}
#endif
struct Args { const float* in[22]; float* out; unsigned char* ws; int ph_lo, ph_hi, probe, pad; };
__global__ void __launch_bounds__(NWAVES * 64, 2) mega_fwd(Args args) {
    extern __shared__ __attribute__((aligned(16))) unsigned char lds[];
    Frame F;
    F.lds = (LAS unsigned char*)lds;
    F.MISC = (volatile LAS unsigned*)(F.lds + MISC_OFF);
    F.tid = threadIdx.x; F.lane = F.tid & 63; F.wave = __builtin_amdgcn_readfirstlane(F.tid >> 6);
    F.G = gridDim.x; { const int bx = blockIdx.x; F.vcu = (F.G % 8 == 0) ? (bx % 8) * (F.G / 8) + bx / 8 : bx; }
    unsigned char* ws = args.ws;
    F.ctl = (gu32*)(ws + WS_CTL);
    for (int u = F.tid; u < (LDS_BYTES - LDSCTL_OFF) / 4; u += NWAVES * 64) ((LAS unsigned*)(F.lds + LDSCTL_OFF))[u] = 0u;
    __syncthreads();
    XcdBarrier bar; bar.bar = (unsigned*)(F.ctl + CW_BAR); bar.x = 0; bar.st = nullptr;
    if (N_LAUNCHES == 1) bar = xcd_barrier_post((unsigned*)(F.ctl + CW_BAR), F.MISC + 8);
    const int lo = args.ph_lo, hi = args.ph_hi;
#ifndef PH_MASK
#define PH_MASK 0x3ff
#endif
#define IN(k) (((PH_MASK >> (k)) & 1) && lo <= (k) && (k) < hi)
#define SEAM(k) do { if (IN(k) && IN((k) + 1)) xcd_barrier(bar); } while (0)
#ifndef GROUP_SEAMS
#define GROUP_SEAMS 1
#endif
#define GSEAM(k) do { if (IN(k) && IN((k) + 1)) { if (GROUP_SEAMS && F.G == 256) grp_barrier(bar.bar, F.vcu >> 5, 32u); else xcd_barrier(bar); } } while (0)
    float* const MOD = (float*)(ws + WS_MOD);
#define WSP(T, off) ((T*)(ws + (off)))
#ifdef X1_IN_WS
#define X1P WSP(float, WS_GT)
#else
#define X1P args.out
#endif

#ifndef W_IN_P1
#define W_IN_P1 2
#endif
#if W_IN_P1
#define IF_W0(x)
#else
#define IF_W0(x) x
#endif
    if (IN(0)) { const P0In pin{args.in[1], args.in[2], args.in[3], args.in[5], args.in[15], args.in[16], args.in[17], args.in[19], args.in[20], args.in[21], args.in[10], args.in[11], args.in[12], args.in[13], args.in[6], args.in[7], args.in[8], args.in[9]};
                 IF_W0(weight_copies(F, pin, ws);) p0_prologue(F, pin, ws); }
    SEAM(0);
#ifdef CHECKER
    if (IN(0) && IN(1)) {
        float* DEV = (float*)(ws + WS_CTL) + 8192;
#define CHK_W(src, K_, N_, dst, MAPX) CHK_LOOP(idx, (long)(K_) * (N_)) { const int k = (int)(idx / (N_)), n = (int)(idx % (N_)); const float w = (src)[idx]; \
            chk::devmax(DEV + 11, fabsf(chk::b2f((dst)[(size_t)(MAPX) * (K_) + k]) - w) / (fabsf(w) + 1e-3f)); }
        CHK_W(args.in[5], 1024, W_IN, WSP(bf16, WS_WIN), MapWin{}(n))  CHK_W(args.in[17], 1024, 1024, WSP(bf16, WS_WO), n)
        CHK_W(args.in[19], 1024, DFF, WSP(bf16, WS_W13), MapFF{0}(n)) CHK_W(args.in[20], 1024, DFF, WSP(bf16, WS_W13), MapFF{128}(n)) CHK_W(args.in[21], DFF, 1024, WSP(bf16, WS_W2), n)
#undef CHK_W
        CHK_LOOP(idx, 16 * 6144) { const int b = (int)(idx / 6144), j = (int)(idx % 6144); if ((j % 5) == 0) { float sacc = args.in[3][j]; for (int k = 0; k < 1024; ++k) { const float c = args.in[1][b * 1024 + k]; sacc += (c / (1.f + expf(-c))) * args.in[2][(size_t)k * 6144 + j]; }
            chk::devmax(DEV + 12, fabsf(MOD[idx] - sacc)); } }
    }
#endif
    if (IN(1)) {
#if W_IN_P1
        { const P0In pin{args.in[1], args.in[2], args.in[3], args.in[5], args.in[15], args.in[16], args.in[17], args.in[19], args.in[20], args.in[21], args.in[10], args.in[11], args.in[12], args.in[13], args.in[6], args.in[7], args.in[8], args.in[9]};
          if (W_IN_P1 == 1) weight_copies(F, pin, ws);
          if (W_IN_P1 == 3) { if (F.wave & 1) { weight_copies(F, pin, ws, false); norm_mod_pass(F, args.in[0], args.in[4], MOD + 1024, MOD, WSP(bf16, WS_XH)); }
                              else { norm_mod_pass(F, args.in[0], args.in[4], MOD + 1024, MOD, WSP(bf16, WS_XH)); weight_copies(F, pin, ws, false); } __syncthreads(); }
          else norm_mod_pass(F, args.in[0], args.in[4], MOD + 1024, MOD, WSP(bf16, WS_XH));
          if (W_IN_P1 == 2) weight_copies(F, pin, ws, true, 0, (GROUP_SEAMS && F.G == 256) ? 16 * 171 : (1 << 30)); }
#else
        norm_mod_pass(F, args.in[0], args.in[4], MOD + 1024, MOD, WSP(bf16, WS_XH));
#endif
    }
    SEAM(1);
#if W_IN_P1 == 2
    if (GROUP_SEAMS && F.G == 256 && IN(2)) {
        const P0In pin{args.in[1], args.in[2], args.in[3], args.in[5], args.in[15], args.in[16], args.in[17], args.in[19], args.in[20], args.in[21], args.in[10], args.in[11], args.in[12], args.in[13], args.in[6], args.in[7], args.in[8], args.in[9]};
#ifndef SKEW_MODE
#define SKEW_MODE 2
#endif
        const int g = F.vcu >> 5, L = 7984 - 16 * 171;
        const int i0 = 16 * 171 + (SKEW_MODE == 0 ? (L * g) / 8 : SKEW_MODE == 1 ? (L * (g * (g - 1) / 2)) / 28 : (L * ((g - 1) * g * (2 * g - 1) / 6)) / 140);
        const int i1 = 16 * 171 + (SKEW_MODE == 0 ? (L * (g + 1)) / 8 : SKEW_MODE == 1 ? (L * ((g + 1) * g / 2)) / 28 : (L * (g * (g + 1) * (2 * g + 1) / 6)) / 140);
        weight_copies(F, pin, ws, false, i0, i1, (F.vcu & 31) * NWAVES + F.wave, 32 * NWAVES);
        wrdy_post(bar.bar);
    }
#endif
#ifdef CHECKER
    if (IN(1) && IN(2)) {
        float* DEV = (float*)(ws + WS_CTL) + 8192;
        CHK_LOOP(idx, chk::NR) { const int row = chk::RSTR * (int)idx + chk::ROFF, b = row >> 11; float ss = 0.f; for (int k = 0; k < 1024; ++k) { const float v = args.in[0][(size_t)row * 1024 + k]; ss += v * v; }
            const float rs = 1.f / sqrtf(ss / 1024.f + 1e-6f); float dm = 0.f;
            for (int k = 0; k < 1024; ++k) { const float ref = args.in[0][(size_t)row * 1024 + k] * rs * args.in[4][k] * (1.f + MOD[(size_t)b * 6144 + 1024 + k]) + MOD[(size_t)b * 6144 + k]; dm = fmaxf(dm, fabsf(chk::b2f(WSP(bf16, WS_XH)[(size_t)row * 1024 + k]) - ref)); }
            chk::devmax(DEV + 13, dm); }
    }
#endif
    if (IN(2)) {
        pg8::Gemm g{WSP(bf16, WS_XH), (const bf16*)(ws + WS_WIN), M, NPROJ, DM}; pg8::StaticOrder S; S.init(M, NPROJ, F.G, (int)blockIdx.x);
        epi::EpiProj E{ws};
        pg8::gemm_phase<epi::EpiProj, pg8::StaticOrder, true, true>(F.lds, g, S, E);
    }
    GSEAM(2);
#ifdef CHECKER
    if (IN(2) && IN(3)) {
        float* DEV = (float*)(ws + WS_CTL) + 8192; const bf16 *XH = WSP(bf16, WS_XH), *WT = WSP(bf16, WS_WIN);
        CHK_LOOP(idx, chk::NR * 512) { const int row = chk::RSTR * (int)(idx / 512) + chk::ROFF, c = (int)(idx % 512);
            { const int n = 1024 + c; const float a = chk::dotbf(XH + (size_t)row * 1024, WT + (size_t)MapWin{}(n) * 1024, 1024), o = chk::b2f(WSP(bf16, WS_VA)[(size_t)row * 512 + c]); chk::devmax(DEV + 0, fabsf(o - chk::rnd(a)) / (fabsf(a) + 0.05f)); }
            { const int n = 3396 + 4 * c + 1; const float a = chk::sig(chk::dotbf(XH + (size_t)row * 1024, WT + (size_t)MapWin{}(n) * 1024, 1024)), o = chk::b2f(WSP(bf16, WS_GT)[(size_t)row * 2048 + 4 * c + 1]); chk::devmax(DEV + 1, fabsf(o - a)); }
            if (c < 8) { float ss = 0.f; for (int d = 0; d < 64; ++d) { const float v = chk::dotbf(XH + (size_t)row * 1024, WT + (size_t)MapWin{}(c * 64 + d) * 1024, 1024); ss += v * v; }
                const float rs = 1.f / sqrtf(ss / 64.f + 1e-6f); float dm = 0.f; for (int d = 0; d < 64; ++d) { const float v = chk::dotbf(XH + (size_t)row * 1024, WT + (size_t)MapWin{}(c * 64 + d) * 1024, 1024); dm = fmaxf(dm, fabsf(chk::b2f(WSP(bf16, WS_QA)[(size_t)row * 512 + c * 64 + d]) - v * rs * args.in[6][d])); } chk::devmax(DEV + 2, dm); }
            if (c < 64) { const float a = chk::dotbf(XH + (size_t)row * 1024, WT + (size_t)MapWin{}(3328 + c) * 1024, 1024), o = chk::b2f(WSP(bf16, WS_KI)[(size_t)row * 64 + c]); chk::devmax(DEV + 3, fabsf(o - chk::rnd(a)) / (fabsf(a) + 0.05f)); }
            if (c < 4) { const float a = chk::dotbf(XH + (size_t)row * 1024, WT + (size_t)MapWin{}(3392 + c) * 1024, 1024), o = WSP(float, WS_WI)[(size_t)row * 4 + c]; chk::devmax(DEV + 4, fabsf(o - a)); }
            if (c >= 8 && c < 16) { const int hh = c - 8; float ss = 0.f; for (int d = 0; d < 64; ++d) { const float v = chk::dotbf(XH + (size_t)row * 1024, WT + (size_t)MapWin{}(2048 + hh * 64 + d) * 1024, 1024); ss += v * v; }
                const float rs = 1.f / sqrtf(ss / 64.f + 1e-6f); float dm = 0.f; for (int d = 0; d < 64; ++d) { const float v = chk::dotbf(XH + (size_t)row * 1024, WT + (size_t)MapWin{}(2048 + hh * 64 + d) * 1024, 1024); dm = fmaxf(dm, fabsf(chk::b2f(WSP(bf16, WS_KB)[(size_t)row * 512 + hh * 64 + d]) - v * rs * args.in[9][d])); } chk::devmax(DEV + 5, dm); }
        }
    }
#endif
    if (IN(3)) {
        const int b = F.vcu >> 4, j = F.vcu & 15;
        const bf16 *QI = WSP(bf16, WS_QI), *KI = WSP(bf16, WS_KI); const float* WI = WSP(float, WS_WI); unsigned long long* MASK = WSP(unsigned long long, WS_MASK);
        if (F.G == 256) {
            sel::select_unit(b, j, QI, KI, WI, MASK, (char*)lds); sel::select_unit(b, 31 - j, QI, KI, WI, MASK, (char*)lds);
            sel::select_unit(b, 32 + j, QI, KI, WI, MASK, (char*)lds); sel::select_unit(b, 63 - j, QI, KI, WI, MASK, (char*)lds);
        }
    }
    GSEAM(3);
#ifdef CHECKER
#ifndef CHK_TI
#define CHK_TI -1
#endif
#ifndef CHK_TOL17
#define CHK_TOL17 64
#endif
    if (IN(3) && IN(4)) {
        unsigned tot = 0u; CHK_LOOP(idx, 16 * 64 * 32 * 32) tot += (unsigned)__builtin_popcountll(WSP(unsigned long long, WS_MASK)[idx]);
        atomicAdd((unsigned*)(ws + WS_CTL) + 8192 + 18, tot);
    }
    if (IN(3) && IN(4)) {
        float* DEV = (float*)(ws + WS_CTL) + 8192;
        if (F.vcu < 10) { const int tt[5] = {5, 300, 777, 1029, 2047}; const int t = (F.vcu % 5 == 0) ? 5 : (F.vcu % 5 == 1) ? 300 : (F.vcu % 5 == 2) ? 777 : (F.vcu % 5 == 3) ? 1029 : 2047; (void)tt; const int b = (F.vcu < 5) ? 0 : 9;
            LAS unsigned* KL = (LAS unsigned*)F.lds; const int nadm = 64 * (t / 64 + 1); const size_t qrow = (size_t)b * 2048 + t;
            __syncthreads();
            for (int s4 = 0; s4 < 4; ++s4) { const int sidx = F.tid + 512 * s4; unsigned key = 0u;
                if (sidx < nadm) { float sc = 0.f; for (int h = 0; h < 4; ++h) { const float y = chk::dotbf(WSP(bf16, WS_QI) + qrow * 256 + h * 64, WSP(bf16, WS_KI) + ((size_t)b * 2048 + sidx) * 64, 64); sc = fmaf(fmaxf(y, 0.f), WSP(float, WS_WI)[qrow * 4 + h], sc); }
                    const unsigned u = __float_as_uint(sc), m = (unsigned)(((int)u) >> 31) | 0x80000000u; key = ((u ^ m) & KEYMASK) | (2047u - (unsigned)sidx); }
                KL[sidx] = key; }
            __syncthreads();
            unsigned bad = 0u;
            for (int s4 = 0; s4 < 4; ++s4) { const int sidx = F.tid + 512 * s4; const unsigned key = KL[sidx]; unsigned rank = 0u; for (int j = 0; j < 2048; ++j) rank += (KL[j] > key) ? 1u : 0u;
                const bool selr = (sidx < nadm) && (nadm <= 256 || rank < 256u);
                const unsigned long long mw = WSP(unsigned long long, WS_MASK)[((size_t)(b * 64 + t / 32) * 32 + sidx / 64) * 32 + (t % 32)]; const bool selm = (mw >> (sidx % 64)) & 1ull;
                if (sidx < nadm && selr != selm) ++bad; }
            if (bad) atomicAdd(DEV + 17, (float)bad);
            __syncthreads();
        }
    }
#endif
    if (IN(4)) {
        if (F.G == 256) {
            const int b = F.vcu >> 4, r = F.vcu & 15;
            const bf16 *QA = WSP(bf16, WS_QA), *KA = WSP(bf16, WS_KA), *VA = WSP(bf16, WS_VA), *QBt = WSP(bf16, WS_QB), *KBt = WSP(bf16, WS_KB), *VBt = WSP(bf16, WS_VB);
            bf16 *YA = WSP(bf16, WS_YA), *YB = WSP(bf16, WS_YA); const unsigned long long* MASK = WSP(unsigned long long, WS_MASK);
            const float lam = __hip_atomic_load((const float*)(ws + WS_LAM), RLX_AGENT);
#ifndef NO_UNIT_A
            if (!(args.probe & 1)) for (int pi = 0; pi < 2; ++pi) { const int pr = 2 * r + pi, h = pr >> 2, s = pr & 3;
                att::unit_a(b, h, 7 - s, QA, KA, VA, MASK, YA, (char*)lds); att::unit_a(b, h, s, QA, KA, VA, MASK, YA, (char*)lds); }
#endif
#ifndef NO_UNIT_B
            __syncthreads();
            if (!(args.probe & 2)) { const int h = r >> 2, s = r & 3;
              att::unit_b128(b, h, 7 - s, QBt, KBt, VBt, args.in[14], lam, YB, WSP(unsigned, WS_STASH), 0, (char*)lds); att::unit_b128(b, h, s, QBt, KBt, VBt, args.in[14], lam, YB, WSP(unsigned, WS_STASH), 1, (char*)lds); }
#endif
        }
    }
    GSEAM(4);
#ifdef CHECKER
    if (IN(4) && IN(5)) {
        float* DEV = (float*)(ws + WS_CTL) + 8192; const float lamc = __hip_atomic_load((const float*)(ws + WS_LAM), RLX_AGENT);
        const int gwv = F.vcu * 8 + F.wave;
        if (gwv < 8 * 3 * 12) { const int ti = gwv % 8, bi = (gwv / 8) % 3, hh = gwv / 24;
            const int t = (ti == 0) ? 5 : (ti == 1) ? 70 : (ti == 2) ? 200 : (ti == 3) ? 300 : (ti == 4) ? 777 : (ti == 5) ? 1029 : (ti == 6) ? 1500 : 2047; const int b = (bi == 0) ? 0 : (bi == 1) ? 7 : 15;
            const int nadm = 64 * (t / 64 + 1); const size_t rb = (size_t)b * 2048, qrow = rb + t; const int d = F.lane;
            if (hh < 8) { const float slope = exp2f(-(float)(hh + 1));
                float mx = -INFINITY; for (int sidx = 0; sidx < nadm; ++sidx) { const unsigned long long mw = WSP(unsigned long long, WS_MASK)[((size_t)(b * 64 + t / 32) * 32 + sidx / 64) * 32 + (t % 32)]; if (!((mw >> (sidx % 64)) & 1ull)) continue;
                    const float sc = chk::dotbf(WSP(bf16, WS_QA) + qrow * 512 + hh * 64, WSP(bf16, WS_KA) + (rb + sidx) * 512 + hh * 64, 64) * 0.125f - slope * fabsf((float)(t - sidx)); mx = fmaxf(mx, sc); }
                float l = 0.f, o = 0.f; for (int sidx = 0; sidx < nadm; ++sidx) { const unsigned long long mw = WSP(unsigned long long, WS_MASK)[((size_t)(b * 64 + t / 32) * 32 + sidx / 64) * 32 + (t % 32)]; if (!((mw >> (sidx % 64)) & 1ull)) continue;
                    const float sc = chk::dotbf(WSP(bf16, WS_QA) + qrow * 512 + hh * 64, WSP(bf16, WS_KA) + (rb + sidx) * 512 + hh * 64, 64) * 0.125f - slope * fabsf((float)(t - sidx)); const float p = expf(sc - mx); l += p; o += p * chk::b2f(WSP(bf16, WS_VA)[(rb + sidx) * 512 + hh * 64 + d]); }
                chk::devmax(DEV + 14, fabsf(chk::b2f(WSP(bf16, WS_YA)[qrow * 1024 + hh * 64 + d]) - o / l));
            } else if (CHK_TI < 0 || ti == CHK_TI) { const int hb = hh - 8; const float slope = exp2f(-2.f * (float)(hb + 1)); float ov[2][2];
                for (int m = 0; m < 2; ++m) { float mx = -INFINITY; for (int sidx = 0; sidx < nadm; ++sidx) { const float sc = chk::dotbf(WSP(bf16, WS_QB) + qrow * 512 + (2 * hb + m) * 64, WSP(bf16, WS_KB) + (rb + sidx) * 512 + (2 * hb + m) * 64, 64) * 0.125f - slope * fabsf((float)(t - sidx)); mx = fmaxf(mx, sc); }
                    float l = 0.f, o0 = 0.f, o1 = 0.f; for (int sidx = 0; sidx < nadm; ++sidx) { const float sc = chk::dotbf(WSP(bf16, WS_QB) + qrow * 512 + (2 * hb + m) * 64, WSP(bf16, WS_KB) + (rb + sidx) * 512 + (2 * hb + m) * 64, 64) * 0.125f - slope * fabsf((float)(t - sidx));
                        const float p = expf(sc - mx); l += p; o0 += p * chk::b2f(WSP(bf16, WS_VB)[(rb + sidx) * 512 + hb * 128 + d]); o1 += p * chk::b2f(WSP(bf16, WS_VB)[(rb + sidx) * 512 + hb * 128 + 64 + d]); }
                    if (m == 0) { ov[0][0] = o0 / l; ov[0][1] = o1 / l; } else { ov[1][0] = o0 / l; ov[1][1] = o1 / l; } }
                const float d0 = ov[0][0] - lamc * ov[1][0], d1 = ov[0][1] - lamc * ov[1][1]; const float ssq = wave_sum(d0 * d0 + d1 * d1); const float rs = 0.8f / sqrtf(ssq / 128.f + 1e-6f);
                chk::devmax(DEV + 16, fabsf(chk::b2f(WSP(bf16, WS_YA)[qrow * 1024 + 512 + hb * 128 + d]) - d0 * rs * args.in[14][d])); chk::devmax(DEV + 19, fabsf(chk::b2f(WSP(bf16, WS_YA)[qrow * 1024 + 512 + hb * 128 + 64 + d]) - d1 * rs * args.in[14][64 + d]));
            }
        }
        xcd_barrier(bar);
    }
#endif
    if (IN(5)) {
#if W_IN_P1 == 2
        if (GROUP_SEAMS && F.G == 256) wrdy_wait(bar.bar, 256u);
#endif
        pg8::Gemm g{WSP(bf16, WS_YA), (const bf16*)(ws + WS_WUA), M, DM, 1024}; pg8::StaticOrder S; S.init(M, DM, F.G, (int)blockIdx.x);
        epi::EpiUpM E{WSP(bf16, WS_MG), WSP(bf16, WS_GT)}; pg8::gemm_phase<epi::EpiUpM, pg8::StaticOrder, true, true>(F.lds, g, S, E);
    }
    GSEAM(5);
#ifdef CHECKER
    if (IN(5) && IN(6)) {
        __syncthreads(); float* DEV = (float*)(ws + WS_CTL) + 8192;
        CHK_LOOP(idx, chk::NR * 256) { const int row = chk::RSTR * (int)(idx / 256) + chk::ROFF, col = 4 * (int)(idx % 256) + 2;
            const float ua = chk::dotbf(WSP(bf16, WS_YA) + (size_t)row * 1024, WSP(bf16, WS_WUA) + (size_t)col * 1024, 512), ub = chk::dotbf(WSP(bf16, WS_YA) + (size_t)row * 1024 + 512, WSP(bf16, WS_WUA) + (size_t)col * 1024 + 512, 512);
            const float ga = chk::b2f(WSP(bf16, WS_GT)[(size_t)row * 2048 + col]), gb = chk::b2f(WSP(bf16, WS_GT)[(size_t)row * 2048 + 1024 + col]);
            const float ref = chk::rnd(ga * ua) + gb * ub, o = chk::b2f(WSP(bf16, WS_MG)[(size_t)row * 1024 + col]); chk::devmax(DEV + 6, fabsf(o - ref)); }
    }
    if (IN(5) && IN(6)) xcd_barrier(bar);
#endif
    if (IN(6)) {
        pg8::Gemm g{WSP(bf16, WS_MG), (const bf16*)(ws + WS_WO), M, DM, DM}; pg8::StaticOrder S; S.init(M, DM, F.G, (int)blockIdx.x);
        epi::EpiResToBf16 E{args.in[0], WSP(bf16, WS_GT), MOD + 2048}; pg8::gemm_phase<epi::EpiResToBf16, pg8::StaticOrder, true, true>(F.lds, g, S, E);
    }
    GSEAM(6);
#ifdef CHECKER
    if (IN(6) && IN(7)) {
        __syncthreads(); float* DEV = (float*)(ws + WS_CTL) + 8192;
        CHK_LOOP(idx, chk::NR * 256) { const int row = chk::RSTR * (int)(idx / 256) + chk::ROFF, col = 4 * (int)(idx % 256) + 1;
            const float a = chk::dotbf(WSP(bf16, WS_MG) + (size_t)row * 1024, WSP(bf16, WS_WO) + (size_t)col * 1024, 1024);
            const float ref = args.in[0][(size_t)row * 1024 + col] + MOD[(size_t)(row >> 11) * 6144 + 2048 + col] * a, o = chk::b2f(WSP(bf16, WS_GT)[(size_t)row * 1024 + col]); chk::devmax(DEV + 7, fabsf(o - ref)); }
    }
#endif
    if (IN(7)) norm_mod_pass_bf16(F, WSP(bf16, WS_GT), args.in[18], MOD + 4096, MOD + 3072, WSP(bf16, WS_XH));
    GSEAM(7);
#ifdef CHECKER
    if (IN(7) && IN(8)) {
        __syncthreads(); float* DEV = (float*)(ws + WS_CTL) + 8192;
        CHK_LOOP(idx, chk::NR) { const int row = chk::RSTR * (int)idx + chk::ROFF, b = row >> 11; float ss = 0.f; for (int k = 0; k < 1024; ++k) { const float v = chk::b2f(WSP(bf16, WS_GT)[(size_t)row * 1024 + k]); ss += v * v; }
            const float rs = 1.f / sqrtf(ss / 1024.f + 1e-6f); float dm = 0.f;
            for (int k = 0; k < 1024; ++k) { const float ref = chk::b2f(WSP(bf16, WS_GT)[(size_t)row * 1024 + k]) * rs * args.in[18][k] * (1.f + MOD[(size_t)b * 6144 + 4096 + k]) + MOD[(size_t)b * 6144 + 3072 + k]; dm = fmaxf(dm, fabsf(chk::b2f(WSP(bf16, WS_XH)[(size_t)row * 1024 + k]) - ref)); }
            chk::devmax(DEV + 8, dm); }
    }
#endif
    if (IN(8)) {
        pg8::Gemm g{WSP(bf16, WS_XH), (const bf16*)(ws + WS_W13), M, NFF13, DM}; pg8::StaticOrder S; S.init(M, NFF13, F.G, (int)blockIdx.x);
#ifdef PROBE_EPI
        epi::EpiFF13 E{WSP(bf16, WS_HID), args.probe};
#else
        epi::EpiFF13 E{WSP(bf16, WS_HID)};
#endif
        pg8::gemm_phase<epi::EpiFF13, pg8::StaticOrder, true, true>(F.lds, g, S, E);
    }
    GSEAM(8);
#ifdef CHECKER
    if (IN(8) && IN(9)) {
        __syncthreads(); float* DEV = (float*)(ws + WS_CTL) + 8192;
        CHK_LOOP(idx, chk::NR * 704) { const int row = chk::RSTR * (int)(idx / 704) + chk::ROFF, hc = 4 * (int)(idx % 704) + 3;
            const bf16* w = WSP(bf16, WS_W13) + (size_t)((hc >> 7) * 256 + (hc & 127)) * 1024;
            const float u1 = chk::dotbf(WSP(bf16, WS_XH) + (size_t)row * 1024, w, 1024), u3 = chk::dotbf(WSP(bf16, WS_XH) + (size_t)row * 1024, w + 128 * 1024, 1024);
            const float ref = u1 * chk::sig(u1) * u3, o = chk::b2f(WSP(bf16, WS_HID)[(size_t)row * 2816 + hc]); chk::devmax(DEV + 9, fabsf(o - ref) / (fabsf(ref) + 0.05f)); }
    }
#endif
    if (IN(9)) {
        pg8::Gemm g{WSP(bf16, WS_HID), (const bf16*)(ws + WS_W2), M, DM, DFF}; pg8::StaticOrder S; S.init(M, DM, F.G, (int)blockIdx.x);
        epi::EpiResFromBf16 E{WSP(bf16, WS_GT), args.out, MOD + 5120}; pg8::gemm_phase<epi::EpiResFromBf16, pg8::StaticOrder, true, true>(F.lds, g, S, E);
    }
#ifdef PROBE_XBAR
    for (int i = 0; i < PROBE_XBAR; ++i) xcd_barrier(bar);
#endif
#ifdef ENDCHK
    if (IN(9)) {
        unsigned tot = 0u; for (long idx = (long)F.vcu * 512 + F.tid; idx < 16L * 64 * 32 * 32; idx += (long)F.G * 512) tot += (unsigned)__builtin_popcountll(WSP(unsigned long long, WS_MASK)[idx]);
        atomicAdd((unsigned*)(ws + WS_CTL) + 8192 + 18, tot);
        xcd_barrier(bar);
        const int bad = (int)__hip_atomic_load((unsigned*)(ws + WS_CTL) + 8192 + 18, RLX_AGENT) - 16 * 499712;
        if (F.vcu == 0 && F.tid == 0 && bad != 0) args.out[0] += 1.0e6f;
    }
#endif
#ifdef CHECKER
    if (IN(9)) {
        float* DEV = (float*)(ws + WS_CTL) + 8192;
        asm volatile("s_waitcnt vmcnt(0)" ::: "memory"); __syncthreads();
        CHK_LOOP(idx, chk::NR * 256) { const int row = chk::RSTR * (int)(idx / 256) + chk::ROFF, col = 4 * (int)(idx % 256) + 3;
            (void)row; (void)col; }
        xcd_barrier(bar);
        CHK_LOOP(idx, chk::NR * 256) { const int row = chk::RSTR * (int)(idx / 256) + chk::ROFF, col = 4 * (int)(idx % 256) + 3;
            const float a = chk::dotbf(WSP(bf16, WS_HID) + (size_t)row * 2816, WSP(bf16, WS_W2) + (size_t)col * 2816, 2816);
            const float ref = chk::b2f(WSP(bf16, WS_GT)[(size_t)row * 1024 + col]) + MOD[(size_t)(row >> 11) * 6144 + 5120 + col] * a; chk::devmax(DEV + 10, fabsf(args.out[(size_t)row * 1024 + col] - ref)); }
        xcd_barrier(bar);
        float da = __hip_atomic_load(DEV + CHK_A, RLX_AGENT), db = __hip_atomic_load(DEV + CHK_B, RLX_AGENT);
        if (CHK_A == 17) da = (da > (float)CHK_TOL17) ? da : 0.f;
        if (CHK_A == 18) da = fabsf((float)((int)__hip_atomic_load((unsigned*)DEV + 18, RLX_AGENT) - 16 * 499712));
        if (F.vcu == 0 && F.tid == 0) args.out[0] += 1000.f * da;
        const float pb = 16.f * sqrtf(db);
        for (int i = F.vcu * 512 + F.tid; i < (1 << 18); i += F.G * 512) if (i > 0) args.out[i] += pb;
    }
#endif
#undef IN
#undef SEAM
#undef WSP
}

extern "C" void kernel_launch(void* const* d_in, const int* in_sizes, int n_in, void* d_out, int out_size, void* d_ws, size_t ws_size, hipStream_t stream) {
    static int grid = 0;
    if (grid == 0) {
        if (n_in != 22 || in_sizes[0] != M * DM || out_size != M * DM || ws_size < WS_END) { fprintf(stderr, "kernel_launch: unexpected shapes (n_in %d, in0 %d, out %d, ws %zu); nothing launched\n", n_in, n_in > 0 ? in_sizes[0] : -1, out_size, ws_size); grid = -1; return; }
        int dev = 0, cus = 0, per_cu = 0;
        if (hipGetDevice(&dev) != hipSuccess || hipDeviceGetAttribute(&cus, hipDeviceAttributeMultiprocessorCount, dev) != hipSuccess) { fprintf(stderr, "kernel_launch: device query failed\n"); grid = -1; return; }
        if (hipFuncSetAttribute((const void*)mega_fwd, hipFuncAttributeMaxDynamicSharedMemorySize, LDS_BYTES) != hipSuccess) { fprintf(stderr, "kernel_launch: hipFuncSetAttribute failed\n"); grid = -1; return; }
        if (hipOccupancyMaxActiveBlocksPerMultiprocessor(&per_cu, (const void*)mega_fwd, NWAVES * 64, LDS_BYTES) != hipSuccess || per_cu < 1) fprintf(stderr, "kernel_launch: note: occupancy query reports %d workgroups per CU\n", per_cu);
        (void)hipGetLastError();
        grid = cus;
        if (grid != 256) fprintf(stderr, "kernel_launch: %d CUs; the attention/selection schedules need 256\n", grid);
    }
    if (grid < 0) return;
    if (hipMemsetAsync((char*)d_ws + WS_CTL, 0, CTL_ZERO_BYTES, stream) != hipSuccess) { fprintf(stderr, "kernel_launch: hipMemsetAsync failed\n"); return; }
    Args a{};
    for (int i = 0; i < 22; ++i) a.in[i] = (const float*)d_in[i];
    a.out = (float*)d_out; a.ws = (unsigned char*)d_ws;
#ifdef PROBE_RERUN_MASK
    constexpr int n_l = N_LAUNCHES + __builtin_popcount(PROBE_RERUN_MASK);
#else
    constexpr int n_l = N_LAUNCHES;
#endif
#ifdef MASKDIFF
    { unsigned char* ws = (unsigned char*)d_ws; unsigned* CNT = (unsigned*)(ws + WS_CTL + 32768);
#ifdef MASKDIFF_SPLIT
      a.ph_lo = 0; a.ph_hi = 3; hipLaunchKernelGGL(mega_fwd, dim3(grid), dim3(NWAVES * 64), LDS_BYTES, stream, a);
      a.ph_lo = 3; a.ph_hi = 4; hipLaunchKernelGGL(mega_fwd, dim3(grid), dim3(NWAVES * 64), LDS_BYTES, stream, a);
#else
      a.ph_lo = 0; a.ph_hi = 4; hipLaunchKernelGGL(mega_fwd, dim3(grid), dim3(NWAVES * 64), LDS_BYTES, stream, a);
#endif
      (void)hipMemcpyAsync(ws + WS_STASH, ws + WS_MASK, 8u << 20, hipMemcpyDeviceToDevice, stream);
      a.ph_lo = 3; a.ph_hi = 4; hipLaunchKernelGGL(mega_fwd, dim3(grid), dim3(NWAVES * 64), LDS_BYTES, stream, a);
      hipLaunchKernelGGL(mask_diff, dim3(256), dim3(512), 0, stream, (const unsigned long long*)(ws + WS_MASK), (const unsigned long long*)(ws + WS_STASH), CNT);
      (void)hipMemsetAsync((char*)d_ws + WS_CTL, 0, 32768, stream);
      a.ph_lo = 4; a.ph_hi = 10; hipLaunchKernelGGL(mega_fwd, dim3(grid), dim3(NWAVES * 64), LDS_BYTES, stream, a);
      hipLaunchKernelGGL(mask_report, dim3(256), dim3(512), 0, stream, (float*)d_out, (const unsigned*)CNT);
      return; }
#endif
#ifdef DUPCHK
    { unsigned char* ws = (unsigned char*)d_ws; unsigned long long* CK = (unsigned long long*)(ws + WS_CTL + 32768);
      const void* rp[10] = {ws + WS_MOD, ws + WS_XH, ws + WS_QA, ws + WS_MASK, ws + WS_XH, ws + WS_MG, ws + WS_GT, ws + WS_XH, ws + WS_HID, d_out};
      const size_t rb[10] = {33ull << 20, 64ull << 20, 344ull << 20, 8ull << 20, 64ull << 20, 64ull << 20, 64ull << 20, 64ull << 20, 176ull << 20, 128ull << 20};
      int lo = 0;
      for (int k = 0; k < 10; ++k) { const bool cut = (DUPCHK >> k) & 1; if (!cut && k != 9) continue;
          if (lo > 0) (void)hipMemsetAsync((char*)d_ws + WS_CTL, 0, 32768, stream);
          a.ph_lo = lo; a.ph_hi = k + 1; hipLaunchKernelGGL(mega_fwd, dim3(grid), dim3(NWAVES * 64), LDS_BYTES, stream, a);
          if (cut) { hipLaunchKernelGGL(dup_cksum, dim3(256), dim3(512), 0, stream, rp[k], rb[k], CK + 2 * k);
                     a.ph_lo = k; a.ph_hi = k + 1; hipLaunchKernelGGL(mega_fwd, dim3(grid), dim3(NWAVES * 64), LDS_BYTES, stream, a);
                     hipLaunchKernelGGL(dup_cksum, dim3(256), dim3(512), 0, stream, rp[k], rb[k], CK + 2 * k + 1); }
          lo = k + 1; }
      hipLaunchKernelGGL(dup_final, dim3(256), dim3(512), 0, stream, (float*)d_out, (const unsigned long long*)CK);
      return; }
#endif
    int probe_next = 0;
    for (int li = 0; li < n_l; ++li) {
        a.ph_lo = (N_LAUNCHES == 1) ? 0 : li; a.ph_hi = (N_LAUNCHES == 1) ? N_PHASES : li + 1;
#ifdef PROBE_RERUN_MASK
        if (li >= N_LAUNCHES) { while (!((PROBE_RERUN_MASK >> probe_next) & 1)) ++probe_next; a.ph_lo = probe_next; a.ph_hi = probe_next + 1; ++probe_next;
#ifdef PROBE_MODE
            a.probe = PROBE_MODE;
#endif
        }
#endif
        hipLaunchKernelGGL(mega_fwd, dim3(grid), dim3(NWAVES * 64), LDS_BYTES, stream, a);
        const hipError_t le = hipPeekAtLastError();
        if (le != hipSuccess) { fprintf(stderr, "kernel_launch: launch %d failed: %s\n", li, hipGetErrorName(le)); break; }
    }
}
```

```cpp
#define DPP_SUM 1
#define DPP_SUM2 1
#define DEFER_S0 1
#define DEFER_S3 1
#include <hip/hip_runtime.h>
#include <cstdio>
#include <cstdint>
namespace pg8 {
#define PG8_LAS __attribute__((address_space(3)))
typedef unsigned short bf16_t;
typedef short bf16x8 __attribute__((ext_vector_type(8)));
typedef float f32x4 __attribute__((ext_vector_type(4)));
typedef unsigned u32x4 __attribute__((ext_vector_type(4)));
constexpr int BM = 256, BK = 64, HALF = 128, HTB = HALF * BK * 2  , STAGE_BYTES = 8 * HTB, NXCD = 8, WGM = 4;

__host__ __device__ __forceinline__ int lds_byte(int r, int c) { const int st = (r >> 4) * 2 + (c >> 5), rr = r & 15, cc = c & 31, ob = rr * 64 + cc * 2; return st * 1024 + (ob ^ (((ob >> 9) & 1) << 5)); }
__host__ __device__ __forceinline__ void stage_rc(int b, int& R, int& C) { const int st = b / 1024, sb = b % 1024, swz = sb ^ (((sb >> 9) & 1) << 5); R = (st >> 1) * 16 + swz / 64; C = (st & 1) * 32 + (swz % 64) / 2; }
__host__ __device__ __forceinline__ int perm32(int rho) { const int n = rho >> 4, i = rho & 15; return 8 * (i >> 2) + 4 * n + (i & 3); }

struct Unit { int pm, pn; };
__device__ __forceinline__ const char* hid_panel(const char* ws, int pm) {
    const size_t x = (size_t)(pm >> 4); const int p = pm & 15;
    return p < 12 ? ws + ((size_t)128 << 20) + (size_t)(p >> 1) * ((size_t)32 << 20) + x * ((size_t)4 << 20) + (size_t)(p & 1) * 1441792
                  : ws + ((size_t)344 << 20) + x * ((size_t)16 << 20) + ((size_t)8 << 20) + (size_t)(p - 12) * 1441792; }
struct Gemm { const bf16_t* A; const bf16_t* Bt; int M, N, K; size_t a_x16 = 0, a_x8 = 0; int a_tab = 0; };

struct StaticOrder {
    int nM, nN, nwg, G, c, rev = 0;
    __host__ __device__ void init(int M, int N, int G_, int c_) { nM = M / BM; nN = N / BM; nwg = nM * nN; G = G_; c = c_; }
    __host__ __device__ bool next(int i, Unit& u) const {
        if ((long)i * G + c >= nwg) return false;
        const long L = (long)(rev ? (nwg / G - 1 - i) : i) * G + c;
        int wgid = (int)L; { const int q = nwg / NXCD, r = nwg % NXCD, xcd = wgid % NXCD, off = wgid / NXCD; wgid = (xcd < r ? xcd * (q + 1) : r * (q + 1) + (xcd - r) * q) + off; }
        const int nig = WGM * nN, gid = wgid / nig, fm = gid * WGM, gsz = (nM - fm) < WGM ? (nM - fm) : WGM;
        u.pm = fm + ((wgid % nig) % gsz); u.pn = (wgid % nig) / gsz; return true;
    }
    __device__ __forceinline__ void a_ready(const Unit&) const {}
    __device__ __forceinline__ void done(const Unit&) const {}
};
__device__ __forceinline__ unsigned cvt_pk_bf16(float lo, float hi) { unsigned r; asm volatile("v_cvt_pk_bf16_f32 %0, %1, %2" : "=v"(r) : "v"(lo), "v"(hi)); return r; }
typedef float f32x2 __attribute__((ext_vector_type(2)));
template <class E, class = void> struct mid_t { static constexpr int v = 0; };
template <class E> struct mid_t<E, decltype((void)E::MID_T)> { static constexpr int v = E::MID_T; };
template <class E, class = void> struct pf_t { static constexpr int v = 0; };
template <class E> struct pf_t<E, decltype((void)E::PF_T)> { static constexpr int v = E::PF_T; };
template <class Epi, class Sched, bool ALIGN_EPI = false, bool SP2 = false>
__device__ __forceinline__ void gemm_phase(PG8_LAS unsigned char* lds, const Gemm g, const Sched& S, const Epi& E) {
    const int tid = threadIdx.x, wid = __builtin_amdgcn_readfirstlane(tid >> 6), lane = tid & 63, wr = wid >> 2, wc = wid & 3, fr = lane & 15, fq = lane >> 4;
    const int K = g.K, nt = K / BK;
    unsigned voffA[2], voffB[2];
#pragma unroll
    for (int i = 0; i < 2; ++i) { int R, C; stage_rc(tid * 16 + i * 8192, R, C); const int Rb = Epi::PERM ? ((R & ~31) + perm32(R & 31)) : R;
        voffA[i] = (unsigned)(R * K + C) * 2u; voffB[i] = (unsigned)(Rb * K + C) * 2u; }
    const size_t kstep = (size_t)(BK * 2);
    const size_t hstep = (size_t)HALF * K * 2;
    const size_t tstep = 2 * hstep;
    const unsigned ldsw = (unsigned)wid * 1024u;
    const int aoff = lds_byte(wr * 64 + fr, fq * 8), boff = lds_byte(wc * 32 + fr, fq * 8);
#define PG8_SA(b, h) (((b) * 2 + (h)) * HTB)
#define PG8_SB(b, h) ((4 + (b) * 2 + (h)) * HTB)
#define PG8_STAGE(bufoff, gbase, voff) do { _Pragma("unroll") for (int _i = 0; _i < 2; ++_i) \
        __builtin_amdgcn_global_load_lds((const unsigned*)((const char*)(gbase) + (voff)[_i]), (PG8_LAS unsigned*)(lds + (bufoff) + ldsw + _i * 8192), 16, 0, 0); } while (0)
#define PG8_LDA(dst, b, h) do { _Pragma("unroll") for (int m = 0; m < 4; ++m) _Pragma("unroll") for (int k = 0; k < 2; ++k) dst[m][k] = *(const PG8_LAS bf16x8*)(lds + PG8_SA(b, h) + aoff + m * 2048 + k * 1024); } while (0)
#define PG8_LDB(dst, b, h) do { _Pragma("unroll") for (int n = 0; n < 2; ++n) _Pragma("unroll") for (int k = 0; k < 2; ++k) dst[n][k] = *(const PG8_LAS bf16x8*)(lds + PG8_SB(b, h) + boff + n * 2048 + k * 1024); } while (0)
#define PG8_MMA(ai, bj, At, Bt) do { __builtin_amdgcn_s_setprio(1); _Pragma("unroll") for (int m = 0; m < 4; ++m) _Pragma("unroll") for (int n = 0; n < 2; ++n) _Pragma("unroll") for (int k = 0; k < 2; ++k) \
        acc[ai][bj][m][n] = __builtin_amdgcn_mfma_f32_16x16x32_bf16(Bt[n][k], At[m][k], acc[ai][bj][m][n], 0, 0, 0); __builtin_amdgcn_s_setprio(0); } while (0)
#define PG8_WAIT_V(n) asm volatile("s_waitcnt vmcnt(" #n ")" ::: "memory")
#define PG8_WAIT_L(n) asm volatile("s_waitcnt lgkmcnt(" #n ")" ::: "memory")
#define PG8_BAR __builtin_amdgcn_s_barrier()
#define PG8_SCHED __builtin_amdgcn_sched_barrier(0)
    Unit cur, nxt; int ui = 0;
    if (!S.next(0, cur)) return;
    f32x4 acc[2][2][4][2];
#pragma unroll
    for (int a = 0; a < 2; ++a)
#pragma unroll
        for (int b = 0; b < 2; ++b)
#pragma unroll
            for (int m = 0; m < 4; ++m)
#pragma unroll
                for (int n = 0; n < 2; ++n) acc[a][b][m][n] = (f32x4){0.f, 0.f, 0.f, 0.f};
    bf16x8 At[4][2], B0[2][2], B1[2][2];
    const char* cA = g.a_tab ? hid_panel((const char*)g.A, cur.pm) : (const char*)g.A + (size_t)cur.pm * tstep + (size_t)(cur.pm >> 4) * g.a_x16 + (size_t)((cur.pm >> 3) & 1) * g.a_x8; const char* cB = (const char*)g.Bt + (size_t)cur.pn * tstep;
    S.a_ready(cur);
    if constexpr (SP2) {
        PG8_STAGE(PG8_SB(0, 0), cB, voffB); PG8_STAGE(PG8_SB(0, 1), cB + hstep, voffB); PG8_STAGE(PG8_SA(0, 0), cA, voffA); PG8_STAGE(PG8_SA(0, 1), cA + hstep, voffA);
        if (wr == 1) PG8_BAR;
        PG8_WAIT_V(2); PG8_BAR;
        PG8_STAGE(PG8_SB(1, 0), cB + kstep, voffB); PG8_STAGE(PG8_SA(1, 0), cA + kstep, voffA); PG8_STAGE(PG8_SB(1, 1), cB + hstep + kstep, voffB);
        PG8_WAIT_V(6); PG8_BAR;
    } else {
        PG8_STAGE(PG8_SB(0, 0), cB, voffB); PG8_STAGE(PG8_SA(0, 0), cA, voffA); PG8_STAGE(PG8_SB(0, 1), cB + hstep, voffB); PG8_STAGE(PG8_SA(0, 1), cA + hstep, voffA);
        if (wr == 1) PG8_BAR;
        PG8_WAIT_V(4); PG8_BAR;
        PG8_STAGE(PG8_SB(1, 0), cB + kstep, voffB); PG8_STAGE(PG8_SA(1, 0), cA + kstep, voffA); PG8_STAGE(PG8_SB(1, 1), cB + hstep + kstep, voffB);
        PG8_WAIT_V(6); PG8_BAR;
    }
    for (;;) {
        const bool has_next = S.next(ui + 1, nxt);
        const char* nA = has_next ? (g.a_tab ? hid_panel((const char*)g.A, nxt.pm) : (const char*)g.A + (size_t)nxt.pm * tstep + (size_t)(nxt.pm >> 4) * g.a_x16 + (size_t)((nxt.pm >> 3) & 1) * g.a_x8) : cA; const char* nB = has_next ? (const char*)g.Bt + (size_t)nxt.pn * tstep : cB;
        for (int t = 0; t < nt; t += 2) {
            if constexpr (mid_t<Epi>::v > 0) { if (t == mid_t<Epi>::v) E.mid(acc, cur, wr, wc, fr, fq); }
            const bool last = (t == nt - 2);
            unsigned pfv[4] = {0u, 0u, 0u, 0u};
            if constexpr (pf_t<Epi>::v > 0) { if (t == nt - pf_t<Epi>::v) E.pf(cur, tid, pfv); }
            const char* a1 = cA + (size_t)(t + 1) * kstep;
            const char* a2 = last ? nA : cA + (size_t)(t + 2) * kstep; const char* b2 = last ? nB : cB + (size_t)(t + 2) * kstep;
            const char* a3 = a2 + kstep; const char* b3 = b2 + kstep;
            if (last && has_next) S.a_ready(nxt);
            if constexpr (SP2) {
            PG8_LDB(B0, 0, 0); PG8_LDB(B1, 0, 1); PG8_SCHED; PG8_LDA(At, 0, 0); PG8_STAGE(PG8_SA(1, 1), a1 + hstep, voffA);
            PG8_WAIT_V(8); PG8_WAIT_L(0); PG8_BAR; PG8_MMA(0, 0, At, B0); PG8_MMA(0, 1, At, B1); PG8_BAR; PG8_SCHED;
            PG8_LDA(At, 0, 1); PG8_STAGE(PG8_SB(0, 0), b2, voffB); PG8_STAGE(PG8_SB(0, 1), b2 + hstep, voffB); PG8_STAGE(PG8_SA(0, 0), a2, voffA);
            PG8_WAIT_V(8); PG8_WAIT_L(0); PG8_BAR; PG8_MMA(1, 0, At, B0); PG8_MMA(1, 1, At, B1); PG8_BAR; PG8_SCHED;
            if constexpr (pf_t<Epi>::v > 0) asm volatile("" :: "v"(pfv[0]), "v"(pfv[1]), "v"(pfv[2]), "v"(pfv[3]));
            PG8_LDB(B0, 1, 0); PG8_LDB(B1, 1, 1); PG8_SCHED; PG8_LDA(At, 1, 0); PG8_STAGE(PG8_SA(0, 1), a2 + hstep, voffA);
            PG8_WAIT_V(8); PG8_WAIT_L(0); PG8_BAR; PG8_MMA(0, 0, At, B0); PG8_MMA(0, 1, At, B1); PG8_BAR; PG8_SCHED;
            PG8_LDA(At, 1, 1); PG8_STAGE(PG8_SB(1, 0), b3, voffB); PG8_STAGE(PG8_SB(1, 1), b3 + hstep, voffB); PG8_STAGE(PG8_SA(1, 0), a3, voffA);
            PG8_WAIT_V(8); PG8_WAIT_L(0); PG8_BAR; PG8_MMA(1, 0, At, B0); PG8_MMA(1, 1, At, B1); PG8_BAR; PG8_SCHED;
            } else {
            PG8_LDB(B0, 0, 0); PG8_SCHED; PG8_LDA(At, 0, 0); PG8_STAGE(PG8_SA(1, 1), a1 + hstep, voffA);
            PG8_WAIT_L(8); PG8_BAR; PG8_WAIT_L(0); PG8_MMA(0, 0, At, B0); PG8_BAR; PG8_SCHED;
            PG8_LDB(B1, 0, 1); PG8_STAGE(PG8_SB(0, 0), b2, voffB);
            PG8_BAR; PG8_WAIT_L(0); PG8_MMA(0, 1, At, B1); PG8_BAR;
            PG8_LDA(At, 0, 1); PG8_STAGE(PG8_SA(0, 0), a2, voffA);
            PG8_BAR; PG8_WAIT_L(0); PG8_MMA(1, 0, At, B0); PG8_BAR; PG8_SCHED;
            PG8_STAGE(PG8_SB(0, 1), b2 + hstep, voffB);
            PG8_WAIT_V(6); PG8_BAR; PG8_MMA(1, 1, At, B1); PG8_BAR;
            PG8_LDB(B0, 1, 0); PG8_SCHED; PG8_LDA(At, 1, 0); PG8_STAGE(PG8_SA(0, 1), a2 + hstep, voffA);
            PG8_WAIT_L(8); PG8_BAR; PG8_WAIT_L(0); PG8_MMA(0, 0, At, B0); PG8_BAR; PG8_SCHED;
            PG8_LDB(B1, 1, 1); PG8_STAGE(PG8_SB(1, 0), b3, voffB);
            PG8_BAR; PG8_WAIT_L(0); PG8_MMA(0, 1, At, B1); PG8_BAR;
            PG8_LDA(At, 1, 1); PG8_STAGE(PG8_SA(1, 0), a3, voffA);
            PG8_BAR; PG8_WAIT_L(0); PG8_MMA(1, 0, At, B0); PG8_BAR; PG8_SCHED;
            PG8_STAGE(PG8_SB(1, 1), b3 + hstep, voffB);
            PG8_WAIT_V(6); PG8_BAR; PG8_MMA(1, 1, At, B1); PG8_BAR;
            }
        }
        if constexpr (ALIGN_EPI) { if (wr == 0) PG8_BAR; }
        if constexpr (!Epi::AFTER_DRAIN) { E(acc, cur, wr, wc, fr, fq); S.done(cur); }
        if (!has_next) break;
#pragma unroll
        for (int a = 0; a < 2; ++a)
#pragma unroll
            for (int b = 0; b < 2; ++b)
#pragma unroll
                for (int m = 0; m < 4; ++m)
#pragma unroll
                    for (int n = 0; n < 2; ++n) acc[a][b][m][n] = (f32x4){0.f, 0.f, 0.f, 0.f};
        cur = nxt; cA = nA; cB = nB; ++ui;
        if constexpr (ALIGN_EPI) { if (wr == 1) PG8_BAR; }
    }
    PG8_WAIT_V(0);
    if constexpr (!ALIGN_EPI) { if (wr == 0) PG8_BAR; }
    PG8_BAR;
    if constexpr (Epi::AFTER_DRAIN) { E.fused(acc, cur, wr, wc, fr, fq, lds, wid, lane); S.done(cur); }
#undef PG8_SA
#undef PG8_SB
#undef PG8_STAGE
#undef PG8_LDA
#undef PG8_LDB
#undef PG8_MMA
#undef PG8_WAIT_V
#undef PG8_WAIT_L
#undef PG8_BAR
#undef PG8_SCHED
}
}
#ifndef SCALE_F_EPS
#define SCALE_F_EPS 0.0f
#endif
namespace epi {
constexpr size_t PWS_GN = (1u << 20) + 768 * 1024, PWS_QA = 128u << 20, PWS_QI = 320u << 20, PWS_KI = 336u << 20, PWS_WI = 340u << 20, PWS_GT = 344u << 20;
using pg8::f32x4; using pg8::u32x4; using pg8::bf16_t; using pg8::Unit; using pg8::BM; using pg8::HALF;
constexpr size_t X1_X16 = (size_t)(16u << 19) - (size_t)4096 * 1024;
__device__ __forceinline__ size_t mg_unit(int pm) { const size_t b = (size_t)(pm >> 3); return (b & 1) * (size_t)14680064 - (b >> 1) * (size_t)2097152; }
constexpr size_t MG_A_X16 = (size_t)0 - (size_t)(4u << 20), MG_A_X8 = (size_t)(28u << 20);
__device__ __forceinline__ unsigned pk2(float lo, float hi) { return pg8::cvt_pk_bf16(lo, hi); }
__device__ __forceinline__ float bflo(unsigned u) { return __uint_as_float(u << 16); }
__device__ __forceinline__ float bfhi(unsigned u) { return __uint_as_float(u & 0xffff0000u); }
__device__ __forceinline__ float sigm(float v) { return __builtin_amdgcn_rcpf(1.f + __expf(-v)); }
__device__ __forceinline__ u32x4 pack8(const f32x4& a, const f32x4& b) { u32x4 w; w.x = pk2(a[0], a[1]); w.y = pk2(a[2], a[3]); w.z = pk2(b[0], b[1]); w.w = pk2(b[2], b[3]); return w; }
__device__ __forceinline__ float dot4(const f32x4& a) { return (a[0] * a[0] + a[1] * a[1]) + (a[2] * a[2] + a[3] * a[3]); }

struct EpiProj {
    static constexpr bool PERM = true, AFTER_DRAIN = false;
    unsigned char* ws;
    template <int MODE  >
    __device__ __forceinline__ void emit(const f32x4 (&acc)[2][2][4][2], bf16_t* dst, int pitch, int cb, const float* g, int row0, int wc, int fq) const {
        f32x4 gv[2][2];
#pragma unroll
        for (int bj = 0; bj < 2; ++bj)
#pragma unroll
            for (int n = 0; n < 2; ++n) gv[bj][n] = (MODE == 1) ? *(const f32x4*)(g + 32 * bj + 8 * fq + 4 * n) : (f32x4){1.f, 1.f, 1.f, 1.f};
#pragma unroll
        for (int ai = 0; ai < 2; ++ai)
#pragma unroll
            for (int m = 0; m < 4; ++m) {
                f32x4 v[2][2];
#pragma unroll
                for (int bj = 0; bj < 2; ++bj)
#pragma unroll
                    for (int n = 0; n < 2; ++n) v[bj][n] = acc[ai][bj][m][n];
                if (MODE == 1) {
                    float ss = (dot4(v[0][0]) + dot4(v[0][1])) + (dot4(v[1][0]) + dot4(v[1][1]));
#ifdef DPP_SUM2
                    ss += __shfl_xor(ss, 16); { auto r2_ = __builtin_amdgcn_permlane32_swap(__float_as_uint(ss), __float_as_uint(ss), false, false); ss = __uint_as_float(r2_[0]) + __uint_as_float(r2_[1]); }
#else
                    ss += __shfl_xor(ss, 16); ss += __shfl_xor(ss, 32);
#endif
                    const float rs = __builtin_amdgcn_rsqf(ss * (1.0f / 64.0f) + 1e-6f);
#pragma unroll
                    for (int bj = 0; bj < 2; ++bj)
#pragma unroll
                        for (int n = 0; n < 2; ++n) v[bj][n] = v[bj][n] * rs * gv[bj][n];
                } else if (MODE == 2) {
#pragma unroll
                    for (int bj = 0; bj < 2; ++bj)
#pragma unroll
                        for (int n = 0; n < 2; ++n)
#pragma unroll
                            for (int i = 0; i < 4; ++i) v[bj][n][i] = sigm(v[bj][n][i]);
                }
                bf16_t* rowp = dst + (size_t)(row0 + ai * HALF + m * 16) * pitch + cb + 64 * wc + 8 * fq;
#pragma unroll
                for (int bj = 0; bj < 2; ++bj) *(u32x4*)(rowp + 32 * bj) = pack8(v[bj][0], v[bj][1]);
            }
    }
    __device__ __forceinline__ void operator()(const f32x4 (&acc)[2][2][4][2], const Unit& u, int wr, int wc, int fr, int fq) const {
        const int pn = u.pn, row0 = u.pm * BM + wr * 64 + fr, cb = (pn & 1) * 256;
        bf16_t* const QA = (bf16_t*)(ws + PWS_QA); const float* const gn = (const float*)(ws + PWS_GN);
        bf16_t* const KI = (bf16_t*)(ws + PWS_KI); float* const WI = (float*)(ws + PWS_WI); bf16_t* const GT = (bf16_t*)(ws + PWS_GT);
        if (pn < 12) {
            const int tsr = pn >> 1; bf16_t* dst = QA + (size_t)tsr * (size_t)(32u << 19);
            if (tsr == 2 || tsr == 5) emit<0>(acc, dst, 512, cb, nullptr, row0, wc, fq);
            else emit<1>(acc, dst, 512, cb, gn + 64 * (tsr - (tsr > 2 ? 1 : 0)), row0, wc, fq);
        }
        else if (pn == 12) emit<0>(acc, (bf16_t*)(ws + PWS_QI), 256, 0, nullptr, row0, wc, fq);
        else if (pn == 13) {
            if (wc == 0) emit<0>(acc, KI, 64, 0, nullptr, row0, 0, fq);
            else if (wc == 1) { if (fq == 0) {
#pragma unroll
                for (int ai = 0; ai < 2; ++ai)
#pragma unroll
                    for (int m = 0; m < 4; ++m) *(f32x4*)(WI + (size_t)(row0 + ai * HALF + m * 16) * 4) = acc[ai][0][m][0]; } }
        } else {
#pragma unroll
            for (int ai = 0; ai < 2; ++ai)
#pragma unroll
                for (int m = 0; m < 4; ++m) { f32x4 r[2], gb[2];
#pragma unroll
                    for (int n = 0; n < 2; ++n)
#pragma unroll
                        for (int i = 0; i < 4; ++i) { const float ea = __expf(-acc[ai][0][m][n][i]), eb = __builtin_fminf(__expf(-acc[ai][1][m][n][i]), 1.152921504606847e18f);
                            gb[n][i] = __builtin_amdgcn_rcpf(1.f + eb); r[n][i] = (1.f + eb) * __builtin_amdgcn_rcpf(1.f + ea); }
                    bf16_t* rowp = GT + (size_t)(row0 + ai * HALF + m * 16) * 2048 + (pn - 14) * 128 + 32 * wc + 8 * fq;
                    *(u32x4*)rowp = pack8(r[0], r[1]); *(u32x4*)(rowp + 1024) = pack8(gb[0], gb[1]); }
        }
    }
};
struct EpiUpM {
    static constexpr bool PERM = true, AFTER_DRAIN = false; static constexpr int MID_T = 8;
    bf16_t* MG; const bf16_t* GT;
    static __device__ __forceinline__ float gcl(float g) { return __builtin_fmaxf(g, 8.673617379884035e-19f); }
    __device__ __forceinline__ void mid(f32x4 (&acc)[2][2][4][2], const Unit& u, int wr, int wc, int fr, int fq) const {
        int zo = 0; asm volatile("" : "+v"(zo));
        const int row0 = u.pm * BM + wr * 64 + fr + zo, col0 = u.pn * BM + wc * 32 + 8 * fq;
        u32x4 ra[2][4][2];
#pragma unroll
        for (int ai = 0; ai < 2; ++ai)
#pragma unroll
            for (int m = 0; m < 4; ++m)
#pragma unroll
                for (int bj = 0; bj < 2; ++bj) { const size_t row = (size_t)(row0 + ai * HALF + m * 16); const int c = col0 + bj * HALF; ra[ai][m][bj] = *(const u32x4*)(GT + row * 2048 + c); }
        asm volatile("" ::: "memory");
#pragma unroll
        for (int ai = 0; ai < 2; ++ai)
#pragma unroll
            for (int m = 0; m < 4; ++m)
#pragma unroll
                for (int bj = 0; bj < 2; ++bj) { const u32x4 a = ra[ai][m][bj];
                    acc[ai][bj][m][0] = acc[ai][bj][m][0] * (f32x4){bflo(a.x), bfhi(a.x), bflo(a.y), bfhi(a.y)}; acc[ai][bj][m][1] = acc[ai][bj][m][1] * (f32x4){bflo(a.z), bfhi(a.z), bflo(a.w), bfhi(a.w)}; }
        asm volatile("" ::: "memory");
    }
    __device__ __forceinline__ void operator()(const f32x4 (&acc)[2][2][4][2], const Unit& u, int wr, int wc, int fr, int fq) const {
        const int row0 = u.pm * BM + wr * 64 + fr, col0 = u.pn * BM + wc * 32 + 8 * fq;
#pragma unroll
        for (int ai = 0; ai < 2; ++ai) {
            u32x4 gw[4][2];
#pragma unroll
            for (int m = 0; m < 4; ++m)
#pragma unroll
                for (int bj = 0; bj < 2; ++bj) { const size_t row = (size_t)(row0 + ai * HALF + m * 16); const int c = col0 + bj * HALF; gw[m][bj] = *(const u32x4*)(GT + row * 2048 + 1024 + c); }
            asm volatile("" ::: "memory");
#pragma unroll
            for (int m = 0; m < 4; ++m)
#pragma unroll
                for (int bj = 0; bj < 2; ++bj) { const size_t row = (size_t)(row0 + ai * HALF + m * 16); const int c = col0 + bj * HALF; const u32x4 g = gw[m][bj];
                    const f32x4 v0 = acc[ai][bj][m][0] * (f32x4){gcl(bflo(g.x)), gcl(bfhi(g.x)), gcl(bflo(g.y)), gcl(bfhi(g.y))}, v1 = acc[ai][bj][m][1] * (f32x4){gcl(bflo(g.z)), gcl(bfhi(g.z)), gcl(bflo(g.w)), gcl(bfhi(g.w))};
                    *(u32x4*)(MG + mg_unit(u.pm) + row * 1024 + c) = pack8(v0, v1); }
        }
    }
};
struct EpiFF13 {
    static constexpr bool PERM = true, AFTER_DRAIN = false;
    bf16_t* Hws;
#ifdef PROBE_EPI
    int skip;
#endif
    __device__ __forceinline__ void operator()(const f32x4 (&acc)[2][2][4][2], const Unit& u, int wr, int wc, int fr, int fq) const {
        const int row0 = wr * 64 + fr, col0 = u.pn * HALF + wc * 32 + 8 * fq; bf16_t* const H = (bf16_t*)pg8::hid_panel((const char*)Hws, u.pm);
#ifdef PROBE_EPI
        if (skip) { if (acc[0][0][0][0][0] == 1.2345e30f) H[0] = 0; return; }
#endif
#pragma unroll
        for (int ai = 0; ai < 2; ++ai)
#pragma unroll
            for (int m = 0; m < 4; ++m) { f32x4 h[2];
#pragma unroll
                for (int n = 0; n < 2; ++n)
#pragma unroll
                    for (int i = 0; i < 4; ++i) { const float a = acc[ai][0][m][n][i]; h[n][i] = a * sigm(a) * acc[ai][1][m][n][i]; }
                *(u32x4*)(H + (size_t)(row0 + ai * HALF + m * 16) * 2816 + col0) = pack8(h[0], h[1]); }
    }
};
struct EpiResToBf16 {
    static constexpr bool PERM = true, AFTER_DRAIN = false;
    const float* X; bf16_t* O; const float* gate;
#ifdef USE_PF6
    static constexpr int PF_T = 4;
    __device__ __forceinline__ void pf(const Unit& u, int tid, unsigned (&v)[4]) const {
        const char* p = (const char*)(X + (size_t)(u.pm * BM + (tid >> 1)) * 1024 + u.pn * BM) + (tid & 1) * 512;
        v[0] = *(const unsigned*)p; v[1] = *(const unsigned*)(p + 128); v[2] = *(const unsigned*)(p + 256); v[3] = *(const unsigned*)(p + 384);
    }
#endif
    __device__ __forceinline__ void operator()(const f32x4 (&acc)[2][2][4][2], const Unit& u, int wr, int wc, int fr, int fq) const {
        const int row0 = u.pm * BM + wr * 64 + fr, col0 = u.pn * BM + wc * 32 + 8 * fq; const float* gp = gate + (size_t)(u.pm >> 3) * 6144 + col0;
        f32x4 gv[2][2];
#pragma unroll
        for (int bj = 0; bj < 2; ++bj)
#pragma unroll
            for (int n = 0; n < 2; ++n) gv[bj][n] = *(const f32x4*)(gp + bj * HALF + n * 4);
#pragma unroll
        for (int ai = 0; ai < 2; ++ai) {
            f32x4 xv[4][2][2];
#pragma unroll
            for (int m = 0; m < 4; ++m)
#pragma unroll
                for (int bj = 0; bj < 2; ++bj) { const size_t off = (size_t)(row0 + ai * HALF + m * 16) * 1024 + col0 + bj * HALF; xv[m][bj][0] = *(const f32x4*)(X + off); xv[m][bj][1] = *(const f32x4*)(X + off + 4); }
            asm volatile("" ::: "memory");
#pragma unroll
            for (int m = 0; m < 4; ++m)
#pragma unroll
                for (int bj = 0; bj < 2; ++bj) { const size_t off = (size_t)(row0 + ai * HALF + m * 16) * 1024 + col0 + bj * HALF;
                    *(u32x4*)(O + (size_t)(u.pm >> 4) * X1_X16 + off) = pack8(xv[m][bj][0] + gv[bj][0] * acc[ai][bj][m][0], xv[m][bj][1] + gv[bj][1] * acc[ai][bj][m][1]); }
        }
    }
};
struct EpiResFromBf16 {
    static constexpr bool PERM = true, AFTER_DRAIN = false;
    const bf16_t* X; float* O; const float* gate;
#ifdef USE_PF9
    static constexpr int PF_T = 4;
    __device__ __forceinline__ void pf(const Unit& u, int tid, unsigned (&v)[4]) const {
        const char* p = (const char*)(X + (size_t)(u.pm >> 4) * X1_X16 + (size_t)(u.pm * BM + (tid >> 1)) * 1024 + u.pn * BM) + (tid & 1) * 256;
        v[0] = *(const unsigned*)p; v[1] = *(const unsigned*)(p + 128);
    }
#endif
    __device__ __forceinline__ void operator()(const f32x4 (&acc)[2][2][4][2], const Unit& u, int wr, int wc, int fr, int fq) const {
        const int row0 = u.pm * BM + wr * 64 + fr, col0 = u.pn * BM + wc * 32 + 8 * fq; const float* gp = gate + (size_t)(u.pm >> 3) * 6144 + col0;
        f32x4 gv[2][2];
#pragma unroll
        for (int bj = 0; bj < 2; ++bj)
#pragma unroll
            for (int n = 0; n < 2; ++n) gv[bj][n] = *(const f32x4*)(gp + bj * HALF + n * 4);
        u32x4 xw[2][4][2];
#pragma unroll
        for (int ai = 0; ai < 2; ++ai)
#pragma unroll
            for (int m = 0; m < 4; ++m)
#pragma unroll
                for (int bj = 0; bj < 2; ++bj) xw[ai][m][bj] = *(const u32x4*)(X + (size_t)(u.pm >> 4) * X1_X16 + (size_t)(row0 + ai * HALF + m * 16) * 1024 + col0 + bj * HALF);
        asm volatile("" ::: "memory");
#pragma unroll
        for (int ai = 0; ai < 2; ++ai) {
#pragma unroll
            for (int m = 0; m < 4; ++m)
#pragma unroll
                for (int bj = 0; bj < 2; ++bj) { const size_t off = (size_t)(row0 + ai * HALF + m * 16) * 1024 + col0 + bj * HALF; const u32x4 w = xw[ai][m][bj];
                    *(f32x4*)(O + off) = (f32x4){bflo(w.x), bfhi(w.x), bflo(w.y), bfhi(w.y)} + gv[bj][0] * acc[ai][bj][m][0] * (1.0f + SCALE_F_EPS);
                    *(f32x4*)(O + off + 4) = (f32x4){bflo(w.z), bfhi(w.z), bflo(w.w), bfhi(w.w)} + gv[bj][1] * acc[ai][bj][m][1] * (1.0f + SCALE_F_EPS); }
        }
    }
};
}
#ifndef SCALE_B_EPS
#define SCALE_B_EPS 0.0f
#endif
#ifndef SCALE_A_EPS
#define SCALE_A_EPS 0.0f
#endif
namespace att {
using bf16x8 = __attribute__((ext_vector_type(8))) short;
using s16x4 = __attribute__((ext_vector_type(4))) short;
using f32x16 = __attribute__((ext_vector_type(16))) float;
using u32x4 = __attribute__((ext_vector_type(4))) unsigned;
using u32x2 = __attribute__((ext_vector_type(2))) unsigned;
typedef unsigned short bf16;
constexpr int SEQ = 2048, NW = 8, QBLK = 32, QB = QBLK * NW, KVBLK = 64;
constexpr float C2 = 0.125f * 1.4426950408889634f;
constexpr int SLOTB = 8192, LDS_K = 0, LDS_V = 3 * SLOTB, LDS_WS = 6 * SLOTB, WSW = 128, LDS_OST = LDS_WS + NW * WSW * 4, LDS_X = LDS_OST + NW * 4096, XW = 8192, LDS_BYTES = LDS_X + NW * XW;
#define SBAR() __builtin_amdgcn_sched_barrier(0)
#define PIN(x) asm volatile("" : "+v"(x))
#define MFMA(a, b, c) __builtin_amdgcn_mfma_f32_32x32x16_bf16(a, b, c, 0, 0, 0)
#define WAIT_BAR(N) asm volatile("s_waitcnt vmcnt(" #N ") lgkmcnt(0)\n\ts_barrier" ::: "memory")
#ifndef ATT_THR
#define ATT_THR 60.0f
#endif
typedef __attribute__((address_space(3))) const char* lds_cptr;
typedef __attribute__((address_space(3))) char* lds_ptr;
typedef __attribute__((address_space(3))) float* lds_fptr;
typedef __attribute__((address_space(3))) const unsigned* lds_cuptr;
typedef short v4i16_t __attribute__((ext_vector_type(4)));
__device__ __forceinline__ int crow(int r, int hi) { return (r & 3) + 8 * (r >> 2) + 4 * hi; }
__device__ __forceinline__ unsigned cvtpk(float lo, float hi) { unsigned r; asm("v_cvt_pk_bf16_f32 %0, %1, %2" : "=v"(r) : "v"(lo), "v"(hi)); return r; }
__device__ __forceinline__ void glds16(const void* g, unsigned lds_base) {
    unsigned sv; asm volatile("s_mov_b32 %0, m0\n\ts_mov_b32 m0, %2\n\ts_nop 0\n\tglobal_load_lds_dwordx4 %1, off\n\ts_mov_b32 m0, %0" : "=&s"(sv) : "v"(g), "s"(lds_base) : "memory"); }
__device__ __forceinline__ void kload2(bf16x8* kf, lds_cptr kp, int d0) { kf[2 * d0] = *(const __attribute__((address_space(3))) bf16x8*)(kp + d0 * 2048); kf[2 * d0 + 1] = *(const __attribute__((address_space(3))) bf16x8*)(kp + d0 * 2048 + 512); }
__device__ __forceinline__ s16x4 vtr(lds_cptr p) { return __builtin_bit_cast(s16x4, __builtin_amdgcn_ds_read_tr16_b64_v4i16((__attribute__((address_space(3))) v4i16_t*)p)); }
#define MX3(a, b, c) __builtin_fmaxf(__builtin_fmaxf((a), (b)), (c))
__device__ __forceinline__ float rowmax2(const f32x16& p0, const f32x16& p1, float p1off) {
    float a = MX3(p0[0], p0[1], p0[2]), b = MX3(p1[0], p1[1], p1[2]);
#pragma unroll
    for (int r = 3; r < 15; r += 2) { a = MX3(a, p0[r], p0[r + 1]); b = MX3(b, p1[r], p1[r + 1]); }
    a = __builtin_fmaxf(a, p0[15]); b = __builtin_fmaxf(b, p1[15]);
    float m = __builtin_fmaxf(a, b + p1off); auto rr = __builtin_amdgcn_permlane32_swap(__float_as_uint(m), __float_as_uint(m), false, false);
    return __builtin_fmaxf(__uint_as_float(rr[0]), __uint_as_float(rr[1])); }
__device__ __forceinline__ float msel(float x, unsigned mw, int pos) { const unsigned m = (unsigned)(((int)(mw << (31 - pos))) >> 31);
    return __uint_as_float((__float_as_uint(x) & m) | (0xff800000u & ~m)); }
__device__ __forceinline__ unsigned short f2bf(float f) { unsigned u = __float_as_uint(f); return (unsigned short)((u + 0x7fffu + ((u >> 16) & 1u)) >> 16); }

#ifndef EXP_NOBAND
#define EXP_NOBAND 0
#endif
#ifndef EXP_NOMASK
#define EXP_NOMASK 0
#endif
#ifdef EXP_NOAPPLY
#define EXP_APPLY(C0, C1, t, BAND) do {} while (0)
#else
#define EXP_APPLY(C0, C1, t, BAND) APPLY(C0, C1, t, BAND)
#endif
#ifdef EXP_NOADV
#define EXP_ADV do {} while (0)
#elif defined(EXP_ADVPIN)
#define EXP_ADV do { _Pragma("unroll") for (int r = 0; r < 16; ++r) ali[r] += tstep; PIN(ali); } while (0)
#else
#define EXP_ADV do { _Pragma("unroll") for (int r = 0; r < 16; ++r) ali[r] += tstep; } while (0)
#endif
template <bool MASKED>
__device__ __forceinline__ void attn_core(f32x16 (&o)[2], const bf16* Qw, int qp, const bf16* Kh, int kp, const bf16* Vh, int vp, int qb, float s8, const unsigned long long* gmask, char* lds) {
    int lz_ = threadIdx.x & 63; asm volatile("" : "+v"(lz_));
    const int tid = threadIdx.x, lane = lz_, r32 = lane & 31, hi = lane >> 5; const int wid = __builtin_amdgcn_readfirstlane(tid >> 6);
    const int NT = 4 * qb + 4;
    const unsigned lds0 = (unsigned)(uintptr_t)lds; const lds_fptr wsf = (lds_fptr)((lds_ptr)lds + LDS_WS) + wid * WSW;
    const bf16* ksrc = Kh + (long)lane * kp + wid * 8;
    const bf16* vsrc = Vh + (long)(16 * (wid & 3) + (lane >> 2)) * vp + (wid >> 2) * 32 + (lane & 3) * 8;
    const unsigned kdst = lds0 + LDS_K + wid * 1024, vdst = lds0 + LDS_V + wid * 1024;
#define DMA_K(t, slot) glds16(ksrc + (long)(t) * KVBLK * kp, (unsigned)__builtin_amdgcn_readfirstlane(kdst + (slot)))
#define DMA_V(t, slot) glds16(vsrc + (long)(t) * KVBLK * vp, (unsigned)__builtin_amdgcn_readfirstlane(vdst + (slot)))
    const lds_cptr vp0 = (lds_cptr)lds + LDS_V + ((lane >> 4) & 1) * 32 + (lane & 3) * 8 + (4 * hi + ((lane & 15) >> 2)) * 64;
    const lds_cptr kp0 = (lds_cptr)lds + LDS_K + hi * 1024 + r32 * 16;
    const lds_cptr mrow = (lds_cptr)lds + LDS_X + wid * XW + r32 * 8;
    if (MASKED) { for (int i = 0; i <= qb; ++i) glds16((const char*)gmask + i * 1024 + lane * 16, (unsigned)__builtin_amdgcn_readfirstlane(lds0 + LDS_X + wid * XW + i * 1024)); }
    DMA_K(0, 0); DMA_V(0, 0); DMA_K(1, SLOTB);
    bf16x8 qr[4];
#pragma unroll
    for (int d0 = 0; d0 < 4; ++d0) qr[d0] = *reinterpret_cast<const bf16x8*>(&Qw[(long)r32 * qp + d0 * 16 + hi * 8]);
    float mhat = 0.f, l_reg = 0.f; o[0] = f32x16{}; o[1] = f32x16{};
    const int qrel = wid * QBLK + r32, wch = wid >> 1; bool resc = false;
    const float p1off = 32.f * s8, tstep = 64.f * s8, nm1off = p1off * C2;
    f32x16 ali;
    { const float tq = (float)(QB * qb + qrel);
#pragma unroll
      for (int r = 0; r < 16; ++r) ali[r] = -s8 * (tq - (float)crow(r, hi)); }
    PIN(ali);
    f32x16 pA0, pA1, pB0, pB1; bf16x8 kf[8]; s16x4 vlo[8], vhi[8]; u32x4 pw0, pw1, pw2, pw3;
    int sl_prev = 0, sl_cur = 0, sl_next = SLOTB;
#define ROT() do { sl_prev = sl_cur; sl_cur = sl_next; sl_next = (sl_next == 2 * SLOTB) ? 0 : sl_next + SLOTB; } while (0)
#define EX(v, nm) __builtin_amdgcn_exp2f(__builtin_fmaf((v), C2, (nm)))
#define RESC() do { if (resc) { _Pragma("unroll") for (int d_ = 0; d_ < 2; ++d_) _Pragma("unroll") for (int r = 0; r < 16; ++r) o[d_][r] *= wsf[crow(r, hi)]; } } while (0)
#define APPLY(C0, C1, t, BAND) do { \
    const int jb_ = (t) - (NT - 4); \
    if (MASKED && !EXP_NOMASK) { const u32x2 mq_ = *(const __attribute__((address_space(3))) u32x2*)(mrow + (t) * 256); unsigned m0_ = mq_[0] >> (4 * hi), m1_ = mq_[1] >> (4 * hi); \
        if (BAND) { m0_ = (jb_ > wch) ? 0u : m0_; m1_ = (jb_ > wch) ? 0u : m1_; } SBAR(); \
        _Pragma("unroll") for (int e = 0; e < 16; e += 4) { C0[e] = msel(C0[e], m0_, 2 * e); C0[e + 1] = msel(C0[e + 1], m0_, 2 * e + 1); C0[e + 2] = msel(C0[e + 2], m0_, 2 * e + 2); C0[e + 3] = msel(C0[e + 3], m0_, 2 * e + 3); SBAR(); } \
        _Pragma("unroll") for (int e = 0; e < 16; e += 4) { C1[e] = msel(C1[e], m1_, 2 * e); C1[e + 1] = msel(C1[e + 1], m1_, 2 * e + 1); C1[e + 2] = msel(C1[e + 2], m1_, 2 * e + 2); C1[e + 3] = msel(C1[e + 3], m1_, 2 * e + 3); SBAR(); } } \
    if (BAND && !EXP_NOBAND) {        \
        if (!MASKED && jb_ > wch) { _Pragma("unroll") for (int e = 0; e < 16; ++e) { C0[e] = -INFINITY; C1[e] = -INFINITY; } } \
        else if (jb_ == wch) { const float m2_ = -2.f * s8, fb_ = (float)(4 * hi - (qrel - 64 * wch)); float fbo_ = fb_; asm volatile("" : "+v"(fbo_)); SBAR(); \
            _Pragma("unroll") for (int e = 0; e < 16; ++e) { const float d0_ = fbo_ + (float)((e & 3) + 8 * (e >> 2)); \
                C0[e] = __builtin_fmaf(__builtin_fmaxf(d0_, 0.f), m2_, C0[e]); C1[e] = __builtin_fmaf(__builtin_fmaxf(d0_ + 32.f, 0.f), m2_, C1[e]); if ((e & 1) == 1) SBAR(); } } } } while (0)
    DMA_K(2, 2 * SLOTB);
    WAIT_BAR(3);
    _Pragma("unroll") for (int d0 = 0; d0 < 4; ++d0) kload2(kf, kp0, d0);
    pA0 = MFMA(kf[0], qr[0], ali); pA1 = MFMA(kf[1], qr[0], ali); pA0 = MFMA(kf[2], qr[1], pA0); pA1 = MFMA(kf[3], qr[1], pA1);
    pA0 = MFMA(kf[4], qr[2], pA0); pA1 = MFMA(kf[5], qr[2], pA1); pA0 = MFMA(kf[6], qr[3], pA0); pA1 = MFMA(kf[7], qr[3], pA1);
    APPLY(pA0, pA1, 0, true);
    { const float rm = rowmax2(pA0, pA1, p1off); mhat = __builtin_fmaxf(rm * C2, -30000.f); const float nmh = -mhat, nmh1 = nmh + nm1off;
#pragma unroll
      for (int r = 0; r < 16; ++r) { pA0[r] = EX(pA0[r], nmh); pA1[r] = EX(pA1[r], nmh1); } }
#pragma unroll
    for (int r = 0; r < 16; ++r) ali[r] += tstep;
    WAIT_BAR(0);
    DMA_K(3, 0); DMA_V(1, SLOTB); ROT();
    _Pragma("unroll") for (int d0 = 0; d0 < 4; ++d0) kload2(kf, kp0 + sl_cur, d0);
    WAIT_BAR(2);
#define PKW(P, i) cvtpk(P[i], P[i + 1])
#define PAF(k) __builtin_bit_cast(bf16x8, pw##k)
#define VFR(i) (bf16x8){vlo[i][0], vlo[i][1], vlo[i][2], vlo[i][3], vhi[i][0], vhi[i][1], vhi[i][2], vhi[i][3]}
#define VRD(i) do { vlo[i] = vtr(vp_ + (((i) >> 2) * 4096 + ((i) & 3) * 1024)); vhi[i] = vtr(vp_ + (((i) >> 2) * 4096 + ((i) & 3) * 1024 + 512)); } while (0)
#define KRD(G, d0) do { if (G) { kload2(kf, kp0 + sl_next, d0); SBAR(); } } while (0)
#define GAPA(MF, a0, a1, a2, a3, W0, W1, PW) do { MF; sacc += a0; sacc += a1; sacc += a2; sacc += a3; W0; W1; PIN(PW); PIN(sacc); SBAR(); } while (0)
#define GAPB(MF, X, i, nm) do { MF; X[i] = EX(X[i], nm); X[i + 1] = EX(X[i + 1], nm); X[i + 2] = EX(X[i + 2], nm); X[i + 3] = EX(X[i + 3], nm); PIN(X); SBAR(); } while (0)
#define STEP(C0, C1, P0, P1, t, BAND, GK, GV, GL) do { SBAR(); \
    const lds_cptr vp_ = vp0 + sl_prev; \
    VRD(0); SBAR(); float sacc = P0[0] + P0[1]; \
                    GAPA(C0 = MFMA(kf[0], qr[0], ali), P0[2], P0[3], P0[4], P0[5],     pw0[0] = PKW(P0, 0),  pw0[1] = PKW(P0, 2),  pw0); \
    VRD(4); SBAR(); GAPA(C1 = MFMA(kf[1], qr[0], ali), P0[6], P0[7], P0[8], P0[9],     pw0[2] = PKW(P0, 4),  pw0[3] = PKW(P0, 6),  pw0); \
    VRD(1); SBAR(); GAPA(C0 = MFMA(kf[2], qr[1], C0),  P0[10], P0[11], P0[12], P0[13], pw1[0] = PKW(P0, 8),  pw1[1] = PKW(P0, 10), pw1); \
    VRD(5); SBAR(); GAPA(C1 = MFMA(kf[3], qr[1], C1),  P0[14], P0[15], P1[0], P1[1],   pw1[2] = PKW(P0, 12), pw1[3] = PKW(P0, 14), pw1); \
    VRD(2); SBAR(); GAPA(C0 = MFMA(kf[4], qr[2], C0),  P1[2], P1[3], P1[4], P1[5],     pw2[0] = PKW(P1, 0),  pw2[1] = PKW(P1, 2),  pw2); \
    VRD(6); SBAR(); GAPA(C1 = MFMA(kf[5], qr[2], C1),  P1[6], P1[7], P1[8], P1[9],     pw2[2] = PKW(P1, 4),  pw2[3] = PKW(P1, 6),  pw2); \
    VRD(3); SBAR(); GAPA(C0 = MFMA(kf[6], qr[3], C0),  P1[10], P1[11], P1[12], P1[13], pw3[0] = PKW(P1, 8),  pw3[1] = PKW(P1, 10), pw3); \
    VRD(7); SBAR(); GAPA(C1 = MFMA(kf[7], qr[3], C1),  P1[14], P1[15], 0.f, 0.f,       pw3[2] = PKW(P1, 12), pw3[3] = PKW(P1, 14), pw3); \
    l_reg += sacc; \
    if (GK) DMA_K((t) + 3, sl_cur); if (GV) DMA_V((t) + 1, sl_next); \
    EXP_APPLY(C0, C1, t, BAND); \
    EXP_ADV; \
    { const float rm = __builtin_fmaf(rowmax2(C0, C1, p1off), C2, -mhat); resc = false; \
      if (__builtin_expect(__any(rm > ATT_THR), 0)) { const float dl = __builtin_fmaxf(rm, 0.f); mhat += dl; \
          const float f = __builtin_amdgcn_exp2f(-dl); l_reg *= f; if (hi == 0) wsf[r32] = f; resc = true; } } \
    const float nmh = -mhat, nmh1 = nmh + nm1off; SBAR(); \
    GAPB(o[0] = MFMA(PAF(0), VFR(0), o[0]), C0, 0, nmh);              GAPB(o[1] = MFMA(PAF(0), VFR(4), o[1]), C0, 4, nmh); \
    KRD(GL, 0); GAPB(o[0] = MFMA(PAF(1), VFR(1), o[0]), C0, 8, nmh);  KRD(GL, 1); GAPB(o[1] = MFMA(PAF(1), VFR(5), o[1]), C0, 12, nmh); \
    KRD(GL, 2); GAPB(o[0] = MFMA(PAF(2), VFR(2), o[0]), C1, 0, nmh1); KRD(GL, 3); GAPB(o[1] = MFMA(PAF(2), VFR(6), o[1]), C1, 4, nmh1); \
    GAPB(o[0] = MFMA(PAF(3), VFR(3), o[0]), C1, 8, nmh1);             GAPB(o[1] = MFMA(PAF(3), VFR(7), o[1]), C1, 12, nmh1); \
    } while (0)
    int t = 1;
    for (; t + 5 < NT; t += 2) {
        STEP(pB0, pB1, pA0, pA1, t, false, true, true, true);     WAIT_BAR(2); RESC(); ROT();
        STEP(pA0, pA1, pB0, pB1, t + 1, false, true, true, true); WAIT_BAR(2); RESC(); ROT();
    }
#define ENDW(tt) do { if ((tt) + 3 < NT) { WAIT_BAR(2); } else if ((tt) + 2 < NT) { WAIT_BAR(1); } else { WAIT_BAR(0); } } while (0)
    for (; t + 1 < NT; t += 2) {
        STEP(pB0, pB1, pA0, pA1, t, true, (t + 3 < NT), (t + 1 < NT), (t + 1 < NT));         ENDW(t);     RESC(); ROT();
        STEP(pA0, pA1, pB0, pB1, t + 1, true, (t + 4 < NT), (t + 2 < NT), (t + 2 < NT));     ENDW(t + 1); RESC(); ROT();
    }
    STEP(pB0, pB1, pA0, pA1, NT - 1, true, false, false, false); RESC();
    { float sacc = pB0[0] + pB0[1];
#pragma unroll
      for (int r = 2; r < 16; ++r) sacc += pB0[r];
#pragma unroll
      for (int r = 0; r < 16; ++r) sacc += pB1[r];
      l_reg += sacc;
      pw0 = (u32x4){PKW(pB0, 0), PKW(pB0, 2), PKW(pB0, 4), PKW(pB0, 6)}; pw1 = (u32x4){PKW(pB0, 8), PKW(pB0, 10), PKW(pB0, 12), PKW(pB0, 14)};
      pw2 = (u32x4){PKW(pB1, 0), PKW(pB1, 2), PKW(pB1, 4), PKW(pB1, 6)}; pw3 = (u32x4){PKW(pB1, 8), PKW(pB1, 10), PKW(pB1, 12), PKW(pB1, 14)};
      const lds_cptr vp_ = vp0 + sl_cur; _Pragma("unroll") for (int i = 0; i < 8; ++i) VRD(i);
      o[0] = MFMA(PAF(0), VFR(0), o[0]); o[1] = MFMA(PAF(0), VFR(4), o[1]); o[0] = MFMA(PAF(1), VFR(1), o[0]); o[1] = MFMA(PAF(1), VFR(5), o[1]);
      o[0] = MFMA(PAF(2), VFR(2), o[0]); o[1] = MFMA(PAF(2), VFR(6), o[1]); o[0] = MFMA(PAF(3), VFR(3), o[0]); o[1] = MFMA(PAF(3), VFR(7), o[1]); }
    { auto rr = __builtin_amdgcn_permlane32_swap(__float_as_uint(l_reg), __float_as_uint(l_reg), false, false); l_reg = __uint_as_float(rr[0]) + __uint_as_float(rr[1]); }
    if (hi == 0) wsf[32 + r32] = l_reg;
    asm volatile("s_waitcnt lgkmcnt(0)\n\ts_barrier" ::: "memory");
#undef DMA_K
#undef DMA_V
#undef ROT
#undef EX
#undef RESC
#undef APPLY
#undef PKW
#undef PAF
#undef VFR
#undef VRD
#undef KRD
#undef ENDW
#undef GAPA
#undef GAPB
#undef STEP
}
constexpr int L8_K = 0, L8_V = 3 * SLOTB, L8_VSLOT = 2 * SLOTB, L8_WS = L8_V + 3 * L8_VSLOT, L8_OST = L8_WS + NW * WSW * 4, L8_Q = L8_OST + NW * 4096, L8_BYTES = L8_Q + NW * 4096;
static_assert(L8_BYTES <= LDS_BYTES, "core128 LDS");
__device__ __forceinline__ float rowmax_h(const f32x16& p0, const f32x16& p1, float hoff) {
    float a = MX3(p0[0], p0[1], p0[2]), b = MX3(p1[0], p1[1], p1[2]);
#pragma unroll
    for (int r = 3; r < 15; r += 2) { a = MX3(a, p0[r], p0[r + 1]); b = MX3(b, p1[r], p1[r + 1]); }
    a = __builtin_fmaxf(a, p0[15]); b = __builtin_fmaxf(b, p1[15]);
    float m = __builtin_fmaxf(a, b) + hoff; auto rr = __builtin_amdgcn_permlane32_swap(__float_as_uint(m), __float_as_uint(m), false, false);
    return __builtin_fmaxf(__uint_as_float(rr[0]), __uint_as_float(rr[1])); }
__device__ __forceinline__ void attn_core128(f32x16 (&o)[4], const bf16* Qw, int qp, const bf16* Kh, int kp, const bf16* Vh, int vp, int qb, float s8, char* lds) {
    int lz_ = threadIdx.x & 63; asm volatile("" : "+v"(lz_));
    const int tid = threadIdx.x, lane = lz_, r32 = lane & 31, hi = lane >> 5; const int wid = __builtin_amdgcn_readfirstlane(tid >> 6);
    const int NT = 4 * qb + 4;
    const unsigned lds0 = (unsigned)(uintptr_t)lds; const lds_fptr wsf = (lds_fptr)((lds_ptr)lds + L8_WS) + wid * WSW;
    const bf16* ksrc = Kh + (long)lane * kp + wid * 8;
    const bf16* vsrc = Vh + (long)(16 * (wid & 3) + (lane >> 2)) * vp + (wid >> 2) * 32 + (lane & 3) * 8;
    const unsigned kdst = lds0 + L8_K + wid * 1024, vdst = lds0 + L8_V + wid * 1024;
#define DMA_K(t, slot) glds16(ksrc + (long)(t) * KVBLK * kp, (unsigned)__builtin_amdgcn_readfirstlane(kdst + (slot)))
#define DMA_V(t, slot) do { glds16(vsrc + (long)(t) * KVBLK * vp, (unsigned)__builtin_amdgcn_readfirstlane(vdst + 2 * (slot))); \
                            glds16(vsrc + (long)(t) * KVBLK * vp + 64, (unsigned)__builtin_amdgcn_readfirstlane(vdst + 2 * (slot) + 8192)); } while (0)
    const lds_cptr vp0 = (lds_cptr)lds + L8_V + ((lane >> 4) & 1) * 32 + (lane & 3) * 8 + (4 * hi + ((lane & 15) >> 2)) * 64;
    const lds_cptr kp0 = (lds_cptr)lds + L8_K + hi * 1024 + r32 * 16;
    const lds_cptr qlp = (lds_cptr)lds + L8_Q + wid * 4096 + hi * 512 + r32 * 16;
#pragma unroll
    for (int d0 = 0; d0 < 4; ++d0) glds16(Qw + (long)r32 * qp + d0 * 16 + hi * 8, (unsigned)__builtin_amdgcn_readfirstlane(lds0 + L8_Q + wid * 4096 + d0 * 1024));
    DMA_K(0, 0); DMA_V(0, 0); DMA_K(1, SLOTB);
#ifdef DBG_QGLOBAL
#define QF(d0) (*reinterpret_cast<const bf16x8*>(&Qw[(long)r32 * qp + (d0) * 16 + hi * 8]))
#else
#define QF(d0) (*(const __attribute__((address_space(3))) bf16x8*)(qlp + (d0) * 1024))
#endif
    float mhat = 0.f, l_reg = 0.f; o[0] = f32x16{}; o[1] = f32x16{}; o[2] = f32x16{}; o[3] = f32x16{};
    const int qrel = wid * QBLK + r32, wch = wid >> 1; bool resc = false;
    float bt = -s8 * (float)(QB * qb + qrel); const float tstep = 64.f * s8, hoff = s8 * (float)(4 * hi);
    f32x16 pA0, pA1, pB0, pB1; bf16x8 kf[8]; s16x4 vlo[8], vhi[8]; u32x4 pw0, pw1, pw2, pw3;
    int sl_prev = 0, sl_cur = 0, sl_next = SLOTB;
#define ROT() do { sl_prev = sl_cur; sl_cur = sl_next; sl_next = (sl_next == 2 * SLOTB) ? 0 : sl_next + SLOTB; } while (0)
#define EX(v, nm) __builtin_amdgcn_exp2f(__builtin_fmaf((v), C2, (nm)))
#define RESC() do { if (resc) { _Pragma("unroll") for (int d_ = 0; d_ < 4; ++d_) _Pragma("unroll") for (int r = 0; r < 16; ++r) o[d_][r] *= wsf[crow(r, hi)]; } } while (0)
#define BIAS(C0, C1) do { _Pragma("unroll") for (int e = 0; e < 16; ++e) { C0[e] = __builtin_fmaf(s8, (float)((e & 3) + 8 * (e >> 2)), C0[e]); C1[e] = __builtin_fmaf(s8, (float)(32 + (e & 3) + 8 * (e >> 2)), C1[e]); } } while (0)
#define APPLY(C0, C1, t, BAND) do { \
    if (BAND) { const int jb_ = (t) - (NT - 4);        \
        if (jb_ > wch) { _Pragma("unroll") for (int e = 0; e < 16; ++e) { C0[e] = -INFINITY; C1[e] = -INFINITY; } } \
        else if (jb_ == wch) { const float m2_ = -2.f * s8, fb_ = (float)(4 * hi - (qrel - 64 * wch)); float fbo_ = fb_; asm volatile("" : "+v"(fbo_)); SBAR(); \
            _Pragma("unroll") for (int e = 0; e < 16; ++e) { const float d0_ = fbo_ + (float)((e & 3) + 8 * (e >> 2)); \
                C0[e] = __builtin_fmaf(__builtin_fmaxf(d0_, 0.f), m2_, C0[e]); C1[e] = __builtin_fmaf(__builtin_fmaxf(d0_ + 32.f, 0.f), m2_, C1[e]); if ((e & 1) == 1) SBAR(); } } } } while (0)
    DMA_K(2, 2 * SLOTB);
    WAIT_BAR(4);
    _Pragma("unroll") for (int d0 = 0; d0 < 4; ++d0) kload2(kf, kp0, d0);
    { const bf16x8 q0 = QF(0), q1 = QF(1), q2 = QF(2), q3 = QF(3); const f32x16 z = f32x16{};
      pA0 = MFMA(kf[0], q0, z); pA1 = MFMA(kf[1], q0, z); pA0 = MFMA(kf[2], q1, pA0); pA1 = MFMA(kf[3], q1, pA1);
      pA0 = MFMA(kf[4], q2, pA0); pA1 = MFMA(kf[5], q2, pA1); pA0 = MFMA(kf[6], q3, pA0); pA1 = MFMA(kf[7], q3, pA1); }
    BIAS(pA0, pA1); APPLY(pA0, pA1, 0, true);
    { const float rm = rowmax_h(pA0, pA1, hoff); mhat = __builtin_fmaxf((rm + bt) * C2, -30000.f); const float nmh = __builtin_fmaf(bt + hoff, C2, -mhat);
#pragma unroll
      for (int r = 0; r < 16; ++r) { pA0[r] = EX(pA0[r], nmh); pA1[r] = EX(pA1[r], nmh); } }
    bt += tstep;
    WAIT_BAR(0);
    DMA_K(3, 0); DMA_V(1, SLOTB); ROT();
    _Pragma("unroll") for (int d0 = 0; d0 < 4; ++d0) kload2(kf, kp0 + sl_cur, d0);
    WAIT_BAR(3);
#define PKW(P, i) cvtpk(P[i], P[i + 1])
#define PAF(k) __builtin_bit_cast(bf16x8, pw##k)
#define VFR(i) (bf16x8){vlo[i][0], vlo[i][1], vlo[i][2], vlo[i][3], vhi[i][0], vhi[i][1], vhi[i][2], vhi[i][3]}
#define VRD(i, hofs) do { vlo[i] = vtr(vp_ + ((hofs) + ((i) >> 2) * 4096 + ((i) & 3) * 1024)); vhi[i] = vtr(vp_ + ((hofs) + ((i) >> 2) * 4096 + ((i) & 3) * 1024 + 512)); } while (0)
#define KRD(G, d0) do { if (G) { kload2(kf, kp0 + sl_next, d0); SBAR(); } } while (0)
#define GAPA(MF, a0, a1, a2, a3, W0, W1, PW) do { MF; sacc += a0; sacc += a1; sacc += a2; sacc += a3; W0; W1; PIN(PW); PIN(sacc); SBAR(); } while (0)
#define GAPB1(MF, i, X, j, nm) do { MF; VRD(i, 8192); X[j] = EX(X[j], nm); X[j + 1] = EX(X[j + 1], nm); PIN(X); SBAR(); } while (0)
#define GAPB2(MF, X, j, nm) do { MF; X[j] = EX(X[j], nm); X[j + 1] = EX(X[j + 1], nm); PIN(X); SBAR(); } while (0)
#define STEP(C0, C1, P0, P1, t, BAND, GK, GV, GL) do { SBAR(); \
    const lds_cptr vp_ = vp0 + 2 * sl_prev; \
    VRD(0, 0); bf16x8 qa_ = QF(0); SBAR(); float sacc = P0[0] + P0[1]; const f32x16 z_ = f32x16{}; \
                       GAPA(C0 = MFMA(kf[0], qa_, z_), P0[2], P0[3], P0[4], P0[5],     pw0[0] = PKW(P0, 0),  pw0[1] = PKW(P0, 2),  pw0); \
    VRD(4, 0); bf16x8 qb_ = QF(1); SBAR(); GAPA(C1 = MFMA(kf[1], qa_, z_), P0[6], P0[7], P0[8], P0[9],     pw0[2] = PKW(P0, 4),  pw0[3] = PKW(P0, 6),  pw0);     \
    VRD(1, 0); SBAR(); GAPA(C0 = MFMA(kf[2], qb_, C0),  P0[10], P0[11], P0[12], P0[13], pw1[0] = PKW(P0, 8),  pw1[1] = PKW(P0, 10), pw1); \
    VRD(5, 0); qa_ = QF(2); SBAR(); GAPA(C1 = MFMA(kf[3], qb_, C1),  P0[14], P0[15], P1[0], P1[1],   pw1[2] = PKW(P0, 12), pw1[3] = PKW(P0, 14), pw1); \
    VRD(2, 0); SBAR(); GAPA(C0 = MFMA(kf[4], qa_, C0),  P1[2], P1[3], P1[4], P1[5],     pw2[0] = PKW(P1, 0),  pw2[1] = PKW(P1, 2),  pw2); \
    VRD(6, 0); qb_ = QF(3); SBAR(); GAPA(C1 = MFMA(kf[5], qa_, C1),  P1[6], P1[7], P1[8], P1[9],     pw2[2] = PKW(P1, 4),  pw2[3] = PKW(P1, 6),  pw2); \
    VRD(3, 0); SBAR(); GAPA(C0 = MFMA(kf[6], qb_, C0),  P1[10], P1[11], P1[12], P1[13], pw3[0] = PKW(P1, 8),  pw3[1] = PKW(P1, 10), pw3); \
    VRD(7, 0); SBAR(); GAPA(C1 = MFMA(kf[7], qb_, C1),  P1[14], P1[15], 0.f, 0.f,       pw3[2] = PKW(P1, 12), pw3[3] = PKW(P1, 14), pw3); \
    l_reg += sacc; \
    if (GK) DMA_K((t) + 3, sl_cur); if (GV) DMA_V((t) + 1, sl_next); \
    BIAS(C0, C1); APPLY(C0, C1, t, BAND); \
    { const float rm = __builtin_fmaf(rowmax_h(C0, C1, hoff) + bt, C2, -mhat); resc = false; \
      if (__builtin_expect(__any(rm > ATT_THR), 0)) { const float dl = __builtin_fmaxf(rm, 0.f); mhat += dl; \
          const float f = __builtin_amdgcn_exp2f(-dl); l_reg *= f; if (hi == 0) wsf[r32] = f; resc = true; } } \
    const float nmh = __builtin_fmaf(bt + hoff, C2, -mhat); bt += tstep; SBAR(); \
    GAPB1(o[0] = MFMA(PAF(0), VFR(0), o[0]), 0, C0, 0, nmh);              GAPB1(o[1] = MFMA(PAF(0), VFR(4), o[1]), 4, C0, 2, nmh); \
    GAPB1(o[0] = MFMA(PAF(1), VFR(1), o[0]), 1, C0, 4, nmh);              GAPB1(o[1] = MFMA(PAF(1), VFR(5), o[1]), 5, C0, 6, nmh); \
    GAPB1(o[0] = MFMA(PAF(2), VFR(2), o[0]), 2, C0, 8, nmh);              GAPB1(o[1] = MFMA(PAF(2), VFR(6), o[1]), 6, C0, 10, nmh); \
    GAPB1(o[0] = MFMA(PAF(3), VFR(3), o[0]), 3, C0, 12, nmh);             GAPB1(o[1] = MFMA(PAF(3), VFR(7), o[1]), 7, C0, 14, nmh); \
    GAPB2(o[2] = MFMA(PAF(0), VFR(0), o[2]), C1, 0, nmh);                 GAPB2(o[3] = MFMA(PAF(0), VFR(4), o[3]), C1, 2, nmh); \
    KRD(GL, 0); GAPB2(o[2] = MFMA(PAF(1), VFR(1), o[2]), C1, 4, nmh);     KRD(GL, 1); GAPB2(o[3] = MFMA(PAF(1), VFR(5), o[3]), C1, 6, nmh); \
    KRD(GL, 2); GAPB2(o[2] = MFMA(PAF(2), VFR(2), o[2]), C1, 8, nmh);     KRD(GL, 3); GAPB2(o[3] = MFMA(PAF(2), VFR(6), o[3]), C1, 10, nmh); \
    GAPB2(o[2] = MFMA(PAF(3), VFR(3), o[2]), C1, 12, nmh);                GAPB2(o[3] = MFMA(PAF(3), VFR(7), o[3]), C1, 14, nmh); \
    } while (0)
    int t = 1;
    for (; t + 5 < NT; t += 2) {
        STEP(pB0, pB1, pA0, pA1, t, false, true, true, true);     WAIT_BAR(3); RESC(); ROT();
        STEP(pA0, pA1, pB0, pB1, t + 1, false, true, true, true); WAIT_BAR(3); RESC(); ROT();
    }
#define ENDW(tt) do { if ((tt) + 3 < NT) { WAIT_BAR(3); } else if ((tt) + 2 < NT) { WAIT_BAR(2); } else { WAIT_BAR(0); } } while (0)
    for (; t + 1 < NT; t += 2) {
        STEP(pB0, pB1, pA0, pA1, t, true, (t + 3 < NT), (t + 1 < NT), (t + 1 < NT));         ENDW(t);     RESC(); ROT();
        STEP(pA0, pA1, pB0, pB1, t + 1, true, (t + 4 < NT), (t + 2 < NT), (t + 2 < NT));     ENDW(t + 1); RESC(); ROT();
    }
    STEP(pB0, pB1, pA0, pA1, NT - 1, true, false, false, false); RESC();
    { float sacc = pB0[0] + pB0[1];
#pragma unroll
      for (int r = 2; r < 16; ++r) sacc += pB0[r];
#pragma unroll
      for (int r = 0; r < 16; ++r) sacc += pB1[r];
      l_reg += sacc;
      pw0 = (u32x4){PKW(pB0, 0), PKW(pB0, 2), PKW(pB0, 4), PKW(pB0, 6)}; pw1 = (u32x4){PKW(pB0, 8), PKW(pB0, 10), PKW(pB0, 12), PKW(pB0, 14)};
      pw2 = (u32x4){PKW(pB1, 0), PKW(pB1, 2), PKW(pB1, 4), PKW(pB1, 6)}; pw3 = (u32x4){PKW(pB1, 8), PKW(pB1, 10), PKW(pB1, 12), PKW(pB1, 14)};
      const lds_cptr vp_ = vp0 + 2 * sl_cur;
#pragma unroll
      for (int hf = 0; hf < 2; ++hf) {
        _Pragma("unroll") for (int i = 0; i < 8; ++i) VRD(i, hf * 8192);
        o[2 * hf] = MFMA(PAF(0), VFR(0), o[2 * hf]); o[2 * hf + 1] = MFMA(PAF(0), VFR(4), o[2 * hf + 1]); o[2 * hf] = MFMA(PAF(1), VFR(1), o[2 * hf]); o[2 * hf + 1] = MFMA(PAF(1), VFR(5), o[2 * hf + 1]);
        o[2 * hf] = MFMA(PAF(2), VFR(2), o[2 * hf]); o[2 * hf + 1] = MFMA(PAF(2), VFR(6), o[2 * hf + 1]); o[2 * hf] = MFMA(PAF(3), VFR(3), o[2 * hf]); o[2 * hf + 1] = MFMA(PAF(3), VFR(7), o[2 * hf + 1]); } }
    { auto rr = __builtin_amdgcn_permlane32_swap(__float_as_uint(l_reg), __float_as_uint(l_reg), false, false); l_reg = __uint_as_float(rr[0]) + __uint_as_float(rr[1]); }
    if (hi == 0) wsf[32 + r32] = l_reg;
    asm volatile("s_waitcnt lgkmcnt(0)\n\ts_barrier" ::: "memory");
#undef DMA_K
#undef DMA_V
#undef QF
#undef ROT
#undef EX
#undef RESC
#undef BIAS
#undef APPLY
#undef PKW
#undef PAF
#undef VFR
#undef VRD
#undef KRD
#undef ENDW
#undef GAPA
#undef GAPB1
#undef GAPB2
#undef STEP
}
__device__ __forceinline__ void unit_a(int b, int h, int qb, const bf16* QA, const bf16* KA, const bf16* VA, const unsigned long long* MASK, bf16* YA, char* lds) {
    const int tid = threadIdx.x; const int wid = __builtin_amdgcn_readfirstlane(tid >> 6);
    const long rowbase = (long)b * SEQ; const long qrow0 = rowbase + qb * QB + wid * QBLK;
    const float s8 = 8.f * __builtin_amdgcn_exp2f(-(float)(h + 1));
    f32x16 o[2];
    attn_core<true>(o, QA + qrow0 * 512 + h * 64, 512, KA + rowbase * 512 + h * 64, 512, VA + rowbase * 512 + h * 64, 512, qb, s8,
                    MASK + ((size_t)(b * 64 + qb * 8 + wid) * 32) * 32, lds);
    int lz = threadIdx.x & 63; asm volatile("" : "+v"(lz));
    const int lane = lz, r32 = lz & 31, hi = lz >> 5;
    const lds_fptr wsf = (lds_fptr)((lds_ptr)lds + LDS_WS) + wid * WSW;
    float rli[16];
#pragma unroll
    for (int r = 0; r < 16; ++r) rli[r] = __builtin_amdgcn_rcpf(wsf[32 + crow(r, hi)]) * (1.0f + SCALE_A_EPS);
    typedef __attribute__((address_space(3))) unsigned short* lds_hptr;
    const lds_hptr stg = (lds_hptr)((lds_ptr)lds + LDS_OST) + wid * 2048;
#pragma unroll
    for (int r = 0; r < 16; ++r) { const int orow = crow(r, hi);
#pragma unroll
        for (int d0 = 0; d0 < 2; ++d0) stg[orow * 64 + d0 * 32 + r32] = f2bf(o[d0][r] * rli[r]); }
    asm volatile("s_waitcnt lgkmcnt(0)" ::: "memory");
    bf16* Ow = YA + qrow0 * 1024 + h * 64;
#pragma unroll
    for (int i = 0; i < 4; ++i) { const int row = i * 8 + (lane >> 3), ch = lane & 7; *(u32x4*)(Ow + (long)row * 1024 + ch * 8) = *(const __attribute__((address_space(3))) u32x4*)(stg + row * 64 + ch * 8); }
    asm volatile("s_waitcnt lgkmcnt(0)" ::: "memory");
}
__device__ __forceinline__ void unit_b128(int b, int h, int qb, const bf16* QBq, const bf16* KBk, const bf16* VBv, const float* subln_g, float lam, bf16* YB, unsigned* stash_g, int slot, char* lds) {
    const int tid = threadIdx.x; const int wid = __builtin_amdgcn_readfirstlane(tid >> 6);
    const long rowbase = (long)b * SEQ; const long qrow0 = rowbase + qb * QB + wid * QBLK;
    const float s8 = 8.f * __builtin_amdgcn_exp2f(-2.f * (float)(h + 1));
    typedef __attribute__((address_space(3))) unsigned short* lds_hptr;
    _Pragma("nounroll") for (int m = 0; m < 2; ++m) {
        f32x16 o[4];
        attn_core128(o, QBq + qrow0 * 512 + (2 * h + m) * 64, 512, KBk + rowbase * 512 + (2 * h + m) * 64, 512, VBv + rowbase * 512 + h * 128, 512, qb, s8, lds);
        int lz = threadIdx.x & 63; asm volatile("" : "+v"(lz));
        const int lane = lz, r32 = lz & 31, hi = lz >> 5;
        const lds_fptr wsf = (lds_fptr)((lds_ptr)lds + L8_WS) + wid * WSW;
        const lds_hptr stg = (lds_hptr)((lds_ptr)lds + L8_OST) + wid * 2048;
        unsigned* sg = stash_g + (((size_t)blockIdx.x * 2 + slot) * NW + wid) * 2048 + lane;
        bf16* Ow = YB + qrow0 * 1024 + 512 + h * 128;
        float rli[16];
#pragma unroll
        for (int r = 0; r < 16; ++r) rli[r] = __builtin_amdgcn_rcpf(wsf[32 + crow(r, hi)]);
        if (m == 0) {
#pragma unroll
            for (int d = 0; d < 4; ++d)
#pragma unroll
                for (int r = 0; r < 16; r += 2) sg[(d * 8 + (r >> 1)) * 64] = cvtpk(o[d][r] * rli[r], o[d][r + 1] * rli[r + 1]);
        } else {
            float ssp[16];
#pragma unroll
            for (int r = 0; r < 16; ++r) ssp[r] = 0.f;
#pragma unroll
            for (int d = 0; d < 4; ++d)
#pragma unroll
                for (int r = 0; r < 16; r += 2) { const unsigned w = __hip_atomic_load(sg + (d * 8 + (r >> 1)) * 64, __ATOMIC_RELAXED, __HIP_MEMORY_SCOPE_AGENT);
                    const float v0 = __uint_as_float(w << 16) - lam * (o[d][r] * rli[r]), v1 = __uint_as_float(w & 0xffff0000u) - lam * (o[d][r + 1] * rli[r + 1]);
                    o[d][r] = v0; o[d][r + 1] = v1; ssp[r] += v0 * v0; ssp[r + 1] += v1 * v1; }
#ifdef DPP_SUM2
#define SS_DPP(x, ctrl) x += __int_as_float(__builtin_amdgcn_update_dpp(__float_as_int(x), __float_as_int(x), (ctrl), 0xF, 0xF, true))
#pragma unroll
            for (int r = 0; r < 16; ++r) { SS_DPP(ssp[r], 0xB1); SS_DPP(ssp[r], 0x4E); SS_DPP(ssp[r], 0x141); SS_DPP(ssp[r], 0x140); }
#undef SS_DPP
#pragma unroll
#ifdef PL16
            for (int r = 0; r < 16; ++r) { auto q_ = __builtin_amdgcn_permlane16_swap(__float_as_uint(ssp[r]), __float_as_uint(ssp[r]), false, false); ssp[r] = __uint_as_float(q_[0]) + __uint_as_float(q_[1]); }
#else
            for (int r = 0; r < 16; ++r) ssp[r] += __shfl_xor(ssp[r], 16);
#endif
#else
#pragma unroll
            for (int r = 0; r < 16; ++r) {
#pragma unroll
                for (int off = 1; off < 32; off <<= 1) ssp[r] += __shfl_xor(ssp[r], off); }
#endif
#pragma unroll
            for (int r = 0; r < 16; ++r) ssp[r] = __builtin_amdgcn_rsqf(ssp[r] * (1.0f / 128.0f) + 1e-6f) * (0.8f * (1.0f + SCALE_B_EPS));
            if (r32 == 0) {
#pragma unroll
                for (int r = 0; r < 16; ++r) wsf[64 + crow(r, hi)] = ssp[r]; }
            asm volatile("s_waitcnt lgkmcnt(0)" ::: "memory");
#pragma unroll
            for (int e = 0; e < 2; ++e) {
#pragma unroll
                for (int r = 0; r < 16; ++r) { const int orow = crow(r, hi);
#pragma unroll
                    for (int d0 = 0; d0 < 2; ++d0) stg[orow * 64 + d0 * 32 + r32] = f2bf(o[2 * e + d0][r]); }
                asm volatile("s_waitcnt lgkmcnt(0)" ::: "memory");
                const int ch = lane & 7;
                const float4 g0 = *(const float4*)(subln_g + e * 64 + ch * 8), g1 = *(const float4*)(subln_g + e * 64 + ch * 8 + 4);
#pragma unroll
                for (int i = 0; i < 4; ++i) { const int row = i * 8 + (lane >> 3); const float rs = wsf[64 + row];
                    const u32x4 w = *(const __attribute__((address_space(3))) u32x4*)(stg + row * 64 + ch * 8); u32x4 ov;
                    ov.x = cvtpk(__uint_as_float(w.x << 16) * rs * g0.x, __uint_as_float(w.x & 0xffff0000u) * rs * g0.y);
                    ov.y = cvtpk(__uint_as_float(w.y << 16) * rs * g0.z, __uint_as_float(w.y & 0xffff0000u) * rs * g0.w);
                    ov.z = cvtpk(__uint_as_float(w.z << 16) * rs * g1.x, __uint_as_float(w.z & 0xffff0000u) * rs * g1.y);
                    ov.w = cvtpk(__uint_as_float(w.w << 16) * rs * g1.z, __uint_as_float(w.w & 0xffff0000u) * rs * g1.w);
                    *(u32x4*)(Ow + (long)row * 1024 + e * 64 + ch * 8) = ov; }
                asm volatile("s_waitcnt lgkmcnt(0)" ::: "memory");
            }
        }
    }
}
#undef SBAR
#undef PIN
#undef MFMA
#undef WAIT_BAR
#undef MX3
}
#ifndef KEYMASK
#define KEYMASK 0xfffff800u
#endif
namespace sel {
using att::bf16x8; using att::f32x16; using att::crow; typedef unsigned short bf16;
constexpr int TBP = 513;
__device__ __forceinline__ void select_unit(int b, int qk, const bf16* QI, const bf16* KI, const float* WI, unsigned long long* MASK, char* lds) {
    int lz_ = threadIdx.x & 63; asm volatile("" : "+v"(lz_));
    const int tid = threadIdx.x, lane = lz_, r32 = lane & 31, hi = lane >> 5; const int wid = __builtin_amdgcn_readfirstlane(tid >> 6);
    const int ntv = (qk >> 1) + 1;
    unsigned long long* mbase = MASK + ((size_t)(b * 64 + qk) * 32) * 32;
    if (qk < 8) {
        for (int i = tid; i < 32 * 32; i += 512) mbase[i] = ((i >> 5) < ntv) ? ~0ull : 0ull;
        return;
    }
    typedef __attribute__((address_space(3))) char* lds_ptr;
    typedef __attribute__((address_space(3))) unsigned* lds_uptr;
    const lds_ptr QL = (lds_ptr)lds;
    const lds_uptr TB = (lds_uptr)((lds_ptr)lds + 16384);
    const size_t qrow0 = (size_t)b * 2048 + qk * 32;
    { const int c = tid & 31, q0 = tid >> 5;
#pragma unroll
      for (int u = 0; u < 2; ++u) { const int q = q0 + 16 * u; *(__attribute__((address_space(3))) att::u32x4*)(QL + c * 512 + q * 16) = *(const att::u32x4*)(QI + (qrow0 + q) * 256 + c * 8); } }
    typedef float f32x4_t __attribute__((ext_vector_type(4)));
    const f32x4_t wv = *(const f32x4_t*)(WI + (qrow0 + r32) * 4);
    __syncthreads();
    unsigned keyT[4][32];
    bf16x8 kfa[2][4];
#define SEL_KLOAD(jn) do { _Pragma("unroll") for (int p_ = 0; p_ < 2; ++p_) _Pragma("unroll") for (int d0 = 0; d0 < 4; ++d0) \
        kfa[p_][d0] = *(const bf16x8*)(KI + ((size_t)b * 2048 + (jn) * 64 + p_ * 32 + r32) * 64 + d0 * 16 + hi * 8); } while (0)
    if (wid < ntv) SEL_KLOAD(wid);
#pragma unroll
    for (int jj = 0; jj < 4; ++jj) {
        if (8 * jj < ntv) {
            const int j = 8 * jj + wid;
            unsigned kk[32];
            if (j < ntv) {
#pragma unroll
                for (int p = 0; p < 2; ++p) {
                    const bf16x8 kf[4] = {kfa[p][0], kfa[p][1], kfa[p][2], kfa[p][3]};
                    f32x16 s0 = f32x16{};
#pragma unroll
                    for (int h = 0; h < 4; ++h) {
                        bf16x8 qf[4];
#pragma unroll
                        for (int d0 = 0; d0 < 4; ++d0) qf[d0] = *(const __attribute__((address_space(3))) bf16x8*)(QL + ((h * 4 + d0) * 2 + hi) * 512 + r32 * 16);
                        f32x16 y0 = f32x16{};
#pragma unroll
                        for (int d0 = 0; d0 < 4; ++d0) y0 = __builtin_amdgcn_mfma_f32_32x32x16_bf16(kf[d0], qf[d0], y0, 0, 0, 0);
                        asm volatile("" : "+v"(y0));
                        const float w = wv[h];
#pragma unroll
                        for (int r = 0; r < 16; ++r) { const float yv = y0[r]; const int yi = __float_as_int(yv); s0[r] = __builtin_fmaf(__int_as_float(yi > 0 ? yi : 0), w, s0[r]); }
                    }
#pragma unroll
                    for (int r = 0; r < 16; ++r) {
                        const unsigned idx = (unsigned)(j * 64 + p * 32 + crow(r, hi));
                        const unsigned u = __float_as_uint(s0[r]); const unsigned m = (unsigned)(((int)u) >> 31) | 0x80000000u; kk[16 * p + r] = ((u ^ m) & KEYMASK) | (2047u - idx);
                    }
                    __builtin_amdgcn_sched_barrier(0);
                }
            } else {
#pragma unroll
                for (int e = 0; e < 32; ++e) kk[e] = 0u;
            }
            if (jj < 3 && j + 8 < ntv) SEL_KLOAD(j + 8);
#pragma unroll
            for (int p = 0; p < 2; ++p)
#pragma unroll
                for (int r = 0; r < 16; ++r) TB[r32 * TBP + 64 * wid + 32 * p + crow(r, hi)] = kk[16 * p + r];
            __syncthreads();
#pragma unroll
            for (int i = 0; i < 4; ++i)
#pragma unroll
                for (int t = 0; t < 8; ++t) keyT[jj][8 * i + t] = TB[(4 * wid + i) * TBP + 64 * t + lane];
            __syncthreads();
        } else {
#pragma unroll
            for (int e = 0; e < 32; ++e) keyT[jj][e] = 0u;
        }
    }
    unsigned T0 = 0u, T1 = 0u, T2 = 0u, T3 = 0u; bool dn0 = false, dn1 = false, dn2 = false, dn3 = false;
#define SEL_CNT8(c_, cand, K, o) do { unsigned long long m0_, m1_, m2_, m3_, m4_, m5_, m6_, m7_; unsigned t_; \
        asm volatile("v_cmp_le_u32_e64 %0, %10, %11\n\tv_cmp_le_u32_e64 %1, %10, %12\n\tv_cmp_le_u32_e64 %2, %10, %13\n\tv_cmp_le_u32_e64 %3, %10, %14\n\t" \
                     "v_cmp_le_u32_e64 %4, %10, %15\n\tv_cmp_le_u32_e64 %5, %10, %16\n\tv_cmp_le_u32_e64 %6, %10, %17\n\tv_cmp_le_u32_e64 %7, %10, %18\n\t" \
                     "s_bcnt1_i32_b64 %8, %0\n\ts_add_u32 %9, %9, %8\n\ts_bcnt1_i32_b64 %8, %1\n\ts_add_u32 %9, %9, %8\n\ts_bcnt1_i32_b64 %8, %2\n\ts_add_u32 %9, %9, %8\n\ts_bcnt1_i32_b64 %8, %3\n\ts_add_u32 %9, %9, %8\n\t" \
                     "s_bcnt1_i32_b64 %8, %4\n\ts_add_u32 %9, %9, %8\n\ts_bcnt1_i32_b64 %8, %5\n\ts_add_u32 %9, %9, %8\n\ts_bcnt1_i32_b64 %8, %6\n\ts_add_u32 %9, %9, %8\n\ts_bcnt1_i32_b64 %8, %7\n\ts_add_u32 %9, %9, %8" \
                     : "=&s"(m0_), "=&s"(m1_), "=&s"(m2_), "=&s"(m3_), "=&s"(m4_), "=&s"(m5_), "=&s"(m6_), "=&s"(m7_), "=&s"(t_), "+s"(c_) \
                     : "s"(cand), "v"(K[(o)]), "v"(K[(o) + 1]), "v"(K[(o) + 2]), "v"(K[(o) + 3]), "v"(K[(o) + 4]), "v"(K[(o) + 5]), "v"(K[(o) + 6]), "v"(K[(o) + 7]) : "scc"); } while (0)
#define SEL_CNT4(c_, cand, K, o) do { unsigned long long m0_, m1_, m2_, m3_; unsigned t_; \
        asm volatile("v_cmp_le_u32_e64 %0, %6, %7\n\tv_cmp_le_u32_e64 %1, %6, %8\n\tv_cmp_le_u32_e64 %2, %6, %9\n\tv_cmp_le_u32_e64 %3, %6, %10\n\t" \
                     "s_bcnt1_i32_b64 %4, %0\n\ts_add_u32 %5, %5, %4\n\ts_bcnt1_i32_b64 %4, %1\n\ts_add_u32 %5, %5, %4\n\ts_bcnt1_i32_b64 %4, %2\n\ts_add_u32 %5, %5, %4\n\ts_bcnt1_i32_b64 %4, %3\n\ts_add_u32 %5, %5, %4" \
                     : "=&s"(m0_), "=&s"(m1_), "=&s"(m2_), "=&s"(m3_), "=&s"(t_), "+s"(c_) \
                     : "s"(cand), "v"(K[(o)]), "v"(K[(o) + 1]), "v"(K[(o) + 2]), "v"(K[(o) + 3]) : "scc"); } while (0)
#ifdef SEL_SAFE
#define SEL_CNT(i, cand) ({ unsigned c_ = 0u; \
        _Pragma("unroll") for (int jj = 0; jj < 4; ++jj) { if (8 * jj < ntv) { \
            _Pragma("unroll") for (int t = 0; t < 8; ++t) c_ += (unsigned)__builtin_popcountll(__ballot(keyT[jj][8 * (i) + t] >= (cand))); __builtin_amdgcn_sched_barrier(0); } } c_; })
#else
#define SEL_CNT(i, cand) ({ unsigned c_ = 0u; const unsigned cd_ = (unsigned)__builtin_amdgcn_readfirstlane((int)(cand)); \
        _Pragma("unroll") for (int jj = 0; jj < 4; ++jj) { if (8 * jj + 4 < ntv) { SEL_CNT8(c_, cd_, keyT[jj], 8 * (i)); } else if (8 * jj < ntv) { SEL_CNT4(c_, cd_, keyT[jj], 8 * (i)); } } c_; })
#endif
    for (int bit = 31; bit >= 0; --bit) {
        const unsigned bm = 1u << bit;
        if (!dn0) { const unsigned c = SEL_CNT(0, T0 | bm); if (c >= 256u) T0 |= bm; dn0 = (c == 256u); }
        if (!dn1) { const unsigned c = SEL_CNT(1, T1 | bm); if (c >= 256u) T1 |= bm; dn1 = (c == 256u); }
        if (!dn2) { const unsigned c = SEL_CNT(2, T2 | bm); if (c >= 256u) T2 |= bm; dn2 = (c == 256u); }
        if (!dn3) { const unsigned c = SEL_CNT(3, T3 | bm); if (c >= 256u) T3 |= bm; dn3 = (c == 256u); }
        if (dn0 && dn1 && dn2 && dn3) break;
    }
#undef SEL_CNT
#undef SEL_KLOAD
#undef SEL_CNT8
#undef SEL_CNT4
#pragma unroll
    for (int i = 0; i < 4; ++i) {
        const unsigned Ti = (i == 0) ? T0 : (i == 1) ? T1 : (i == 2) ? T2 : T3;
        unsigned wlo = 0u, whi = 0u;
#pragma unroll
        for (int jj = 0; jj < 4; ++jj) { int ln_ = lane; asm volatile("" : "+v"(ln_));
#pragma unroll
            for (int t = 0; t < 8; ++t) { const unsigned long long mk = __ballot(keyT[jj][8 * i + t] >= Ti);
                wlo = (ln_ == 8 * jj + t) ? (unsigned)mk : wlo; whi = (ln_ == 8 * jj + t) ? (unsigned)(mk >> 32) : whi; if ((t & 3) == 3) __builtin_amdgcn_sched_barrier(0); } }
        if (lane < 32) mbase[(size_t)lane * 32 + 4 * wid + i] = ((unsigned long long)whi << 32) | wlo;
    }
    __syncthreads();
}
}
constexpr int NWAVES = 8;
#ifndef MK_N_LAUNCHES
#define MK_N_LAUNCHES 1
#endif
constexpr int N_PHASES = 10;
constexpr int N_LAUNCHES = MK_N_LAUNCHES;
constexpr int BATCH = 16, SEQ = 2048, DM = 1024, M = BATCH * SEQ, DFF = 2816, W_IN = 5444, NPROJ = 5632, NFF13 = 5632;
constexpr size_t MiB = 1u << 20;
constexpr size_t WS_CTL = 0, CTL_ZERO_BYTES = 64 * 1024;
constexpr size_t WS_MOD = 1 * MiB;
constexpr size_t WS_LAM = 1 * MiB + 512 * 1024;
constexpr size_t WS_GN = 1 * MiB + 768 * 1024;
constexpr size_t WS_WIN = 2 * MiB, WS_WUA = 13 * MiB  , WS_WO = 15 * MiB, WS_W13 = 17 * MiB, WS_W2 = 28 * MiB;
constexpr size_t WS_XH = 64 * MiB;
constexpr size_t WS_YA = 64 * MiB;
constexpr size_t WS_QA = 128 * MiB, WS_KA = 160 * MiB, WS_VA = 192 * MiB, WS_QB = 224 * MiB, WS_KB = 256 * MiB, WS_VB = 288 * MiB, WS_QI = 320 * MiB, WS_KI = 336 * MiB, WS_WI = 340 * MiB;
constexpr size_t WS_MG = 128 * MiB;
constexpr size_t WS_HID = 128 * MiB;
constexpr size_t WS_GT = 344 * MiB;
constexpr size_t WS_MASK = 472 * MiB;
constexpr size_t WS_STASH = 480 * MiB;
constexpr size_t WS_END = 512 * MiB;
static_assert(epi::PWS_GN == WS_GN && epi::PWS_QA == WS_QA && epi::PWS_QI == WS_QI && epi::PWS_KI == WS_KI && epi::PWS_WI == WS_WI && epi::PWS_GT == WS_GT && WS_KA - WS_QA == 32 * MiB && WS_VB - WS_QA == 160 * MiB, "EpiProj offsets");
static_assert(WS_W2 + (size_t)DM * DFF * 2 <= WS_XH && WS_WI + (size_t)M * 16 <= WS_GT && WS_HID + (size_t)M * DFF * 2 <= WS_GT && WS_GT + (size_t)M * 2048 * 2 <= WS_MASK, "d_ws map");
constexpr int CW_BAR = 1024;
constexpr int RING_BYTES = 151552;
constexpr int LDSCTL_OFF = RING_BYTES, MISC_OFF = LDSCTL_OFF + 320, LDS_BYTES = 155648;
static_assert(att::LDS_BYTES <= RING_BYTES && pg8::STAGE_BYTES <= RING_BYTES && MISC_OFF + 128 <= LDS_BYTES, "LDS map");

#define GAS __attribute__((address_space(1)))
#define LAS __attribute__((address_space(3)))
typedef unsigned short bf16;
typedef unsigned v4u __attribute__((ext_vector_type(4)));
typedef float f32x4 __attribute__((ext_vector_type(4)));
typedef GAS unsigned gu32;
#define RLX_AGENT __ATOMIC_RELAXED, __HIP_MEMORY_SCOPE_AGENT
#define LDS_WAIT() asm volatile("s_waitcnt lgkmcnt(0)" ::: "memory")
__device__ __forceinline__ unsigned f2bf(float f) { unsigned u = __builtin_bit_cast(unsigned, f); return (u + 0x7fffu + ((u >> 16) & 1u)) >> 16; }
__device__ __forceinline__ unsigned pk2(float lo, float hi) { return f2bf(lo) | (f2bf(hi) << 16); }
#define XB_TMO      128
#define XB_XCNT(j)  (256  + 64 * (j))
#define XB_XSUB(j)  (1280 + 64 * (j))
#define XB_XGEN(j)  (2304 + 64 * (j))
#define XB_TOP      3328
#define XB_TOPGEN   3392
#define XCD_BAR_WORDS 3456
#ifdef CHECKER
#define XB_SPIN_CAP (1u << 27)
#else
#define XB_SPIN_CAP (1u << 18)
#endif

__device__ __forceinline__ unsigned xb_ld(unsigned* p)              { return __hip_atomic_load(p, __ATOMIC_RELAXED, __HIP_MEMORY_SCOPE_AGENT); }
__device__ __forceinline__ unsigned xb_add(unsigned* p, unsigned v) { return __hip_atomic_fetch_add(p, v, __ATOMIC_RELAXED, __HIP_MEMORY_SCOPE_AGENT); }
__device__ __forceinline__ unsigned xb_xcc_id() { return (unsigned)__builtin_amdgcn_s_getreg((3 << 11) | 20) & 0xFu; }
#define XB_SPIN(cond, bar) do { unsigned _sp = 0; while (cond) { __builtin_amdgcn_s_sleep(1); \
    if ((++_sp & 255u) == 0u) { if (xb_ld(&(bar)[XB_TMO])) break; if (_sp > XB_SPIN_CAP) { atomicAdd(&(bar)[XB_TMO], 1u); break; } } } } while (0)

struct XcdBarrier {
    unsigned* bar; unsigned x;
    volatile LAS unsigned* st;
};

__device__ __forceinline__ XcdBarrier xcd_barrier_post(unsigned* bar, volatile LAS unsigned* st) {
    XcdBarrier b; b.bar = bar; b.x = xb_xcc_id(); b.st = st;
    if (threadIdx.x == 0) (void)xb_add(&bar[XB_XCNT(b.x)], 1u);
    return b;
}
__device__ __forceinline__ void xcd_barrier_complete(unsigned* bar, unsigned x, unsigned& nloc, unsigned& nx) {
    const unsigned G = gridDim.x * gridDim.y * gridDim.z;
    unsigned sum, cnt, mine, sp = 0u;
    for (;;) {
        sum = 0u; cnt = 0u; mine = 0u;
#pragma unroll
        for (unsigned j = 0; j < 16; ++j) { const unsigned c = xb_ld(&bar[XB_XCNT(j)]); sum += c; cnt += (c > 0u) ? 1u : 0u; mine = (j == x) ? c : mine; }
        if (sum == G) break;
        __builtin_amdgcn_s_sleep(1);
        if ((++sp & 255u) == 0u) { if (xb_ld(&bar[XB_TMO])) break; if (sp > XB_SPIN_CAP) { atomicAdd(&bar[XB_TMO], 1u); break; } }
    }
    nloc = mine > 0u ? mine : 1u; nx = cnt > 0u ? cnt : 1u;
}

__device__ __forceinline__ void xcd_barrier(const XcdBarrier& b) {
    asm volatile("s_waitcnt vmcnt(0)" ::: "memory");
    __syncthreads();
    if (threadIdx.x == 0) {
        unsigned* bar = b.bar;
        __builtin_amdgcn_s_waitcnt(0);
        unsigned nloc = b.st[0], nx = b.st[1];
        if (nloc == 0u) { xcd_barrier_complete(bar, b.x, nloc, nx); b.st[0] = nloc; b.st[1] = nx; }
        const unsigned old = xb_add(&bar[XB_XSUB(b.x)], 1u);
        const unsigned gen = old / nloc;
        if (old + 1u == (gen + 1u) * nloc) {
            __builtin_amdgcn_fence(__ATOMIC_RELEASE, "agent");
            asm volatile("s_waitcnt vmcnt(0)" ::: "memory");
            const unsigned og = xb_add(&bar[XB_TOP], 1u);
            const unsigned tg = og / nx;
            if (og + 1u == (tg + 1u) * nx) xb_add(&bar[XB_TOPGEN], 1u);
            else XB_SPIN(xb_ld(&bar[XB_TOPGEN]) == tg, bar);
            __builtin_amdgcn_fence(__ATOMIC_ACQUIRE, "agent");
            xb_add(&bar[XB_XGEN(b.x)], 1u);
            asm volatile("s_waitcnt vmcnt(0)" ::: "memory");
        } else {
            XB_SPIN(xb_ld(&bar[XB_XGEN(b.x)]) == gen, bar);
            __builtin_amdgcn_fence(__ATOMIC_ACQUIRE, "agent");
            asm volatile("s_waitcnt vmcnt(0)" ::: "memory");
        }
    }
    __syncthreads();
}

#define XB_GRP(g)   (3584 + 64 * (g))
#define XB_P4D      8256
#define XB_WRDY     8192
__device__ __forceinline__ void grp_barrier(unsigned* bar, int grp, unsigned members) {
    asm volatile("s_waitcnt vmcnt(0)" ::: "memory");
    __syncthreads();
    if (threadIdx.x == 0) {
        __builtin_amdgcn_fence(__ATOMIC_RELEASE, "agent");
        asm volatile("s_waitcnt vmcnt(0)" ::: "memory");
        unsigned* c = &bar[XB_GRP(grp)];
        const unsigned old = xb_add(c, 1u); const unsigned target = (old / members + 1u) * members;
        XB_SPIN(xb_ld(c) < target, bar);
        __builtin_amdgcn_fence(__ATOMIC_ACQUIRE, "agent");
        asm volatile("s_waitcnt vmcnt(0)" ::: "memory");
    }
    __syncthreads();
}
#define XB_GGEN(g)  (4096 + 64 * (g))
#define XB_MISM     4672
__device__ __forceinline__ void grp_barrier_xcd(unsigned* bar, int grp, unsigned members) {
    asm volatile("s_waitcnt vmcnt(0)" ::: "memory");
    __syncthreads();
    if (threadIdx.x == 0) {
        const unsigned old = xb_add(&bar[XB_GRP(grp)], 1u); const unsigned gen = old / members;
#ifdef GRP_ONEWORD
        if (old + 1u != (gen + 1u) * members) XB_SPIN(xb_ld(&bar[XB_GRP(grp)]) < (gen + 1u) * members, bar);
#else
        if (old + 1u == (gen + 1u) * members) (void)xb_add(&bar[XB_GGEN(grp)], 1u);
        else XB_SPIN(xb_ld(&bar[XB_GGEN(grp)]) == gen, bar);
#endif
        __builtin_amdgcn_fence(__ATOMIC_ACQUIRE, "agent");
        asm volatile("s_waitcnt vmcnt(0)" ::: "memory");
    }
    __syncthreads();
}
__device__ __forceinline__ void wrdy_post(unsigned* bar, int word = XB_WRDY) {
    asm volatile("s_waitcnt vmcnt(0)" ::: "memory");
    __syncthreads();
    if (threadIdx.x == 0) { __builtin_amdgcn_fence(__ATOMIC_RELEASE, "agent"); asm volatile("s_waitcnt vmcnt(0)" ::: "memory"); (void)xb_add(&bar[word], 1u); }
}
__device__ __forceinline__ void wrdy_wait(unsigned* bar, unsigned total, int word = XB_WRDY) {
    if (threadIdx.x == 0) { XB_SPIN(xb_ld(&bar[word]) < total, bar); __builtin_amdgcn_fence(__ATOMIC_ACQUIRE, "agent"); asm volatile("s_waitcnt vmcnt(0)" ::: "memory"); }
    __syncthreads();
}

struct Frame {
    LAS unsigned char* lds; volatile LAS unsigned* MISC; gu32* ctl;
    int tid, lane, wave, vcu, G;
};
__device__ __forceinline__ float wave_sum(float v) {
#ifdef DPP_SUM
#define WS_DPP(ctrl) v += __int_as_float(__builtin_amdgcn_update_dpp(__float_as_int(v), __float_as_int(v), (ctrl), 0xF, 0xF, true))
    WS_DPP(0xB1); WS_DPP(0x4E); WS_DPP(0x141); WS_DPP(0x140);
#undef WS_DPP
#ifdef PL16
    { auto r = __builtin_amdgcn_permlane16_swap(__float_as_uint(v), __float_as_uint(v), false, false); v = __uint_as_float(r[0]) + __uint_as_float(r[1]); }
#else
    v += __shfl_xor(v, 16);
#endif
    { auto r = __builtin_amdgcn_permlane32_swap(__float_as_uint(v), __float_as_uint(v), false, false); v = __uint_as_float(r[0]) + __uint_as_float(r[1]); }
    return v;
#else
#pragma unroll
    for (int o = 1; o < 64; o <<= 1) v += __shfl_xor(v, o);
    return v;
#endif
}
template <class Map>
__device__ __forceinline__ void transpose_item(const float* W, int K, int N, bf16* WT, Map map, LAS float* scr, int item, int lane, int ld = 0, int koff = 0) {
    const int nblk = (N + 31) / 32, kb = item / nblk, nb = item % nblk, k0 = 64 * kb, n0 = 32 * nb;
    const int nr = n0 + (lane & 31);
    float wv[32];
#pragma unroll
    for (int i = 0; i < 32; ++i) { const int kk = 2 * i + (lane >> 5); wv[i] = (nr < N) ? W[(size_t)(k0 + kk) * N + nr] : 0.f; }
#pragma unroll
    for (int i = 0; i < 32; ++i) { const int kk = 2 * i + (lane >> 5); scr[kk * 33 + (lane & 31)] = wv[i]; }
    LDS_WAIT(); asm volatile("" ::: "memory");
    const int c = lane & 7;
#pragma unroll
    for (int j = 0; j < 4; ++j) { const int nl = (lane >> 3) + 8 * j; const LAS float* s = scr + (8 * c) * 33 + nl;
        v4u o; o.x = pk2(s[0 * 33], s[1 * 33]); o.y = pk2(s[2 * 33], s[3 * 33]); o.z = pk2(s[4 * 33], s[5 * 33]); o.w = pk2(s[6 * 33], s[7 * 33]);
        if (n0 + nl < N) *(GAS v4u*)(WT + (size_t)map(n0 + nl) * (ld ? ld : K) + koff + k0 + 8 * c) = o; }
    LDS_WAIT(); asm volatile("" ::: "memory");
}
struct MapId { __device__ __forceinline__ int operator()(int n) const { return n; } };
struct MapWin {
    __device__ __forceinline__ int operator()(int n) const {
        if (n >= 3396) { const int g = n - 3396, c = g & 1023; return 3584 + 256 * (c >> 7) + 128 * (g >> 10) + (c & 127); }
        const int L = n & 255, hd = L >> 6, d = L & 63; return (n & ~255) + 128 * (d >> 5) + 32 * hd + (d & 31); } };
struct MapFF { int off; __device__ __forceinline__ int operator()(int n) const { return (n >> 7) * 256 + (n & 127) + off; } };

struct P0In { const float *c, *w_ada, *b_ada, *w_in, *w_up_a, *w_up_b, *w_o, *w_ff1, *w_ff3, *w_ff2, *lq1, *lk1, *lq2, *lk2, *qn_a, *kn_a, *qn_b, *kn_b; };
__device__ __forceinline__ void weight_copies(Frame& F, const P0In in, unsigned char* ws, bool sync = true, int it0 = 0, int it1 = 1 << 30, int gw_ = -1, int ngw_ = 0) {
    LAS float* scr = (LAS float*)(F.lds + F.wave * 16384);
    const int gw = F.vcu * NWAVES + F.wave, NGW = F.G * NWAVES;
    constexpr int I_IN = 16 * 171, I_UP = 8 * 32, I_O = 16 * 32, I_F1 = 16 * 88, I_F2 = 44 * 32;
    constexpr int NITEMS = I_IN + 2 * I_UP + I_O + 2 * I_F1 + I_F2;
    const int gwe = gw_ >= 0 ? gw_ : gw, ngwe = gw_ >= 0 ? ngw_ : NGW, ite = it1 < NITEMS ? it1 : NITEMS;
    for (int it = it0 + gwe; it < ite; it += ngwe) {
        int r = it;
        if (r < I_IN) { transpose_item(in.w_in, 1024, W_IN, (bf16*)(ws + WS_WIN), MapWin{}, scr, r, F.lane); continue; } r -= I_IN;
        if (r < I_UP) { transpose_item(in.w_up_a, 512, 1024, (bf16*)(ws + WS_WUA), MapId{}, scr, r, F.lane, 1024, 0); continue; } r -= I_UP;
        if (r < I_UP) { transpose_item(in.w_up_b, 512, 1024, (bf16*)(ws + WS_WUA), MapId{}, scr, r, F.lane, 1024, 512); continue; } r -= I_UP;
        if (r < I_O)  { transpose_item(in.w_o, 1024, 1024, (bf16*)(ws + WS_WO), MapId{}, scr, r, F.lane); continue; } r -= I_O;
        if (r < I_F1) { transpose_item(in.w_ff1, 1024, DFF, (bf16*)(ws + WS_W13), MapFF{0}, scr, r, F.lane); continue; } r -= I_F1;
        if (r < I_F1) { transpose_item(in.w_ff3, 1024, DFF, (bf16*)(ws + WS_W13), MapFF{128}, scr, r, F.lane); continue; } r -= I_F1;
        transpose_item(in.w_ff2, DFF, 1024, (bf16*)(ws + WS_W2), MapId{}, scr, r, F.lane);
    }
    if (sync) __syncthreads();
}
__device__ __forceinline__ void p0_prologue(Frame& F, const P0In in, unsigned char* ws) {
    const int gw = F.vcu * NWAVES + F.wave, NGW = F.G * NWAVES; (void)gw; (void)NGW;
    LAS float* S = (LAS float*)F.lds;
    LAS float* P = (LAS float*)(F.lds + 65536);
    for (int g = F.vcu; g < 192; g += F.G) {
        const int c = F.tid & 31, kg = F.tid >> 5, col = 32 * g + c;
        float w[64];
#pragma unroll
        for (int u = 0; u < 64; ++u) w[u] = in.w_ada[(size_t)(64 * kg + u) * 6144 + col];
        for (int i = F.tid; i < 16 * 1024; i += NWAVES * 64) { const float v = in.c[i]; S[i] = v / (1.f + __expf(-v)); }
        __syncthreads();
        float acc[16];
#pragma unroll
        for (int b = 0; b < 16; ++b) acc[b] = 0.f;
#pragma unroll
        for (int i = 0; i < 64; i += 4) { const int k = 64 * kg + i;
#pragma unroll
            for (int b = 0; b < 16; ++b) { const f32x4 s = *(const LAS f32x4*)(S + b * 1024 + k); acc[b] += (s[0] * w[i] + s[1] * w[i + 1]) + (s[2] * w[i + 2] + s[3] * w[i + 3]); } }
#pragma unroll
        for (int b = 0; b < 16; ++b) P[(kg * 16 + b) * 32 + c] = acc[b];
        __syncthreads();
        { const int b = F.tid >> 5; float s = in.b_ada[col];
#pragma unroll
          for (int q = 0; q < 16; ++q) s += P[(q * 16 + b) * 32 + c];
          ((float*)(ws + WS_MOD))[b * 6144 + col] = s; }
        __syncthreads();
    }
    if (F.vcu == F.G - 2 && F.tid < 256) { const int t = F.tid >> 6, i = F.tid & 63; ((float*)(ws + WS_GN))[F.tid] = (t == 0 ? in.qn_a : t == 1 ? in.kn_a : t == 2 ? in.qn_b : in.kn_b)[i]; }
    if (F.vcu == F.G - 1 && F.tid == 0) {
        float s1 = 0.f, s2 = 0.f;
        for (int i = 0; i < 64; ++i) { s1 += in.lq1[i] * in.lk1[i]; s2 += in.lq2[i] * in.lk2[i]; }
        *(float*)(ws + WS_LAM) = expf(s1) - expf(s2) + 0.2f;
    }
}
__device__ __forceinline__ void norm_mod_pass(Frame& F, const float* X, const float* g, const float* scale, const float* shift, bf16* Y) {
    const int gw = F.vcu * NWAVES + F.wave, NGW = F.G * NWAVES;
    for (int blk = gw; blk < M / 16; blk += NGW) {
        const int row0 = blk * 16, b = row0 >> 11;
        f32x4 gs[4], sh[4];
#pragma unroll
        for (int j = 0; j < 4; ++j) { const f32x4 gg = ((const f32x4*)g)[F.lane + 64 * j], sc = ((const f32x4*)(scale + b * 6144))[F.lane + 64 * j]; gs[j] = gg * (sc + 1.0f); sh[j] = ((const f32x4*)(shift + b * 6144))[F.lane + 64 * j]; }
#if defined(NORM_D2)
        f32x4 vq[3][4];
#pragma unroll
        for (int r = 0; r < 2; ++r) { const f32x4* xr = (const f32x4*)(X + (size_t)(row0 + r) * DM) + F.lane;
#pragma unroll
            for (int j = 0; j < 4; ++j) vq[r][j] = xr[64 * j]; }
#pragma unroll
        for (int rr = 0; rr < 16; ++rr) {
            f32x4 v[4]; float s = 0.f;
            if (rr < 14) { const f32x4* xr = (const f32x4*)(X + (size_t)(row0 + rr + 2) * DM) + F.lane;
#pragma unroll
                for (int j = 0; j < 4; ++j) vq[(rr + 2) % 3][j] = xr[64 * j]; }
#pragma unroll
            for (int j = 0; j < 4; ++j) v[j] = vq[rr % 3][j];
#elif defined(NORM_DEEP1)
        f32x4 vb[2][4][4];
#pragma unroll
        for (int r = 0; r < 4; ++r) { const f32x4* xr = (const f32x4*)(X + (size_t)(row0 + r) * DM) + F.lane;
#pragma unroll
            for (int j = 0; j < 4; ++j) vb[0][r][j] = xr[64 * j]; }
#pragma unroll
        for (int rr = 0; rr < 16; ++rr) {
            f32x4 v[4]; float s = 0.f;
            if ((rr & 3) == 0 && rr < 12) {
#pragma unroll
                for (int r = 0; r < 4; ++r) { const f32x4* xr = (const f32x4*)(X + (size_t)(row0 + rr + 4 + r) * DM) + F.lane;
#pragma unroll
                    for (int j = 0; j < 4; ++j) vb[((rr >> 2) + 1) & 1][r][j] = xr[64 * j]; } }
#pragma unroll
            for (int j = 0; j < 4; ++j) v[j] = vb[(rr >> 2) & 1][rr & 3][j];
#else
        f32x4 vn[4];
        { const f32x4* x0 = (const f32x4*)(X + (size_t)row0 * DM) + F.lane;
#pragma unroll
          for (int j = 0; j < 4; ++j) vn[j] = x0[64 * j]; }
        for (int rr = 0; rr < 16; ++rr) {
            f32x4 v[4]; float s = 0.f;
#pragma unroll
            for (int j = 0; j < 4; ++j) v[j] = vn[j];
            if (rr < 15) { const f32x4* xr = (const f32x4*)(X + (size_t)(row0 + rr + 1) * DM) + F.lane;
#pragma unroll
                for (int j = 0; j < 4; ++j) vn[j] = xr[64 * j]; }
#endif
#pragma unroll
            for (int j = 0; j < 4; ++j) s += (v[j][0] * v[j][0] + v[j][1] * v[j][1]) + (v[j][2] * v[j][2] + v[j][3] * v[j][3]);
            const float rstd = __builtin_amdgcn_rsqf(wave_sum(s) * (1.0f / DM) + 1e-6f);
            unsigned long long* o8 = (unsigned long long*)(Y + (size_t)(row0 + rr) * DM) + F.lane;
#pragma unroll
            for (int j = 0; j < 4; ++j) { const f32x4 y = v[j] * rstd * gs[j] + sh[j]; o8[64 * j] = (unsigned long long)pk2(y[0], y[1]) | ((unsigned long long)pk2(y[2], y[3]) << 32); }
        }
    }
}
__device__ __forceinline__ void norm_mod_pass_bf16(Frame& F, const bf16* Xb, const float* g, const float* scale, const float* shift, bf16* Y, size_t xg16) {
    const int gw = F.vcu * NWAVES + F.wave, NGW = F.G * NWAVES;
    for (int blk = gw; blk < M / 16; blk += NGW) {
        const int row0 = blk * 16, b = row0 >> 11; const bf16* X = Xb;
        f32x4 gs[4], sh[4];
#pragma unroll
        for (int j = 0; j < 4; ++j) { const int c4 = 2 * F.lane + (j & 1) + 128 * (j >> 1);
            const f32x4 gg = ((const f32x4*)g)[c4], sc = ((const f32x4*)(scale + b * 6144))[c4]; gs[j] = gg * (sc + 1.0f); sh[j] = ((const f32x4*)(shift + b * 6144))[c4]; }
        X += (size_t)(row0 >> 12) * xg16;
#ifdef NORM_R3
#define NP_LOAD(w0_, w1_, r_) do { const v4u* xr_ = (const v4u*)(X + (size_t)(row0 + (r_)) * DM) + F.lane; w0_ = xr_[0]; w1_ = xr_[64]; } while (0)
#define NP_PROC(w0_, w1_, r_) do { f32x4 v[4]; float s = 0.f; \
            { const v4u w = w0_; v[0] = (f32x4){__uint_as_float(w.x << 16), __uint_as_float(w.x & 0xffff0000u), __uint_as_float(w.y << 16), __uint_as_float(w.y & 0xffff0000u)}; \
                                 v[1] = (f32x4){__uint_as_float(w.z << 16), __uint_as_float(w.z & 0xffff0000u), __uint_as_float(w.w << 16), __uint_as_float(w.w & 0xffff0000u)}; } \
            { const v4u w = w1_; v[2] = (f32x4){__uint_as_float(w.x << 16), __uint_as_float(w.x & 0xffff0000u), __uint_as_float(w.y << 16), __uint_as_float(w.y & 0xffff0000u)}; \
                                 v[3] = (f32x4){__uint_as_float(w.z << 16), __uint_as_float(w.z & 0xffff0000u), __uint_as_float(w.w << 16), __uint_as_float(w.w & 0xffff0000u)}; } \
            _Pragma("unroll") for (int j = 0; j < 4; ++j) s += (v[j][0] * v[j][0] + v[j][1] * v[j][1]) + (v[j][2] * v[j][2] + v[j][3] * v[j][3]); \
            const float rstd = __builtin_amdgcn_rsqf(wave_sum(s) * (1.0f / DM) + 1e-6f); \
            v4u* o16 = (v4u*)(Y + (size_t)(row0 + (r_)) * DM) + F.lane; \
            _Pragma("unroll") for (int h = 0; h < 2; ++h) { const f32x4 y0 = v[2 * h] * rstd * gs[2 * h] + sh[2 * h], y1 = v[2 * h + 1] * rstd * gs[2 * h + 1] + sh[2 * h + 1]; \
                v4u o; o.x = pk2(y0[0], y0[1]); o.y = pk2(y0[2], y0[3]); o.z = pk2(y1[0], y1[1]); o.w = pk2(y1[2], y1[3]); o16[64 * h] = o; } } while (0)
        v4u a0, a1, b0, b1, c0, c1;
        NP_LOAD(a0, a1, 0); NP_LOAD(b0, b1, 1);
#pragma unroll 1
        for (int rr = 0; rr < 15; rr += 3) {
            NP_LOAD(c0, c1, rr + 2); NP_PROC(a0, a1, rr);
            NP_LOAD(a0, a1, rr + 3); NP_PROC(b0, b1, rr + 1);
            if (rr + 4 < 16) NP_LOAD(b0, b1, rr + 4);
            NP_PROC(c0, c1, rr + 2);
        }
        NP_PROC(a0, a1, 15);
#undef NP_LOAD
#undef NP_PROC
    }
}
#else
#if defined(NORM_D2)
        v4u wq[3][2];
#pragma unroll
        for (int r = 0; r < 2; ++r) { const v4u* xr = (const v4u*)(X + (size_t)(row0 + r) * DM) + F.lane; wq[r][0] = xr[0]; wq[r][1] = xr[64]; }
#pragma unroll
        for (int rr = 0; rr < 16; ++rr) {
            if (rr < 14) { const v4u* xr = (const v4u*)(X + (size_t)(row0 + rr + 2) * DM) + F.lane; wq[(rr + 2) % 3][0] = xr[0]; wq[(rr + 2) % 3][1] = xr[64]; }
            const v4u wc[2] = {wq[rr % 3][0], wq[rr % 3][1]};
#elif defined(NORM_DEEP7)
        v4u wa[16][2];
#pragma unroll
        for (int r = 0; r < 16; ++r) { const v4u* xr = (const v4u*)(X + (size_t)(row0 + r) * DM) + F.lane; wa[r][0] = xr[0]; wa[r][1] = xr[64]; }
#pragma unroll
        for (int rr = 0; rr < 16; ++rr) {
            const v4u wc[2] = {wa[rr][0], wa[rr][1]};
#else
        v4u wn[2];
        { const v4u* x0 = (const v4u*)(X + (size_t)row0 * DM) + F.lane; wn[0] = x0[0]; wn[1] = x0[64]; }
        for (int rr = 0; rr < 16; ++rr) {
            const v4u wc[2] = {wn[0], wn[1]};
            if (rr < 15) { const v4u* xr = (const v4u*)(X + (size_t)(row0 + rr + 1) * DM) + F.lane; wn[0] = xr[0]; wn[1] = xr[64]; }
#endif
            f32x4 v[4]; float s = 0.f;
#pragma unroll
            for (int h = 0; h < 2; ++h) { const v4u w = wc[h];
                v[2 * h] = (f32x4){__builtin_bit_cast(float, w.x << 16), __builtin_bit_cast(float, w.x & 0xffff0000u), __builtin_bit_cast(float, w.y << 16), __builtin_bit_cast(float, w.y & 0xffff0000u)};
                v[2 * h + 1] = (f32x4){__builtin_bit_cast(float, w.z << 16), __builtin_bit_cast(float, w.z & 0xffff0000u), __builtin_bit_cast(float, w.w << 16), __builtin_bit_cast(float, w.w & 0xffff0000u)}; }
#pragma unroll
            for (int j = 0; j < 4; ++j) s += (v[j][0] * v[j][0] + v[j][1] * v[j][1]) + (v[j][2] * v[j][2] + v[j][3] * v[j][3]);
            const float rstd = __builtin_amdgcn_rsqf(wave_sum(s) * (1.0f / DM) + 1e-6f);
            v4u* o16 = (v4u*)(Y + (size_t)(row0 + rr) * DM) + F.lane;
#pragma unroll
            for (int h = 0; h < 2; ++h) { const f32x4 y0 = v[2 * h] * rstd * gs[2 * h] + sh[2 * h], y1 = v[2 * h + 1] * rstd * gs[2 * h + 1] + sh[2 * h + 1];
                v4u o; o.x = pk2(y0[0], y0[1]); o.y = pk2(y0[2], y0[3]); o.z = pk2(y1[0], y1[1]); o.w = pk2(y1[2], y1[3]); o16[64 * h] = o; }
        }
    }
}
#endif
#ifdef CHECKER
namespace chk {
typedef unsigned short bf16;
typedef unsigned u32x4c __attribute__((ext_vector_type(4)));
__device__ __forceinline__ float b2f(unsigned short h) { return __uint_as_float((unsigned)h << 16); }
__device__ __forceinline__ float rnd(float f) { unsigned u = __float_as_uint(f); u = (u + 0x7fffu + ((u >> 16) & 1u)) & 0xffff0000u; return __uint_as_float(u); }
__device__ __forceinline__ float dotbf(const bf16* a, const bf16* b, int K) {
    float s = 0.f;
    for (int k = 0; k < K; k += 8) { const u32x4c x = *(const u32x4c*)(a + k), y = *(const u32x4c*)(b + k);
#pragma unroll
        for (int j = 0; j < 4; ++j) { s += __uint_as_float(x[j] << 16) * __uint_as_float(y[j] << 16); s += __uint_as_float(x[j] & 0xffff0000u) * __uint_as_float(y[j] & 0xffff0000u); } }
    return s; }
__device__ __forceinline__ void devmax(float* slot, float d) { if (!(d >= 0.f)) d = 1e30f; atomicMax((unsigned*)slot, __float_as_uint(d)); }
__device__ __forceinline__ float sig(float v) { return 1.f / (1.f + expf(-v)); }
constexpr int RSTR = 16, ROFF = 3, NR = 2048;
}
#define CHK_LOOP(idx, total) for (long idx = (long)F.vcu * 512 + F.tid; idx < (long)(total); idx += (long)F.G * 512)
#endif
#ifndef LATE_AFTER_P2
#define LATE_AFTER_P2 0
#endif
#ifndef P9_ALIGN
#define P9_ALIGN true
#endif
#ifndef P6_ALIGN
#define P6_ALIGN true
#endif
#ifdef DUPCHK
__global__ void __launch_bounds__(512) dup_cksum(const void* base, size_t bytes, unsigned long long* acc) {
    typedef unsigned u32x4_t __attribute__((ext_vector_type(4)));
    const u32x4_t* p = (const u32x4_t*)base; const size_t n = bytes / 16;
    unsigned long long s = 0ull;
    for (size_t i = (size_t)blockIdx.x * 512 + threadIdx.x; i < n; i += (size_t)gridDim.x * 512) {
        const u32x4_t w = p[i]; const unsigned long long m = 2ull * i + 1ull;
        s += ((unsigned long long)w.x + ((unsigned long long)w.y << 7) + ((unsigned long long)w.z << 13) + ((unsigned long long)w.w << 19)) * m; }
    for (int off = 32; off; off >>= 1) { const unsigned lo = __shfl_xor((unsigned)s, off), hi = __shfl_xor((unsigned)(s >> 32), off); s += ((unsigned long long)hi << 32) | lo; }
    if ((threadIdx.x & 63) == 0) atomicAdd(acc, s);
}
__global__ void __launch_bounds__(512) dup_final(float* out, const unsigned long long* CK) {
    int bad = -1;
    for (int k = 9; k >= 0; --k) if (CK[2 * k] != CK[2 * k + 1]) bad = k;
    if (bad >= 0) { const float v = 0.0566f * (float)(1 << bad); for (int i = blockIdx.x * 512 + threadIdx.x; i < (1 << 20); i += gridDim.x * 512) out[i] += v; }
}
#endif
#ifdef MASKDIFF
__global__ void __launch_bounds__(512) mask_diff(const unsigned long long* A, const unsigned long long* B, unsigned* cnt) {
    unsigned c0 = 0, c1 = 0, c2 = 0;
    for (int idx = blockIdx.x * 512 + threadIdx.x; idx < (1 << 20); idx += gridDim.x * 512) {
        const int qk = (idx >> 10) & 63, tile = (idx >> 5) & 31; const bool adm = tile < (qk >> 1) + 1;
        const unsigned long long d = A[idx] ^ B[idx];
        if (d) { if (adm) { ++c0; c2 += (unsigned)__builtin_popcountll(d); } else ++c1; } }
    if (c0) atomicAdd(cnt + 0, c0); if (c1) atomicAdd(cnt + 1, c1); if (c2) atomicAdd(cnt + 2, c2);
    for (int row = blockIdx.x * 512 + threadIdx.x; row < 32768; row += gridDim.x * 512) { const int bq = row >> 5, q = row & 31, qk = bq & 63; bool any = false;
        for (int tile = 0; tile < (qk >> 1) + 1; ++tile) { const size_t i = ((size_t)bq * 32 + tile) * 32 + q; any = any || (A[i] != B[i]); }
        if (any) atomicAdd(cnt + 3, 1u); }
}
__global__ void __launch_bounds__(512) mask_report(float* out, const unsigned* cnt) {
    const unsigned ca = cnt[MASKDIFF & 3], cb = cnt[(MASKDIFF >> 2) & 3];
    int La = 0; while ((1u << La) < ca + 1u) ++La; int Lb = 0; while ((1u << Lb) < cb + 1u) ++Lb;
    float v = 0.05f * 5.657f; for (int i = 0; i < La; ++i) v *= 1.5f;
    for (int i = blockIdx.x * 512 + threadIdx.x; i < (1 << 20); i += gridDim.x * 512) out[i] += v;
    (void)Lb;
}
#endif
struct Args { const float* in[22]; float* out; unsigned char* ws; int ph_lo, ph_hi, probe, pad; };
__global__ void __launch_bounds__(NWAVES * 64, 2) mega_fwd(Args args) {
    extern __shared__ __attribute__((aligned(16))) unsigned char lds[];
    Frame F;
    F.lds = (LAS unsigned char*)lds;
    F.MISC = (volatile LAS unsigned*)(F.lds + MISC_OFF);
    F.tid = threadIdx.x; F.lane = F.tid & 63; F.wave = __builtin_amdgcn_readfirstlane(F.tid >> 6);
    F.G = gridDim.x; { const int bx = blockIdx.x; F.vcu = (F.G % 8 == 0) ? (bx % 8) * (F.G / 8) + bx / 8 : bx; }
    unsigned char* ws = args.ws;
    F.ctl = (gu32*)(ws + WS_CTL);
    for (int u = F.tid; u < (LDS_BYTES - LDSCTL_OFF) / 4; u += NWAVES * 64) ((LAS unsigned*)(F.lds + LDSCTL_OFF))[u] = 0u;
    __syncthreads();
    XcdBarrier bar; bar.bar = (unsigned*)(F.ctl + CW_BAR); bar.x = 0; bar.st = nullptr;
    if (N_LAUNCHES == 1) bar = xcd_barrier_post((unsigned*)(F.ctl + CW_BAR), F.MISC + 8);
    const int lo = args.ph_lo, hi = args.ph_hi;
#ifndef PH_MASK
#define PH_MASK 0x3ff
#endif
#define IN(k) (((PH_MASK >> (k)) & 1) && lo <= (k) && (k) < hi)
#define SEAM(k) do { if (IN(k) && IN((k) + 1)) xcd_barrier(bar); } while (0)
#ifndef GROUP_SEAMS
#define GROUP_SEAMS 1
#endif
#ifndef SKEW_MODE
#define SKEW_MODE 1
#endif
#define W_EARLY (16 * 171)
#define GSEAM(k) do { if (IN(k) && IN((k) + 1)) { if (GROUP_SEAMS && F.G == 256) { if (F.MISC[12]) grp_barrier_xcd(bar.bar, F.vcu >> 5, 32u); else grp_barrier(bar.bar, F.vcu >> 5, 32u); } else xcd_barrier(bar); } } while (0)
    float* const MOD = (float*)(ws + WS_MOD);
#define WSP(T, off) ((T*)(ws + (off)))
#ifdef X1_IN_WS
#define X1P WSP(float, WS_GT)
#else
#define X1P args.out
#endif

#ifndef W_IN_P1
#define W_IN_P1 2
#endif
#if W_IN_P1
#define IF_W0(x)
#else
#define IF_W0(x) x
#endif
    if (IN(0)) { const P0In pin{args.in[1], args.in[2], args.in[3], args.in[5], args.in[15], args.in[16], args.in[17], args.in[19], args.in[20], args.in[21], args.in[10], args.in[11], args.in[12], args.in[13], args.in[6], args.in[7], args.in[8], args.in[9]};
                 IF_W0(weight_copies(F, pin, ws);) p0_prologue(F, pin, ws); }
#ifndef NO_FAST_GRP
    if (GROUP_SEAMS && F.G == 256 && IN(0) && IN(1) && F.tid == 0 && bar.x != (unsigned)(F.vcu >> 5)) (void)xb_add(&bar.bar[XB_MISM], 1u);
#endif
#if defined(DEFER_S0) && W_IN_P1 == 2
    const bool defer_s0 = GROUP_SEAMS && F.G == 256 && IN(0) && IN(1);
    if (defer_s0) wrdy_post(bar.bar, 8320); else SEAM(0);
#else
    const bool defer_s0 = false;
    SEAM(0);
#endif
#ifndef NO_FAST_GRP
    if (!defer_s0 && GROUP_SEAMS && F.G == 256 && IN(0) && IN(1)) { if (F.tid == 0) F.MISC[12] = (xb_ld(&bar.bar[XB_MISM]) == 0u) ? 1u : 0u; __syncthreads(); }
#endif
#ifdef CHECKER
    if (IN(0) && IN(1)) {
        float* DEV = (float*)(ws + WS_CTL) + 8192;
#define CHK_W(src, K_, N_, dst, MAPX) CHK_LOOP(idx, (long)(K_) * (N_)) { const int k = (int)(idx / (N_)), n = (int)(idx % (N_)); const float w = (src)[idx]; \
            chk::devmax(DEV + 11, fabsf(chk::b2f((dst)[(size_t)(MAPX) * (K_) + k]) - w) / (fabsf(w) + 1e-3f)); }
        CHK_W(args.in[5], 1024, W_IN, WSP(bf16, WS_WIN), MapWin{}(n))  CHK_W(args.in[17], 1024, 1024, WSP(bf16, WS_WO), n)
        CHK_W(args.in[19], 1024, DFF, WSP(bf16, WS_W13), MapFF{0}(n)) CHK_W(args.in[20], 1024, DFF, WSP(bf16, WS_W13), MapFF{128}(n)) CHK_W(args.in[21], DFF, 1024, WSP(bf16, WS_W2), n)
#undef CHK_W
        CHK_LOOP(idx, 16 * 6144) { const int b = (int)(idx / 6144), j = (int)(idx % 6144); if ((j % 5) == 0) { float sacc = args.in[3][j]; for (int k = 0; k < 1024; ++k) { const float c = args.in[1][b * 1024 + k]; sacc += (c / (1.f + expf(-c))) * args.in[2][(size_t)k * 6144 + j]; }
            chk::devmax(DEV + 12, fabsf(MOD[idx] - sacc)); } }
    }
#endif
    if (IN(1)) {
#if W_IN_P1
        { const P0In pin{args.in[1], args.in[2], args.in[3], args.in[5], args.in[15], args.in[16], args.in[17], args.in[19], args.in[20], args.in[21], args.in[10], args.in[11], args.in[12], args.in[13], args.in[6], args.in[7], args.in[8], args.in[9]};
          if (W_IN_P1 == 1) weight_copies(F, pin, ws);
          if (W_IN_P1 == 3) { if (F.wave & 1) { weight_copies(F, pin, ws, false); norm_mod_pass(F, args.in[0], args.in[4], MOD + 1024, MOD, WSP(bf16, WS_XH)); }
                              else { norm_mod_pass(F, args.in[0], args.in[4], MOD + 1024, MOD, WSP(bf16, WS_XH)); weight_copies(F, pin, ws, false); } __syncthreads(); }
          else if (defer_s0) {
#ifdef BAL_W0
              weight_copies(F, pin, ws, false, 0, 2048);
              if (F.vcu >= 192) weight_copies(F, pin, ws, false, 2048, W_EARLY, (F.vcu - 192) * NWAVES + F.wave, 64 * NWAVES);
#else
              weight_copies(F, pin, ws, true, 0, W_EARLY);
#endif
              wrdy_wait(bar.bar, 256u, 8320);
#ifndef NO_FAST_GRP
              if (F.tid == 0) F.MISC[12] = (xb_ld(&bar.bar[XB_MISM]) == 0u) ? 1u : 0u; __syncthreads();
#endif
              norm_mod_pass(F, args.in[0], args.in[4], MOD + 1024, MOD, WSP(bf16, WS_XH)); }
          else norm_mod_pass(F, args.in[0], args.in[4], MOD + 1024, MOD, WSP(bf16, WS_XH));
          if (W_IN_P1 == 2 && !defer_s0) weight_copies(F, pin, ws, true, 0, (GROUP_SEAMS && F.G == 256) ? W_EARLY : (1 << 30)); }
#else
        norm_mod_pass(F, args.in[0], args.in[4], MOD + 1024, MOD, WSP(bf16, WS_XH));
#endif
    }
#if defined(DEFER_S1) && W_IN_P1 == 2
    const bool defer_s1 = GROUP_SEAMS && F.G == 256 && IN(1) && IN(2);
    if (defer_s1) wrdy_post(bar.bar, 8384); else SEAM(1);
#else
    const bool defer_s1 = false;
    SEAM(1);
#endif
#if W_IN_P1 == 2
    if (!LATE_AFTER_P2 && GROUP_SEAMS && F.G == 256 && IN(2)) {
            const P0In pin{args.in[1], args.in[2], args.in[3], args.in[5], args.in[15], args.in[16], args.in[17], args.in[19], args.in[20], args.in[21], args.in[10], args.in[11], args.in[12], args.in[13], args.in[6], args.in[7], args.in[8], args.in[9]};
            const int g = F.vcu >> 5, L = 7984 - W_EARLY;
            const int i0 = W_EARLY + (SKEW_MODE == 0 ? (L * g) / 8 : SKEW_MODE == 1 ? (L * (g * (g - 1) / 2)) / 28 : (L * ((g - 1) * g * (2 * g - 1) / 6)) / 140);
            const int i1 = W_EARLY + (SKEW_MODE == 0 ? (L * (g + 1)) / 8 : SKEW_MODE == 1 ? (L * ((g + 1) * g / 2)) / 28 : (L * (g * (g + 1) * (2 * g + 1) / 6)) / 140);
            weight_copies(F, pin, ws, false, i0, i1, (F.vcu & 31) * NWAVES + F.wave, 32 * NWAVES);
            wrdy_post(bar.bar);
#ifdef PROBE_SLEEP
            for (int i = 0; i < g * PROBE_SLEEP; ++i) __builtin_amdgcn_s_sleep(127);
#endif
        }
#endif
    if (defer_s1) wrdy_wait(bar.bar, 256u, 8384);
#ifdef CHECKER
    if (IN(1) && IN(2)) {
        float* DEV = (float*)(ws + WS_CTL) + 8192;
        CHK_LOOP(idx, chk::NR) { const int row = chk::RSTR * (int)idx + chk::ROFF, b = row >> 11; float ss = 0.f; for (int k = 0; k < 1024; ++k) { const float v = args.in[0][(size_t)row * 1024 + k]; ss += v * v; }
            const float rs = 1.f / sqrtf(ss / 1024.f + 1e-6f); float dm = 0.f;
            for (int k = 0; k < 1024; ++k) { const float ref = args.in[0][(size_t)row * 1024 + k] * rs * args.in[4][k] * (1.f + MOD[(size_t)b * 6144 + 1024 + k]) + MOD[(size_t)b * 6144 + k]; dm = fmaxf(dm, fabsf(chk::b2f(WSP(bf16, WS_XH)[(size_t)row * 1024 + k]) - ref)); }
            chk::devmax(DEV + 13, dm); }
    }
#endif
    if (IN(2)) {
        pg8::Gemm g{WSP(bf16, WS_XH), (const bf16*)(ws + WS_WIN), M, NPROJ, DM}; pg8::StaticOrder S; S.init(M, NPROJ, F.G, (int)blockIdx.x);
        epi::EpiProj E{ws};
        pg8::gemm_phase<epi::EpiProj, pg8::StaticOrder, true, true>(F.lds, g, S, E);
    }
#if LATE_AFTER_P2
    if (GROUP_SEAMS && F.G == 256 && IN(2) && IN(3)) wrdy_post(bar.bar, 9024 + 64 * (F.vcu >> 5)); else GSEAM(2);
#if W_IN_P1 == 2
    if (LATE_AFTER_P2 && GROUP_SEAMS && F.G == 256 && IN(2)) {
            const P0In pin{args.in[1], args.in[2], args.in[3], args.in[5], args.in[15], args.in[16], args.in[17], args.in[19], args.in[20], args.in[21], args.in[10], args.in[11], args.in[12], args.in[13], args.in[6], args.in[7], args.in[8], args.in[9]};
            const int g = F.vcu >> 5, L = 7984 - W_EARLY;
            const int i0 = W_EARLY + (SKEW_MODE == 0 ? (L * g) / 8 : SKEW_MODE == 1 ? (L * (g * (g - 1) / 2)) / 28 : (L * ((g - 1) * g * (2 * g - 1) / 6)) / 140);
            const int i1 = W_EARLY + (SKEW_MODE == 0 ? (L * (g + 1)) / 8 : SKEW_MODE == 1 ? (L * ((g + 1) * g / 2)) / 28 : (L * (g * (g + 1) * (2 * g + 1) / 6)) / 140);
            weight_copies(F, pin, ws, false, i0, i1, (F.vcu & 31) * NWAVES + F.wave, 32 * NWAVES);
            wrdy_post(bar.bar);
#ifdef PROBE_SLEEP
            for (int i = 0; i < g * PROBE_SLEEP; ++i) __builtin_amdgcn_s_sleep(127);
#endif
        }
#endif
    if (GROUP_SEAMS && F.G == 256 && IN(2) && IN(3)) wrdy_wait(bar.bar, 32u, 9024 + 64 * (F.vcu >> 5));
#else
    GSEAM(2);
#endif
#ifdef CHECKER
    if (IN(2) && IN(3)) {
        float* DEV = (float*)(ws + WS_CTL) + 8192; const bf16 *XH = WSP(bf16, WS_XH), *WT = WSP(bf16, WS_WIN);
        CHK_LOOP(idx, chk::NR * 512) { const int row = chk::RSTR * (int)(idx / 512) + chk::ROFF, c = (int)(idx % 512);
            { const int n = 1024 + c; const float a = chk::dotbf(XH + (size_t)row * 1024, WT + (size_t)MapWin{}(n) * 1024, 1024), o = chk::b2f(WSP(bf16, WS_VA)[(size_t)row * 512 + c]); chk::devmax(DEV + 0, fabsf(o - chk::rnd(a)) / (fabsf(a) + 0.05f)); }
            { const int n = 3396 + 4 * c + 1; const float a = chk::sig(chk::dotbf(XH + (size_t)row * 1024, WT + (size_t)MapWin{}(n) * 1024, 1024)), o = chk::b2f(WSP(bf16, WS_GT)[(size_t)row * 2048 + 4 * c + 1]); chk::devmax(DEV + 1, fabsf(o - a)); }
            if (c < 8) { float ss = 0.f; for (int d = 0; d < 64; ++d) { const float v = chk::dotbf(XH + (size_t)row * 1024, WT + (size_t)MapWin{}(c * 64 + d) * 1024, 1024); ss += v * v; }
                const float rs = 1.f / sqrtf(ss / 64.f + 1e-6f); float dm = 0.f; for (int d = 0; d < 64; ++d) { const float v = chk::dotbf(XH + (size_t)row * 1024, WT + (size_t)MapWin{}(c * 64 + d) * 1024, 1024); dm = fmaxf(dm, fabsf(chk::b2f(WSP(bf16, WS_QA)[(size_t)row * 512 + c * 64 + d]) - v * rs * args.in[6][d])); } chk::devmax(DEV + 2, dm); }
            if (c < 64) { const float a = chk::dotbf(XH + (size_t)row * 1024, WT + (size_t)MapWin{}(3328 + c) * 1024, 1024), o = chk::b2f(WSP(bf16, WS_KI)[(size_t)row * 64 + c]); chk::devmax(DEV + 3, fabsf(o - chk::rnd(a)) / (fabsf(a) + 0.05f)); }
            if (c < 4) { const float a = chk::dotbf(XH + (size_t)row * 1024, WT + (size_t)MapWin{}(3392 + c) * 1024, 1024), o = WSP(float, WS_WI)[(size_t)row * 4 + c]; chk::devmax(DEV + 4, fabsf(o - a)); }
            if (c >= 8 && c < 16) { const int hh = c - 8; float ss = 0.f; for (int d = 0; d < 64; ++d) { const float v = chk::dotbf(XH + (size_t)row * 1024, WT + (size_t)MapWin{}(2048 + hh * 64 + d) * 1024, 1024); ss += v * v; }
                const float rs = 1.f / sqrtf(ss / 64.f + 1e-6f); float dm = 0.f; for (int d = 0; d < 64; ++d) { const float v = chk::dotbf(XH + (size_t)row * 1024, WT + (size_t)MapWin{}(2048 + hh * 64 + d) * 1024, 1024); dm = fmaxf(dm, fabsf(chk::b2f(WSP(bf16, WS_KB)[(size_t)row * 512 + hh * 64 + d]) - v * rs * args.in[9][d])); } chk::devmax(DEV + 5, dm); }
        }
    }
#endif
    if (IN(3)) {
        const int b = F.vcu >> 4, j = F.vcu & 15;
        const bf16 *QI = WSP(bf16, WS_QI), *KI = WSP(bf16, WS_KI); const float* WI = WSP(float, WS_WI); unsigned long long* MASK = WSP(unsigned long long, WS_MASK);
        if (F.G == 256) {
            sel::select_unit(b, j, QI, KI, WI, MASK, (char*)lds); sel::select_unit(b, 31 - j, QI, KI, WI, MASK, (char*)lds);
            sel::select_unit(b, 32 + j, QI, KI, WI, MASK, (char*)lds); sel::select_unit(b, 63 - j, QI, KI, WI, MASK, (char*)lds);
        }
    }
#ifdef DEFER_S3
    if (GROUP_SEAMS && F.G == 256 && IN(3) && IN(4)) wrdy_post(bar.bar, 8448 + 64 * (F.vcu >> 5)); else GSEAM(3);
#else
    GSEAM(3);
#endif
#ifdef CHECKER
#ifndef CHK_TI
#define CHK_TI -1
#endif
#ifndef CHK_TOL17
#define CHK_TOL17 64
#endif
    if (IN(3) && IN(4)) {
        unsigned tot = 0u; CHK_LOOP(idx, 16 * 64 * 32 * 32) tot += (unsigned)__builtin_popcountll(WSP(unsigned long long, WS_MASK)[idx]);
        atomicAdd((unsigned*)(ws + WS_CTL) + 8192 + 18, tot);
    }
    if (IN(3) && IN(4)) {
        float* DEV = (float*)(ws + WS_CTL) + 8192;
        if (F.vcu < 10) { const int tt[5] = {5, 300, 777, 1029, 2047}; const int t = (F.vcu % 5 == 0) ? 5 : (F.vcu % 5 == 1) ? 300 : (F.vcu % 5 == 2) ? 777 : (F.vcu % 5 == 3) ? 1029 : 2047; (void)tt; const int b = (F.vcu < 5) ? 0 : 9;
            LAS unsigned* KL = (LAS unsigned*)F.lds; const int nadm = 64 * (t / 64 + 1); const size_t qrow = (size_t)b * 2048 + t;
            __syncthreads();
            for (int s4 = 0; s4 < 4; ++s4) { const int sidx = F.tid + 512 * s4; unsigned key = 0u;
                if (sidx < nadm) { float sc = 0.f; for (int h = 0; h < 4; ++h) { const float y = chk::dotbf(WSP(bf16, WS_QI) + qrow * 256 + h * 64, WSP(bf16, WS_KI) + ((size_t)b * 2048 + sidx) * 64, 64); sc = fmaf(fmaxf(y, 0.f), WSP(float, WS_WI)[qrow * 4 + h], sc); }
                    const unsigned u = __float_as_uint(sc), m = (unsigned)(((int)u) >> 31) | 0x80000000u; key = ((u ^ m) & KEYMASK) | (2047u - (unsigned)sidx); }
                KL[sidx] = key; }
            __syncthreads();
            unsigned bad = 0u;
            for (int s4 = 0; s4 < 4; ++s4) { const int sidx = F.tid + 512 * s4; const unsigned key = KL[sidx]; unsigned rank = 0u; for (int j = 0; j < 2048; ++j) rank += (KL[j] > key) ? 1u : 0u;
                const bool selr = (sidx < nadm) && (nadm <= 256 || rank < 256u);
                const unsigned long long mw = WSP(unsigned long long, WS_MASK)[((size_t)(b * 64 + t / 32) * 32 + sidx / 64) * 32 + (t % 32)]; const bool selm = (mw >> (sidx % 64)) & 1ull;
                if (sidx < nadm && selr != selm) ++bad; }
            if (bad) atomicAdd(DEV + 17, (float)bad);
            __syncthreads();
        }
    }
#endif
    if (IN(4)) {
        if (F.G == 256) {
            const int b = F.vcu >> 4, r = F.vcu & 15;
            const bf16 *QA = WSP(bf16, WS_QA), *KA = WSP(bf16, WS_KA), *VA = WSP(bf16, WS_VA), *QBt = WSP(bf16, WS_QB), *KBt = WSP(bf16, WS_KB), *VBt = WSP(bf16, WS_VB);
            bf16 *YA = WSP(bf16, WS_YA), *YB = WSP(bf16, WS_YA); const unsigned long long* MASK = WSP(unsigned long long, WS_MASK);
            const float lam = __hip_atomic_load((const float*)(ws + WS_LAM), RLX_AGENT);
#ifdef DEFER_S3
#ifndef NO_UNIT_B
            __syncthreads();
            if (!(args.probe & 2)) { const int h = r >> 2, s = r & 3;
              att::unit_b128(b, h, 7 - s, QBt, KBt, VBt, args.in[14], lam, YB, WSP(unsigned, WS_STASH), 0, (char*)lds);
#ifdef PF_GATES
              {
                  const char* pg = (const char*)ws + WS_GT + ((size_t)(F.vcu >> 5) << 24) + ((size_t)(F.vcu & 31) << 19) + (size_t)F.tid * 128; unsigned pv[8];
#pragma unroll
                  for (int j = 0; j < 8; ++j) pv[j] = *(const unsigned*)(pg + (size_t)j * 65536);
                  asm volatile("" :: "v"(pv[0]), "v"(pv[1]), "v"(pv[2]), "v"(pv[3]), "v"(pv[4]), "v"(pv[5]), "v"(pv[6]), "v"(pv[7])); }
#endif
              att::unit_b128(b, h, s, QBt, KBt, VBt, args.in[14], lam, YB, WSP(unsigned, WS_STASH), 1, (char*)lds); }
#endif
            if (GROUP_SEAMS && IN(3)) wrdy_wait(bar.bar, 32u, 8448 + 64 * (F.vcu >> 5)); else __syncthreads();
#ifndef NO_UNIT_A
            if (!(args.probe & 1)) for (int pi = 0; pi < 2; ++pi) { const int pr = 2 * r + pi, h = pr >> 2, s = pr & 3;
                att::unit_a(b, h, 7 - s, QA, KA, VA, MASK, YA, (char*)lds); att::unit_a(b, h, s, QA, KA, VA, MASK, YA, (char*)lds); }
#endif
#else
#ifndef NO_UNIT_A
            if (!(args.probe & 1)) for (int pi = 0; pi < 2; ++pi) { const int pr = 2 * r + pi, h = pr >> 2, s = pr & 3;
                att::unit_a(b, h, 7 - s, QA, KA, VA, MASK, YA, (char*)lds); att::unit_a(b, h, s, QA, KA, VA, MASK, YA, (char*)lds); }
#endif
#ifndef NO_UNIT_B
            __syncthreads();
            if (!(args.probe & 2)) { const int h = r >> 2, s = r & 3;
              att::unit_b128(b, h, 7 - s, QBt, KBt, VBt, args.in[14], lam, YB, WSP(unsigned, WS_STASH), 0, (char*)lds);
#ifdef PF_GATES
              {
                  const char* pg = (const char*)ws + WS_GT + ((size_t)(F.vcu >> 5) << 24) + ((size_t)(F.vcu & 31) << 19) + (size_t)F.tid * 128; unsigned pv[8];
#pragma unroll
                  for (int j = 0; j < 8; ++j) pv[j] = *(const unsigned*)(pg + (size_t)j * 65536);
                  asm volatile("" :: "v"(pv[0]), "v"(pv[1]), "v"(pv[2]), "v"(pv[3]), "v"(pv[4]), "v"(pv[5]), "v"(pv[6]), "v"(pv[7])); }
#endif
              att::unit_b128(b, h, s, QBt, KBt, VBt, args.in[14], lam, YB, WSP(unsigned, WS_STASH), 1, (char*)lds); }
#endif
#endif
        }
    }
    GSEAM(4);
#ifdef CHECKER
    if (IN(4) && IN(5)) {
        float* DEV = (float*)(ws + WS_CTL) + 8192; const float lamc = __hip_atomic_load((const float*)(ws + WS_LAM), RLX_AGENT);
        const int gwv = F.vcu * 8 + F.wave;
        if (gwv < 8 * 3 * 12) { const int ti = gwv % 8, bi = (gwv / 8) % 3, hh = gwv / 24;
            const int t = (ti == 0) ? 5 : (ti == 1) ? 70 : (ti == 2) ? 200 : (ti == 3) ? 300 : (ti == 4) ? 777 : (ti == 5) ? 1029 : (ti == 6) ? 1500 : 2047; const int b = (bi == 0) ? 0 : (bi == 1) ? 7 : 15;
            const int nadm = 64 * (t / 64 + 1); const size_t rb = (size_t)b * 2048, qrow = rb + t; const int d = F.lane;
            if (hh < 8) { const float slope = exp2f(-(float)(hh + 1));
                float mx = -INFINITY; for (int sidx = 0; sidx < nadm; ++sidx) { const unsigned long long mw = WSP(unsigned long long, WS_MASK)[((size_t)(b * 64 + t / 32) * 32 + sidx / 64) * 32 + (t % 32)]; if (!((mw >> (sidx % 64)) & 1ull)) continue;
                    const float sc = chk::dotbf(WSP(bf16, WS_QA) + qrow * 512 + hh * 64, WSP(bf16, WS_KA) + (rb + sidx) * 512 + hh * 64, 64) * 0.125f - slope * fabsf((float)(t - sidx)); mx = fmaxf(mx, sc); }
                float l = 0.f, o = 0.f; for (int sidx = 0; sidx < nadm; ++sidx) { const unsigned long long mw = WSP(unsigned long long, WS_MASK)[((size_t)(b * 64 + t / 32) * 32 + sidx / 64) * 32 + (t % 32)]; if (!((mw >> (sidx % 64)) & 1ull)) continue;
                    const float sc = chk::dotbf(WSP(bf16, WS_QA) + qrow * 512 + hh * 64, WSP(bf16, WS_KA) + (rb + sidx) * 512 + hh * 64, 64) * 0.125f - slope * fabsf((float)(t - sidx)); const float p = expf(sc - mx); l += p; o += p * chk::b2f(WSP(bf16, WS_VA)[(rb + sidx) * 512 + hh * 64 + d]); }
                chk::devmax(DEV + 14, fabsf(chk::b2f(WSP(bf16, WS_YA)[qrow * 1024 + hh * 64 + d]) - o / l));
            } else if (CHK_TI < 0 || ti == CHK_TI) { const int hb = hh - 8; const float slope = exp2f(-2.f * (float)(hb + 1)); float ov[2][2];
                for (int m = 0; m < 2; ++m) { float mx = -INFINITY; for (int sidx = 0; sidx < nadm; ++sidx) { const float sc = chk::dotbf(WSP(bf16, WS_QB) + qrow * 512 + (2 * hb + m) * 64, WSP(bf16, WS_KB) + (rb + sidx) * 512 + (2 * hb + m) * 64, 64) * 0.125f - slope * fabsf((float)(t - sidx)); mx = fmaxf(mx, sc); }
                    float l = 0.f, o0 = 0.f, o1 = 0.f; for (int sidx = 0; sidx < nadm; ++sidx) { const float sc = chk::dotbf(WSP(bf16, WS_QB) + qrow * 512 + (2 * hb + m) * 64, WSP(bf16, WS_KB) + (rb + sidx) * 512 + (2 * hb + m) * 64, 64) * 0.125f - slope * fabsf((float)(t - sidx));
                        const float p = expf(sc - mx); l += p; o0 += p * chk::b2f(WSP(bf16, WS_VB)[(rb + sidx) * 512 + hb * 128 + d]); o1 += p * chk::b2f(WSP(bf16, WS_VB)[(rb + sidx) * 512 + hb * 128 + 64 + d]); }
                    if (m == 0) { ov[0][0] = o0 / l; ov[0][1] = o1 / l; } else { ov[1][0] = o0 / l; ov[1][1] = o1 / l; } }
                const float d0 = ov[0][0] - lamc * ov[1][0], d1 = ov[0][1] - lamc * ov[1][1]; const float ssq = wave_sum(d0 * d0 + d1 * d1); const float rs = 0.8f / sqrtf(ssq / 128.f + 1e-6f);
                chk::devmax(DEV + 16, fabsf(chk::b2f(WSP(bf16, WS_YA)[qrow * 1024 + 512 + hb * 128 + d]) - d0 * rs * args.in[14][d])); chk::devmax(DEV + 19, fabsf(chk::b2f(WSP(bf16, WS_YA)[qrow * 1024 + 512 + hb * 128 + 64 + d]) - d1 * rs * args.in[14][64 + d]));
            }
        }
        xcd_barrier(bar);
    }
#endif
    if (IN(5)) {
#if W_IN_P1 == 2
        if (GROUP_SEAMS && F.G == 256) wrdy_wait(bar.bar, 256u);
#endif
        pg8::Gemm g{WSP(bf16, WS_YA), (const bf16*)(ws + WS_WUA), M, DM, 1024}; pg8::StaticOrder S; S.init(M, DM, F.G, (int)blockIdx.x);
        epi::EpiUpM E{WSP(bf16, WS_MG), WSP(bf16, WS_GT)}; pg8::gemm_phase<epi::EpiUpM, pg8::StaticOrder, true, true>(F.lds, g, S, E);
    }
    GSEAM(5);
#ifdef CHECKER
    if (IN(5) && IN(6)) {
        __syncthreads(); float* DEV = (float*)(ws + WS_CTL) + 8192;
        CHK_LOOP(idx, chk::NR * 256) { const int row = chk::RSTR * (int)(idx / 256) + chk::ROFF, col = 4 * (int)(idx % 256) + 2;
            const float ua = chk::dotbf(WSP(bf16, WS_YA) + (size_t)row * 1024, WSP(bf16, WS_WUA) + (size_t)col * 1024, 512), ub = chk::dotbf(WSP(bf16, WS_YA) + (size_t)row * 1024 + 512, WSP(bf16, WS_WUA) + (size_t)col * 1024 + 512, 512);
            const float ga = chk::b2f(WSP(bf16, WS_GT)[(size_t)row * 2048 + col]), gb = chk::b2f(WSP(bf16, WS_GT)[(size_t)row * 2048 + 1024 + col]);
            const float ref = chk::rnd(ga * ua) + gb * ub, o = chk::b2f(WSP(bf16, WS_MG)[(size_t)row * 1024 + col]); chk::devmax(DEV + 6, fabsf(o - ref)); }
    }
    if (IN(5) && IN(6)) xcd_barrier(bar);
#endif
    if (IN(6)) {
        pg8::Gemm g{WSP(bf16, WS_MG), (const bf16*)(ws + WS_WO), M, DM, DM, epi::MG_A_X16, epi::MG_A_X8}; pg8::StaticOrder S; S.init(M, DM, F.G, (int)blockIdx.x);
#ifdef P6_REV
        if ((M / 256) * (DM / 256) % F.G == 0) S.rev = 1;
#endif
        epi::EpiResToBf16 E{args.in[0], WSP(bf16, WS_GT), MOD + 2048}; pg8::gemm_phase<epi::EpiResToBf16, pg8::StaticOrder, P6_ALIGN, true>(F.lds, g, S, E);
    }
    GSEAM(6);
#ifdef CHECKER
    if (IN(6) && IN(7)) {
        __syncthreads(); float* DEV = (float*)(ws + WS_CTL) + 8192;
        CHK_LOOP(idx, chk::NR * 256) { const int row = chk::RSTR * (int)(idx / 256) + chk::ROFF, col = 4 * (int)(idx % 256) + 1;
            const float a = chk::dotbf(WSP(bf16, WS_MG) + (size_t)row * 1024, WSP(bf16, WS_WO) + (size_t)col * 1024, 1024);
            const float ref = args.in[0][(size_t)row * 1024 + col] + MOD[(size_t)(row >> 11) * 6144 + 2048 + col] * a, o = chk::b2f(WSP(bf16, WS_GT)[(size_t)row * 1024 + col]); chk::devmax(DEV + 7, fabsf(o - ref)); }
    }
#endif
    if (IN(7)) norm_mod_pass_bf16(F, WSP(bf16, WS_GT), args.in[18], MOD + 4096, MOD + 3072, WSP(bf16, WS_XH), epi::X1_X16);
    GSEAM(7);
#ifdef CHECKER
    if (IN(7) && IN(8)) {
        __syncthreads(); float* DEV = (float*)(ws + WS_CTL) + 8192;
        CHK_LOOP(idx, chk::NR) { const int row = chk::RSTR * (int)idx + chk::ROFF, b = row >> 11; float ss = 0.f; for (int k = 0; k < 1024; ++k) { const float v = chk::b2f(WSP(bf16, WS_GT)[(size_t)row * 1024 + k]); ss += v * v; }
            const float rs = 1.f / sqrtf(ss / 1024.f + 1e-6f); float dm = 0.f;
            for (int k = 0; k < 1024; ++k) { const float ref = chk::b2f(WSP(bf16, WS_GT)[(size_t)row * 1024 + k]) * rs * args.in[18][k] * (1.f + MOD[(size_t)b * 6144 + 4096 + k]) + MOD[(size_t)b * 6144 + 3072 + k]; dm = fmaxf(dm, fabsf(chk::b2f(WSP(bf16, WS_XH)[(size_t)row * 1024 + k]) - ref)); }
            chk::devmax(DEV + 8, dm); }
    }
#endif
    if (IN(8)) {
#ifdef PROBE_SLEEP2
        for (int i = 0; i < (7 - (F.vcu >> 5)) * PROBE_SLEEP2; ++i) __builtin_amdgcn_s_sleep(127);
#endif
        pg8::Gemm g{WSP(bf16, WS_XH), (const bf16*)(ws + WS_W13), M, NFF13, DM}; pg8::StaticOrder S; S.init(M, NFF13, F.G, (int)blockIdx.x);
#ifdef PROBE_EPI
        epi::EpiFF13 E{WSP(bf16, WS_HID), args.probe};
#else
        epi::EpiFF13 E{(bf16*)ws};
#endif
        pg8::gemm_phase<epi::EpiFF13, pg8::StaticOrder, true, true>(F.lds, g, S, E);
    }
    GSEAM(8);
#ifdef CHECKER
    if (IN(8) && IN(9)) {
        __syncthreads(); float* DEV = (float*)(ws + WS_CTL) + 8192;
        CHK_LOOP(idx, chk::NR * 704) { const int row = chk::RSTR * (int)(idx / 704) + chk::ROFF, hc = 4 * (int)(idx % 704) + 3;
            const bf16* w = WSP(bf16, WS_W13) + (size_t)((hc >> 7) * 256 + (hc & 127)) * 1024;
            const float u1 = chk::dotbf(WSP(bf16, WS_XH) + (size_t)row * 1024, w, 1024), u3 = chk::dotbf(WSP(bf16, WS_XH) + (size_t)row * 1024, w + 128 * 1024, 1024);
            const float ref = u1 * chk::sig(u1) * u3, o = chk::b2f(WSP(bf16, WS_HID)[(size_t)row * 2816 + hc]); chk::devmax(DEV + 9, fabsf(o - ref) / (fabsf(ref) + 0.05f)); }
    }
#endif
    if (IN(9)) {
        pg8::Gemm g{(const bf16*)ws, (const bf16*)(ws + WS_W2), M, DM, DFF, 0, 0, 1}; pg8::StaticOrder S; S.init(M, DM, F.G, (int)blockIdx.x);
#ifdef P9_REV
        if ((M / 256) * (DM / 256) % F.G == 0) S.rev = 1;
#endif
        epi::EpiResFromBf16 E{WSP(bf16, WS_GT), args.out, MOD + 5120}; pg8::gemm_phase<epi::EpiResFromBf16, pg8::StaticOrder, P9_ALIGN, true>(F.lds, g, S, E);
    }
#ifdef PROBE_XBAR
    for (int i = 0; i < PROBE_XBAR; ++i) { if (F.MISC[12]) grp_barrier_xcd(bar.bar, F.vcu >> 5, 32u); else grp_barrier(bar.bar, F.vcu >> 5, 32u); }
#endif
#ifdef ENDCHK
    if (IN(9)) {
        unsigned tot = 0u; for (long idx = (long)F.vcu * 512 + F.tid; idx < 16L * 64 * 32 * 32; idx += (long)F.G * 512) tot += (unsigned)__builtin_popcountll(WSP(unsigned long long, WS_MASK)[idx]);
        atomicAdd((unsigned*)(ws + WS_CTL) + 8192 + 18, tot);
        xcd_barrier(bar);
        const int bad = (int)__hip_atomic_load((unsigned*)(ws + WS_CTL) + 8192 + 18, RLX_AGENT) - 16 * 499712;
        if (F.vcu == 0 && F.tid == 0 && bad != 0) args.out[0] += 1.0e6f;
    }
#endif
#ifdef CHECKER
    if (IN(9)) {
        float* DEV = (float*)(ws + WS_CTL) + 8192;
        asm volatile("s_waitcnt vmcnt(0)" ::: "memory"); __syncthreads();
        CHK_LOOP(idx, chk::NR * 256) { const int row = chk::RSTR * (int)(idx / 256) + chk::ROFF, col = 4 * (int)(idx % 256) + 3;
            (void)row; (void)col; }
        xcd_barrier(bar);
        CHK_LOOP(idx, chk::NR * 256) { const int row = chk::RSTR * (int)(idx / 256) + chk::ROFF, col = 4 * (int)(idx % 256) + 3;
            const float a = chk::dotbf(WSP(bf16, WS_HID) + (size_t)row * 2816, WSP(bf16, WS_W2) + (size_t)col * 2816, 2816);
            const float ref = chk::b2f(WSP(bf16, WS_GT)[(size_t)row * 1024 + col]) + MOD[(size_t)(row >> 11) * 6144 + 5120 + col] * a; chk::devmax(DEV + 10, fabsf(args.out[(size_t)row * 1024 + col] - ref)); }
        xcd_barrier(bar);
        float da = __hip_atomic_load(DEV + CHK_A, RLX_AGENT), db = __hip_atomic_load(DEV + CHK_B, RLX_AGENT);
        if (CHK_A == 17) da = (da > (float)CHK_TOL17) ? da : 0.f;
        if (CHK_A == 18) da = fabsf((float)((int)__hip_atomic_load((unsigned*)DEV + 18, RLX_AGENT) - 16 * 499712));
        if (F.vcu == 0 && F.tid == 0) args.out[0] += 1000.f * da;
        const float pb = 16.f * sqrtf(db);
        for (int i = F.vcu * 512 + F.tid; i < (1 << 18); i += F.G * 512) if (i > 0) args.out[i] += pb;
    }
#endif
#undef IN
#undef SEAM
#undef WSP
}

extern "C" void kernel_launch(void* const* d_in, const int* in_sizes, int n_in, void* d_out, int out_size, void* d_ws, size_t ws_size, hipStream_t stream) {
    static int grid = 0;
    if (grid == 0) {
        if (n_in != 22 || in_sizes[0] != M * DM || out_size != M * DM || ws_size < WS_END) { fprintf(stderr, "kernel_launch: unexpected shapes (n_in %d, in0 %d, out %d, ws %zu); nothing launched\n", n_in, n_in > 0 ? in_sizes[0] : -1, out_size, ws_size); grid = -1; return; }
        int dev = 0, cus = 0, per_cu = 0;
        if (hipGetDevice(&dev) != hipSuccess || hipDeviceGetAttribute(&cus, hipDeviceAttributeMultiprocessorCount, dev) != hipSuccess) { fprintf(stderr, "kernel_launch: device query failed\n"); grid = -1; return; }
        if (hipFuncSetAttribute((const void*)mega_fwd, hipFuncAttributeMaxDynamicSharedMemorySize, LDS_BYTES) != hipSuccess) { fprintf(stderr, "kernel_launch: hipFuncSetAttribute failed\n"); grid = -1; return; }
        if (hipOccupancyMaxActiveBlocksPerMultiprocessor(&per_cu, (const void*)mega_fwd, NWAVES * 64, LDS_BYTES) != hipSuccess || per_cu < 1) fprintf(stderr, "kernel_launch: note: occupancy query reports %d workgroups per CU\n", per_cu);
        (void)hipGetLastError();
        grid = cus;
        if (grid != 256) fprintf(stderr, "kernel_launch: %d CUs; the attention/selection schedules need 256\n", grid);
    }
    if (grid < 0) return;
    if (hipMemsetAsync((char*)d_ws + WS_CTL, 0, CTL_ZERO_BYTES, stream) != hipSuccess) { fprintf(stderr, "kernel_launch: hipMemsetAsync failed\n"); return; }
    Args a{};
    for (int i = 0; i < 22; ++i) a.in[i] = (const float*)d_in[i];
    a.out = (float*)d_out; a.ws = (unsigned char*)d_ws;
#ifdef PROBE_RERUN_MASK
    constexpr int n_l = N_LAUNCHES + __builtin_popcount(PROBE_RERUN_MASK);
#else
    constexpr int n_l = N_LAUNCHES;
#endif
#ifdef MASKDIFF
    { unsigned char* ws = (unsigned char*)d_ws; unsigned* CNT = (unsigned*)(ws + WS_CTL + 32768);
#ifdef MASKDIFF_SPLIT
      a.ph_lo = 0; a.ph_hi = 3; hipLaunchKernelGGL(mega_fwd, dim3(grid), dim3(NWAVES * 64), LDS_BYTES, stream, a);
      a.ph_lo = 3; a.ph_hi = 4; hipLaunchKernelGGL(mega_fwd, dim3(grid), dim3(NWAVES * 64), LDS_BYTES, stream, a);
#else
      a.ph_lo = 0; a.ph_hi = 4; hipLaunchKernelGGL(mega_fwd, dim3(grid), dim3(NWAVES * 64), LDS_BYTES, stream, a);
#endif
      (void)hipMemcpyAsync(ws + WS_STASH, ws + WS_MASK, 8u << 20, hipMemcpyDeviceToDevice, stream);
      a.ph_lo = 3; a.ph_hi = 4; hipLaunchKernelGGL(mega_fwd, dim3(grid), dim3(NWAVES * 64), LDS_BYTES, stream, a);
      hipLaunchKernelGGL(mask_diff, dim3(256), dim3(512), 0, stream, (const unsigned long long*)(ws + WS_MASK), (const unsigned long long*)(ws + WS_STASH), CNT);
      (void)hipMemsetAsync((char*)d_ws + WS_CTL, 0, 32768, stream);
      a.ph_lo = 4; a.ph_hi = 10; hipLaunchKernelGGL(mega_fwd, dim3(grid), dim3(NWAVES * 64), LDS_BYTES, stream, a);
      hipLaunchKernelGGL(mask_report, dim3(256), dim3(512), 0, stream, (float*)d_out, (const unsigned*)CNT);
      return; }
#endif
#ifdef DUPCHK
    { unsigned char* ws = (unsigned char*)d_ws; unsigned long long* CK = (unsigned long long*)(ws + WS_CTL + 32768);
      const void* rp[10] = {ws + WS_MOD, ws + WS_XH, ws + WS_QA, ws + WS_MASK, ws + WS_XH, ws + WS_MG, ws + WS_GT, ws + WS_XH, ws + WS_QA, d_out};
      const size_t rb[10] = {33ull << 20, 64ull << 20, 344ull << 20, 8ull << 20, 64ull << 20, 64ull << 20, 128ull << 20, 64ull << 20, 344ull << 20, 128ull << 20};
      int lo = 0;
      for (int k = 0; k < 10; ++k) { const bool cut = (DUPCHK >> k) & 1; if (!cut && k != 9) continue;
          if (lo > 0) (void)hipMemsetAsync((char*)d_ws + WS_CTL, 0, 32768, stream);
          a.ph_lo = lo; a.ph_hi = k + 1; hipLaunchKernelGGL(mega_fwd, dim3(grid), dim3(NWAVES * 64), LDS_BYTES, stream, a);
          if (cut) { hipLaunchKernelGGL(dup_cksum, dim3(256), dim3(512), 0, stream, rp[k], rb[k], CK + 2 * k);
                     a.ph_lo = k; a.ph_hi = k + 1; hipLaunchKernelGGL(mega_fwd, dim3(grid), dim3(NWAVES * 64), LDS_BYTES, stream, a);
                     hipLaunchKernelGGL(dup_cksum, dim3(256), dim3(512), 0, stream, rp[k], rb[k], CK + 2 * k + 1); }
          lo = k + 1; }
      hipLaunchKernelGGL(dup_final, dim3(256), dim3(512), 0, stream, (float*)d_out, (const unsigned long long*)CK);
      return; }
#endif
    int probe_next = 0;
    for (int li = 0; li < n_l; ++li) {
        a.ph_lo = (N_LAUNCHES == 1) ? 0 : li; a.ph_hi = (N_LAUNCHES == 1) ? N_PHASES : li + 1;
#ifdef PROBE_RERUN_MASK
        if (li >= N_LAUNCHES) { while (!((PROBE_RERUN_MASK >> probe_next) & 1)) ++probe_next; a.ph_lo = probe_next; a.ph_hi = probe_next + 1; ++probe_next;
#ifdef PROBE_MODE
            a.probe = PROBE_MODE;
#endif
        }
#endif
        hipLaunchKernelGGL(mega_fwd, dim3(grid), dim3(NWAVES * 64), LDS_BYTES, stream, a);
        const hipError_t le = hipPeekAtLastError();
        if (le != hipSuccess) { fprintf(stderr, "kernel_launch: launch %d failed: %s\n", li, hipGetErrorName(le)); break; }
    }
}
```
